# Optimizing an MI355X kernel written in HIP

```python
import math
import jax, jax.numpy as jnp
from jax import lax
import numpy as np

D_MODEL = 2048
BATCH = 2
SEQ = 16384
DEPTH = 4
DEC_BATCH = 8
DEC_SEQ = 4096
PAST_LEN = 128

GDN_HEADS = 8
GDN_DK = 128
GDN_DV = 128
GDN_CONV = 3
GDN_CHUNK = 64
GDN_WIDTH = GDN_HEADS * GDN_DV
GDN_CONV_CH = 2 * GDN_HEADS * GDN_DK + GDN_HEADS * GDN_DV
SWA_HEADS = 8
SWA_KV_HEADS = 2
SWA_DH = 128
SWA_WINDOW = 128
SWA_BLOCK = 128
SWA_WIDTH = SWA_HEADS * SWA_DH
DIFF_HEADS = 8
DIFF_DH = 64
DIFF_DV = 2 * DIFF_DH
DIFF_WIDTH = DIFF_HEADS * DIFF_DV
DIFF_QBLOCK = 128
N_BRANCH = 3
BRANCH_WIDTH = GDN_WIDTH
NORM_EPS = 1e-6

IN_SIZES = (
    GDN_CONV_CH,
    GDN_WIDTH,
    2 * GDN_HEADS,
    2 * GDN_HEADS,
    SWA_HEADS * SWA_DH,
    2 * SWA_KV_HEADS * SWA_DH,
    SWA_WIDTH,
    2 * DIFF_HEADS * DIFF_DH,
    2 * DIFF_HEADS * DIFF_DH,
    DIFF_WIDTH,
    DIFF_WIDTH,
    N_BRANCH * D_MODEL,
)
IN_WIDTH = sum(IN_SIZES)

kernel_name = "hybrid_bidir_gdn_swa_diffattn_encoder"


def rms_norm(x, gain):
    xf = x.astype(jnp.float32)
    y = xf * lax.rsqrt(jnp.mean(xf * xf, axis=-1, keepdims=True) + NORM_EPS)
    return (y * gain.astype(jnp.float32)).astype(x.dtype)


def l2_normalize(x):
    return x * lax.rsqrt(jnp.sum(x * x, axis=-1, keepdims=True) + NORM_EPS)


def alibi_slopes(n_heads):
    return jnp.asarray([2.0 ** (-8.0 * (h + 1) / n_heads) for h in range(n_heads)], jnp.float32)


def split_columns(a, sizes):
    idx, acc = [], 0
    for s in sizes[:-1]:
        acc += s
        idx.append(acc)
    return jnp.split(a, idx, axis=-1)


def centred_depthwise_conv(x, w):
    k = w.shape[0]
    pad = k // 2
    t = x.shape[1]
    xp = jnp.pad(x, ((0, 0), (pad, pad), (0, 0)))
    return sum(xp[:, j:j + t] * w[j] for j in range(k))


def gated_delta_chunked(q, k, v, g, beta):
    b, t, h, dk = q.shape
    dv = v.shape[-1]
    c = GDN_CHUNK
    n = t // c

    def chunks(a):
        return jnp.moveaxis(a.reshape((b, n, c, h) + a.shape[3:]), 3, 1)

    q, k, v, g, beta = chunks(q), chunks(k), chunks(v), chunks(g), chunks(beta)
    gc = jnp.cumsum(g, axis=-1)
    idx = jnp.arange(c)
    incl = idx[:, None] >= idx[None, :]
    strict = idx[:, None] > idx[None, :]
    decay = jnp.exp(jnp.where(incl, gc[..., :, None] - gc[..., None, :], -jnp.inf))
    kb = k * beta[..., None]
    low = jnp.einsum('bhncd,bhnsd->bhncs', kb, k) * decay * strict
    m = low + jnp.eye(c, dtype=jnp.float32)
    rhs = jnp.concatenate([v * beta[..., None], kb * jnp.exp(gc)[..., None]], axis=-1)
    sol = lax.linalg.triangular_solve(m, rhs, left_side=True, lower=True, unit_diagonal=True)
    u, w = sol[..., :dv], sol[..., dv:]
    qk = jnp.einsum('bhncd,bhnsd->bhncs', q, k) * decay
    q_dec = q * jnp.exp(gc)[..., None]
    g_last = gc[..., -1]
    k_dec = k * jnp.exp(g_last[..., None] - gc)[..., None]

    def step(s, xs):
        q_n, w_n, u_n, qk_n, k_n, gl_n = xs
        v_new = u_n - jnp.einsum('bhcd,bhde->bhce', w_n, s)
        o = jnp.einsum('bhcd,bhde->bhce', q_n, s) + jnp.einsum('bhcs,bhse->bhce', qk_n, v_new)
        s = s * jnp.exp(gl_n)[..., None, None] + jnp.einsum('bhcd,bhce->bhde', k_n, v_new)
        return s, o

    xs = tuple(jnp.moveaxis(a, 2, 0) for a in (q_dec, w, u, qk, k_dec, g_last))
    s0 = jnp.zeros((b, h, dk, dv), jnp.float32)
    _, o = lax.scan(step, s0, xs)
    o = jnp.moveaxis(o, 0, 2)
    return jnp.moveaxis(o, 1, 3).reshape(b, t, h, dv)


def gdn_mixer(qkv, z, beta_raw, a_raw, conv_w, a_log, dt_bias, norm_gain):
    b, t, _ = qkv.shape
    f32 = jnp.float32
    qkv = jax.nn.silu(centred_depthwise_conv(qkv, conv_w)).astype(f32)
    q, k, v = jnp.split(qkv, [GDN_HEADS * GDN_DK, 2 * GDN_HEADS * GDN_DK], axis=-1)
    q = l2_normalize(q.reshape(b, t, GDN_HEADS, GDN_DK)) * (GDN_DK ** -0.5)
    k = l2_normalize(k.reshape(b, t, GDN_HEADS, GDN_DK))
    v = v.reshape(b, t, GDN_HEADS, GDN_DV)
    beta = jax.nn.sigmoid(beta_raw.astype(f32)).reshape(b, t, 2, GDN_HEADS)
    g = -jnp.exp(a_log.astype(f32)) * jax.nn.softplus(a_raw.astype(f32).reshape(b, t, 2, GDN_HEADS) + dt_bias.astype(f32))
    o_fwd = gated_delta_chunked(q, k, v, g[:, :, 0], beta[:, :, 0])
    flip = lambda a: jnp.flip(a, axis=1)
    o_bwd = flip(gated_delta_chunked(flip(q), flip(k), flip(v), flip(g[:, :, 1]), flip(beta[:, :, 1])))
    o = rms_norm(o_fwd + o_bwd, norm_gain).astype(z.dtype)
    return o.reshape(b, t, GDN_WIDTH) * jax.nn.silu(z)


def swa_mixer(q, kv, z, q_gain, k_gain, sink):
    b, t, _ = q.shape
    h, kvh, dh, blk = SWA_HEADS, SWA_KV_HEADS, SWA_DH, SWA_BLOCK
    grp = h // kvh
    nb = t // blk
    q = rms_norm(q.reshape(b, t, h, dh), q_gain)
    k, v = jnp.split(kv, 2, axis=-1)
    k = rms_norm(k.reshape(b, t, kvh, dh), k_gain)
    v = v.reshape(b, t, kvh, dh)

    def neighbourhood(a):
        ap = jnp.pad(a, ((0, 0), (blk, blk), (0, 0), (0, 0)))
        parts = [ap[:, j * blk:j * blk + t].reshape(b, nb, blk, kvh, dh) for j in range(3)]
        return jnp.concatenate(parts, axis=2)

    kb, vb = neighbourhood(k), neighbourhood(v)
    qb = q.reshape(b, nb, blk, kvh, grp, dh)
    s = jnp.einsum('bnqkgd,bnskd->bnkgqs', qb, kb).astype(jnp.float32) * (dh ** -0.5)
    qi = jnp.arange(blk)
    si = jnp.arange(3 * blk)
    rel = si[None, :] - blk - qi[:, None]
    k_pos = jnp.arange(nb)[:, None] * blk - blk + si[None, :]
    valid = (jnp.abs(rel) <= SWA_WINDOW)[None] & ((k_pos >= 0) & (k_pos < t))[:, None, :]
    slopes = alibi_slopes(h).reshape(kvh, grp)
    s = s - slopes[:, :, None, None] * jnp.abs(rel).astype(jnp.float32)
    s = jnp.where(valid[:, None, None], s, -jnp.inf)
    sink_l = sink.astype(jnp.float32).reshape(kvh, grp)[:, :, None, None]
    mx = jnp.maximum(jnp.max(s, axis=-1, keepdims=True), sink_l)
    p = jnp.exp(s - mx)
    p = p / (jnp.sum(p, axis=-1, keepdims=True) + jnp.exp(sink_l - mx))
    o = jnp.einsum('bnkgqs,bnskd->bnqkgd', p.astype(v.dtype), vb)
    return o.reshape(b, t, SWA_WIDTH) * jax.nn.silu(z)


def diff_mixer(q, k, v, z, q_gain, k_gain, lam, norm_gain, lambda_init):
    b, t, _ = q.shape
    h, d, qbk = DIFF_HEADS, DIFF_DH, DIFF_QBLOCK
    nq = t // qbk
    q = rms_norm(q.reshape(b, t, h, 2, d), q_gain)
    k = rms_norm(k.reshape(b, t, h, 2, d), k_gain)
    v = v.reshape(b, t, h, DIFF_DV)
    lf = lam.astype(jnp.float32)
    lmbda = jnp.exp(jnp.sum(lf[0] * lf[1])) - jnp.exp(jnp.sum(lf[2] * lf[3])) + lambda_init
    slopes = alibi_slopes(h)
    k_pos = jnp.arange(t)
    qb = jnp.moveaxis(q.reshape(b, nq, qbk, h, 2, d), 1, 0)

    def block(args):
        q_blk, start = args
        s = jnp.einsum('bqhmd,bshmd->bhmqs', q_blk, k).astype(jnp.float32) * (d ** -0.5)
        q_pos = start + jnp.arange(qbk)
        dist = jnp.abs(q_pos[:, None] - k_pos[None, :]).astype(jnp.float32)
        s = s - slopes[:, None, None, None] * dist
        p = jax.nn.softmax(s, axis=-1)
        a = p[:, :, 0] - lmbda * p[:, :, 1]
        return jnp.einsum('bhqs,bshe->bqhe', a.astype(v.dtype), v)

    o = lax.map(block, (qb, jnp.arange(nq) * qbk))
    o = jnp.moveaxis(o, 0, 1).reshape(b, t, h, DIFF_DV)
    o = rms_norm(o, norm_gain) * (1.0 - lambda_init)
    return o.reshape(b, t, DIFF_WIDTH) * jax.nn.silu(z)


def encoder_layer(x, layer_idx, norm_gain, w_in, conv_w, gdn_a_log, gdn_dt_bias, gdn_norm_gain,
                  swa_q_gain, swa_k_gain, swa_sink, diff_q_gain, diff_k_gain, diff_lambda,
                  diff_norm_gain, w_branch, w_out):
    b, t, _ = x.shape
    hn = rms_norm(x, norm_gain)
    proj = hn @ w_in
    (g_qkv, g_z, g_beta, g_a, s_q, s_kv, s_z, d_q, d_k, d_v, d_z, merge) = split_columns(proj, IN_SIZES)
    y_a = gdn_mixer(g_qkv, g_z, g_beta, g_a, conv_w, gdn_a_log, gdn_dt_bias, gdn_norm_gain)
    y_b = swa_mixer(s_q, s_kv, s_z, swa_q_gain, swa_k_gain, swa_sink)
    lambda_init = 0.8 - 0.6 * math.exp(-0.3 * layer_idx)
    y_c = diff_mixer(d_q, d_k, d_v, d_z, diff_q_gain, diff_k_gain, diff_lambda, diff_norm_gain, lambda_init)
    branches = jnp.stack([y_a, y_b, y_c], axis=2)
    widened = jnp.einsum('btnc,ncd->btnd', branches, w_branch)
    gates = jax.nn.sigmoid(merge.reshape(b, t, N_BRANCH, D_MODEL))
    merged = jnp.sum(gates * widened, axis=2)
    return x + merged @ w_out


def run_trunk(x, norm_gain, w_in, conv_w, gdn_a_log, gdn_dt_bias, gdn_norm_gain, swa_q_gain,
              swa_k_gain, swa_sink, diff_q_gain, diff_k_gain, diff_lambda, diff_norm_gain, w_branch, w_out):
    for l in range(DEPTH):
        x = encoder_layer(x, l, norm_gain[l], w_in[l], conv_w[l], gdn_a_log[l], gdn_dt_bias[l],
                          gdn_norm_gain[l], swa_q_gain[l], swa_k_gain[l], swa_sink[l], diff_q_gain[l],
                          diff_k_gain[l], diff_lambda[l], diff_norm_gain[l], w_branch[l], w_out[l])
    return x


def setup_inputs(seed: int = 0) -> dict:
    key = jax.random.key(seed)
    ks = jax.random.split(key, 20)
    f32 = jnp.float32
    nrm = lambda k, shape: jax.random.normal(k, shape, f32)
    x_prompt = nrm(ks[0], (BATCH, SEQ, D_MODEL))
    x_sample = nrm(ks[1], (DEC_BATCH, DEC_SEQ, D_MODEL))
    norm_gain = 1.0 + 0.02 * nrm(ks[2], (DEPTH, D_MODEL))
    w_in = nrm(ks[3], (DEPTH, D_MODEL, IN_WIDTH)) * (D_MODEL ** -0.5)
    conv_w = nrm(ks[4], (DEPTH, GDN_CONV, GDN_CONV_CH)) * (GDN_CONV ** -0.5)
    gdn_a_log = jnp.log(jax.random.uniform(ks[5], (DEPTH, 2, GDN_HEADS), f32, 1.0, 16.0))
    dt = jnp.exp(jax.random.uniform(ks[6], (DEPTH, 2, GDN_HEADS), f32, math.log(1e-3), math.log(1e-1)))
    gdn_dt_bias = dt + jnp.log(-jnp.expm1(-dt))
    gdn_norm_gain = 1.0 + 0.02 * nrm(ks[7], (DEPTH, GDN_DV))
    swa_q_gain = 1.0 + 0.02 * nrm(ks[8], (DEPTH, SWA_DH))
    swa_k_gain = 1.0 + 0.02 * nrm(ks[9], (DEPTH, SWA_DH))
    swa_sink = 0.5 * nrm(ks[10], (DEPTH, SWA_HEADS))
    diff_q_gain = 1.0 + 0.02 * nrm(ks[11], (DEPTH, DIFF_DH))
    diff_k_gain = 1.0 + 0.02 * nrm(ks[12], (DEPTH, DIFF_DH))
    diff_lambda = 0.1 * nrm(ks[13], (DEPTH, 4, DIFF_DH))
    diff_norm_gain = 1.0 + 0.02 * nrm(ks[14], (DEPTH, DIFF_DV))
    w_branch = nrm(ks[15], (DEPTH, N_BRANCH, BRANCH_WIDTH, D_MODEL)) * (BRANCH_WIDTH ** -0.5)
    w_out = nrm(ks[16], (DEPTH, D_MODEL, D_MODEL)) * ((2.0 * DEPTH * D_MODEL) ** -0.5)
    return {"x_prompt": x_prompt, "x_sample": x_sample, "norm_gain": norm_gain, "w_in": w_in,
            "conv_w": conv_w, "gdn_a_log": gdn_a_log, "gdn_dt_bias": gdn_dt_bias,
            "gdn_norm_gain": gdn_norm_gain, "swa_q_gain": swa_q_gain, "swa_k_gain": swa_k_gain,
            "swa_sink": swa_sink, "diff_q_gain": diff_q_gain, "diff_k_gain": diff_k_gain,
            "diff_lambda": diff_lambda, "diff_norm_gain": diff_norm_gain, "w_branch": w_branch,
            "w_out": w_out}


def reference(x_prompt, x_sample, norm_gain, w_in, conv_w, gdn_a_log, gdn_dt_bias, gdn_norm_gain,
              swa_q_gain, swa_k_gain, swa_sink, diff_q_gain, diff_k_gain, diff_lambda, diff_norm_gain,
              w_branch, w_out):
    y_prompt = run_trunk(x_prompt, norm_gain, w_in, conv_w, gdn_a_log, gdn_dt_bias, gdn_norm_gain,
                         swa_q_gain, swa_k_gain, swa_sink, diff_q_gain, diff_k_gain, diff_lambda,
                         diff_norm_gain, w_branch, w_out)
    y_sample = run_trunk(x_sample, norm_gain, w_in, conv_w, gdn_a_log, gdn_dt_bias, gdn_norm_gain,
                         swa_q_gain, swa_k_gain, swa_sink, diff_q_gain, diff_k_gain, diff_lambda,
                         diff_norm_gain, w_branch, w_out)
    return (y_prompt, y_sample)
```

```cpp
#include <hip/hip_runtime.h>
#include <cstdio>
#include <cstdint>
namespace pg8 {
#define PG8_LAS __attribute__((address_space(3)))
typedef unsigned short bf16_t;
typedef short bf16x8 __attribute__((ext_vector_type(8)));
typedef float f32x4 __attribute__((ext_vector_type(4)));
typedef unsigned u32x4 __attribute__((ext_vector_type(4)));
constexpr int BM = 256, BK = 64, HALF = 128, HTB = HALF * BK * 2  , STAGE_BYTES = 8 * HTB, NXCD = 8, WGM = 4;

__host__ __device__ __forceinline__ int lds_byte(int r, int c) { const int st = (r >> 4) * 2 + (c >> 5), rr = r & 15, cc = c & 31, ob = rr * 64 + cc * 2; return st * 1024 + (ob ^ (((ob >> 9) & 1) << 5)); }
__host__ __device__ __forceinline__ void stage_rc(int b, int& R, int& C) { const int st = b / 1024, sb = b % 1024, swz = sb ^ (((sb >> 9) & 1) << 5); R = (st >> 1) * 16 + swz / 64; C = (st & 1) * 32 + (swz % 64) / 2; }
__host__ __device__ __forceinline__ int perm32(int rho) { const int n = rho >> 4, i = rho & 15; return 8 * (i >> 2) + 4 * n + (i & 3); }

struct Unit { int pm, pn; };
struct Gemm { const bf16_t* A; const bf16_t* Bt; int M, N, K; };

struct StaticOrder {
    int nM, nN, nwg, G, c;
    __host__ __device__ void init(int M, int N, int G_, int c_) { nM = M / BM; nN = N / BM; nwg = nM * nN; G = G_; c = c_; }
    __host__ __device__ bool next(int i, Unit& u) const {
        const long L = (long)i * G + c; if (L >= nwg) return false;
        int wgid = (int)L; { const int q = nwg / NXCD, r = nwg % NXCD, xcd = wgid % NXCD, off = wgid / NXCD; wgid = (xcd < r ? xcd * (q + 1) : r * (q + 1) + (xcd - r) * q) + off; }
        const int nig = WGM * nN, gid = wgid / nig, fm = gid * WGM, gsz = (nM - fm) < WGM ? (nM - fm) : WGM;
        u.pm = fm + ((wgid % nig) % gsz); u.pn = (wgid % nig) / gsz; return true;
    }
    __device__ __forceinline__ void a_ready(const Unit&) const {}
    __device__ __forceinline__ void done(const Unit&) const {}
};

typedef float f32x2_c __attribute__((ext_vector_type(2)));
typedef unsigned u32x2 __attribute__((ext_vector_type(2)));
typedef __bf16 bf16x2_c __attribute__((ext_vector_type(2)));
__device__ __forceinline__ unsigned cvt_pk_bf16(float lo, float hi) { const f32x2_c v = {lo, hi}; const bf16x2_c b = __builtin_convertvector(v, bf16x2_c); return __builtin_bit_cast(unsigned, b); }
__device__ __forceinline__ float sigmoid_f(float v) { return __builtin_amdgcn_rcpf(1.0f + __builtin_amdgcn_exp2f(-1.4426950408889634f * v)); }
__device__ __forceinline__ float bflo(unsigned w) { return __uint_as_float(w << 16); }
__device__ __forceinline__ float bfhi(unsigned w) { return __uint_as_float(w & 0xffff0000u); }

struct EpiProj {
    static constexpr bool PERM = true, AFTER_DRAIN = false;
    bf16_t* O; int ldc; int sig_lo, sig_hi; const float* rowss; float inv_d, eps;
    __device__ __forceinline__ void operator()(const f32x4 (&acc)[2][2][4][2], const Unit& u, int wr, int wc, int fr, int fq) const {
        const int row0 = u.pm * BM + wr * 64 + fr, col0 = u.pn * BM + wc * 32 + 8 * fq;
        const bool sig = (u.pn >= sig_lo) && (u.pn < sig_hi);
#pragma unroll
        for (int ai = 0; ai < 2; ++ai)
#pragma unroll
            for (int m = 0; m < 4; ++m) { const int row = row0 + ai * HALF + m * 16; bf16_t* rowp = O + (size_t)row * ldc + col0;
                const float rstd = 1.0f / sqrtf(rowss[row] * inv_d + eps);
#pragma unroll
                for (int bj = 0; bj < 2; ++bj) { f32x4 v0 = acc[ai][bj][m][0] * rstd, v1 = acc[ai][bj][m][1] * rstd;
                    if (sig) {
#pragma unroll
                        for (int j = 0; j < 4; ++j) { v0[j] = sigmoid_f(v0[j]); v1[j] = sigmoid_f(v1[j]); } }
                    u32x4 w; w.x = cvt_pk_bf16(v0[0], v0[1]); w.y = cvt_pk_bf16(v0[2], v0[3]); w.z = cvt_pk_bf16(v1[0], v1[1]); w.w = cvt_pk_bf16(v1[2], v1[3]);
                    *(u32x4*)(rowp + bj * HALF) = w; } }
    }
};
struct EpiMerge {
    static constexpr bool PERM = true, AFTER_DRAIN = false;
    const bf16_t* G; int ldg; bf16_t* T; int ldt; bf16_t* O; int ldo;
    __device__ __forceinline__ void operator()(const f32x4 (&acc)[2][2][4][2], const Unit& u, int wr, int wc, int fr, int fq) const {
        const int n = u.pm >> 6, pm = u.pm & 63, pn = u.pn & 7;
        const int row0 = pm * BM + wr * 64 + fr, col0 = pn * BM + wc * 32 + 8 * fq;
        const bf16_t* Gn = G + n * 2048;
#pragma unroll
        for (int ai = 0; ai < 2; ++ai)
#pragma unroll
            for (int m2 = 0; m2 < 4; m2 += 2) {
                u32x4 gw[2][2], tw[2][2];
#pragma unroll
                for (int mm = 0; mm < 2; ++mm)
#pragma unroll
                    for (int bj = 0; bj < 2; ++bj) { const size_t row = (size_t)(row0 + ai * HALF + (m2 + mm) * 16); const int col = col0 + bj * HALF;
                        gw[mm][bj] = *(const u32x4*)(Gn + row * ldg + col); if (n >= 1) tw[mm][bj] = *(const u32x4*)(T + row * ldt + col); else tw[mm][bj] = (u32x4){0u, 0u, 0u, 0u}; }
#pragma unroll
                for (int mm = 0; mm < 2; ++mm)
#pragma unroll
                    for (int bj = 0; bj < 2; ++bj) { const int m = m2 + mm; const size_t row = (size_t)(row0 + ai * HALF + m * 16); const int col = col0 + bj * HALF;
                        const u32x4 g = gw[mm][bj], t = tw[mm][bj];
                        f32x4 v0 = acc[ai][bj][m][0], v1 = acc[ai][bj][m][1];
                        v0[0] = v0[0] * sigmoid_f(bflo(g.x)) + bflo(t.x); v0[1] = v0[1] * sigmoid_f(bfhi(g.x)) + bfhi(t.x); v0[2] = v0[2] * sigmoid_f(bflo(g.y)) + bflo(t.y); v0[3] = v0[3] * sigmoid_f(bfhi(g.y)) + bfhi(t.y);
                        v1[0] = v1[0] * sigmoid_f(bflo(g.z)) + bflo(t.z); v1[1] = v1[1] * sigmoid_f(bfhi(g.z)) + bfhi(t.z); v1[2] = v1[2] * sigmoid_f(bflo(g.w)) + bflo(t.w); v1[3] = v1[3] * sigmoid_f(bfhi(g.w)) + bfhi(t.w);
                        u32x4 w; w.x = cvt_pk_bf16(v0[0], v0[1]); w.y = cvt_pk_bf16(v0[2], v0[3]); w.z = cvt_pk_bf16(v1[0], v1[1]); w.w = cvt_pk_bf16(v1[2], v1[3]);
                        if (n <= 1) *(u32x4*)(T + row * ldt + col) = w; else *(u32x4*)(O + row * ldo + col) = w; }
                asm volatile("" ::: "memory"); }
    }
};
struct MergeOrder {
    StaticOrder S;
    __device__ __forceinline__ bool next(int i, Unit& u) const { const int ou = i / 3, n = i - ou * 3; Unit v; if (!S.next(ou, v)) return false; u.pm = n * 64 + v.pm; u.pn = n * 8 + v.pn; return true; }
    __device__ __forceinline__ void a_ready(const Unit&) const {}
    __device__ __forceinline__ void done(const Unit&) const {}
};
struct EpiOut {
    static constexpr bool PERM = false, AFTER_DRAIN = false;
    const float* base; float* out; int ldc; const float* gain_next; bf16_t* hn; float* rowss;
    __device__ __forceinline__ void operator()(const f32x4 (&acc)[2][2][4][2], const Unit& u, int wr, int wc, int fr, int fq) const {
        const int row0 = u.pm * BM + wr * 64 + fr, col0 = u.pn * BM + wc * 32 + 4 * fq;
        f32x4 gn[2][2];
        if (gain_next) {
#pragma unroll
            for (int bj = 0; bj < 2; ++bj)
#pragma unroll
                for (int n = 0; n < 2; ++n) gn[bj][n] = *(const f32x4*)(gain_next + col0 + bj * HALF + n * 16); }
#pragma unroll
        for (int ai = 0; ai < 2; ++ai)
#pragma unroll
            for (int m2 = 0; m2 < 4; m2 += 2) {
                f32x4 bb[2][2][2];
#pragma unroll
                for (int mm = 0; mm < 2; ++mm)
#pragma unroll
                    for (int bj = 0; bj < 2; ++bj)
#pragma unroll
                        for (int n = 0; n < 2; ++n) bb[mm][bj][n] = *(const f32x4*)(base + (size_t)(row0 + ai * HALF + (m2 + mm) * 16) * ldc + col0 + bj * HALF + n * 16);
#pragma unroll
                for (int mm = 0; mm < 2; ++mm) { const int m = m2 + mm; const int row = row0 + ai * HALF + m * 16; const size_t off = (size_t)row * ldc + col0; float ss = 0.f;
#pragma unroll
                    for (int bj = 0; bj < 2; ++bj)
#pragma unroll
                        for (int n = 0; n < 2; ++n) { const f32x4 x = bb[mm][bj][n] + acc[ai][bj][m][n]; *(f32x4*)(out + off + bj * HALF + n * 16) = x;
                            if (gain_next) { const f32x4 g = gn[bj][n]; ss += (x[0] * x[0] + x[1] * x[1]) + (x[2] * x[2] + x[3] * x[3]);
                                u32x2 w; w.x = cvt_pk_bf16(x[0] * g[0], x[1] * g[1]); w.y = cvt_pk_bf16(x[2] * g[2], x[3] * g[3]); *(u32x2*)(hn + off + bj * HALF + n * 16) = w; } }
                    if (gain_next) {
                        ss += __builtin_bit_cast(float, __builtin_amdgcn_ds_swizzle(__builtin_bit_cast(int, ss), 0x1F | (16 << 10)));
                        ss += __shfl_xor(ss, 32);
                        if (fq == 0) __hip_atomic_fetch_add(rowss + row, ss, __ATOMIC_RELAXED, __HIP_MEMORY_SCOPE_AGENT); } }
                asm volatile("" ::: "memory"); }
    }
};

template <class Epi, class Sched, bool ALIGN_EPI = false, bool SP2 = false>
__device__ __forceinline__ void gemm_phase(PG8_LAS unsigned char* lds, const Gemm g, const Sched& S, const Epi& E) {
    int tid_ = threadIdx.x; asm volatile("" : "+v"(tid_));
    const int tid = tid_, wid = __builtin_amdgcn_readfirstlane(tid >> 6), lane = tid & 63, wr = wid >> 2, wc = wid & 3, fr = lane & 15, fq = lane >> 4;
    const int K = g.K, nt = K / BK;
    unsigned voffA[2], voffB[2];
#pragma unroll
    for (int i = 0; i < 2; ++i) { int R, C; stage_rc(tid * 16 + i * 8192, R, C); const int Rb = Epi::PERM ? ((R & ~31) + perm32(R & 31)) : R;
        voffA[i] = (unsigned)(R * K + C) * 2u; voffB[i] = (unsigned)(Rb * K + C) * 2u; }
    const size_t kstep = (size_t)(BK * 2);
    const size_t hstep = (size_t)HALF * K * 2;
    const size_t tstep = 2 * hstep;
    const unsigned ldsw = (unsigned)wid * 1024u;
    const int aoff = lds_byte(wr * 64 + fr, fq * 8), boff = lds_byte(wc * 32 + fr, fq * 8);
#define PG8_SA(b, h) (((b) * 2 + (h)) * HTB)
#define PG8_SB(b, h) ((4 + (b) * 2 + (h)) * HTB)
#define PG8_STAGE(bufoff, gbase, voff) do { _Pragma("unroll") for (int _i = 0; _i < 2; ++_i) \
        __builtin_amdgcn_global_load_lds((const unsigned*)((const char*)(gbase) + (voff)[_i]), (PG8_LAS unsigned*)(lds + (bufoff) + ldsw + _i * 8192), 16, 0, 0); } while (0)
#define PG8_LDA(dst, b, h) do { _Pragma("unroll") for (int m = 0; m < 4; ++m) _Pragma("unroll") for (int k = 0; k < 2; ++k) dst[m][k] = *(const PG8_LAS bf16x8*)(lds + PG8_SA(b, h) + aoff + m * 2048 + k * 1024); } while (0)
#define PG8_LDB(dst, b, h) do { _Pragma("unroll") for (int n = 0; n < 2; ++n) _Pragma("unroll") for (int k = 0; k < 2; ++k) dst[n][k] = *(const PG8_LAS bf16x8*)(lds + PG8_SB(b, h) + boff + n * 2048 + k * 1024); } while (0)
#define PG8_MMA(ai, bj, At, Bt) do { __builtin_amdgcn_s_setprio(1); _Pragma("unroll") for (int m = 0; m < 4; ++m) _Pragma("unroll") for (int n = 0; n < 2; ++n) _Pragma("unroll") for (int k = 0; k < 2; ++k) \
        acc[ai][bj][m][n] = __builtin_amdgcn_mfma_f32_16x16x32_bf16(Bt[n][k], At[m][k], acc[ai][bj][m][n], 0, 0, 0); __builtin_amdgcn_s_setprio(0); } while (0)
#define PG8_WAIT_V(n) asm volatile("s_waitcnt vmcnt(" #n ")" ::: "memory")
#define PG8_WAIT_L(n) asm volatile("s_waitcnt lgkmcnt(" #n ")" ::: "memory")
#define PG8_BAR __builtin_amdgcn_s_barrier()
#define PG8_SCHED __builtin_amdgcn_sched_barrier(0)
    Unit cur, nxt; int ui = 0;
    if (!S.next(0, cur)) return;
    f32x4 acc[2][2][4][2];
#pragma unroll
    for (int a = 0; a < 2; ++a)
#pragma unroll
        for (int b = 0; b < 2; ++b)
#pragma unroll
            for (int m = 0; m < 4; ++m)
#pragma unroll
                for (int n = 0; n < 2; ++n) acc[a][b][m][n] = (f32x4){0.f, 0.f, 0.f, 0.f};
    bf16x8 At[4][2], B0[2][2], B1[2][2];
    const char* cA = (const char*)g.A + (size_t)cur.pm * tstep; const char* cB = (const char*)g.Bt + (size_t)cur.pn * tstep;
    S.a_ready(cur);
    if constexpr (SP2) {
        PG8_STAGE(PG8_SB(0, 0), cB, voffB); PG8_STAGE(PG8_SB(0, 1), cB + hstep, voffB); PG8_STAGE(PG8_SA(0, 0), cA, voffA); PG8_STAGE(PG8_SA(0, 1), cA + hstep, voffA);
        if (wr == 1) PG8_BAR;
        PG8_WAIT_V(2); PG8_BAR;
        PG8_STAGE(PG8_SB(1, 0), cB + kstep, voffB); PG8_STAGE(PG8_SA(1, 0), cA + kstep, voffA); PG8_STAGE(PG8_SB(1, 1), cB + hstep + kstep, voffB);
        PG8_WAIT_V(6); PG8_BAR;
    } else {
        PG8_STAGE(PG8_SB(0, 0), cB, voffB); PG8_STAGE(PG8_SA(0, 0), cA, voffA); PG8_STAGE(PG8_SB(0, 1), cB + hstep, voffB); PG8_STAGE(PG8_SA(0, 1), cA + hstep, voffA);
        if (wr == 1) PG8_BAR;
        PG8_WAIT_V(4); PG8_BAR;
        PG8_STAGE(PG8_SB(1, 0), cB + kstep, voffB); PG8_STAGE(PG8_SA(1, 0), cA + kstep, voffA); PG8_STAGE(PG8_SB(1, 1), cB + hstep + kstep, voffB);
        PG8_WAIT_V(6); PG8_BAR;
    }
    for (;;) {
        const bool has_next = S.next(ui + 1, nxt);
        const char* nA = has_next ? (const char*)g.A + (size_t)nxt.pm * tstep : cA; const char* nB = has_next ? (const char*)g.Bt + (size_t)nxt.pn * tstep : cB;
        for (int t = 0; t < nt; t += 2) {
            const bool last = (t == nt - 2);
            const char* a1 = cA + (size_t)(t + 1) * kstep;
            const char* a2 = last ? nA : cA + (size_t)(t + 2) * kstep; const char* b2 = last ? nB : cB + (size_t)(t + 2) * kstep;
            const char* a3 = a2 + kstep; const char* b3 = b2 + kstep;
            if (last && has_next) S.a_ready(nxt);
            if constexpr (SP2) {
            PG8_LDB(B0, 0, 0); PG8_LDB(B1, 0, 1); PG8_SCHED; PG8_LDA(At, 0, 0); PG8_STAGE(PG8_SA(1, 1), a1 + hstep, voffA);
            PG8_WAIT_V(8); PG8_WAIT_L(0); PG8_BAR; PG8_MMA(0, 0, At, B0); PG8_MMA(0, 1, At, B1); PG8_BAR; PG8_SCHED;
            PG8_LDA(At, 0, 1); PG8_STAGE(PG8_SB(0, 0), b2, voffB); PG8_STAGE(PG8_SB(0, 1), b2 + hstep, voffB); PG8_STAGE(PG8_SA(0, 0), a2, voffA);
            PG8_WAIT_V(8); PG8_WAIT_L(0); PG8_BAR; PG8_MMA(1, 0, At, B0); PG8_MMA(1, 1, At, B1); PG8_BAR; PG8_SCHED;
            PG8_LDB(B0, 1, 0); PG8_LDB(B1, 1, 1); PG8_SCHED; PG8_LDA(At, 1, 0); PG8_STAGE(PG8_SA(0, 1), a2 + hstep, voffA);
            PG8_WAIT_V(8); PG8_WAIT_L(0); PG8_BAR; PG8_MMA(0, 0, At, B0); PG8_MMA(0, 1, At, B1); PG8_BAR; PG8_SCHED;
            PG8_LDA(At, 1, 1); PG8_STAGE(PG8_SB(1, 0), b3, voffB); PG8_STAGE(PG8_SB(1, 1), b3 + hstep, voffB); PG8_STAGE(PG8_SA(1, 0), a3, voffA);
            PG8_WAIT_V(8); PG8_WAIT_L(0); PG8_BAR; PG8_MMA(1, 0, At, B0); PG8_MMA(1, 1, At, B1); PG8_BAR; PG8_SCHED;
            } else {
            PG8_LDB(B0, 0, 0); PG8_SCHED; PG8_LDA(At, 0, 0); PG8_STAGE(PG8_SA(1, 1), a1 + hstep, voffA);
            PG8_WAIT_L(8); PG8_BAR; PG8_WAIT_L(0); PG8_MMA(0, 0, At, B0); PG8_BAR; PG8_SCHED;
            PG8_LDB(B1, 0, 1); PG8_STAGE(PG8_SB(0, 0), b2, voffB);
            PG8_BAR; PG8_WAIT_L(0); PG8_MMA(0, 1, At, B1); PG8_BAR;
            PG8_LDA(At, 0, 1); PG8_STAGE(PG8_SA(0, 0), a2, voffA);
            PG8_BAR; PG8_WAIT_L(0); PG8_MMA(1, 0, At, B0); PG8_BAR; PG8_SCHED;
            PG8_STAGE(PG8_SB(0, 1), b2 + hstep, voffB);
            PG8_WAIT_V(6); PG8_BAR; PG8_MMA(1, 1, At, B1); PG8_BAR;
            PG8_LDB(B0, 1, 0); PG8_SCHED; PG8_LDA(At, 1, 0); PG8_STAGE(PG8_SA(0, 1), a2 + hstep, voffA);
            PG8_WAIT_L(8); PG8_BAR; PG8_WAIT_L(0); PG8_MMA(0, 0, At, B0); PG8_BAR; PG8_SCHED;
            PG8_LDB(B1, 1, 1); PG8_STAGE(PG8_SB(1, 0), b3, voffB);
            PG8_BAR; PG8_WAIT_L(0); PG8_MMA(0, 1, At, B1); PG8_BAR;
            PG8_LDA(At, 1, 1); PG8_STAGE(PG8_SA(1, 0), a3, voffA);
            PG8_BAR; PG8_WAIT_L(0); PG8_MMA(1, 0, At, B0); PG8_BAR; PG8_SCHED;
            PG8_STAGE(PG8_SB(1, 1), b3 + hstep, voffB);
            PG8_WAIT_V(6); PG8_BAR; PG8_MMA(1, 1, At, B1); PG8_BAR;
            }
        }
        if constexpr (ALIGN_EPI) { if (wr == 0) PG8_BAR; }
        if constexpr (!Epi::AFTER_DRAIN) { E(acc, cur, wr, wc, fr, fq); S.done(cur); }
        if (!has_next) break;
#pragma unroll
        for (int a = 0; a < 2; ++a)
#pragma unroll
            for (int b = 0; b < 2; ++b)
#pragma unroll
                for (int m = 0; m < 4; ++m)
#pragma unroll
                    for (int n = 0; n < 2; ++n) acc[a][b][m][n] = (f32x4){0.f, 0.f, 0.f, 0.f};
        cur = nxt; cA = nA; cB = nB; ++ui;
        if constexpr (ALIGN_EPI) { if (wr == 1) PG8_BAR; }
    }
    PG8_WAIT_V(0);
    if constexpr (!ALIGN_EPI) { if (wr == 0) PG8_BAR; }
    PG8_BAR;
    if constexpr (Epi::AFTER_DRAIN) { E.fused(acc, cur, wr, wc, fr, fq, lds, wid, lane); S.done(cur); }
#undef PG8_SA
#undef PG8_SB
#undef PG8_STAGE
#undef PG8_LDA
#undef PG8_LDB
#undef PG8_MMA
#undef PG8_WAIT_V
#undef PG8_WAIT_L
#undef PG8_BAR
#undef PG8_SCHED
}
}

#define GAS __attribute__((address_space(1)))
#define LAS __attribute__((address_space(3)))
typedef unsigned short bf16;
typedef unsigned v4u __attribute__((ext_vector_type(4)));
typedef unsigned v2u __attribute__((ext_vector_type(2)));
typedef float f32x4 __attribute__((ext_vector_type(4)));
typedef float f32x16 __attribute__((ext_vector_type(16)));
typedef short bf16x8 __attribute__((ext_vector_type(8)));
typedef short s16x4 __attribute__((ext_vector_type(4)));

constexpr int DM = 2048, DEPTH = 4, NTOK = 65536, PASS_ROWS = 16384, NPASS = 4;
constexpr int IN_REAL = 16928, NPROJ = 17152, LDP = NPROJ;
constexpr int C_GQKV = 0, C_GZ = 3072, C_SQ = 4096, C_SKV = 5120, C_SZ = 5632, C_DQ = 6656, C_DK = 7680, C_DV = 8704, C_DZ = 9728, C_GATE = 10752, C_BA = 16896;
constexpr float NORM_EPS = 1e-6f, LOG2E = 1.4426950408889634f;
constexpr int NWAVES = 8, NTHREADS = 512;

constexpr size_t MiB = 1u << 20;
constexpr size_t WS_CTL = 0, CTL_ZERO_BYTES = 2 * MiB;
constexpr size_t WS_ROWSS = 1 * MiB;
constexpr size_t WS_WIN = 2 * MiB;
constexpr size_t SZ_WIN_L = (size_t)NPROJ * DM * 2;
constexpr size_t WS_WBR = WS_WIN + 4 * SZ_WIN_L;
constexpr size_t SZ_WBR_1 = (size_t)2048 * 1024 * 2;
constexpr size_t WS_WOUT = WS_WBR + 12 * SZ_WBR_1;
constexpr size_t SZ_WOUT_L = (size_t)DM * DM * 2;
constexpr size_t WS_HN = WS_WOUT + 4 * SZ_WOUT_L;
constexpr size_t WS_PROJ = WS_HN + (size_t)NTOK * DM * 2;
constexpr size_t WS_Y = WS_PROJ + (size_t)PASS_ROWS * NPROJ * 2;
constexpr size_t SZ_Y1 = (size_t)PASS_ROWS * 1024 * 2;
constexpr size_t WS_GDN = WS_Y + 3 * SZ_Y1;
constexpr int REC_BYTES = 73728, REC_FW = 0, REC_FQ = 16384, REC_FK = 32768, REC_FQK = 49152, REC_FU = 57344, REC_LOAD = 57344, REC_GAM = REC_FQK + 2048;
constexpr size_t WS_GAM = WS_GDN + (size_t)2 * 256 * 8 * REC_BYTES;
constexpr size_t WS_ODIR = WS_GAM + 16384;
constexpr size_t WS_MTMP = WS_ODIR + 2 * SZ_Y1;
constexpr size_t WS_MRG = WS_MTMP + (size_t)PASS_ROWS * DM * 2;
constexpr size_t WS_PARK = WS_MRG + (size_t)PASS_ROWS * DM * 2;
constexpr size_t WS_PART = WS_PARK + (size_t)256 * 8 * 64 * 64 * 4;
constexpr int PART_SLOTS = 640;
constexpr size_t WS_PARTL = WS_PART + (size_t)PART_SLOTS * 2 * 256 * 128 * 4;
constexpr size_t WS_END = WS_PARTL + (size_t)PART_SLOTS * 2 * 256 * 4;
constexpr int CW_BAR = 4096;
constexpr int CW_QUEUE = 16384;

constexpr int LDS_BYTES = 159744;
constexpr int MISC_OFF = LDS_BYTES - 512;

#define LDS_WAIT() asm volatile("s_waitcnt lgkmcnt(0)" ::: "memory")
#define VM_WAIT() asm volatile("s_waitcnt vmcnt(0)" ::: "memory")
__device__ __forceinline__ float bf2f(bf16 b) { return __uint_as_float(((unsigned)b) << 16); }
__device__ __forceinline__ float bflo(unsigned w) { return __uint_as_float(w << 16); }
__device__ __forceinline__ float bfhi(unsigned w) { return __uint_as_float(w & 0xffff0000u); }
typedef float f32x2_t __attribute__((ext_vector_type(2)));
typedef __bf16 bf16x2_t __attribute__((ext_vector_type(2)));
__device__ __forceinline__ unsigned cvtpk(float lo, float hi) { const f32x2_t v = {lo, hi}; const bf16x2_t b = __builtin_convertvector(v, bf16x2_t); return __builtin_bit_cast(unsigned, b); }
__device__ __forceinline__ bf16 f2bf1(float f) { return (bf16)(cvtpk(f, 0.f) & 0xffffu); }
template <int O> __device__ __forceinline__ float xshfl(float v) {
    static_assert(O >= 1 && O <= 16, "xshfl: in-half xor only");
    return __builtin_bit_cast(float, __builtin_amdgcn_ds_swizzle(__builtin_bit_cast(int, v), 0x1F | (O << 10)));
}
__device__ __forceinline__ float half_sum(float v) {
    unsigned a = __float_as_uint(v), b = a; asm volatile("" : "+v"(b));
    auto rr = __builtin_amdgcn_permlane32_swap(a, b, false, false); return __uint_as_float(rr[0]) + __uint_as_float(rr[1]); }
__device__ __forceinline__ float half_max(float v) {
    unsigned a = __float_as_uint(v), b = a; asm volatile("" : "+v"(b));
    auto rr = __builtin_amdgcn_permlane32_swap(a, b, false, false); return fmaxf(__uint_as_float(rr[0]), __uint_as_float(rr[1])); }
__device__ __forceinline__ float wave_sum(float v) { v += xshfl<1>(v); v += xshfl<2>(v); v += xshfl<4>(v); v += xshfl<8>(v); v += xshfl<16>(v); return half_sum(v); }
__device__ __forceinline__ float wave_max(float v) { v = fmaxf(v, xshfl<1>(v)); v = fmaxf(v, xshfl<2>(v)); v = fmaxf(v, xshfl<4>(v)); v = fmaxf(v, xshfl<8>(v)); v = fmaxf(v, xshfl<16>(v)); return half_max(v); }
__device__ __forceinline__ float silu_f(float v) { return v * __builtin_amdgcn_rcpf(1.0f + __expf(-v)); }
__device__ __forceinline__ int crow(int r, int hi) { return (r & 3) + 8 * (r >> 2) + 4 * hi; }
#define MFMA32(a, b, c) __builtin_amdgcn_mfma_f32_32x32x16_bf16((a), (b), (c), 0, 0, 0)
#define XB_TMO      128
#define XB_XCNT(j)  (256  + 64 * (j))
#define XB_XSUB(j)  (1280 + 64 * (j))
#define XB_XGEN(j)  (2304 + 64 * (j))
#define XB_TOP      3328
#define XB_TOPGEN   3392
#define XCD_BAR_WORDS 3456
#define XB_SPIN_CAP (1u << 18)

__device__ __forceinline__ unsigned xb_ld(unsigned* p)              { return __hip_atomic_load(p, __ATOMIC_RELAXED, __HIP_MEMORY_SCOPE_AGENT); }
__device__ __forceinline__ unsigned xb_add(unsigned* p, unsigned v) { return __hip_atomic_fetch_add(p, v, __ATOMIC_RELAXED, __HIP_MEMORY_SCOPE_AGENT); }
__device__ __forceinline__ unsigned xb_xcc_id() { return (unsigned)__builtin_amdgcn_s_getreg((3 << 11) | 20) & 0xFu; }
#define XB_SPIN(cond, bar) do { unsigned _sp = 0; while (cond) { __builtin_amdgcn_s_sleep(1); \
    if ((++_sp & 255u) == 0u) { if (xb_ld(&(bar)[XB_TMO])) break; if (_sp > XB_SPIN_CAP) { atomicAdd(&(bar)[XB_TMO], 1u); break; } } } } while (0)

struct XcdBarrier {
    unsigned* bar; unsigned x;
    volatile LAS unsigned* st;
};

__device__ __forceinline__ XcdBarrier xcd_barrier_post(unsigned* bar, volatile LAS unsigned* st) {
    XcdBarrier b; b.bar = bar; b.x = xb_xcc_id(); b.st = st;
    if (threadIdx.x == 0) (void)xb_add(&bar[XB_XCNT(b.x)], 1u);
    return b;
}
__device__ __forceinline__ void xcd_barrier_complete(unsigned* bar, unsigned x, unsigned& nloc, unsigned& nx) {
    const unsigned G = gridDim.x * gridDim.y * gridDim.z;
    unsigned sum, cnt, mine, sp = 0u;
    for (;;) {
        sum = 0u; cnt = 0u; mine = 0u;
#pragma unroll
        for (unsigned j = 0; j < 16; ++j) { const unsigned c = xb_ld(&bar[XB_XCNT(j)]); sum += c; cnt += (c > 0u) ? 1u : 0u; mine = (j == x) ? c : mine; }
        if (sum == G) break;
        __builtin_amdgcn_s_sleep(1);
        if ((++sp & 255u) == 0u) { if (xb_ld(&bar[XB_TMO])) break; if (sp > XB_SPIN_CAP) { atomicAdd(&bar[XB_TMO], 1u); break; } }
    }
    nloc = mine > 0u ? mine : 1u; nx = cnt > 0u ? cnt : 1u;
}

__device__ __forceinline__ void xcd_barrier(const XcdBarrier& b) {
    asm volatile("s_waitcnt vmcnt(0)" ::: "memory");
    __syncthreads();
    if (threadIdx.x == 0) {
        unsigned* bar = b.bar;
        __builtin_amdgcn_s_waitcnt(0);
        unsigned nloc = b.st[0], nx = b.st[1];
        if (nloc == 0u) { xcd_barrier_complete(bar, b.x, nloc, nx); b.st[0] = nloc; b.st[1] = nx; }
        const unsigned old = xb_add(&bar[XB_XSUB(b.x)], 1u);
        const unsigned gen = old / nloc;
        if (old + 1u == (gen + 1u) * nloc) {
            __builtin_amdgcn_fence(__ATOMIC_RELEASE, "agent");
            asm volatile("s_waitcnt vmcnt(0)" ::: "memory");
            const unsigned og = xb_add(&bar[XB_TOP], 1u);
            const unsigned tg = og / nx;
            if (og + 1u == (tg + 1u) * nx) xb_add(&bar[XB_TOPGEN], 1u);
            else XB_SPIN(xb_ld(&bar[XB_TOPGEN]) == tg, bar);
            __builtin_amdgcn_fence(__ATOMIC_ACQUIRE, "agent");
            xb_add(&bar[XB_XGEN(b.x)], 1u);
            asm volatile("s_waitcnt vmcnt(0)" ::: "memory");
        } else {
            XB_SPIN(xb_ld(&bar[XB_XGEN(b.x)]) == gen, bar);
            __builtin_amdgcn_fence(__ATOMIC_ACQUIRE, "agent");
            asm volatile("s_waitcnt vmcnt(0)" ::: "memory");
        }
    }
    __syncthreads();
}
__device__ __forceinline__ void transpose_item(const float* W, int K, int N, bf16* WT, int k0, int n0, int drow0, LAS float* scr, int lane) {
#pragma unroll 8
    for (int i = 0; i < 32; ++i) { const int kk = 2 * i + (lane >> 5); scr[kk * 33 + (lane & 31)] = W[(size_t)(k0 + kk) * N + n0 + (lane & 31)]; }
    LDS_WAIT(); asm volatile("" ::: "memory");
    const int c = lane & 7;
#pragma unroll
    for (int j = 0; j < 4; ++j) { const int n = (lane >> 3) + 8 * j; const LAS float* s = scr + (8 * c) * 33 + n;
        v4u o; o.x = cvtpk(s[0 * 33], s[1 * 33]); o.y = cvtpk(s[2 * 33], s[3 * 33]); o.z = cvtpk(s[4 * 33], s[5 * 33]); o.w = cvtpk(s[6 * 33], s[7 * 33]);
        *(v4u*)(WT + (size_t)(drow0 + n) * K + k0 + 8 * c) = o; }
    LDS_WAIT(); asm volatile("" ::: "memory");
}
__device__ __forceinline__ void phase_prologue(LAS unsigned char* lds, const float* w_in, const float* w_branch, const float* w_out, unsigned char* ws, int gw, int ngw, int wave, int lane) {
    LAS float* scr = (LAS float*)(lds + wave * 16384);
    constexpr int NB_IN = IN_REAL / 32;
    constexpr int I_IN = 32 * NB_IN;
    constexpr int I_BR = 16 * 64;
    constexpr int I_OUT = 32 * 64;
    constexpr int TOT = 4 * I_IN + 12 * I_BR + 4 * I_OUT;
    for (int it = gw; it < TOT; it += ngw) {
        int r = it;
        if (r < 4 * I_IN) { const int l = r / I_IN; r -= l * I_IN; const int kb = r / NB_IN, nb = r % NB_IN, n0 = nb * 32;
            const int drow = (n0 < 4096) ? n0 : ((n0 < 4128) ? (C_BA + (n0 - 4096)) : (n0 - 32));
            transpose_item(w_in + (size_t)l * DM * IN_REAL, DM, IN_REAL, (bf16*)(ws + WS_WIN + (size_t)l * SZ_WIN_L), kb * 64, n0, drow, scr, lane); continue; }
        r -= 4 * I_IN;
        if (r < 12 * I_BR) { const int m = r / I_BR; r -= m * I_BR; const int kb = r / 64, nb = r % 64;
            transpose_item(w_branch + (size_t)m * 1024 * 2048, 1024, 2048, (bf16*)(ws + WS_WBR + (size_t)m * SZ_WBR_1), kb * 64, nb * 32, nb * 32, scr, lane); continue; }
        r -= 12 * I_BR;
        { const int l = r / I_OUT; r -= l * I_OUT; const int kb = r / 64, nb = r % 64;
            transpose_item(w_out + (size_t)l * DM * DM, DM, DM, (bf16*)(ws + WS_WOUT + (size_t)l * SZ_WOUT_L), kb * 64, nb * 32, nb * 32, scr, lane); }
    }
    const v4u z = {0u, 0u, 0u, 0u};
    for (int i = gw * 64 + lane; i < 4 * 57344; i += ngw * 64) { const int l = i / 57344, q = i % 57344;
        *(v4u*)(ws + WS_WIN + (size_t)l * SZ_WIN_L + (size_t)IN_REAL * DM * 2 + (size_t)q * 16) = z; }
}
__device__ __forceinline__ void rms_row(const float* xrow, const float* gain, bf16* orow, float* rowss, int lane) {
    const f32x4* xr = (const f32x4*)xrow + lane; const f32x4* gr = (const f32x4*)gain + lane;
    f32x4 v[8]; float s = 0.f;
#pragma unroll
    for (int j = 0; j < 8; ++j) { v[j] = xr[64 * j]; s += (v[j].x * v[j].x + v[j].y * v[j].y) + (v[j].z * v[j].z + v[j].w * v[j].w); }
    s = wave_sum(s);
    if (lane == 0) *rowss = s;
    v2u* o8 = (v2u*)orow + lane;
#pragma unroll
    for (int j = 0; j < 8; ++j) { const f32x4 g = gr[64 * j]; v2u o; o.x = cvtpk(v[j].x * g.x, v[j].y * g.y); o.y = cvtpk(v[j].z * g.z, v[j].w * g.w); o8[64 * j] = o; }
}
__device__ __forceinline__ void knorm_row(bf16* prow, const float* swa_k_gain, const float* diff_k_gain, int lane) {
    {
        v2u* p = (v2u*)(prow + C_SKV) + lane; const v2u w = *p;
        float a = bflo(w.x), b = bfhi(w.x), c = bflo(w.y), d = bfhi(w.y);
        float ss = (a * a + b * b) + (c * c + d * d);
        ss += xshfl<1>(ss); ss += xshfl<2>(ss); ss += xshfl<4>(ss); ss += xshfl<8>(ss); ss += xshfl<16>(ss);
        const float rs = 1.0f / sqrtf(ss * (1.0f / 128.0f) + NORM_EPS);
        const f32x4 g = *((const f32x4*)swa_k_gain + (lane & 31));
        v2u o; o.x = cvtpk(a * rs * g.x, b * rs * g.y); o.y = cvtpk(c * rs * g.z, d * rs * g.w); *p = o;
    }
    {
        v4u* p = (v4u*)(prow + C_DK) + 2 * lane; const v4u w0 = p[0], w1 = p[1];
        float x[16] = {bflo(w0.x), bfhi(w0.x), bflo(w0.y), bfhi(w0.y), bflo(w0.z), bfhi(w0.z), bflo(w0.w), bfhi(w0.w),
                       bflo(w1.x), bfhi(w1.x), bflo(w1.y), bfhi(w1.y), bflo(w1.z), bfhi(w1.z), bflo(w1.w), bfhi(w1.w)};
        float ss = 0.f;
#pragma unroll
        for (int e = 0; e < 16; ++e) ss += x[e] * x[e];
        ss += xshfl<1>(ss); ss += xshfl<2>(ss);
        const float rs = 1.0f / sqrtf(ss * (1.0f / 64.0f) + NORM_EPS);
        const float* g = diff_k_gain + 16 * (lane & 3);
#pragma unroll
        for (int e = 0; e < 16; ++e) x[e] *= rs * g[e];
        v4u o0, o1; o0.x = cvtpk(x[0], x[1]); o0.y = cvtpk(x[2], x[3]); o0.z = cvtpk(x[4], x[5]); o0.w = cvtpk(x[6], x[7]);
        o1.x = cvtpk(x[8], x[9]); o1.y = cvtpk(x[10], x[11]); o1.z = cvtpk(x[12], x[13]); o1.w = cvtpk(x[14], x[15]);
        p[0] = o0; p[1] = o1;
    }
}
__device__ __forceinline__ void gdn_final_row(const bf16* of, const bf16* ob, const bf16* zrow, const float* gain, bf16* yrow, int lane) {
    const v4u* pf = (const v4u*)of + 2 * lane; const v4u* pb = (const v4u*)ob + 2 * lane; const v4u* pz = (const v4u*)zrow + 2 * lane;
    float x[16], z[16];
#pragma unroll
    for (int q = 0; q < 2; ++q) { const v4u a = pf[q], b = pb[q], c = pz[q];
        x[8 * q + 0] = bflo(a.x) + bflo(b.x); x[8 * q + 1] = bfhi(a.x) + bfhi(b.x); x[8 * q + 2] = bflo(a.y) + bflo(b.y); x[8 * q + 3] = bfhi(a.y) + bfhi(b.y);
        x[8 * q + 4] = bflo(a.z) + bflo(b.z); x[8 * q + 5] = bfhi(a.z) + bfhi(b.z); x[8 * q + 6] = bflo(a.w) + bflo(b.w); x[8 * q + 7] = bfhi(a.w) + bfhi(b.w);
        z[8 * q + 0] = bflo(c.x); z[8 * q + 1] = bfhi(c.x); z[8 * q + 2] = bflo(c.y); z[8 * q + 3] = bfhi(c.y);
        z[8 * q + 4] = bflo(c.z); z[8 * q + 5] = bfhi(c.z); z[8 * q + 6] = bflo(c.w); z[8 * q + 7] = bfhi(c.w); }
    float ss = 0.f;
#pragma unroll
    for (int e = 0; e < 16; ++e) ss += x[e] * x[e];
    ss += xshfl<1>(ss); ss += xshfl<2>(ss); ss += xshfl<4>(ss);
    const float rs = 1.0f / sqrtf(ss * (1.0f / 128.0f) + NORM_EPS);
    const float* g = gain + 16 * (lane & 7);
#pragma unroll
    for (int e = 0; e < 16; ++e) x[e] = x[e] * rs * g[e] * silu_f(z[e]);
    v4u o0, o1; o0.x = cvtpk(x[0], x[1]); o0.y = cvtpk(x[2], x[3]); o0.z = cvtpk(x[4], x[5]); o0.w = cvtpk(x[6], x[7]);
    o1.x = cvtpk(x[8], x[9]); o1.y = cvtpk(x[10], x[11]); o1.z = cvtpk(x[12], x[13]); o1.w = cvtpk(x[14], x[15]);
    v4u* py = (v4u*)yrow + 2 * lane; py[0] = o0; py[1] = o1;
}
__device__ __forceinline__ void diff_final_row(const unsigned char* ws, int slot0, int np, int rr, float lam, float lambda_init, const bf16* zrow, const float* gain, bf16* yrow, int lane) {
    typedef float f32x2v __attribute__((ext_vector_type(2)));
    const float* PO = (const float*)(ws + WS_PART); const float* PL = (const float*)(ws + WS_PARTL);
    f32x2v o0 = {0.f, 0.f}, o1 = {0.f, 0.f}; float l0 = 0.f, l1 = 0.f;
    for (int p = 0; p < np; ++p) { const int s = slot0 + p;
        o0 += *(const f32x2v*)(PO + ((size_t)(s * 2 + 0) * 256 + rr) * 128 + 2 * lane); o1 += *(const f32x2v*)(PO + ((size_t)(s * 2 + 1) * 256 + rr) * 128 + 2 * lane);
        l0 += PL[(s * 2 + 0) * 256 + rr]; l1 += PL[(s * 2 + 1) * 256 + rr]; }
    const float r0 = 1.0f / l0, r1 = lam / l1;
    const float a = o0.x * r0 - o1.x * r1, b = o0.y * r0 - o1.y * r1;
    const float rs = (1.0f / sqrtf(wave_sum(a * a + b * b) * (1.0f / 128.0f) + NORM_EPS)) * (1.0f - lambda_init);
    const unsigned zw = *(const unsigned*)(zrow + 2 * lane);
    const float ya = a * rs * gain[2 * lane] * silu_f(bflo(zw)), yb = b * rs * gain[2 * lane + 1] * silu_f(bfhi(zw));
    *(unsigned*)(yrow + 2 * lane) = cvtpk(ya, yb);
}
constexpr int D1_QROW = 0, D1_KROW = 17408, D1_KT = 34816, D1_VT = 53248, D1_LM = 71680, D1_TB = 106496, D1_BETA = 143360, D1_GC = 143872, D1_END = 144384;
constexpr int ROWP = 272, TRP = 144, LMP = 272, TBP = 144;
#define TSW(rw, boff) ((rw) * TRP + ((boff) ^ ((((rw) >> 3) & 7) << 4)))
__device__ __forceinline__ unsigned char* gdn_rec(unsigned char* ws, int d, int ci, int h) { return ws + WS_GDN + (((size_t)d * 256 + ci) * 8 + h) * REC_BYTES; }

#ifndef DUP_D1
#define DUP_D1 0
#endif
__device__ __forceinline__ void gdn_prep_unit(LAS unsigned char* lds, unsigned char* ws, const float* conv_w, const float* a_log, const float* dt_bias,
                                              int l, int Tp, int ci, int h, int nci, int nh, unsigned& pre_ba, int tid, int wave, int lane) {
    const bf16* PROJ = (const bf16*)(ws + WS_PROJ);
    const int row0 = ci * 64, tin = row0 % Tp; const bool first = (tin == 0), last = (tin + 64 == Tp);
    LAS float* BETA = (LAS float*)(lds + D1_BETA); LAS float* GC = (LAS float*)(lds + D1_GC);
    if (tid < 128) {
        const int d = tid >> 6, r = tid & 63, c = d ? 63 - r : r;
        const float braw = bflo(pre_ba), araw = bfhi(pre_ba);
        if (nci >= 0) { const bf16* pn = PROJ + (size_t)(nci * 64 + c) * LDP + C_BA; pre_ba = (unsigned)pn[d * 8 + nh] | ((unsigned)pn[16 + d * 8 + nh] << 16); }
        const float beta = __builtin_amdgcn_rcpf(1.0f + __expf(-braw));
        const float x = araw + dt_bias[(l * 2 + d) * 8 + h];
        const float sp = fmaxf(x, 0.f) + log1pf(__expf(-fabsf(x)));
        float gcv = -__expf(a_log[(l * 2 + d) * 8 + h]) * sp;
#pragma unroll
        for (int off = 1; off < 64; off <<= 1) { const float t = __shfl_up(gcv, off); if (r >= off) gcv += t; }
        BETA[d * 64 + r] = beta; GC[d * 64 + r] = gcv;
        if (r == 63) *(float*)(gdn_rec(ws, d, ci, h) + REC_GAM) = __expf(gcv);
    }
    __syncthreads();
    for (int rep1 = 0; rep1 < (DUP_D1 == 1 ? 2 : 1); ++rep1) {
        const int sub = tid & 15, ch0 = sub * 8;
#pragma unroll 3
        for (int rnd = 0; rnd < 6; ++rnd) {
            const int it = rnd * 32 + (tid >> 4), mat = it >> 6, c = it & 63;
            const int chan = mat * 1024 + h * 128 + ch0;
            const bf16* px = PROJ + (size_t)(row0 + c) * LDP + C_GQKV + chan;
            const v4u zz = {0u, 0u, 0u, 0u};
            const v4u x1 = *(const v4u*)px;
            const v4u x0 = (c == 0 && first) ? zz : *(const v4u*)(px - LDP);
            const v4u x2 = (c == 63 && last) ? zz : *(const v4u*)(px + LDP);
            const float* cw = conv_w + (size_t)l * 3 * 3072 + chan;
            const f32x4 w0a = *(const f32x4*)cw, w0b = *(const f32x4*)(cw + 4), w1a = *(const f32x4*)(cw + 3072), w1b = *(const f32x4*)(cw + 3072 + 4), w2a = *(const f32x4*)(cw + 6144), w2b = *(const f32x4*)(cw + 6144 + 4);
            const float w0[8] = {w0a.x, w0a.y, w0a.z, w0a.w, w0b.x, w0b.y, w0b.z, w0b.w}, w1[8] = {w1a.x, w1a.y, w1a.z, w1a.w, w1b.x, w1b.y, w1b.z, w1b.w}, w2[8] = {w2a.x, w2a.y, w2a.z, w2a.w, w2b.x, w2b.y, w2b.z, w2b.w};
            const float a0[8] = {bflo(x0.x), bfhi(x0.x), bflo(x0.y), bfhi(x0.y), bflo(x0.z), bfhi(x0.z), bflo(x0.w), bfhi(x0.w)};
            const float a1[8] = {bflo(x1.x), bfhi(x1.x), bflo(x1.y), bfhi(x1.y), bflo(x1.z), bfhi(x1.z), bflo(x1.w), bfhi(x1.w)};
            const float a2[8] = {bflo(x2.x), bfhi(x2.x), bflo(x2.y), bfhi(x2.y), bflo(x2.z), bfhi(x2.z), bflo(x2.w), bfhi(x2.w)};
            float y[8]; float ss = 0.f;
#pragma unroll
            for (int e = 0; e < 8; ++e) { const float a = a0[e] * w0[e] + a1[e] * w1[e] + a2[e] * w2[e]; y[e] = a * __builtin_amdgcn_rcpf(1.0f + __expf(-a)); ss += y[e] * y[e]; }
            if (mat < 2) {
                ss += xshfl<1>(ss); ss += xshfl<2>(ss); ss += xshfl<4>(ss); ss += xshfl<8>(ss);
                float rs = __builtin_amdgcn_rsqf(ss + NORM_EPS); if (mat == 0) rs *= 0.08838834764831845f;
#pragma unroll
                for (int e = 0; e < 8; ++e) y[e] *= rs;
            }
            if (mat == 0) {
                v4u o; o.x = cvtpk(y[0], y[1]); o.y = cvtpk(y[2], y[3]); o.z = cvtpk(y[4], y[5]); o.w = cvtpk(y[6], y[7]);
                *(LAS v4u*)(lds + D1_QROW + c * ROWP + ch0 * 2) = o;
                const int t = ch0 >> 5, kk = ch0 & 31, s = kk >> 4, b = (kk >> 3) & 1;
#pragma unroll
                for (int d = 0; d < 2; ++d) { const int r = d ? 63 - c : c; const float e = __expf(GC[d * 64 + r]); const int i = r >> 5, rr = r & 31;
                    unsigned char* fb = gdn_rec(ws, d, ci, h) + REC_FQ + (((i * 4 + t) * 2 + s) * 64) * 16 + b * 8;
                    v2u lo, hi2; lo.x = cvtpk(y[0] * e, y[1] * e); lo.y = cvtpk(y[2] * e, y[3] * e); hi2.x = cvtpk(y[4] * e, y[5] * e); hi2.y = cvtpk(y[6] * e, y[7] * e);
                    *(v2u*)(fb + rr * 16) = lo; *(v2u*)(fb + (rr + 32) * 16) = hi2; }
            } else if (mat == 1) {
                v4u o; o.x = cvtpk(y[0], y[1]); o.y = cvtpk(y[2], y[3]); o.z = cvtpk(y[4], y[5]); o.w = cvtpk(y[6], y[7]);
                *(LAS v4u*)(lds + D1_KROW + c * ROWP + ch0 * 2) = o;
#pragma unroll
                for (int e = 0; e < 8; ++e) *(LAS bf16*)(lds + D1_KT + TSW(ch0 + e, c * 2)) = f2bf1(y[e]);
            } else {
#pragma unroll
                for (int e = 0; e < 8; ++e) *(LAS bf16*)(lds + D1_VT + TSW(ch0 + e, c * 2)) = f2bf1(y[e]);
            }
        }
    }
    __syncthreads();
    for (int rep2 = 0; rep2 < (DUP_D1 == 2 ? 2 : 1); ++rep2) {
        const int r32 = lane & 31, hi = lane >> 5;
#pragma unroll 1
        for (int k = wave; k < 12; k += 8) {
            const int d = k / 6, sel = k % 6;
            int ta, tb; int boff;
            if (sel < 3) { ta = (sel >= 1); tb = (sel == 2); boff = D1_KROW; }
            else { ta = (sel == 5); tb = (sel >= 4); boff = D1_QROW; }
            const int ra = 32 * ta + r32, rb = 32 * tb + r32;
            const int rowa = d ? 63 - ra : ra, rowb = d ? 63 - rb : rb;
            const LAS unsigned char* pa = lds + D1_KROW + rowa * ROWP + hi * 16; const LAS unsigned char* pb = lds + boff + rowb * ROWP + hi * 16;
            f32x16 acc = {0.f, 0.f, 0.f, 0.f, 0.f, 0.f, 0.f, 0.f, 0.f, 0.f, 0.f, 0.f, 0.f, 0.f, 0.f, 0.f};
#pragma unroll
            for (int s = 0; s < 8; ++s) acc = MFMA32(*(const LAS bf16x8*)(pa + s * 32), *(const LAS bf16x8*)(pb + s * 32), acc);
            const int colp = 32 * tb + r32;
            const float gcc = GC[d * 64 + colp];
            if (sel < 3) {
                LAS float* Lm = (LAS float*)(lds + D1_LM + d * 17408);
#pragma unroll
                for (int r = 0; r < 16; ++r) { const int rp = 32 * ta + crow(r, hi);
                    const float v = (rp > colp) ? BETA[d * 64 + rp] * acc[r] * __expf(GC[d * 64 + rp] - gcc) : 0.f;
                    Lm[rp * (LMP / 4) + colp] = v; }
            } else {
                float v[16];
#pragma unroll
                for (int r = 0; r < 16; ++r) { const int cp = 32 * ta + crow(r, hi);
                    v[r] = (colp >= cp) ? acc[r] * __expf(gcc - GC[d * 64 + cp]) : 0.f; }
                unsigned char* fb = gdn_rec(ws, d, ci, h) + REC_FQK + (((tb * 2 + ta) * 2) * 64 + lane) * 16;
                v4u o0, o1; o0.x = cvtpk(v[0], v[1]); o0.y = cvtpk(v[2], v[3]); o0.z = cvtpk(v[4], v[5]); o0.w = cvtpk(v[6], v[7]);
                o1.x = cvtpk(v[8], v[9]); o1.y = cvtpk(v[10], v[11]); o1.z = cvtpk(v[12], v[13]); o1.w = cvtpk(v[14], v[15]);
                *(v4u*)fb = o0; *(v4u*)(fb + 1024) = o1;
            }
        }
    }
    __syncthreads();
    constexpr int D1_TS = D1_QROW;
    for (int rep3 = 0; rep3 < (DUP_D1 == 3 ? 2 : 1); ++rep3)
    if (wave < 4) {
        const int d = wave >> 1, blk = wave & 1, j = lane & 31, jp = 32 * blk + j;
        const LAS float* Lm = (const LAS float*)(lds + D1_LM + d * 17408) + (32 * blk) * (LMP / 4) + 32 * blk;
        const float bj = BETA[d * 64 + jp], bgj = bj * __expf(GC[d * 64 + jp]);
        const int col = d ? 63 - jp : jp;
        LAS unsigned char* tb = lds + D1_TB + d * 18432 + (32 * blk) * TBP + col * 2;
        LAS float* ts = (LAS float*)(lds + D1_TS + (d * 2 + blk) * 4352) + j;
        if (lane < 32) {
            float t[32];
#pragma unroll
            for (int r = 0; r < 32; ++r) {
                float a4[4] = {(r == j) ? 1.f : 0.f, 0.f, 0.f, 0.f};
#pragma unroll
                for (int m4 = 0; m4 < (r + 3) / 4; ++m4) { const f32x4 lv = *(const LAS f32x4*)(Lm + r * (LMP / 4) + m4 * 4);
#pragma unroll
                    for (int e = 0; e < 4; ++e) if (m4 * 4 + e < r) a4[e] -= lv[e] * t[m4 * 4 + e]; }
                const float a = (a4[0] + a4[1]) + (a4[2] + a4[3]);
                t[r] = a; ts[r * 33] = a;
                *(LAS bf16*)(tb + r * TBP) = f2bf1(a * bj); *(LAS bf16*)(tb + 9216 + r * TBP) = f2bf1(a * bgj);
            }
        } else if (blk == 0) {
            const int colz = d ? 63 - (32 + j) : 32 + j; LAS unsigned char* tz = lds + D1_TB + d * 18432 + colz * 2;
#pragma unroll
            for (int r = 0; r < 32; ++r) { *(LAS bf16*)(tz + r * TBP) = (bf16)0; *(LAS bf16*)(tz + 9216 + r * TBP) = (bf16)0; }
        }
    } else {
        const int rr = lane & 31, hh = lane >> 5;
#pragma unroll 1
        for (int f = wave - 4; f < 32; f += 4) {
            const int d = f >> 4, t = (f >> 2) & 3, ip = (f >> 1) & 1, s = f & 1;
            const int c0 = 32 * ip + 16 * s + 4 * hh;
            const float gl = GC[d * 64 + 63];
            const int ktr = 32 * t + rr; const LAS unsigned char* kt = lds + D1_KT;
            float ea[4], eb[4];
#pragma unroll
            for (int x = 0; x < 4; ++x) { ea[x] = __expf(gl - GC[d * 64 + c0 + x]); eb[x] = __expf(gl - GC[d * 64 + c0 + 8 + x]); }
            float ka[4], kb[4];
            if (d == 0) { const v2u wa = *(const LAS v2u*)(kt + TSW(ktr, c0 * 2)), wb = *(const LAS v2u*)(kt + TSW(ktr, (c0 + 8) * 2));
                ka[0] = bflo(wa.x); ka[1] = bfhi(wa.x); ka[2] = bflo(wa.y); ka[3] = bfhi(wa.y); kb[0] = bflo(wb.x); kb[1] = bfhi(wb.x); kb[2] = bflo(wb.y); kb[3] = bfhi(wb.y); }
            else { const v2u wa = *(const LAS v2u*)(kt + TSW(ktr, (60 - c0) * 2)), wb = *(const LAS v2u*)(kt + TSW(ktr, (52 - c0) * 2));
                ka[3] = bflo(wa.x); ka[2] = bfhi(wa.x); ka[1] = bflo(wa.y); ka[0] = bfhi(wa.y); kb[3] = bflo(wb.x); kb[2] = bfhi(wb.x); kb[1] = bflo(wb.y); kb[0] = bfhi(wb.y); }
            v4u o; o.x = cvtpk(ka[0] * ea[0], ka[1] * ea[1]); o.y = cvtpk(ka[2] * ea[2], ka[3] * ea[3]); o.z = cvtpk(kb[0] * eb[0], kb[1] * eb[1]); o.w = cvtpk(kb[2] * eb[2], kb[3] * eb[3]);
            *(v4u*)(gdn_rec(ws, d, ci, h) + REC_FK + (((t * 2 + ip) * 2 + s) * 64 + lane) * 16) = o;
        }
    }
    __syncthreads();
    if (wave < 2) {
        const int d = wave, i = lane & 31, hh = lane >> 5;
        const LAS float* L21 = (const LAS float*)(lds + D1_LM + d * 17408) + (32 + i) * (LMP / 4);
        const LAS float* T11 = (const LAS float*)(lds + D1_TS + (d * 2 + 0) * 4352);
        const LAS float* T22 = (const LAS float*)(lds + D1_TS + (d * 2 + 1) * 4352);
        f32x16 P = {0.f, 0.f, 0.f, 0.f, 0.f, 0.f, 0.f, 0.f, 0.f, 0.f, 0.f, 0.f, 0.f, 0.f, 0.f, 0.f};
#pragma unroll
        for (int s = 0; s < 16; ++s) P = __builtin_amdgcn_mfma_f32_32x32x2f32(L21[2 * s + hh], T11[(2 * s + hh) * 33 + i], P, 0, 0, 0);
        f32x16 R = {0.f, 0.f, 0.f, 0.f, 0.f, 0.f, 0.f, 0.f, 0.f, 0.f, 0.f, 0.f, 0.f, 0.f, 0.f, 0.f};
#pragma unroll
        for (int s = 0; s < 16; ++s) R = __builtin_amdgcn_mfma_f32_32x32x2f32(T22[i * 33 + crow(s, hh)], P[s], R, 0, 0, 0);
        const float bj = BETA[d * 64 + i], bgj = bj * __expf(GC[d * 64 + i]);
        const int col = d ? 63 - i : i;
        LAS unsigned char* tb = lds + D1_TB + d * 18432 + 32 * TBP + col * 2;
#pragma unroll
        for (int r = 0; r < 16; ++r) { const float a = -R[r]; const int row = crow(r, hh);
            *(LAS bf16*)(tb + row * TBP) = f2bf1(a * bj); *(LAS bf16*)(tb + 9216 + row * TBP) = f2bf1(a * bgj); }
    }
    __syncthreads();
    for (int rep4 = 0; rep4 < (DUP_D1 == 4 ? 2 : 1); ++rep4) {
        const int r32 = lane & 31, hi = lane >> 5;
#pragma unroll 1
        for (int f = wave; f < 32; f += 8) {
            const int d = f >> 4, kind = (f >> 3) & 1, idx = f & 7;
            const LAS unsigned char* pa; const LAS unsigned char* pb; int xa = 0, xb = 0;
            if (kind == 0) { const int i = idx >> 2, w = idx & 3;
                pa = lds + D1_TB + d * 18432 + (32 * i + r32) * TBP; pb = lds + D1_VT + (32 * w + r32) * TRP; xb = (((32 * w + r32) >> 3) & 7) << 4; }
            else { const int t = idx >> 1, i = idx & 1;
                pa = lds + D1_KT + (32 * t + r32) * TRP; xa = (((32 * t + r32) >> 3) & 7) << 4; pb = lds + D1_TB + d * 18432 + 9216 + (32 * i + r32) * TBP; }
            f32x16 acc = {0.f, 0.f, 0.f, 0.f, 0.f, 0.f, 0.f, 0.f, 0.f, 0.f, 0.f, 0.f, 0.f, 0.f, 0.f, 0.f};
#pragma unroll
            for (int s = 0; s < 4; ++s) acc = MFMA32(*(const LAS bf16x8*)(pa + ((s * 32 + hi * 16) ^ xa)), *(const LAS bf16x8*)(pb + ((s * 32 + hi * 16) ^ xb)), acc);
            const float sg = kind ? -1.f : 1.f;
            v4u o0, o1; o0.x = cvtpk(sg * acc[0], sg * acc[1]); o0.y = cvtpk(sg * acc[2], sg * acc[3]); o0.z = cvtpk(sg * acc[4], sg * acc[5]); o0.w = cvtpk(sg * acc[6], sg * acc[7]);
            o1.x = cvtpk(sg * acc[8], sg * acc[9]); o1.y = cvtpk(sg * acc[10], sg * acc[11]); o1.z = cvtpk(sg * acc[12], sg * acc[13]); o1.w = cvtpk(sg * acc[14], sg * acc[15]);
            if (kind == 0) { const int i = idx >> 2, w = idx & 3; unsigned char* fb = gdn_rec(ws, d, ci, h) + REC_FU + ((w * 2 + i) * 64 + lane) * 32; *(v4u*)fb = o0; *(v4u*)(fb + 16) = o1; }
            else { const int t = idx >> 1, i = idx & 1; unsigned char* fb = gdn_rec(ws, d, ci, h) + REC_FW + (((i * 4 + t) * 2) * 64 + lane) * 16; *(v4u*)fb = o0; *(v4u*)(fb + 1024) = o1; }
        }
    }
    __syncthreads();
}
__device__ __forceinline__ bf16x8 pack8(const f32x16& v, int s) {
    v4u w; w.x = cvtpk(v[8 * s + 0], v[8 * s + 1]); w.y = cvtpk(v[8 * s + 2], v[8 * s + 3]); w.z = cvtpk(v[8 * s + 4], v[8 * s + 5]); w.w = cvtpk(v[8 * s + 6], v[8 * s + 7]);
    return __builtin_bit_cast(bf16x8, w);
}
#define SCAN_BAR() do { asm volatile("s_waitcnt lgkmcnt(0)" ::: "memory"); __builtin_amdgcn_s_barrier(); asm volatile("" ::: "memory"); } while (0)
constexpr int SC_BUF = REC_BYTES;
__device__ __forceinline__ void gdn_scan_unit(LAS unsigned char* lds, unsigned char* ws, int Tp, int sq, int h, int d, int half, int tid, int wave, int lane) {
    const int Nc = Tp / 64, cb = sq * Nc;
    bf16* ODIR = (bf16*)(ws + WS_ODIR) + (size_t)d * PASS_ROWS * 1024;
#define SC_SRC(n) ((const unsigned char*)gdn_rec(ws, d, cb + (d ? Nc - 1 - (n) : (n)), h))
    if (wave >= 2) {
        const int lt = tid - 128;
#define SC_LOAD(st, n) do { const unsigned char* src_ = SC_SRC(n); _Pragma("unroll") for (int k = 0; k < 12; ++k) st[k] = *(const v4u*)(src_ + (lt + 384 * k) * 16); } while (0)
#define SC_WRITE(st, b) do { _Pragma("unroll") for (int k = 0; k < 12; ++k) *(LAS v4u*)(lds + (b) * SC_BUF + (lt + 384 * k) * 16) = st[k]; } while (0)
        v4u s0[12], s1[12];
        SC_LOAD(s0, 0); SC_WRITE(s0, 0);
        if (1 < Nc) SC_LOAD(s1, 1);
        if (2 < Nc) SC_LOAD(s0, 2);
        SCAN_BAR();
#define SC_STEP(n, st) do { if ((n) < Nc) { if ((n) + 1 < Nc) SC_WRITE(st, ((n) + 1) & 1); if ((n) + 3 < Nc) SC_LOAD(st, (n) + 3); SCAN_BAR(); } } while (0)
#pragma unroll 1
        for (int n = 0; n < Nc; n += 2) { SC_STEP(n, s1); SC_STEP(n + 1, s0); }
#undef SC_STEP
#undef SC_WRITE
#undef SC_LOAD
    } else {
        const int w = half * 2 + wave, r32 = lane & 31, hi = lane >> 5;
        f32x16 S[4];
#pragma unroll
        for (int t = 0; t < 4; ++t)
#pragma unroll
            for (int r = 0; r < 16; ++r) S[t][r] = 0.f;
        const __amdgpu_buffer_rsrc_t orsrc = __builtin_amdgcn_make_buffer_rsrc((void*)(ODIR + (size_t)(sq * Tp) * 1024 + h * 128 + 32 * w), 0, 0x7fffffff, 0x00020000);
        SCAN_BAR();
#pragma unroll 1
        for (int n = 0; n < Nc; ++n) {
            const LAS unsigned char* buf = lds + (n & 1) * SC_BUF + lane * 16;
            const float gam = *(const LAS float*)(lds + (n & 1) * SC_BUF + REC_GAM);
#define LDF(off) (*(const LAS bf16x8*)(buf + (off)))
#define FWO(i, t, s) (REC_FW + (((i) * 4 + (t)) * 2 + (s)) * 1024)
#define FQO(i, t, s) (REC_FQ + (((i) * 4 + (t)) * 2 + (s)) * 1024)
#define FKO(t, ip, s) (REC_FK + (((t) * 2 + (ip)) * 2 + (s)) * 1024)
#define FQKO(i, ip, s) (REC_FQK + (((i) * 2 + (ip)) * 2 + (s)) * 1024)
            bf16x8 A[8], B[8];
#pragma unroll
            for (int e = 0; e < 8; ++e) { A[e] = LDF(FWO(e & 1, e >> 2, (e >> 1) & 1)); B[e] = LDF(FWO(e & 1, 2 + (e >> 2), (e >> 1) & 1)); }
            v4u ua[2], ub[2];
#pragma unroll
            for (int i = 0; i < 2; ++i) { const LAS v4u* pu = (const LAS v4u*)(lds + (n & 1) * SC_BUF + REC_FU + ((w * 2 + i) * 64 + lane) * 32); ua[i] = pu[0]; ub[i] = pu[1]; }
            __builtin_amdgcn_sched_barrier(0);
            bf16x8 Sf[4][2];
#pragma unroll
            for (int t = 0; t < 4; ++t) { Sf[t][0] = pack8(S[t], 0); Sf[t][1] = pack8(S[t], 1); }
            f32x16 V[2];
#pragma unroll
            for (int i = 0; i < 2; ++i) { const v4u a = ua[i], b = ub[i];
                V[i][0] = bflo(a.x); V[i][1] = bfhi(a.x); V[i][2] = bflo(a.y); V[i][3] = bfhi(a.y); V[i][4] = bflo(a.z); V[i][5] = bfhi(a.z); V[i][6] = bflo(a.w); V[i][7] = bfhi(a.w);
                V[i][8] = bflo(b.x); V[i][9] = bfhi(b.x); V[i][10] = bflo(b.y); V[i][11] = bfhi(b.y); V[i][12] = bflo(b.z); V[i][13] = bfhi(b.z); V[i][14] = bflo(b.w); V[i][15] = bfhi(b.w); }
            __builtin_amdgcn_sched_barrier(0);
#pragma unroll
            for (int e = 0; e < 8; ++e) V[e & 1] = MFMA32(A[e], Sf[e >> 2][(e >> 1) & 1], V[e & 1]);
            __builtin_amdgcn_sched_barrier(0);
#pragma unroll
            for (int e = 0; e < 8; ++e) A[e] = LDF(FQO(e & 1, e >> 2, (e >> 1) & 1));
            __builtin_amdgcn_sched_barrier(0);
#pragma unroll
            for (int e = 0; e < 8; ++e) V[e & 1] = MFMA32(B[e], Sf[2 + (e >> 2)][(e >> 1) & 1], V[e & 1]);
            __builtin_amdgcn_sched_barrier(0);
#pragma unroll
            for (int e = 0; e < 8; ++e) B[e] = LDF(FQO(e & 1, 2 + (e >> 2), (e >> 1) & 1));
            __builtin_amdgcn_sched_barrier(0);
            f32x16 O[2];
#pragma unroll
            for (int i = 0; i < 2; ++i)
#pragma unroll
                for (int r = 0; r < 16; ++r) O[i][r] = 0.f;
#pragma unroll
            for (int e = 0; e < 8; ++e) O[e & 1] = MFMA32(A[e], Sf[e >> 2][(e >> 1) & 1], O[e & 1]);
            __builtin_amdgcn_sched_barrier(0);
#pragma unroll
            for (int e = 0; e < 8; ++e) A[e] = LDF(FKO(e & 3, 0, e >> 2));
            bf16x8 Vf[2][2];
#pragma unroll
            for (int i = 0; i < 2; ++i) { Vf[i][0] = pack8(V[i], 0); Vf[i][1] = pack8(V[i], 1); }
#pragma unroll
            for (int t = 0; t < 4; ++t)
#pragma unroll
                for (int r = 0; r < 16; ++r) S[t][r] *= gam;
            __builtin_amdgcn_sched_barrier(0);
#pragma unroll
            for (int e = 0; e < 8; ++e) O[e & 1] = MFMA32(B[e], Sf[2 + (e >> 2)][(e >> 1) & 1], O[e & 1]);
            __builtin_amdgcn_sched_barrier(0);
#pragma unroll
            for (int e = 0; e < 8; ++e) B[e] = LDF(FKO(e & 3, 1, e >> 2));
            __builtin_amdgcn_sched_barrier(0);
#pragma unroll
            for (int e = 0; e < 8; ++e) S[e & 3] = MFMA32(A[e], Vf[0][e >> 2], S[e & 3]);
            __builtin_amdgcn_sched_barrier(0);
            A[0] = LDF(FQKO(0, 0, 0)); A[1] = LDF(FQKO(1, 0, 0)); A[2] = LDF(FQKO(0, 0, 1)); A[3] = LDF(FQKO(1, 0, 1)); A[4] = LDF(FQKO(1, 1, 0)); A[5] = LDF(FQKO(1, 1, 1));
            __builtin_amdgcn_sched_barrier(0);
#pragma unroll
            for (int e = 0; e < 8; ++e) S[e & 3] = MFMA32(B[e], Vf[1][e >> 2], S[e & 3]);
            __builtin_amdgcn_sched_barrier(0);
            O[0] = MFMA32(A[0], Vf[0][0], O[0]); O[1] = MFMA32(A[1], Vf[0][0], O[1]); O[0] = MFMA32(A[2], Vf[0][1], O[0]); O[1] = MFMA32(A[3], Vf[0][1], O[1]);
            O[1] = MFMA32(A[4], Vf[1][0], O[1]); O[1] = MFMA32(A[5], Vf[1][1], O[1]);
#undef LDF
#undef FWO
#undef FQO
#undef FKO
#undef FQKO
            { const int tau0 = 64 * n + 4 * hi;
#pragma unroll
              for (int i = 0; i < 2; ++i)
#pragma unroll
                for (int r = 0; r < 16; ++r) { const int tau = tau0 + 32 * i + (r & 3) + 8 * (r >> 2); const int trow = d ? Tp - 1 - tau : tau;
                    __builtin_amdgcn_raw_buffer_store_b16((short)f2bf1(O[i][r]), orsrc, (trow * 1024 + r32) * 2, 0, 0); } }
            SCAN_BAR();
        }
    }
#undef SC_SRC
}
#define KSWZ(row, colB) ((row) * 256 + ((colB) ^ (((row) & 7) << 4)))
#define SBAR() __builtin_amdgcn_sched_barrier(0)
constexpr int AT_V = 0, AT_K = 32768, AT_OST = 0, AT_OST_W = 16896, AT_WS = 8 * AT_OST_W;
constexpr float ATT_THR = 11.5f;
__device__ __forceinline__ int v_st(int k, int c) { const int kk = (k & ~0xC) | ((k & 4) << 1) | ((k & 8) >> 1); return ((kk >> 3) * 4 + (c >> 5)) * 512 + ((kk & 7) * 32 + (c & 31)) * 2; }
__device__ __forceinline__ int v_rd_base(int lane) { return ((lane & 3) << 3) | (((lane >> 2) & 3) << 6) | (((lane >> 4) & 1) << 5) | (((lane >> 5) & 1) << 8); }
constexpr int v_rd_off(int d0, int ks, int half) { return d0 * 512 + ks * 4096 + half * 2048; }
template <int OFF> __device__ __forceinline__ s16x4 tr_read(int vb) {
    s16x4 r; asm volatile("ds_read_b64_tr_b16 %0, %1 offset:%2" : "=&v"(r) : "v"(vb), "i"(OFF) : "memory"); return r;
}
struct VFrag { s16x4 l0, h0, l1, h1, l2, h2, l3, h3; };
template <int D0> __device__ __forceinline__ void vfrag_issue(VFrag& f, int vb) {
    f.l0 = tr_read<v_rd_off(D0, 0, 0)>(vb); f.h0 = tr_read<v_rd_off(D0, 0, 1)>(vb); f.l1 = tr_read<v_rd_off(D0, 1, 0)>(vb); f.h1 = tr_read<v_rd_off(D0, 1, 1)>(vb);
    f.l2 = tr_read<v_rd_off(D0, 2, 0)>(vb); f.h2 = tr_read<v_rd_off(D0, 2, 1)>(vb); f.l3 = tr_read<v_rd_off(D0, 3, 0)>(vb); f.h3 = tr_read<v_rd_off(D0, 3, 1)>(vb);
}
__device__ __forceinline__ void pv_mma(f32x16& od, const VFrag& f, bf16x8 pa0, bf16x8 pa1, bf16x8 pa2, bf16x8 pa3) {
#define PK(L, H) (bf16x8){L[0], L[1], L[2], L[3], H[0], H[1], H[2], H[3]}
    od = MFMA32(pa0, PK(f.l0, f.h0), od); od = MFMA32(pa1, PK(f.l1, f.h1), od); od = MFMA32(pa2, PK(f.l2, f.h2), od); od = MFMA32(pa3, PK(f.l3, f.h3), od);
#undef PK
}
__device__ __forceinline__ void pv_d0(f32x16* o, VFrag& f0, int vb, bf16x8 pa0, bf16x8 pa1, bf16x8 pa2, bf16x8 pa3) {
    VFrag f1;
    SBAR(); vfrag_issue<1>(f1, vb);
    asm volatile("s_waitcnt lgkmcnt(8)" ::: "memory"); SBAR(); pv_mma(o[0], f0, pa0, pa1, pa2, pa3);
    SBAR(); vfrag_issue<2>(f0, vb);
    asm volatile("s_waitcnt lgkmcnt(8)" ::: "memory"); SBAR(); pv_mma(o[1], f1, pa0, pa1, pa2, pa3);
    SBAR(); vfrag_issue<3>(f1, vb);
    asm volatile("s_waitcnt lgkmcnt(8)" ::: "memory"); SBAR(); pv_mma(o[2], f0, pa0, pa1, pa2, pa3);
    asm volatile("s_waitcnt lgkmcnt(0)" ::: "memory"); SBAR(); pv_mma(o[3], f1, pa0, pa1, pa2, pa3);
    SBAR();
}
template <bool FIXED>
__device__ __forceinline__ float softmax_tile(f32x16& p0, f32x16& p1, float& m_reg, float& l_reg, bf16x8& pa0, bf16x8& pa1, bf16x8& pa2, bf16x8& pa3) {
    float alpha = 1.f;
    if (!FIXED) {
        float pmax = p0[0];
#pragma unroll
        for (int r = 1; r < 16; ++r) pmax = fmaxf(pmax, p0[r]);
#pragma unroll
        for (int r = 0; r < 16; ++r) pmax = fmaxf(pmax, p1[r]);
        pmax = half_max(pmax);
        if (!__all(pmax - m_reg <= ATT_THR)) { const float mn = fmaxf(m_reg, pmax); alpha = __builtin_amdgcn_exp2f(m_reg - mn); m_reg = mn; }
        const float mn = m_reg;
#pragma unroll
        for (int r = 0; r < 16; ++r) { p0[r] = __builtin_amdgcn_exp2f(p0[r] - mn); p1[r] = __builtin_amdgcn_exp2f(p1[r] - mn); }
    } else {
#pragma unroll
        for (int r = 0; r < 16; ++r) { p0[r] = __builtin_amdgcn_exp2f(p0[r]); p1[r] = __builtin_amdgcn_exp2f(p1[r]); }
    }
    float ps = 0.f;
#pragma unroll
    for (int r = 0; r < 16; ++r) ps += p0[r];
#pragma unroll
    for (int r = 0; r < 16; ++r) ps += p1[r];
    ps = half_sum(ps);
    l_reg = l_reg * alpha + ps;
#define PK4(P, BASE, OUT) do { unsigned a0 = cvtpk(P[BASE + 0], P[BASE + 1]), a1 = cvtpk(P[BASE + 2], P[BASE + 3]);   \
    unsigned b0 = cvtpk(P[BASE + 4], P[BASE + 5]), b1 = cvtpk(P[BASE + 6], P[BASE + 7]);                              \
    auto r0 = __builtin_amdgcn_permlane32_swap(a0, b0, false, false); auto r1 = __builtin_amdgcn_permlane32_swap(a1, b1, false, false); \
    v4u w = {r0[0], r1[0], r0[1], r1[1]}; OUT = __builtin_bit_cast(bf16x8, w); } while (0)
    PK4(p0, 0, pa0); PK4(p0, 8, pa1); PK4(p1, 0, pa2); PK4(p1, 8, pa3);
#undef PK4
    return alpha;
}

__device__ __forceinline__ int diff_radius(float bnat, int h) {
    const float slope_n = exp2f(-(float)(h + 1));
    const float dn = (2.0f * bnat + logf(2.0f / (1.0f - expf(-slope_n))) + 22.18f) / slope_n;
    return (dn < 1.0e6f) ? (int)dn + 1 : 1000000;
}
struct AttnParams { const float* q_gain; const float* sink; const float* lam; const float* norm_gain; float bnat; };
#define KSWZ64(row, colB) ((row) * 128 + ((colB) ^ ((((row) >> 1) & 7) << 4)))

template <int MODE, bool FIXED>
__device__ __forceinline__ void attn_unit(LAS unsigned char* lds, unsigned char* ws, const AttnParams& P, int l, int Tp, int sq, int h, int qb, int part, int np, int pslot, int tid, int wave, int lane) {
    constexpr int NPASS_M = MODE ? 2 : 1, NDD = MODE ? 4 : 8;
    const bf16* PROJ = (const bf16*)(ws + WS_PROJ);
    const int r32 = lane & 31, hi = lane >> 5;
    const int seq0 = sq * Tp, q0 = qb * 256;
    const int qcol = MODE ? C_DQ + h * 128 : C_SQ + h * 128;
    const int kcol = MODE ? C_DK + h * 128 : C_SKV + (h >> 2) * 128;
    const int vcol = MODE ? C_DV + h * 128 : C_SKV + 256 + (h >> 2) * 128;
    const int zcol = MODE ? C_DZ + h * 128 : C_SZ + h * 128;
    int jlo = 0, jhi = Tp / 64;
    const float slope_n = exp2f(-(float)(h + 1)), slope2 = slope_n * LOG2E;
    if (MODE == 0) { jlo = (q0 - 128) / 64; if (jlo < 0) jlo = 0; const int e = (q0 + 384) / 64; if (e < jhi) jhi = e; }
    else {
        float bn = P.bnat; asm volatile("" : "+v"(bn));
        float smin = 1.0e30f;
        { const bf16* qp = PROJ + (size_t)(seq0 + q0 + wave * 32 + r32) * LDP + qcol + hi * 8; const bf16* kp = PROJ + (size_t)(seq0 + q0 + wave * 32 + r32) * LDP + kcol + hi * 8;
#pragma unroll
          for (int mq = 0; mq < 2; ++mq) { float ss = 0.f, dot = 0.f;
#pragma unroll
              for (int d0 = 0; d0 < 4; ++d0) { const v4u wq = *(const v4u*)(qp + mq * 64 + d0 * 16), wk = *(const v4u*)(kp + mq * 64 + d0 * 16);
                  const float* g = P.q_gain + d0 * 16 + hi * 8; const f32x4 ga = *(const f32x4*)g, gb = *(const f32x4*)(g + 4);
                  const float q8[8] = {bflo(wq.x), bfhi(wq.x), bflo(wq.y), bfhi(wq.y), bflo(wq.z), bfhi(wq.z), bflo(wq.w), bfhi(wq.w)};
                  const float k8[8] = {bflo(wk.x), bfhi(wk.x), bflo(wk.y), bfhi(wk.y), bflo(wk.z), bfhi(wk.z), bflo(wk.w), bfhi(wk.w)};
                  const float g8[8] = {ga.x, ga.y, ga.z, ga.w, gb.x, gb.y, gb.z, gb.w};
#pragma unroll
                  for (int e = 0; e < 8; ++e) { ss += q8[e] * q8[e]; dot += q8[e] * g8[e] * k8[e]; } }
              ss = half_sum(ss); dot = half_sum(dot);
              smin = fminf(smin, dot * (1.0f / sqrtf(ss * (1.0f / 64.0f) + NORM_EPS)) * 0.125f); }
          smin = -wave_max(-smin);
          LAS float* sm = (LAS float*)(lds + AT_WS) + 512;
          if (lane == 0) sm[wave] = smin;
          asm volatile("s_waitcnt lgkmcnt(0)" ::: "memory"); __builtin_amdgcn_s_barrier(); asm volatile("" ::: "memory");
          smin = fminf(fminf(fminf(sm[0], sm[1]), fminf(sm[2], sm[3])), fminf(fminf(sm[4], sm[5]), fminf(sm[6], sm[7]))); }
        float beff = 0.5f * (bn - smin + 0.1f); if (!(beff < bn)) beff = bn;
        const int dk = diff_radius(beff, h);
        const int a = q0 - dk; jlo = a > 0 ? (a >> 6) : 0; const int e = ((q0 + 255 + dk) >> 6) + 1; if (e < jhi) jhi = e;
        if (np > 1) { const int len = (jhi - jlo + np - 1) / np; jlo += part * len; const int e2 = jlo + len; if (e2 < jhi) jhi = e2; }
    }
    LAS unsigned char* V_lds = lds + AT_V; LAS unsigned char* K_lds = lds + AT_K;
    LAS float* wsf = (LAS float*)(lds + AT_WS) + wave * 64; LAS float* li_l = wsf; LAS float* al_l = wsf + 32;
    float* park = (float*)(ws + WS_PARK) + (size_t)(blockIdx.x * NWAVES + wave) * 4096 + lane * 4;
    const float qposh = (float)(q0 + wave * 32 + r32 - 4 * hi);
    const int vb0 = (int)(uintptr_t)V_lds + v_rd_base(lane);
    const int sr = tid >> 4, sc = (tid & 15) * 8, vst0 = v_st(sr, sc), vst1 = v_st(32 + sr, sc);
    const int kr1 = tid >> 3, kc1 = (tid & 7) * 8;
    f32x16 o[4]; float l_reg = 0.f;
#pragma unroll 1
    for (int mp = 0; mp < NPASS_M; ++mp) {
        bf16x8 qr[NDD];
        {
            const bf16* qp = PROJ + (size_t)(seq0 + q0 + wave * 32 + r32) * LDP + qcol + mp * 64 + hi * 8;
            float qf[NDD][8]; float ss = 0.f;
#pragma unroll
            for (int d0 = 0; d0 < NDD; ++d0) { const v4u w = *(const v4u*)(qp + d0 * 16);
                qf[d0][0] = bflo(w.x); qf[d0][1] = bfhi(w.x); qf[d0][2] = bflo(w.y); qf[d0][3] = bfhi(w.y); qf[d0][4] = bflo(w.z); qf[d0][5] = bfhi(w.z); qf[d0][6] = bflo(w.w); qf[d0][7] = bfhi(w.w);
#pragma unroll
                for (int e = 0; e < 8; ++e) ss += qf[d0][e] * qf[d0][e]; }
            ss = half_sum(ss);
            const float rs = MODE ? (1.0f / sqrtf(ss * (1.0f / 64.0f) + NORM_EPS)) * (0.125f * LOG2E) : (1.0f / sqrtf(ss * (1.0f / 128.0f) + NORM_EPS)) * (0.08838834764831845f * LOG2E);
#pragma unroll
            for (int d0 = 0; d0 < NDD; ++d0) { const float* g = P.q_gain + d0 * 16 + hi * 8;
                const f32x4 ga = *(const f32x4*)g, gb = *(const f32x4*)(g + 4);
                v4u w; w.x = cvtpk(qf[d0][0] * rs * ga.x, qf[d0][1] * rs * ga.y); w.y = cvtpk(qf[d0][2] * rs * ga.z, qf[d0][3] * rs * ga.w);
                w.z = cvtpk(qf[d0][4] * rs * gb.x, qf[d0][5] * rs * gb.y); w.w = cvtpk(qf[d0][6] * rs * gb.z, qf[d0][7] * rs * gb.w);
                qr[d0] = __builtin_bit_cast(bf16x8, w); }
        }
        float m_reg = (MODE == 0) ? P.sink[h] * LOG2E : -1e30f; l_reg = (MODE == 0) ? (FIXED ? exp2f(P.sink[h] * LOG2E) : 1.f) : 0.f;
#pragma unroll
        for (int d = 0; d < 4; ++d)
#pragma unroll
            for (int r = 0; r < 16; ++r) o[d][r] = 0.f;
        const bf16* Vg = PROJ + (size_t)seq0 * LDP + vcol + sc;
        const bf16* Kg = MODE ? PROJ + (size_t)(seq0 + kr1) * LDP + kcol + mp * 64 + kc1 : PROJ + (size_t)seq0 * LDP + kcol + sc;
        constexpr int DEPTH = 1;
        struct Stg { v4u vs0, vs1, ks0, ks1; };
        Stg sA, sB;
#define SLOAD(S, k0) do { S.vs0 = *(const v4u*)(Vg + (size_t)((k0) + sr) * LDP); S.vs1 = *(const v4u*)(Vg + (size_t)((k0) + 32 + sr) * LDP); \
        if (MODE) { S.ks0 = *(const v4u*)(Kg + (size_t)(k0) * LDP); } \
        else { S.ks0 = *(const v4u*)(Kg + (size_t)((k0) + sr) * LDP); S.ks1 = *(const v4u*)(Kg + (size_t)((k0) + 32 + sr) * LDP); } } while (0)
#define SWRITE(S, b) do { *(LAS v4u*)(V_lds + (b) * 16384 + vst0) = S.vs0; *(LAS v4u*)(V_lds + (b) * 16384 + vst1) = S.vs1; \
        if (MODE) { *(LAS v4u*)(K_lds + (b) * 16384 + KSWZ64(kr1, kc1 * 2)) = S.ks0; } \
        else { *(LAS v4u*)(K_lds + (b) * 16384 + KSWZ(sr, sc * 2)) = S.ks0; *(LAS v4u*)(K_lds + (b) * 16384 + KSWZ(32 + sr, sc * 2)) = S.ks1; } } while (0)
#define TILE(S, jj) do { const int j_ = (jj); const int b_ = (j_ - jlo) & 1; \
            SWRITE(S, b_); \
            if (j_ + DEPTH < jhi) SLOAD(S, (j_ + DEPTH) * 64); \
            asm volatile("s_waitcnt lgkmcnt(0)" ::: "memory"); __builtin_amdgcn_s_barrier(); asm volatile("" ::: "memory"); \
              \
            if (MODE == 1 || (j_ * 64 + 63 >= q0 + wave * 32 - 128 && j_ * 64 <= q0 + wave * 32 + 31 + 128)) { \
            const LAS unsigned char* Kb = K_lds + b_ * 16384; const int vb = vb0 + b_ * 16384; \
            const float fi = qposh - (float)(j_ * 64);                 \
            f32x16 p0, p1; \
            _Pragma("unroll") for (int r = 0; r < 16; ++r) { p0[r] = 0.f; p1[r] = 0.f; } \
            _Pragma("unroll") for (int dd = 0; dd < NDD; ++dd) { const int cb = (dd * 16 + hi * 8) * 2; \
                const bf16x8 b0 = MODE ? *(const LAS bf16x8*)(Kb + KSWZ64(r32, cb)) : *(const LAS bf16x8*)(Kb + KSWZ(r32, cb)); \
                const bf16x8 b1 = MODE ? *(const LAS bf16x8*)(Kb + KSWZ64(32 + r32, cb)) : *(const LAS bf16x8*)(Kb + KSWZ(32 + r32, cb)); \
                p0 = MFMA32(b0, qr[dd], p0); p1 = MFMA32(b1, qr[dd], p1); } \
            VFrag vf0; SBAR(); vfrag_issue<0>(vf0, vb); SBAR();                \
            _Pragma("unroll") for (int r = 0; r < 16; ++r) { const float dd0 = fabsf(fi - (float)((r & 3) + 8 * (r >> 2))), dd1 = fabsf(fi - (float)(32 + (r & 3) + 8 * (r >> 2))); \
                p0[r] = fmaf(-slope2, dd0, p0[r]); p1[r] = fmaf(-slope2, dd1, p1[r]); \
                if (MODE == 0) { if (dd0 > 128.f) p0[r] = -INFINITY; if (dd1 > 128.f) p1[r] = -INFINITY; } } \
            bf16x8 pa0, pa1, pa2, pa3; \
            const float alpha = softmax_tile<FIXED>(p0, p1, m_reg, l_reg, pa0, pa1, pa2, pa3); \
            if (!FIXED && __any(alpha < 1.f)) { if (hi == 0) al_l[r32] = alpha; asm volatile("s_waitcnt lgkmcnt(0)" ::: "memory"); \
                _Pragma("unroll") for (int r = 0; r < 16; ++r) { const float a = al_l[crow(r, hi)]; \
                    _Pragma("unroll") for (int d = 0; d < 4; ++d) o[d][r] *= a; } } \
            pv_d0(o, vf0, vb, pa0, pa1, pa2, pa3); } } while (0)
        if (jlo < jhi) SLOAD(sA, jlo * 64);
        if (DEPTH == 2 && jlo + 1 < jhi) SLOAD(sB, (jlo + 1) * 64);
#pragma unroll 1
        for (int j = jlo; j < jhi; j += 2) {
            TILE(sA, j);
            if (j + 1 < jhi) { if (DEPTH == 2) TILE(sB, j + 1); else TILE(sA, j + 1); }
        }
#undef TILE
#undef SLOAD
#undef SWRITE
        asm volatile("s_waitcnt lgkmcnt(0)" ::: "memory"); __builtin_amdgcn_s_barrier(); asm volatile("" ::: "memory");
        if (MODE == 1 && pslot >= 0) {
            float* po = (float*)(ws + WS_PART) + ((size_t)(pslot * 2 + mp) * 256 + wave * 32 + 4 * hi) * 128 + r32;
#pragma unroll
            for (int g = 0; g < 4; ++g) { float* pg = po + g * 8 * 128; asm volatile("" : "+v"(pg));
#pragma unroll
                for (int e = 0; e < 4; ++e)
#pragma unroll
                    for (int d = 0; d < 4; ++d) pg[e * 128 + d * 32] = o[d][4 * g + e]; }
            if (hi == 0) ((float*)(ws + WS_PARTL))[(pslot * 2 + mp) * 256 + wave * 32 + r32] = l_reg;
        } else
        if (MODE == 1 && mp == 0) {
            if (hi == 0) li_l[r32] = l_reg;
            asm volatile("s_waitcnt lgkmcnt(0)" ::: "memory");
#pragma unroll
            for (int r4 = 0; r4 < 4; ++r4) { float rl[4];
#pragma unroll
                for (int e = 0; e < 4; ++e) rl[e] = __builtin_amdgcn_rcpf(li_l[crow(4 * r4 + e, hi)]);
#pragma unroll
                for (int d = 0; d < 4; ++d) { f32x4 t; t.x = o[d][4 * r4] * rl[0]; t.y = o[d][4 * r4 + 1] * rl[1]; t.z = o[d][4 * r4 + 2] * rl[2]; t.w = o[d][4 * r4 + 3] * rl[3];
                    *(f32x4*)(park + (d * 4 + r4) * 256) = t; } }
            asm volatile("s_waitcnt lgkmcnt(0)" ::: "memory");
        }
    }
    if (MODE == 1 && pslot >= 0) return;
    float lam = 0.f; int ll_ = l; asm volatile("" : "+s"(ll_)); const float lin = 0.8f - 0.6f * expf(-0.3f * (float)ll_);
    if (MODE == 1) { const float a = P.lam[lane] * P.lam[64 + lane], bq = P.lam[128 + lane] * P.lam[192 + lane]; lam = expf(wave_sum(a)) - expf(wave_sum(bq)) + lin; }
    LAS float* ost = (LAS float*)(lds + AT_OST + wave * AT_OST_W);
    {
        if (hi == 0) li_l[r32] = l_reg;
        asm volatile("s_waitcnt lgkmcnt(0)" ::: "memory");
#pragma unroll
        for (int r4 = 0; r4 < 4; ++r4) { float rl[4];
#pragma unroll
            for (int e = 0; e < 4; ++e) rl[e] = __builtin_amdgcn_rcpf(li_l[crow(4 * r4 + e, hi)]);
#pragma unroll
            for (int d = 0; d < 4; ++d) { f32x4 pk = {0.f, 0.f, 0.f, 0.f}; if (MODE == 1) pk = *(const f32x4*)(park + (d * 4 + r4) * 256);
#pragma unroll
                for (int e = 0; e < 4; ++e) { float v = o[d][4 * r4 + e] * rl[e]; if (MODE == 1) v = pk[e] - lam * v;
                    ost[crow(4 * r4 + e, hi) * 132 + d * 32 + r32] = v; } } }
    }
    asm volatile("s_waitcnt lgkmcnt(0)" ::: "memory");
    {
        const int row = lane >> 1, half = lane & 1;
        const LAS f32x4* src = (const LAS f32x4*)(ost + row * 132 + half * 64);
        float v[64];
#pragma unroll
        for (int k = 0; k < 16; ++k) { const f32x4 t = src[k]; v[4 * k] = t.x; v[4 * k + 1] = t.y; v[4 * k + 2] = t.z; v[4 * k + 3] = t.w; }
        const size_t grow = (size_t)(seq0 + q0 + wave * 32 + row);
        float rs = 1.f;
        if (MODE == 1) { float ss = 0.f;
#pragma unroll
            for (int e = 0; e < 64; ++e) ss += v[e] * v[e];
            ss += xshfl<1>(ss); rs = (1.0f / sqrtf(ss * (1.0f / 128.0f) + NORM_EPS)) * (1.0f - lin); }
        const v4u* zp = (const v4u*)(PROJ + grow * LDP + zcol + half * 64);
        bf16* yb = (bf16*)(ws + WS_Y + (MODE ? 2 : 1) * SZ_Y1) + grow * 1024 + h * 128 + half * 64;
#pragma unroll
        for (int k = 0; k < 8; ++k) { const v4u zw = zp[k];
            const float z[8] = {bflo(zw.x), bfhi(zw.x), bflo(zw.y), bfhi(zw.y), bflo(zw.z), bfhi(zw.z), bflo(zw.w), bfhi(zw.w)};
            float y[8];
#pragma unroll
            for (int e = 0; e < 8; ++e) { float g = 1.f; if (MODE == 1) g = P.norm_gain[half * 64 + 8 * k + e]; y[e] = v[8 * k + e] * rs * g * silu_f(z[e]); }
            v4u w; w.x = cvtpk(y[0], y[1]); w.y = cvtpk(y[2], y[3]); w.z = cvtpk(y[4], y[5]); w.w = cvtpk(y[6], y[7]);
            *(v4u*)(yb + 8 * k) = w; }
    }
    asm volatile("s_waitcnt lgkmcnt(0)" ::: "memory"); __builtin_amdgcn_s_barrier(); asm volatile("" ::: "memory");
}
#ifndef ONLY_PHASE
#define ONLY_PHASE -1
#endif
#ifndef ONLY_SUB
#define ONLY_SUB -1
#endif
#define PH4_ON(k) (ONLY_SUB < 0 || ONLY_SUB == (k))
#define PH_ON(k) (ONLY_PHASE < 0 || ONLY_PHASE == (k))
#ifndef DUP_PHASE
#define DUP_PHASE -1
#endif
#define NREP(k) ((DUP_PHASE == (k)) ? 2 : 1)
#ifndef DUP_PASSES
#define DUP_PASSES 15
#endif
#ifndef SPLIT_TILES
#define SPLIT_TILES 128
#endif
#ifndef SPLIT_MAX
#define SPLIT_MAX 2
#endif
#ifndef MK_PER_PHASE
#define MK_PER_PHASE 0
#endif
constexpr int N_ITER = DEPTH * NPASS, PH_PER_IT = 7, N_PHASES = 1 + N_ITER * PH_PER_IT;
struct Args { const float* in[17]; float* out; unsigned char* ws; int ph_lo, ph_hi; };
#define WG_SYNC_LDS() do { asm volatile("s_waitcnt lgkmcnt(0)" ::: "memory"); __builtin_amdgcn_s_barrier(); asm volatile("" ::: "memory"); } while (0)

__global__ void __launch_bounds__(NTHREADS, 2) fwd_kernel(Args args) {
    extern __shared__ __attribute__((aligned(16))) unsigned char lds_raw[];
    LAS unsigned char* lds = (LAS unsigned char*)lds_raw;
    volatile LAS unsigned* MISC = (volatile LAS unsigned*)(lds + MISC_OFF);
    const int tid0 = threadIdx.x;
    const int G = gridDim.x, bx = blockIdx.x, ngw = G * NWAVES;
    unsigned char* ws = args.ws;
    unsigned* ctl = (unsigned*)(ws + WS_CTL);
    if (tid0 < 128) MISC[tid0] = 0u;
    __syncthreads();
    XcdBarrier bar; bar.bar = ctl + CW_BAR; bar.x = 0; bar.st = nullptr;
    if (!MK_PER_PHASE) bar = xcd_barrier_post(ctl + CW_BAR, MISC + 8);
    const int lo = args.ph_lo, hi = args.ph_hi;
#define IN(k) (lo <= (k) && (k) < hi)
#define LAUNDER_TID() int tid = tid0; asm volatile("" : "+v"(tid)); const int lane = tid & 63, wave = __builtin_amdgcn_readfirstlane(tid >> 6), gw = bx * NWAVES + wave; (void)lane; (void)gw
#define TBR(i) __builtin_amdgcn_readfirstlane((int)TB[i])
#define T_GT 0
#define T_PB 32
#define T_NPH 40
#define T_NDF 48
#define T_LEN 56
#define DIFF_TABLE(bd_, fixd_) volatile LAS int* TB = (volatile LAS int*)(MISC + 16); do { const int per_ = nseq * (Tp / 256); \
        if (tid0 == 0) { int ps = 0; \
            for (int hh = 7; hh >= 0; --hh) { const int dk = diff_radius((bd_), hh); int ntm = (255 + 2 * dk) / 64 + 2; if (ntm > Tp / 64) ntm = Tp / 64; \
                int np = (fixd_) ? (ntm + SPLIT_TILES - 1) / SPLIT_TILES : 1; if (np > SPLIT_MAX) np = SPLIT_MAX; if (np > 1 && ps + np * per_ > PART_SLOTS) np = 1; \
                TB[T_NPH + hh] = np; TB[T_PB + hh] = (np > 1) ? ps : -1; if (np > 1) ps += np * per_; TB[T_LEN + hh] = (ntm + np - 1) / np; } \
              \
            int g = 0; unsigned done_ = 0u; \
            for (int k = 0; k < 8; ++k) { int best = -1, bl = -1; for (int hh = 7; hh >= 0; --hh) if (!((done_ >> hh) & 1u) && TB[T_LEN + hh] > bl) { bl = TB[T_LEN + hh]; best = hh; } \
                done_ |= 1u << best; const int np = TB[T_NPH + best]; for (int p = 0; p < np; ++p) TB[T_GT + g++] = best | (p << 8) | (np << 16); } \
            TB[T_NDF] = g * per_; } \
        __syncthreads(); } while (0)
#define DIFF_BOUND(bd_) float bd_; { int ln_ = tid0; asm volatile("" : "+v"(ln_)); const int ln = ln_ & 63; const float* dqg_ = diff_q_gain + l * 64; const float* dkg_ = diff_k_gain + l * 64; \
        float gq = fabsf(dqg_[ln]), gk = fabsf(dkg_[ln]); \
        gq = wave_max(gq); gk = wave_max(gk); \
        bd_ = 8.0f * gq * gk * 1.02f; }
#define SEAM(k) do { if (!MK_PER_PHASE && IN(k) && IN((k) + 1)) xcd_barrier(bar); } while (0)

    const __attribute__((address_space(4))) unsigned char* kargs = (const __attribute__((address_space(4))) unsigned char*)__builtin_amdgcn_kernarg_segment_ptr();
#define INP(k) ([&]() { const __attribute__((address_space(4))) unsigned char* kp_ = kargs; asm volatile("" : "+s"(kp_)); return *(const float* const __attribute__((address_space(4)))*)(kp_ + 8 * (k)); }())
#define x_prompt INP(0)
#define x_sample INP(1)
#define norm_gain INP(2)
#define w_in INP(3)
#define conv_w INP(4)
#define a_log INP(5)
#define dt_bias INP(6)
#define gdn_norm_gain INP(7)
#define swa_q_gain INP(8)
#define swa_k_gain INP(9)
#define swa_sink INP(10)
#define diff_q_gain INP(11)
#define diff_k_gain INP(12)
#define diff_lambda INP(13)
#define diff_norm_gain INP(14)
#define w_branch INP(15)
#define w_out INP(16)

    if (PH_ON(0) && IN(0)) for (int rep = 0; rep < NREP(12); ++rep) { LAUNDER_TID(); phase_prologue(lds, w_in, w_branch, w_out, ws, gw, ngw, wave, lane); __syncthreads(); }
    SEAM(0);

    bf16* HN = (bf16*)(ws + WS_HN); bf16* PROJ = (bf16*)(ws + WS_PROJ); bf16* MRG = (bf16*)(ws + WS_MRG);
#pragma unroll 1
    for (int it = 0; it < N_ITER; ++it) {
        const int l = it >> 2, p = it & 3, pb = 1 + it * PH_PER_IT;
        const int Tp = (p < 2) ? 16384 : 4096, nseq = PASS_ROWS / Tp;
#define XIN() ((l == 0) ? ((p < 2) ? x_prompt + (size_t)p * PASS_ROWS * DM : x_sample + (size_t)(p - 2) * PASS_ROWS * DM) : (const float*)args.out + (size_t)p * PASS_ROWS * DM)

        bf16* HNp = HN + (size_t)p * PASS_ROWS * DM; float* RSp = (float*)(ws + WS_ROWSS) + (size_t)l * NTOK + (size_t)p * PASS_ROWS;
        if (PH_ON(1) && IN(pb + 0) && l == 0) { LAUNDER_TID(); const float* xin = XIN(); const float* ng = norm_gain; for (int m = gw; m < PASS_ROWS; m += ngw) rms_row(xin + (size_t)m * DM, ng, HNp + (size_t)m * DM, RSp + m, lane); }
        if (l == 0) SEAM(pb + 0);
        if (PH_ON(2) && IN(pb + 1)) for (int rep = 0; rep < NREP(2); ++rep) {
            if (rep) xcd_barrier(bar);
            pg8::Gemm g{HNp, (const bf16*)(ws + WS_WIN + (size_t)l * SZ_WIN_L), PASS_ROWS, NPROJ, DM}; pg8::StaticOrder S; S.init(PASS_ROWS, NPROJ, G, bx);
            pg8::EpiProj E{PROJ, LDP, 0, 0, RSp, 1.0f / DM, NORM_EPS};
            pg8::gemm_phase<pg8::EpiProj, pg8::StaticOrder, true, true>(lds, g, S, E);
        }
        SEAM(pb + 1);
        if (PH_ON(3) && IN(pb + 2)) {
            LAUNDER_TID();
            { const float* cw = conv_w; const float* al = a_log; const float* db = dt_bias;
              for (int rep = 0; rep < NREP(3); ++rep) {
                  unsigned pre_ba = 0u;
                  if (tid < 128 && bx < 2048) { const int d = tid >> 6, r = tid & 63, c = d ? 63 - r : r; const bf16* pn = PROJ + (size_t)((bx >> 3) * 64 + c) * LDP + C_BA;
                      pre_ba = (unsigned)pn[d * 8 + (bx & 7)] | ((unsigned)pn[16 + d * 8 + (bx & 7)] << 16); }
                  for (int u = bx; u < 2048; u += G) { const int un = u + G; gdn_prep_unit(lds, ws, cw, al, db, l, Tp, u >> 3, u & 7, un < 2048 ? (un >> 3) : -1, un & 7, pre_ba, tid, wave, lane); } } }
            { const float* skg = swa_k_gain + l * 128; const float* dkg = diff_k_gain + l * 64;
              for (int m = gw; m < PASS_ROWS; m += ngw) knorm_row(PROJ + (size_t)m * LDP, skg, dkg, lane); }
        }
        SEAM(pb + 2);
#if DUP_PHASE == 10
        for (int xb = 0; xb < 5; ++xb) xcd_barrier(bar);
#endif
        if (PH_ON(4) && IN(pb + 3)) for (int rep = 0; rep < (((DUP_PHASE == 4 || DUP_PHASE == 5 || DUP_PHASE == 8 || DUP_PHASE == 9 || DUP_PHASE == 11) && (DUP_PASSES >> p & 1)) ? 2 : 1); ++rep) {
            if (rep) xcd_barrier(bar);
            const int nchain = nseq * 32, nqb = Tp / 256, nblk = nseq * 8 * nqb;
            float bd, bs;
            const float* dqg = diff_q_gain + l * 64; const float* sqg = swa_q_gain + l * 128;
            { int ln_ = tid0; asm volatile("" : "+v"(ln_)); const int ln = ln_ & 63; const float* dkg = diff_k_gain + l * 64; const float* skg = swa_k_gain + l * 128;
              float gq = fabsf(dqg[ln]), gk = fabsf(dkg[ln]);
              float sq_ = fmaxf(fabsf(sqg[ln]), fabsf(sqg[64 + ln])), sk_ = fmaxf(fabsf(skg[ln]), fabsf(skg[64 + ln]));
              gq = wave_max(gq); gk = wave_max(gk); sq_ = wave_max(sq_); sk_ = wave_max(sk_);
              bd = 8.0f * gq * gk * 1.02f; bs = 11.3137085f * sq_ * sk_ * 1.02f; }
            const bool fixd = (bd * LOG2E < 60.f) && (bd == bd), fixs = (bs * LOG2E < 60.f) && (bs == bs);
#define UNIFORM_F(x) __builtin_bit_cast(float, __builtin_amdgcn_readfirstlane(__builtin_bit_cast(int, (float)(x))))
            AttnParams PD{dqg, nullptr, diff_lambda + l * 256, diff_norm_gain + l * 128, UNIFORM_F(bd)};
            AttnParams PS{sqg, swa_sink + l * 8, nullptr, nullptr, UNIFORM_F(bs)};
            DIFF_TABLE(bd, fixd);
            const int ndiff = TBR(T_NDF);
            const int item_lo = (rep == 1 && (DUP_PHASE == 8 || DUP_PHASE == 11)) ? nchain : ((rep == 1 && DUP_PHASE == 9) ? nchain + ndiff : 0);
            const int total = (rep == 1 && DUP_PHASE == 5) ? nchain : ((rep == 1 && (DUP_PHASE == 8 || DUP_PHASE == 11)) ? nchain + ndiff : nchain + ndiff + nblk);
#pragma unroll 1
            for (;;) {
                LAUNDER_TID();
                if (tid == 0) MISC[0] = __hip_atomic_fetch_add(ctl + CW_QUEUE + it * 64 + rep * 32, 1u, __ATOMIC_RELAXED, __HIP_MEMORY_SCOPE_AGENT);
                __syncthreads();
                const int item = __builtin_amdgcn_readfirstlane((int)MISC[0]) + item_lo;
                __syncthreads();
                if (item >= total) break;
                if (PH4_ON(0) && item < nchain) { gdn_scan_unit(lds, ws, Tp, item >> 5, (item >> 2) & 7, (item >> 1) & 1, item & 1, tid, wave, lane); }
                else if (PH4_ON(1) && item < nchain + ndiff) { const int u = item - nchain, per = nseq * nqb;
                    const int g = u / per, un = u - g * per, e = TBR(T_GT + g), hh = e & 0xff, part = (e >> 8) & 0xff, np = e >> 16, sq = un / nqb, qb = un - sq * nqb;
                    const int pslot = (np > 1) ? TBR(T_PB + hh) + un * np + part : -1;
                    const bool pe_ = (DUP_PHASE == 11 && rep == 1);
                    if (fixd) attn_unit<1, true>(lds, ws, PD, l, Tp, sq, hh, qb, pe_ ? 999999 : part, pe_ ? 1000000 : np, pe_ ? PART_SLOTS - 1 : pslot, tid, wave, lane); else if (DUP_PHASE < 0) attn_unit<1, false>(lds, ws, PD, l, Tp, sq, hh, qb, 0, 1, -1, tid, wave, lane); }
                else if (PH4_ON(2)) { const int u = item - nchain - ndiff;
                    if (fixs) attn_unit<0, true>(lds, ws, PS, l, Tp, u / (8 * nqb), (u / nqb) & 7, u % nqb, 0, 1, -1, tid, wave, lane); else attn_unit<0, false>(lds, ws, PS, l, Tp, u / (8 * nqb), (u / nqb) & 7, u % nqb, 0, 1, -1, tid, wave, lane); }
                __syncthreads();
            }
        }
        SEAM(pb + 3);
        if (PH_ON(5) && IN(pb + 4)) {
            LAUNDER_TID();
            const bf16* OD = (const bf16*)(ws + WS_ODIR);
            const float* gng = gdn_norm_gain + l * 128;
            for (int m = gw; m < PASS_ROWS; m += ngw)
                gdn_final_row(OD + (size_t)m * 1024, OD + (size_t)(PASS_ROWS + m) * 1024, PROJ + (size_t)m * LDP + C_GZ, gng, (bf16*)(ws + WS_Y) + (size_t)m * 1024, lane);
            { DIFF_BOUND(bdf); const bool fixf = (bdf * LOG2E < 60.f) && (bdf == bdf);
              DIFF_TABLE(bdf, fixf);
              const float* dl = diff_lambda + l * 256; const float* dng = diff_norm_gain + l * 128;
              const float lin = 0.8f - 0.6f * expf(-0.3f * (float)l);
              const float lam = expf(wave_sum(dl[lane] * dl[64 + lane])) - expf(wave_sum(dl[128 + lane] * dl[192 + lane])) + lin;
              const int nqb = Tp / 256;
              for (int hh = 7; hh >= 0; --hh) { const int np = TBR(T_NPH + hh); if (np <= 1) continue; const int pb0 = TBR(T_PB + hh);
                  for (int m = gw; m < PASS_ROWS; m += ngw) { const int sq = m / Tp, t = m - sq * Tp, qb = t >> 8, rr = t & 255;
                      diff_final_row(ws, pb0 + (sq * nqb + qb) * np, np, rr, lam, lin, PROJ + (size_t)m * LDP + C_DZ + hh * 128, dng, (bf16*)(ws + WS_Y + 2 * SZ_Y1) + (size_t)m * 1024 + hh * 128, lane); } } }
        }
        SEAM(pb + 4);
        if (PH_ON(6) && IN(pb + 5)) for (int rep = 0; rep < NREP(6); ++rep) {
            if (rep) xcd_barrier(bar);
            pg8::MergeOrder S; S.S.init(PASS_ROWS, DM, G, bx);
            pg8::Gemm g{(const bf16*)(ws + WS_Y), (const bf16*)(ws + WS_WBR + (size_t)(l * 3) * SZ_WBR_1), 3 * PASS_ROWS, 3 * DM, 1024};
            pg8::EpiMerge E{PROJ + C_GATE, LDP, (bf16*)(ws + WS_MTMP), DM, MRG, DM};
            pg8::gemm_phase<pg8::EpiMerge, pg8::MergeOrder, true, true>(lds, g, S, E);
        }
        SEAM(pb + 5);
        if (PH_ON(7) && IN(pb + 6)) for (int rep = 0; rep < ((l == 0) ? NREP(7) : 1); ++rep) {
            if (rep) xcd_barrier(bar);
            pg8::Gemm g{MRG, (const bf16*)(ws + WS_WOUT + (size_t)l * SZ_WOUT_L), PASS_ROWS, DM, DM}; pg8::StaticOrder S; S.init(PASS_ROWS, DM, G, bx);
            pg8::EpiOut E{XIN(), args.out + (size_t)p * PASS_ROWS * DM, DM, (l + 1 < DEPTH) ? norm_gain + (l + 1) * DM : (const float*)nullptr, HNp, (float*)(ws + WS_ROWSS) + (size_t)(l + 1 < DEPTH ? l + 1 : l) * NTOK + (size_t)p * PASS_ROWS};
            pg8::gemm_phase<pg8::EpiOut, pg8::StaticOrder, true, true>(lds, g, S, E);
        }
    }
#undef IN
#undef SEAM
#undef TBR
#undef T_GT
#undef T_PB
#undef T_NPH
#undef T_NDF
#undef T_LEN
#undef DIFF_TABLE
#undef DIFF_BOUND
#undef XIN
#undef x_prompt
#undef x_sample
#undef norm_gain
#undef w_in
#undef conv_w
#undef a_log
#undef dt_bias
#undef gdn_norm_gain
#undef swa_q_gain
#undef swa_k_gain
#undef swa_sink
#undef diff_q_gain
#undef diff_k_gain
#undef diff_lambda
#undef diff_norm_gain
#undef w_branch
#undef w_out
#undef INP
}

extern "C" void kernel_launch(void* const* d_in, const int* in_sizes, int n_in, void* d_out, int out_size, void* d_ws, size_t ws_size, hipStream_t stream) {
    static int grid = 0;
    if (grid == 0) {
        if (n_in != 17 || in_sizes[0] != 2 * 16384 * DM || in_sizes[1] != 8 * 4096 * DM || out_size != NTOK * DM || ws_size < WS_END) {
            fprintf(stderr, "kernel_launch: shape mismatch (n_in %d, in0 %d, in1 %d, out %d, ws %zu, need %zu); nothing launched\n", n_in, n_in > 0 ? in_sizes[0] : -1, n_in > 1 ? in_sizes[1] : -1, out_size, ws_size, (size_t)WS_END);
            grid = -1; return; }
        int dev = 0, cus = 0, per_cu = 0;
        if (hipGetDevice(&dev) != hipSuccess || hipDeviceGetAttribute(&cus, hipDeviceAttributeMultiprocessorCount, dev) != hipSuccess) { fprintf(stderr, "kernel_launch: device query failed\n"); grid = -1; return; }
        if (hipFuncSetAttribute((const void*)fwd_kernel, hipFuncAttributeMaxDynamicSharedMemorySize, LDS_BYTES) != hipSuccess) { fprintf(stderr, "kernel_launch: hipFuncSetAttribute(%d B LDS) failed\n", LDS_BYTES); grid = -1; return; }
        if (hipOccupancyMaxActiveBlocksPerMultiprocessor(&per_cu, (const void*)fwd_kernel, NTHREADS, LDS_BYTES) != hipSuccess || per_cu < 1)
            fprintf(stderr, "kernel_launch: note: occupancy query reports %d workgroups per CU\n", per_cu);
        (void)hipGetLastError();
        grid = cus;
    }
    if (grid < 0) return;
    if (hipMemsetAsync((char*)d_ws + WS_CTL, 0, CTL_ZERO_BYTES, stream) != hipSuccess) { fprintf(stderr, "kernel_launch: memset failed\n"); return; }
    Args a{};
    for (int i = 0; i < 17; ++i) a.in[i] = (const float*)d_in[i];
    a.out = (float*)d_out; a.ws = (unsigned char*)d_ws;
#if MK_PER_PHASE
    for (int k = 0; k < N_PHASES; ++k) { a.ph_lo = k; a.ph_hi = k + 1; hipLaunchKernelGGL(fwd_kernel, dim3(grid), dim3(NTHREADS), LDS_BYTES, stream, a); }
#else
    a.ph_lo = 0; a.ph_hi = N_PHASES;
    hipLaunchKernelGGL(fwd_kernel, dim3(grid), dim3(NTHREADS), LDS_BYTES, stream, a);
#endif
    const hipError_t le = hipPeekAtLastError();
    if (le != hipSuccess) fprintf(stderr, "kernel_launch: launch failed: %s\n", hipGetErrorName(le));
}
```

```cpp
#include <hip/hip_runtime.h>
#include <cstdio>
#include <cstdint>
namespace pg8 {
#define PG8_LAS __attribute__((address_space(3)))
typedef unsigned short bf16_t;
typedef short bf16x8 __attribute__((ext_vector_type(8)));
typedef float f32x4 __attribute__((ext_vector_type(4)));
typedef unsigned u32x4 __attribute__((ext_vector_type(4)));
constexpr int BM = 256, BK = 64, HALF = 128, HTB = HALF * BK * 2  , STAGE_BYTES = 8 * HTB, NXCD = 8, WGM = 4;

__host__ __device__ __forceinline__ int lds_byte(int r, int c) { const int st = (r >> 4) * 2 + (c >> 5), rr = r & 15, cc = c & 31, ob = rr * 64 + cc * 2; return st * 1024 + (ob ^ (((ob >> 9) & 1) << 5)); }
__host__ __device__ __forceinline__ void stage_rc(int b, int& R, int& C) { const int st = b / 1024, sb = b % 1024, swz = sb ^ (((sb >> 9) & 1) << 5); R = (st >> 1) * 16 + swz / 64; C = (st & 1) * 32 + (swz % 64) / 2; }
__host__ __device__ __forceinline__ int perm32(int rho) { const int n = rho >> 4, i = rho & 15; return 8 * (i >> 2) + 4 * n + (i & 3); }

struct Unit { int pm, pn; };
struct Gemm { const bf16_t* A; const bf16_t* Bt; int M, N, K; };

struct StaticOrder {
    int nM, nN, nwg, G, c;
    __host__ __device__ void init(int M, int N, int G_, int c_) { nM = M / BM; nN = N / BM; nwg = nM * nN; G = G_; c = c_; }
    __host__ __device__ bool next(int i, Unit& u) const {
        const long L = (long)i * G + c; if (L >= nwg) return false;
        int wgid = (int)L; { const int q = nwg / NXCD, r = nwg % NXCD, xcd = wgid % NXCD, off = wgid / NXCD; wgid = (xcd < r ? xcd * (q + 1) : r * (q + 1) + (xcd - r) * q) + off; }
        const int nig = WGM * nN, gid = wgid / nig, fm = gid * WGM, gsz = (nM - fm) < WGM ? (nM - fm) : WGM;
        u.pm = fm + ((wgid % nig) % gsz); u.pn = (wgid % nig) / gsz; return true;
    }
    __device__ __forceinline__ void a_ready(const Unit&) const {}
    __device__ __forceinline__ void done(const Unit&) const {}
};

typedef float f32x2_c __attribute__((ext_vector_type(2)));
typedef unsigned u32x2 __attribute__((ext_vector_type(2)));
typedef __bf16 bf16x2_c __attribute__((ext_vector_type(2)));
__device__ __forceinline__ unsigned cvt_pk_bf16(float lo, float hi) { const f32x2_c v = {lo, hi}; const bf16x2_c b = __builtin_convertvector(v, bf16x2_c); return __builtin_bit_cast(unsigned, b); }
__device__ __forceinline__ float sigmoid_f(float v) { return __builtin_amdgcn_rcpf(1.0f + __builtin_amdgcn_exp2f(-1.4426950408889634f * v)); }
__device__ __forceinline__ float bflo(unsigned w) { return __uint_as_float(w << 16); }
__device__ __forceinline__ float bfhi(unsigned w) { return __uint_as_float(w & 0xffff0000u); }

struct EpiProj {
    static constexpr bool PERM = true, AFTER_DRAIN = false;
    bf16_t* O; int ldc; int sig_lo, sig_hi; const float* rowss; float inv_d, eps;
#if DUP_PHASE == 17
    size_t tstride;
#endif
    int sig_col0;
    int ba_tile;
    unsigned long long ztiles;
    int qn_lo, qn_hi; const float* qgain; float qscale;
    int kn_lo, kn_hi; const float* kgain;
    __device__ __forceinline__ void operator()(const f32x4 (&acc)[2][2][4][2], const Unit& u, int wr, int wc, int fr, int fq) const {
        const int row0 = u.pm * BM + wr * 64 + fr, col0 = u.pn * BM + wc * 64 + 8 * fq;
        const bool sig = (u.pn >= sig_lo) && (u.pn < sig_hi);
        const bool qn = (u.pn >= qn_lo) && (u.pn < qn_hi);
        const bool kn = qn || ((u.pn >= kn_lo) && (u.pn < kn_hi));
        const float* ngain = qn ? qgain : kgain; const float nsc = qn ? qscale : 1.0f;
        const bool zt = (u.pn < 64) && ((ztiles >> u.pn) & 1ull);
        const bool ba = (u.pn == ba_tile);
        if (ba && wc != 0) return;
        f32x4 kg[2][2];
#pragma unroll
        for (int bj = 0; bj < 2; ++bj)
#pragma unroll
            for (int n = 0; n < 2; ++n) kg[bj][n] = kn ? *(const f32x4*)(ngain + bj * 32 + 8 * fq + 4 * n) * nsc : (f32x4){1.f, 1.f, 1.f, 1.f};
        float rs[2][4];
#pragma unroll
        for (int ai = 0; ai < 2; ++ai)
#pragma unroll
            for (int m = 0; m < 4; ++m) rs[ai][m] = rowss[row0 + ai * HALF + m * 16];
#pragma unroll
        for (int ai = 0; ai < 2; ++ai)
#pragma unroll
            for (int m = 0; m < 4; ++m) { const int row = row0 + ai * HALF + m * 16; bf16_t* rowp = O + (size_t)row * ldc + col0;
#if DUP_PHASE == 17
                rowp += (size_t)u.pn * tstride;
#endif
                const float rstd = __builtin_amdgcn_rsqf(rs[ai][m] * inv_d + eps);
                f32x4 v[2][2];
#pragma unroll
                for (int bj = 0; bj < 2; ++bj) { v[bj][0] = acc[ai][bj][m][0] * rstd; v[bj][1] = acc[ai][bj][m][1] * rstd; }
                if (kn) {
                    float ss = 0.f;
#pragma unroll
                    for (int bj = 0; bj < 2; ++bj)
#pragma unroll
                        for (int n = 0; n < 2; ++n)
#pragma unroll
                            for (int j = 0; j < 4; ++j) ss += v[bj][n][j] * v[bj][n][j];
                    ss += __builtin_bit_cast(float, __builtin_amdgcn_ds_swizzle(__builtin_bit_cast(int, ss), 0x1F | (16 << 10)));
                    ss += __shfl_xor(ss, 32);
                    const float rk = __builtin_amdgcn_rsqf(ss * (1.0f / 64.0f) + eps);
#pragma unroll
                    for (int bj = 0; bj < 2; ++bj)
#pragma unroll
                        for (int n = 0; n < 2; ++n) v[bj][n] = v[bj][n] * rk * kg[bj][n];
                }
                if (zt) {
#pragma unroll
                    for (int bj = 0; bj < 2; ++bj)
#pragma unroll
                        for (int n = 0; n < 2; ++n)
#pragma unroll
                            for (int j = 0; j < 4; ++j) v[bj][n][j] *= sigmoid_f(v[bj][n][j]);
                }
                if (sig) {
                    unsigned char* rowb = (unsigned char*)(O + (size_t)row * ldc + sig_col0) + (u.pn * BM + wc * 64 + 16 * fq - sig_col0);
                    u32x4 w;
#pragma unroll
                    for (int bj = 0; bj < 2; ++bj)
#pragma unroll
                        for (int n = 0; n < 2; ++n) { unsigned pk = 0u;
#pragma unroll
                            for (int j = 0; j < 4; ++j) pk = __builtin_amdgcn_cvt_pk_u8_f32(__builtin_floorf(sigmoid_f(v[bj][n][j]) * 255.0f + 0.5f), j, pk);
                            w[bj * 2 + n] = pk; }
                    __builtin_nontemporal_store(w, (u32x4*)rowb);
                } else {
#pragma unroll
                for (int bj = 0; bj < 2; ++bj) { f32x4 v0 = v[bj][0], v1 = v[bj][1];
                    if (ba && bj == 1) continue;
                    u32x4 w; w.x = cvt_pk_bf16(v0[0], v0[1]); w.y = cvt_pk_bf16(v0[2], v0[3]); w.z = cvt_pk_bf16(v1[0], v1[1]); w.w = cvt_pk_bf16(v1[2], v1[3]);
                    __builtin_nontemporal_store(w, (u32x4*)(rowp + bj * 32)); } } }
    }
};
struct EpiNull {
    static constexpr bool PERM = true, AFTER_DRAIN = false;
    __device__ __forceinline__ void operator()(const f32x4 (&acc)[2][2][4][2], const Unit& u, int wr, int wc, int fr, int fq) const {
        float s = 0.f;
#pragma unroll
        for (int a = 0; a < 2; ++a)
#pragma unroll
            for (int b = 0; b < 2; ++b)
#pragma unroll
                for (int m = 0; m < 4; ++m)
#pragma unroll
                    for (int n = 0; n < 2; ++n) s += acc[a][b][m][n][0];
        asm volatile("" :: "v"(s));
    }
};
struct EpiMerge {
    static constexpr bool PERM = true, AFTER_DRAIN = false;
    const unsigned char* G; int ldg; bf16_t* T; int ldt; bf16_t* O; int ldo;
    __device__ __forceinline__ void operator()(const f32x4 (&acc)[2][2][4][2], const Unit& u, int wr, int wc, int fr, int fq) const {
        const int n = u.pm >> 6, pm = u.pm & 63, pn = u.pn & 7;
        const int row0 = pm * BM + wr * 64 + fr, col0 = pn * BM + wc * 32 + 8 * fq;
        const unsigned char* Gn = G + n * 2048;
#pragma unroll
        for (int ai = 0; ai < 2; ++ai)
#pragma unroll
            for (int m2 = 0; m2 < 4; m2 += 2) {
                u32x2 gw[2][2]; u32x4 tw[2][2];
#pragma unroll
                for (int mm = 0; mm < 2; ++mm)
#pragma unroll
                    for (int bj = 0; bj < 2; ++bj) { const size_t row = (size_t)(row0 + ai * HALF + (m2 + mm) * 16); const int col = col0 + bj * HALF;
                        gw[mm][bj] = *(const u32x2*)(Gn + row * ldg + col); if (n >= 1) tw[mm][bj] = *(const u32x4*)(T + row * ldt + col); else tw[mm][bj] = (u32x4){0u, 0u, 0u, 0u}; }
#pragma unroll
                for (int mm = 0; mm < 2; ++mm)
#pragma unroll
                    for (int bj = 0; bj < 2; ++bj) { const int m = m2 + mm; const size_t row = (size_t)(row0 + ai * HALF + m * 16); const int col = col0 + bj * HALF;
                        const u32x2 g = gw[mm][bj]; const u32x4 t = tw[mm][bj];
                        const float qs = 1.0f / 255.0f;
                        f32x4 v0 = acc[ai][bj][m][0], v1 = acc[ai][bj][m][1];
                        v0[0] = v0[0] * ((float)(g.x & 0xffu) * qs) + bflo(t.x); v0[1] = v0[1] * ((float)((g.x >> 8) & 0xffu) * qs) + bfhi(t.x); v0[2] = v0[2] * ((float)((g.x >> 16) & 0xffu) * qs) + bflo(t.y); v0[3] = v0[3] * ((float)(g.x >> 24) * qs) + bfhi(t.y);
                        v1[0] = v1[0] * ((float)(g.y & 0xffu) * qs) + bflo(t.z); v1[1] = v1[1] * ((float)((g.y >> 8) & 0xffu) * qs) + bfhi(t.z); v1[2] = v1[2] * ((float)((g.y >> 16) & 0xffu) * qs) + bflo(t.w); v1[3] = v1[3] * ((float)(g.y >> 24) * qs) + bfhi(t.w);
                        u32x4 w; w.x = cvt_pk_bf16(v0[0], v0[1]); w.y = cvt_pk_bf16(v0[2], v0[3]); w.z = cvt_pk_bf16(v1[0], v1[1]); w.w = cvt_pk_bf16(v1[2], v1[3]);
                        if (n <= 1) *(u32x4*)(T + row * ldt + col) = w; else *(u32x4*)(O + row * ldo + col) = w; }
                asm volatile("" ::: "memory"); }
    }
};
struct MergeOrder {
    StaticOrder S;
    __device__ __forceinline__ bool next(int i, Unit& u) const { const int ou = i / 3, n = i - ou * 3; Unit v; if (!S.next(ou, v)) return false; u.pm = n * 64 + v.pm; u.pn = n * 8 + v.pn; return true; }
    __device__ __forceinline__ void a_ready(const Unit&) const {}
    __device__ __forceinline__ void done(const Unit&) const {}
};
struct EpiOut {
    static constexpr bool PERM = false, AFTER_DRAIN = false;
    const float* base; float* out; int ldc; const float* gain_next; bf16_t* hn; float* rowss;
    __device__ __forceinline__ void operator()(const f32x4 (&acc)[2][2][4][2], const Unit& u, int wr, int wc, int fr, int fq) const {
        const int row0 = u.pm * BM + wr * 64 + fr, col0 = u.pn * BM + wc * 32 + 4 * fq;
        f32x4 gn[2][2];
        if (gain_next) {
#pragma unroll
            for (int bj = 0; bj < 2; ++bj)
#pragma unroll
                for (int n = 0; n < 2; ++n) gn[bj][n] = *(const f32x4*)(gain_next + col0 + bj * HALF + n * 16); }
#pragma unroll
        for (int ai = 0; ai < 2; ++ai)
#pragma unroll
            for (int m2 = 0; m2 < 4; m2 += 2) {
                f32x4 bb[2][2][2];
#pragma unroll
                for (int mm = 0; mm < 2; ++mm)
#pragma unroll
                    for (int bj = 0; bj < 2; ++bj)
#pragma unroll
                        for (int n = 0; n < 2; ++n) bb[mm][bj][n] = *(const f32x4*)(base + (size_t)(row0 + ai * HALF + (m2 + mm) * 16) * ldc + col0 + bj * HALF + n * 16);
#pragma unroll
                for (int mm = 0; mm < 2; ++mm) { const int m = m2 + mm; const int row = row0 + ai * HALF + m * 16; const size_t off = (size_t)row * ldc + col0; float ss = 0.f;
#pragma unroll
                    for (int bj = 0; bj < 2; ++bj)
#pragma unroll
                        for (int n = 0; n < 2; ++n) { const f32x4 x = bb[mm][bj][n] + acc[ai][bj][m][n]; *(f32x4*)(out + off + bj * HALF + n * 16) = x;
                            if (gain_next) { const f32x4 g = gn[bj][n]; ss += (x[0] * x[0] + x[1] * x[1]) + (x[2] * x[2] + x[3] * x[3]);
                                u32x2 w; w.x = cvt_pk_bf16(x[0] * g[0], x[1] * g[1]); w.y = cvt_pk_bf16(x[2] * g[2], x[3] * g[3]); *(u32x2*)(hn + off + bj * HALF + n * 16) = w; } }
                    if (gain_next) {
                        ss += __builtin_bit_cast(float, __builtin_amdgcn_ds_swizzle(__builtin_bit_cast(int, ss), 0x1F | (16 << 10)));
                        ss += __shfl_xor(ss, 32);
                        if (fq == 0) __hip_atomic_fetch_add(rowss + row, ss, __ATOMIC_RELAXED, __HIP_MEMORY_SCOPE_AGENT); } }
                asm volatile("" ::: "memory"); }
    }
};

template <class Epi, class Sched, bool ALIGN_EPI = false, bool SP2 = false>
__device__ __forceinline__ void gemm_phase(PG8_LAS unsigned char* lds, const Gemm g, const Sched& S, const Epi& E) {
    int tid_ = threadIdx.x; asm volatile("" : "+v"(tid_));
    const int tid = tid_, wid = __builtin_amdgcn_readfirstlane(tid >> 6), lane = tid & 63, wr = wid >> 2, wc = wid & 3, fr = lane & 15, fq = lane >> 4;
    const int K = g.K, nt = K / BK;
    unsigned voffA[2], voffB[2];
#pragma unroll
    for (int i = 0; i < 2; ++i) { int R, C; stage_rc(tid * 16 + i * 8192, R, C); const int Rb = Epi::PERM ? ((R & ~31) + perm32(R & 31)) : R;
        voffA[i] = (unsigned)(R * K + C) * 2u; voffB[i] = (unsigned)(Rb * K + C) * 2u; }
    const size_t kstep = (size_t)(BK * 2);
    const size_t hstep = (size_t)HALF * K * 2;
    const size_t tstep = 2 * hstep;
    const unsigned ldsw = (unsigned)wid * 1024u;
    const int aoff = lds_byte(wr * 64 + fr, fq * 8), boff = lds_byte(wc * 32 + fr, fq * 8);
#define PG8_SA(b, h) (((b) * 2 + (h)) * HTB)
#define PG8_SB(b, h) ((4 + (b) * 2 + (h)) * HTB)
#define PG8_STAGE(bufoff, gbase, voff) do { _Pragma("unroll") for (int _i = 0; _i < 2; ++_i) \
        __builtin_amdgcn_global_load_lds((const unsigned*)((const char*)(gbase) + (voff)[_i]), (PG8_LAS unsigned*)(lds + (bufoff) + ldsw + _i * 8192), 16, 0, 0); } while (0)
#define PG8_LDA(dst, b, h) do { _Pragma("unroll") for (int m = 0; m < 4; ++m) _Pragma("unroll") for (int k = 0; k < 2; ++k) dst[m][k] = *(const PG8_LAS bf16x8*)(lds + PG8_SA(b, h) + aoff + m * 2048 + k * 1024); } while (0)
#define PG8_LDB(dst, b, h) do { _Pragma("unroll") for (int n = 0; n < 2; ++n) _Pragma("unroll") for (int k = 0; k < 2; ++k) dst[n][k] = *(const PG8_LAS bf16x8*)(lds + PG8_SB(b, h) + boff + n * 2048 + k * 1024); } while (0)
#define PG8_MMA(ai, bj, At, Bt) do { __builtin_amdgcn_s_setprio(1); _Pragma("unroll") for (int m = 0; m < 4; ++m) _Pragma("unroll") for (int n = 0; n < 2; ++n) _Pragma("unroll") for (int k = 0; k < 2; ++k) \
        acc[ai][bj][m][n] = __builtin_amdgcn_mfma_f32_16x16x32_bf16(Bt[n][k], At[m][k], acc[ai][bj][m][n], 0, 0, 0); __builtin_amdgcn_s_setprio(0); } while (0)
#define PG8_WAIT_V(n) asm volatile("s_waitcnt vmcnt(" #n ")" ::: "memory")
#define PG8_WAIT_L(n) asm volatile("s_waitcnt lgkmcnt(" #n ")" ::: "memory")
#define PG8_BAR __builtin_amdgcn_s_barrier()
#define PG8_SCHED __builtin_amdgcn_sched_barrier(0)
    Unit cur, nxt; int ui = 0;
    if (!S.next(0, cur)) return;
    f32x4 acc[2][2][4][2];
#pragma unroll
    for (int a = 0; a < 2; ++a)
#pragma unroll
        for (int b = 0; b < 2; ++b)
#pragma unroll
            for (int m = 0; m < 4; ++m)
#pragma unroll
                for (int n = 0; n < 2; ++n) acc[a][b][m][n] = (f32x4){0.f, 0.f, 0.f, 0.f};
    bf16x8 At[4][2], B0[2][2], B1[2][2];
    const char* cA = (const char*)g.A + (size_t)cur.pm * tstep; const char* cB = (const char*)g.Bt + (size_t)cur.pn * tstep;
    S.a_ready(cur);
    if constexpr (SP2) {
        PG8_STAGE(PG8_SB(0, 0), cB, voffB); PG8_STAGE(PG8_SB(0, 1), cB + hstep, voffB); PG8_STAGE(PG8_SA(0, 0), cA, voffA); PG8_STAGE(PG8_SA(0, 1), cA + hstep, voffA);
        if (wr == 1) PG8_BAR;
        PG8_WAIT_V(2); PG8_BAR;
        PG8_STAGE(PG8_SB(1, 0), cB + kstep, voffB); PG8_STAGE(PG8_SA(1, 0), cA + kstep, voffA); PG8_STAGE(PG8_SB(1, 1), cB + hstep + kstep, voffB);
        PG8_WAIT_V(6); PG8_BAR;
    } else {
        PG8_STAGE(PG8_SB(0, 0), cB, voffB); PG8_STAGE(PG8_SA(0, 0), cA, voffA); PG8_STAGE(PG8_SB(0, 1), cB + hstep, voffB); PG8_STAGE(PG8_SA(0, 1), cA + hstep, voffA);
        if (wr == 1) PG8_BAR;
        PG8_WAIT_V(4); PG8_BAR;
        PG8_STAGE(PG8_SB(1, 0), cB + kstep, voffB); PG8_STAGE(PG8_SA(1, 0), cA + kstep, voffA); PG8_STAGE(PG8_SB(1, 1), cB + hstep + kstep, voffB);
        PG8_WAIT_V(6); PG8_BAR;
    }
    for (;;) {
        const bool has_next = S.next(ui + 1, nxt);
        const char* nA = has_next ? (const char*)g.A + (size_t)nxt.pm * tstep : cA; const char* nB = has_next ? (const char*)g.Bt + (size_t)nxt.pn * tstep : cB;
        for (int t = 0; t < nt; t += 2) {
            const bool last = (t == nt - 2);
            const char* a1 = cA + (size_t)(t + 1) * kstep;
            const char* a2 = last ? nA : cA + (size_t)(t + 2) * kstep; const char* b2 = last ? nB : cB + (size_t)(t + 2) * kstep;
            const char* a3 = a2 + kstep; const char* b3 = b2 + kstep;
            if (last && has_next) S.a_ready(nxt);
            if constexpr (SP2) {
            PG8_LDB(B0, 0, 0); PG8_LDB(B1, 0, 1); PG8_SCHED; PG8_LDA(At, 0, 0); PG8_STAGE(PG8_SA(1, 1), a1 + hstep, voffA);
            PG8_WAIT_V(8); PG8_WAIT_L(0); PG8_BAR; PG8_MMA(0, 0, At, B0); PG8_MMA(0, 1, At, B1); PG8_BAR; PG8_SCHED;
            PG8_LDA(At, 0, 1); PG8_STAGE(PG8_SB(0, 0), b2, voffB); PG8_STAGE(PG8_SB(0, 1), b2 + hstep, voffB); PG8_STAGE(PG8_SA(0, 0), a2, voffA);
            PG8_WAIT_V(8); PG8_WAIT_L(0); PG8_BAR; PG8_MMA(1, 0, At, B0); PG8_MMA(1, 1, At, B1); PG8_BAR; PG8_SCHED;
            PG8_LDB(B0, 1, 0); PG8_LDB(B1, 1, 1); PG8_SCHED; PG8_LDA(At, 1, 0); PG8_STAGE(PG8_SA(0, 1), a2 + hstep, voffA);
            PG8_WAIT_V(8); PG8_WAIT_L(0); PG8_BAR; PG8_MMA(0, 0, At, B0); PG8_MMA(0, 1, At, B1); PG8_BAR; PG8_SCHED;
            PG8_LDA(At, 1, 1); PG8_STAGE(PG8_SB(1, 0), b3, voffB); PG8_STAGE(PG8_SB(1, 1), b3 + hstep, voffB); PG8_STAGE(PG8_SA(1, 0), a3, voffA);
            PG8_WAIT_V(8); PG8_WAIT_L(0); PG8_BAR; PG8_MMA(1, 0, At, B0); PG8_MMA(1, 1, At, B1); PG8_BAR; PG8_SCHED;
            } else {
            PG8_LDB(B0, 0, 0); PG8_SCHED; PG8_LDA(At, 0, 0); PG8_STAGE(PG8_SA(1, 1), a1 + hstep, voffA);
            PG8_WAIT_L(8); PG8_BAR; PG8_WAIT_L(0); PG8_MMA(0, 0, At, B0); PG8_BAR; PG8_SCHED;
            PG8_LDB(B1, 0, 1); PG8_STAGE(PG8_SB(0, 0), b2, voffB);
            PG8_BAR; PG8_WAIT_L(0); PG8_MMA(0, 1, At, B1); PG8_BAR;
            PG8_LDA(At, 0, 1); PG8_STAGE(PG8_SA(0, 0), a2, voffA);
            PG8_BAR; PG8_WAIT_L(0); PG8_MMA(1, 0, At, B0); PG8_BAR; PG8_SCHED;
            PG8_STAGE(PG8_SB(0, 1), b2 + hstep, voffB);
            PG8_WAIT_V(6); PG8_BAR; PG8_MMA(1, 1, At, B1); PG8_BAR;
            PG8_LDB(B0, 1, 0); PG8_SCHED; PG8_LDA(At, 1, 0); PG8_STAGE(PG8_SA(0, 1), a2 + hstep, voffA);
            PG8_WAIT_L(8); PG8_BAR; PG8_WAIT_L(0); PG8_MMA(0, 0, At, B0); PG8_BAR; PG8_SCHED;
            PG8_LDB(B1, 1, 1); PG8_STAGE(PG8_SB(1, 0), b3, voffB);
            PG8_BAR; PG8_WAIT_L(0); PG8_MMA(0, 1, At, B1); PG8_BAR;
            PG8_LDA(At, 1, 1); PG8_STAGE(PG8_SA(1, 0), a3, voffA);
            PG8_BAR; PG8_WAIT_L(0); PG8_MMA(1, 0, At, B0); PG8_BAR; PG8_SCHED;
            PG8_STAGE(PG8_SB(1, 1), b3 + hstep, voffB);
            PG8_WAIT_V(6); PG8_BAR; PG8_MMA(1, 1, At, B1); PG8_BAR;
            }
        }
        if constexpr (ALIGN_EPI) { if (wr == 0) PG8_BAR; }
        if constexpr (!Epi::AFTER_DRAIN) { E(acc, cur, wr, wc, fr, fq); S.done(cur); }
        if (!has_next) break;
#pragma unroll
        for (int a = 0; a < 2; ++a)
#pragma unroll
            for (int b = 0; b < 2; ++b)
#pragma unroll
                for (int m = 0; m < 4; ++m)
#pragma unroll
                    for (int n = 0; n < 2; ++n) acc[a][b][m][n] = (f32x4){0.f, 0.f, 0.f, 0.f};
        cur = nxt; cA = nA; cB = nB; ++ui;
        if constexpr (ALIGN_EPI) { if (wr == 1) PG8_BAR; }
    }
    PG8_WAIT_V(0);
    if constexpr (!ALIGN_EPI) { if (wr == 0) PG8_BAR; }
    PG8_BAR;
    if constexpr (Epi::AFTER_DRAIN) { E.fused(acc, cur, wr, wc, fr, fq, lds, wid, lane); S.done(cur); }
#undef PG8_SA
#undef PG8_SB
#undef PG8_STAGE
#undef PG8_LDA
#undef PG8_LDB
#undef PG8_MMA
#undef PG8_WAIT_V
#undef PG8_WAIT_L
#undef PG8_BAR
#undef PG8_SCHED
}
}

#define GAS __attribute__((address_space(1)))
#define LAS __attribute__((address_space(3)))
typedef unsigned short bf16;
typedef unsigned v4u __attribute__((ext_vector_type(4)));
typedef unsigned v2u __attribute__((ext_vector_type(2)));
typedef float f32x4 __attribute__((ext_vector_type(4)));
typedef float f32x16 __attribute__((ext_vector_type(16)));
typedef short bf16x8 __attribute__((ext_vector_type(8)));
typedef short s16x4 __attribute__((ext_vector_type(4)));

constexpr int DM = 2048, DEPTH = 4, NTOK = 65536, PASS_ROWS = 16384, NPASS = 4;
constexpr int IN_REAL = 16928, NPROJ = 17152, LDP = NPROJ;
constexpr int C_GQKV = 0, C_GZ = 3072, C_SQ = 4096, C_SKV = 5120, C_SZ = 5632, C_DQ = 6656, C_DK = 7680, C_DV = 8704, C_DZ = 9728, C_GATE = 10752, C_BA = 16896;
constexpr float NORM_EPS = 1e-6f, LOG2E = 1.4426950408889634f;
constexpr int NWAVES = 8, NTHREADS = 512;

constexpr size_t MiB = 1u << 20;
constexpr size_t WS_CTL = 0, CTL_ZERO_BYTES = 2 * MiB;
constexpr size_t WS_ROWSS = 1 * MiB;
constexpr size_t WS_WIN = 2 * MiB;
constexpr size_t SZ_WIN_L = (size_t)NPROJ * DM * 2;
constexpr size_t WS_WBR = WS_WIN + 4 * SZ_WIN_L;
constexpr size_t SZ_WBR_1 = (size_t)2048 * 1024 * 2;
constexpr size_t WS_WOUT = WS_WBR + 12 * SZ_WBR_1;
constexpr size_t SZ_WOUT_L = (size_t)DM * DM * 2;
constexpr size_t WS_HN = WS_WOUT + 4 * SZ_WOUT_L;
constexpr size_t WS_PROJ = WS_HN + (size_t)NTOK * DM * 2;
constexpr size_t WS_Y = WS_PROJ + (size_t)PASS_ROWS * NPROJ * 2;
constexpr size_t SZ_Y1 = (size_t)PASS_ROWS * 1024 * 2;
constexpr size_t WS_GDN = WS_Y + 3 * SZ_Y1;
constexpr int REC_BYTES = 73728, REC_FW = 0, REC_FQ = 16384, REC_FK = 32768, REC_FQK = 49152, REC_FU = 57344, REC_LOAD = 57344, REC_GAM = REC_FQK + 2048;
constexpr size_t WS_GAM = WS_GDN + (size_t)2 * 256 * 8 * REC_BYTES;
constexpr size_t WS_ODIR = WS_GAM + 16384;
constexpr size_t WS_MTMP = WS_ODIR + 2 * SZ_Y1;
constexpr size_t WS_MRG = WS_MTMP + (size_t)PASS_ROWS * DM * 2;
constexpr size_t WS_PARK = WS_MRG + (size_t)PASS_ROWS * DM * 2;
constexpr size_t WS_PART = WS_PARK + (size_t)256 * 8 * 64 * 64 * 4;
constexpr int PART_SLOTS = 640;
constexpr size_t WS_PARTL = WS_PART + (size_t)PART_SLOTS * 2 * 256 * 128 * 4;
constexpr size_t WS_END = WS_PARTL + (size_t)PART_SLOTS * 2 * 256 * 4;
constexpr int CW_BAR = 4096;
constexpr int CW_DEP = 32768;
constexpr int CW_QUEUE = 16384;

constexpr int LDS_BYTES = 159744;
constexpr int MISC_OFF = LDS_BYTES - 512;

#define LDS_WAIT() asm volatile("s_waitcnt lgkmcnt(0)" ::: "memory")
#define VM_WAIT() asm volatile("s_waitcnt vmcnt(0)" ::: "memory")
__device__ __forceinline__ float bf2f(bf16 b) { return __uint_as_float(((unsigned)b) << 16); }
__device__ __forceinline__ float bflo(unsigned w) { return __uint_as_float(w << 16); }
__device__ __forceinline__ float bfhi(unsigned w) { return __uint_as_float(w & 0xffff0000u); }
typedef float f32x2_t __attribute__((ext_vector_type(2)));
typedef __bf16 bf16x2_t __attribute__((ext_vector_type(2)));
__device__ __forceinline__ unsigned cvtpk(float lo, float hi) { const f32x2_t v = {lo, hi}; const bf16x2_t b = __builtin_convertvector(v, bf16x2_t); return __builtin_bit_cast(unsigned, b); }
__device__ __forceinline__ bf16 f2bf1(float f) { return (bf16)(cvtpk(f, 0.f) & 0xffffu); }
template <int O> __device__ __forceinline__ float xshfl(float v) {
    static_assert(O >= 1 && O <= 16, "xshfl: in-half xor only");
    return __builtin_bit_cast(float, __builtin_amdgcn_ds_swizzle(__builtin_bit_cast(int, v), 0x1F | (O << 10)));
}
__device__ __forceinline__ float half_sum(float v) {
    unsigned a = __float_as_uint(v), b = a; asm volatile("" : "+v"(b));
    auto rr = __builtin_amdgcn_permlane32_swap(a, b, false, false); return __uint_as_float(rr[0]) + __uint_as_float(rr[1]); }
__device__ __forceinline__ float half_max(float v) {
    unsigned a = __float_as_uint(v), b = a; asm volatile("" : "+v"(b));
    auto rr = __builtin_amdgcn_permlane32_swap(a, b, false, false); return fmaxf(__uint_as_float(rr[0]), __uint_as_float(rr[1])); }
__device__ __forceinline__ float wave_sum(float v) { v += xshfl<1>(v); v += xshfl<2>(v); v += xshfl<4>(v); v += xshfl<8>(v); v += xshfl<16>(v); return half_sum(v); }
__device__ __forceinline__ float wave_max(float v) { v = fmaxf(v, xshfl<1>(v)); v = fmaxf(v, xshfl<2>(v)); v = fmaxf(v, xshfl<4>(v)); v = fmaxf(v, xshfl<8>(v)); v = fmaxf(v, xshfl<16>(v)); return half_max(v); }
__device__ __forceinline__ float silu_f(float v) { return v * __builtin_amdgcn_rcpf(1.0f + __expf(-v)); }
__device__ __forceinline__ int crow(int r, int hi) { return (r & 3) + 8 * (r >> 2) + 4 * hi; }
#define MFMA32(a, b, c) __builtin_amdgcn_mfma_f32_32x32x16_bf16((a), (b), (c), 0, 0, 0)
#define XB_TMO      128
#define XB_XCNT(j)  (256  + 64 * (j))
#define XB_XSUB(j)  (1280 + 64 * (j))
#define XB_XGEN(j)  (2304 + 64 * (j))
#define XB_TOP      3328
#define XB_TOPGEN   3392
#define XCD_BAR_WORDS 3456
#define XB_SPIN_CAP (1u << 18)

__device__ __forceinline__ unsigned xb_ld(unsigned* p)              { return __hip_atomic_load(p, __ATOMIC_RELAXED, __HIP_MEMORY_SCOPE_AGENT); }
__device__ __forceinline__ unsigned xb_add(unsigned* p, unsigned v) { return __hip_atomic_fetch_add(p, v, __ATOMIC_RELAXED, __HIP_MEMORY_SCOPE_AGENT); }
__device__ __forceinline__ unsigned xb_xcc_id() { return (unsigned)__builtin_amdgcn_s_getreg((3 << 11) | 20) & 0xFu; }
#define XB_SPIN(cond, bar) do { unsigned _sp = 0; while (cond) { __builtin_amdgcn_s_sleep(1); \
    if ((++_sp & 255u) == 0u) { if (xb_ld(&(bar)[XB_TMO])) break; if (_sp > XB_SPIN_CAP) { atomicAdd(&(bar)[XB_TMO], 1u); break; } } } } while (0)

struct XcdBarrier {
    unsigned* bar; unsigned x;
    volatile LAS unsigned* st;
};

__device__ __forceinline__ XcdBarrier xcd_barrier_post(unsigned* bar, volatile LAS unsigned* st) {
    XcdBarrier b; b.bar = bar; b.x = xb_xcc_id(); b.st = st;
    if (threadIdx.x == 0) (void)xb_add(&bar[XB_XCNT(b.x)], 1u);
    return b;
}
__device__ __forceinline__ void xcd_barrier_complete(unsigned* bar, unsigned x, unsigned& nloc, unsigned& nx) {
    const unsigned G = gridDim.x * gridDim.y * gridDim.z;
    unsigned sum, cnt, mine, sp = 0u;
    for (;;) {
        sum = 0u; cnt = 0u; mine = 0u;
#pragma unroll
        for (unsigned j = 0; j < 16; ++j) { const unsigned c = xb_ld(&bar[XB_XCNT(j)]); sum += c; cnt += (c > 0u) ? 1u : 0u; mine = (j == x) ? c : mine; }
        if (sum == G) break;
        __builtin_amdgcn_s_sleep(1);
        if ((++sp & 255u) == 0u) { if (xb_ld(&bar[XB_TMO])) break; if (sp > XB_SPIN_CAP) { atomicAdd(&bar[XB_TMO], 1u); break; } }
    }
    nloc = mine > 0u ? mine : 1u; nx = cnt > 0u ? cnt : 1u;
}

__device__ __forceinline__ void xcd_barrier(const XcdBarrier& b) {
    asm volatile("s_waitcnt vmcnt(0)" ::: "memory");
    __syncthreads();
    if (threadIdx.x == 0) {
        unsigned* bar = b.bar;
        __builtin_amdgcn_s_waitcnt(0);
        unsigned nloc = b.st[0], nx = b.st[1];
        if (nloc == 0u) { xcd_barrier_complete(bar, b.x, nloc, nx); b.st[0] = nloc; b.st[1] = nx; }
        const unsigned old = xb_add(&bar[XB_XSUB(b.x)], 1u);
        const unsigned gen = old / nloc;
        if (old + 1u == (gen + 1u) * nloc) {
            __builtin_amdgcn_fence(__ATOMIC_RELEASE, "agent");
            asm volatile("s_waitcnt vmcnt(0)" ::: "memory");
            const unsigned og = xb_add(&bar[XB_TOP], 1u);
            const unsigned tg = og / nx;
            if (og + 1u == (tg + 1u) * nx) xb_add(&bar[XB_TOPGEN], 1u);
            else XB_SPIN(xb_ld(&bar[XB_TOPGEN]) == tg, bar);
            __builtin_amdgcn_fence(__ATOMIC_ACQUIRE, "agent");
            xb_add(&bar[XB_XGEN(b.x)], 1u);
            asm volatile("s_waitcnt vmcnt(0)" ::: "memory");
        } else {
            XB_SPIN(xb_ld(&bar[XB_XGEN(b.x)]) == gen, bar);
            __builtin_amdgcn_fence(__ATOMIC_ACQUIRE, "agent");
            asm volatile("s_waitcnt vmcnt(0)" ::: "memory");
        }
    }
    __syncthreads();
}
__device__ __forceinline__ int win_row(int dl) {
    const int L = dl & 255;
    const int p = (dl >= C_GATE && dl < C_GATE + 6144) ? (((L >> 3) & 1) * 128 + (L >> 6) * 32 + ((L >> 4) & 3) * 8 + (L & 7)) : (((L >> 5) & 1) * 128 + (L >> 6) * 32 + (L & 31));
    return (dl & ~255) + p;
}
template <bool MAPW = false>
__device__ __forceinline__ void transpose_item(const float* W, int K, int N, bf16* WT, int k0, int n0, int drow0, LAS float* scr, int lane) {
#pragma unroll 8
    for (int i = 0; i < 32; ++i) { const int kk = 2 * i + (lane >> 5); scr[kk * 33 + (lane & 31)] = W[(size_t)(k0 + kk) * N + n0 + (lane & 31)]; }
    LDS_WAIT(); asm volatile("" ::: "memory");
    const int c = lane & 7;
#pragma unroll
    for (int j = 0; j < 4; ++j) { const int n = (lane >> 3) + 8 * j; const LAS float* s = scr + (8 * c) * 33 + n;
        v4u o; o.x = cvtpk(s[0 * 33], s[1 * 33]); o.y = cvtpk(s[2 * 33], s[3 * 33]); o.z = cvtpk(s[4 * 33], s[5 * 33]); o.w = cvtpk(s[6 * 33], s[7 * 33]);
        *(v4u*)(WT + (size_t)(MAPW ? win_row(drow0 + n) : drow0 + n) * K + k0 + 8 * c) = o; }
    LDS_WAIT(); asm volatile("" ::: "memory");
}
__device__ __forceinline__ void phase_prologue(LAS unsigned char* lds, const float* w_in, const float* w_branch, const float* w_out, unsigned char* ws, int gw, int ngw, int wave, int lane) {
    LAS float* scr = (LAS float*)(lds + wave * 16384);
    constexpr int NB_IN = IN_REAL / 32;
    constexpr int I_IN = 32 * NB_IN;
    constexpr int I_BR = 16 * 64;
    constexpr int I_OUT = 32 * 64;
    constexpr int TOT = 4 * I_IN + 12 * I_BR + 4 * I_OUT;
    for (int it = gw; it < TOT; it += ngw) {
        int r = it;
        if (r < 4 * I_IN) { const int l = r / I_IN; r -= l * I_IN; const int kb = r / NB_IN, nb = r % NB_IN, n0 = nb * 32;
            const int drow = (n0 < 4096) ? n0 : ((n0 < 4128) ? (C_BA + (n0 - 4096)) : (n0 - 32));
            transpose_item<true>(w_in + (size_t)l * DM * IN_REAL, DM, IN_REAL, (bf16*)(ws + WS_WIN + (size_t)l * SZ_WIN_L), kb * 64, n0, drow, scr, lane); continue; }
        r -= 4 * I_IN;
        if (r < 12 * I_BR) { const int m = r / I_BR; r -= m * I_BR; const int kb = r / 64, nb = r % 64;
            transpose_item(w_branch + (size_t)m * 1024 * 2048, 1024, 2048, (bf16*)(ws + WS_WBR + (size_t)m * SZ_WBR_1), kb * 64, nb * 32, nb * 32, scr, lane); continue; }
        r -= 12 * I_BR;
        { const int l = r / I_OUT; r -= l * I_OUT; const int kb = r / 64, nb = r % 64;
            transpose_item(w_out + (size_t)l * DM * DM, DM, DM, (bf16*)(ws + WS_WOUT + (size_t)l * SZ_WOUT_L), kb * 64, nb * 32, nb * 32, scr, lane); }
    }
    const v4u z = {0u, 0u, 0u, 0u};
    for (int i = gw * 64 + lane; i < 4 * 57344; i += ngw * 64) { const int l = i / 57344, q = i % 57344;
        *(v4u*)(ws + WS_WIN + (size_t)l * SZ_WIN_L + (size_t)IN_REAL * DM * 2 + (size_t)q * 16) = z; }
}
__device__ __forceinline__ void rms_row(const float* xrow, const float* gain, bf16* orow, float* rowss, int lane) {
    const f32x4* xr = (const f32x4*)xrow + lane; const f32x4* gr = (const f32x4*)gain + lane;
    f32x4 v[8]; float s = 0.f;
#pragma unroll
    for (int j = 0; j < 8; ++j) { v[j] = xr[64 * j]; s += (v[j].x * v[j].x + v[j].y * v[j].y) + (v[j].z * v[j].z + v[j].w * v[j].w); }
    s = wave_sum(s);
    if (lane == 0) *rowss = s;
    v2u* o8 = (v2u*)orow + lane;
#pragma unroll
    for (int j = 0; j < 8; ++j) { const f32x4 g = gr[64 * j]; v2u o; o.x = cvtpk(v[j].x * g.x, v[j].y * g.y); o.y = cvtpk(v[j].z * g.z, v[j].w * g.w); o8[64 * j] = o; }
}
template <bool DIFF>
__device__ __forceinline__ void knorm_row(bf16* prow, const float* swa_k_gain, const float* diff_k_gain, int lane) {
    {
        v2u* p = (v2u*)(prow + C_SKV) + lane; const v2u w = *p;
        float a = bflo(w.x), b = bfhi(w.x), c = bflo(w.y), d = bfhi(w.y);
        float ss = (a * a + b * b) + (c * c + d * d);
        ss += xshfl<1>(ss); ss += xshfl<2>(ss); ss += xshfl<4>(ss); ss += xshfl<8>(ss); ss += xshfl<16>(ss);
        const float rs = 1.0f / sqrtf(ss * (1.0f / 128.0f) + NORM_EPS);
        const f32x4 g = *((const f32x4*)swa_k_gain + (lane & 31));
        v2u o; o.x = cvtpk(a * rs * g.x, b * rs * g.y); o.y = cvtpk(c * rs * g.z, d * rs * g.w); *p = o;
    }
    if (DIFF) {
        v4u* p = (v4u*)(prow + C_DK) + 2 * lane; const v4u w0 = p[0], w1 = p[1];
        float x[16] = {bflo(w0.x), bfhi(w0.x), bflo(w0.y), bfhi(w0.y), bflo(w0.z), bfhi(w0.z), bflo(w0.w), bfhi(w0.w),
                       bflo(w1.x), bfhi(w1.x), bflo(w1.y), bfhi(w1.y), bflo(w1.z), bfhi(w1.z), bflo(w1.w), bfhi(w1.w)};
        float ss = 0.f;
#pragma unroll
        for (int e = 0; e < 16; ++e) ss += x[e] * x[e];
        ss += xshfl<1>(ss); ss += xshfl<2>(ss);
        const float rs = 1.0f / sqrtf(ss * (1.0f / 64.0f) + NORM_EPS);
        const float* g = diff_k_gain + 16 * (lane & 3);
#pragma unroll
        for (int e = 0; e < 16; ++e) x[e] *= rs * g[e];
        v4u o0, o1; o0.x = cvtpk(x[0], x[1]); o0.y = cvtpk(x[2], x[3]); o0.z = cvtpk(x[4], x[5]); o0.w = cvtpk(x[6], x[7]);
        o1.x = cvtpk(x[8], x[9]); o1.y = cvtpk(x[10], x[11]); o1.z = cvtpk(x[12], x[13]); o1.w = cvtpk(x[14], x[15]);
        p[0] = o0; p[1] = o1;
    }
}
__device__ __forceinline__ void gdn_final_row(const bf16* of, const bf16* ob, const bf16* zrow, const float* gain, bf16* yrow, int lane) {
    const v4u* pf = (const v4u*)of + 2 * lane; const v4u* pb = (const v4u*)ob + 2 * lane; const v4u* pz = (const v4u*)zrow + 2 * lane;
    float x[16], z[16];
#pragma unroll
    for (int q = 0; q < 2; ++q) { const v4u a = pf[q], b = pb[q], c = pz[q];
        x[8 * q + 0] = bflo(a.x) + bflo(b.x); x[8 * q + 1] = bfhi(a.x) + bfhi(b.x); x[8 * q + 2] = bflo(a.y) + bflo(b.y); x[8 * q + 3] = bfhi(a.y) + bfhi(b.y);
        x[8 * q + 4] = bflo(a.z) + bflo(b.z); x[8 * q + 5] = bfhi(a.z) + bfhi(b.z); x[8 * q + 6] = bflo(a.w) + bflo(b.w); x[8 * q + 7] = bfhi(a.w) + bfhi(b.w);
        z[8 * q + 0] = bflo(c.x); z[8 * q + 1] = bfhi(c.x); z[8 * q + 2] = bflo(c.y); z[8 * q + 3] = bfhi(c.y);
        z[8 * q + 4] = bflo(c.z); z[8 * q + 5] = bfhi(c.z); z[8 * q + 6] = bflo(c.w); z[8 * q + 7] = bfhi(c.w); }
    float ss = 0.f;
#pragma unroll
    for (int e = 0; e < 16; ++e) ss += x[e] * x[e];
    ss += xshfl<1>(ss); ss += xshfl<2>(ss); ss += xshfl<4>(ss);
    const float rs = 1.0f / sqrtf(ss * (1.0f / 128.0f) + NORM_EPS);
    const float* g = gain + 16 * (lane & 7);
#pragma unroll
    for (int e = 0; e < 16; ++e) x[e] = x[e] * rs * g[e] * z[e];
    v4u o0, o1; o0.x = cvtpk(x[0], x[1]); o0.y = cvtpk(x[2], x[3]); o0.z = cvtpk(x[4], x[5]); o0.w = cvtpk(x[6], x[7]);
    o1.x = cvtpk(x[8], x[9]); o1.y = cvtpk(x[10], x[11]); o1.z = cvtpk(x[12], x[13]); o1.w = cvtpk(x[14], x[15]);
    v4u* py = (v4u*)yrow + 2 * lane; py[0] = o0; py[1] = o1;
}
__device__ __forceinline__ void diff_final_row(const unsigned char* ws, int slot0, int np, int rr, float lam, float lambda_init, const bf16* zrow, const float* gain, bf16* yrow, int lane) {
    typedef float f32x2v __attribute__((ext_vector_type(2)));
    const float* PO = (const float*)(ws + WS_PART); const float* PL = (const float*)(ws + WS_PARTL);
    f32x2v o0 = {0.f, 0.f}, o1 = {0.f, 0.f}; float l0 = 0.f, l1 = 0.f;
    for (int p = 0; p < np; ++p) { const int s = slot0 + p;
        o0 += *(const f32x2v*)(PO + ((size_t)(s * 2 + 0) * 256 + rr) * 128 + 2 * lane); o1 += *(const f32x2v*)(PO + ((size_t)(s * 2 + 1) * 256 + rr) * 128 + 2 * lane);
        l0 += PL[(s * 2 + 0) * 256 + rr]; l1 += PL[(s * 2 + 1) * 256 + rr]; }
    const float r0 = 1.0f / l0, r1 = lam / l1;
    const float a = o0.x * r0 - o1.x * r1, b = o0.y * r0 - o1.y * r1;
    const float rs = (1.0f / sqrtf(wave_sum(a * a + b * b) * (1.0f / 128.0f) + NORM_EPS)) * (1.0f - lambda_init);
    const unsigned zw = *(const unsigned*)(zrow + 2 * lane);
    const float ya = a * rs * gain[2 * lane] * bflo(zw), yb = b * rs * gain[2 * lane + 1] * bfhi(zw);
    *(unsigned*)(yrow + 2 * lane) = cvtpk(ya, yb);
}
constexpr int D1_QROW = 0, D1_KROW = 17408, D1_KT = 34816, D1_VT = 53248, D1_LM = 71680, D1_TB = 106496, D1_BETA = 143360, D1_GC = 143872, D1_END = 144384;
constexpr int ROWP = 272, TRP = 144, LMP = 272, TBP = 144;
#define TSW(rw, boff) ((rw) * TRP + ((boff) ^ ((((rw) >> 3) & 7) << 4)))
__device__ __forceinline__ unsigned char* gdn_rec(unsigned char* ws, int d, int ci, int h) { return ws + WS_GDN + (((size_t)d * 256 + ci) * 8 + h) * REC_BYTES; }

#ifndef DUP_D1
#define DUP_D1 0
#endif
__device__ __forceinline__ void gdn_prep_unit(LAS unsigned char* lds, unsigned char* ws, const float* conv_w, const float* a_log, const float* dt_bias,
                                              int l, int Tp, int ci, int h, int nci, int nh, unsigned& pre_ba, int tid, int wave, int lane) {
    const bf16* PROJ = (const bf16*)(ws + WS_PROJ);
    const int row0 = ci * 64, tin = row0 % Tp; const bool first = (tin == 0), last = (tin + 64 == Tp);
    LAS float* BETA = (LAS float*)(lds + D1_BETA); LAS float* GC = (LAS float*)(lds + D1_GC);
    if (tid < 128) {
        const int d = tid >> 6, r = tid & 63, c = d ? 63 - r : r;
        const float braw = bflo(pre_ba), araw = bfhi(pre_ba);
        if (nci >= 0) { const bf16* pn = PROJ + (size_t)(nci * 64 + c) * LDP + C_BA; pre_ba = (unsigned)pn[d * 8 + nh] | ((unsigned)pn[16 + d * 8 + nh] << 16); }
        const float beta = __builtin_amdgcn_rcpf(1.0f + __expf(-braw));
        const float x = araw + dt_bias[(l * 2 + d) * 8 + h];
        const float sp = fmaxf(x, 0.f) + log1pf(__expf(-fabsf(x)));
        float gcv = -__expf(a_log[(l * 2 + d) * 8 + h]) * sp;
#pragma unroll
        for (int off = 1; off < 64; off <<= 1) { const float t = __shfl_up(gcv, off); if (r >= off) gcv += t; }
        BETA[d * 64 + r] = beta; GC[d * 64 + r] = gcv;
        if (r == 63) *(float*)(gdn_rec(ws, d, ci, h) + REC_GAM) = __expf(gcv);
    }
    __syncthreads();
    for (int rep1 = 0; rep1 < (DUP_D1 == 1 ? 2 : 1); ++rep1) {
        const int sub = tid & 15, ch0 = sub * 8;
#pragma unroll 3
        for (int rnd = 0; rnd < 6; ++rnd) {
            const int it = rnd * 32 + (tid >> 4), mat = it >> 6, c = it & 63;
            const int chan = mat * 1024 + h * 128 + ch0;
            const bf16* px = PROJ + (size_t)(row0 + c) * LDP + C_GQKV + chan;
            const v4u zz = {0u, 0u, 0u, 0u};
            const v4u x1 = *(const v4u*)px;
            const v4u x0 = (c == 0 && first) ? zz : *(const v4u*)(px - LDP);
            const v4u x2 = (c == 63 && last) ? zz : *(const v4u*)(px + LDP);
            const float* cw = conv_w + (size_t)l * 3 * 3072 + chan;
            const f32x4 w0a = *(const f32x4*)cw, w0b = *(const f32x4*)(cw + 4), w1a = *(const f32x4*)(cw + 3072), w1b = *(const f32x4*)(cw + 3072 + 4), w2a = *(const f32x4*)(cw + 6144), w2b = *(const f32x4*)(cw + 6144 + 4);
            const float w0[8] = {w0a.x, w0a.y, w0a.z, w0a.w, w0b.x, w0b.y, w0b.z, w0b.w}, w1[8] = {w1a.x, w1a.y, w1a.z, w1a.w, w1b.x, w1b.y, w1b.z, w1b.w}, w2[8] = {w2a.x, w2a.y, w2a.z, w2a.w, w2b.x, w2b.y, w2b.z, w2b.w};
            const float a0[8] = {bflo(x0.x), bfhi(x0.x), bflo(x0.y), bfhi(x0.y), bflo(x0.z), bfhi(x0.z), bflo(x0.w), bfhi(x0.w)};
            const float a1[8] = {bflo(x1.x), bfhi(x1.x), bflo(x1.y), bfhi(x1.y), bflo(x1.z), bfhi(x1.z), bflo(x1.w), bfhi(x1.w)};
            const float a2[8] = {bflo(x2.x), bfhi(x2.x), bflo(x2.y), bfhi(x2.y), bflo(x2.z), bfhi(x2.z), bflo(x2.w), bfhi(x2.w)};
            float y[8]; float ss = 0.f;
#pragma unroll
            for (int e = 0; e < 8; ++e) { const float a = a0[e] * w0[e] + a1[e] * w1[e] + a2[e] * w2[e]; y[e] = a * __builtin_amdgcn_rcpf(1.0f + __expf(-a)); ss += y[e] * y[e]; }
            if (mat < 2) {
                ss += xshfl<1>(ss); ss += xshfl<2>(ss); ss += xshfl<4>(ss); ss += xshfl<8>(ss);
                float rs = __builtin_amdgcn_rsqf(ss + NORM_EPS); if (mat == 0) rs *= 0.08838834764831845f;
#pragma unroll
                for (int e = 0; e < 8; ++e) y[e] *= rs;
            }
            if (mat == 0) {
                v4u o; o.x = cvtpk(y[0], y[1]); o.y = cvtpk(y[2], y[3]); o.z = cvtpk(y[4], y[5]); o.w = cvtpk(y[6], y[7]);
                *(LAS v4u*)(lds + D1_QROW + c * ROWP + ch0 * 2) = o;
                const int t = ch0 >> 5, kk = ch0 & 31, s = kk >> 4, b = (kk >> 3) & 1;
#pragma unroll
                for (int d = 0; d < 2; ++d) { const int r = d ? 63 - c : c; const float e = __expf(GC[d * 64 + r]); const int i = r >> 5, rr = r & 31;
                    unsigned char* fb = gdn_rec(ws, d, ci, h) + REC_FQ + (((i * 4 + t) * 2 + s) * 64) * 16 + b * 8;
                    v2u lo, hi2; lo.x = cvtpk(y[0] * e, y[1] * e); lo.y = cvtpk(y[2] * e, y[3] * e); hi2.x = cvtpk(y[4] * e, y[5] * e); hi2.y = cvtpk(y[6] * e, y[7] * e);
                    *(v2u*)(fb + rr * 16) = lo; *(v2u*)(fb + (rr + 32) * 16) = hi2; }
            } else if (mat == 1) {
                v4u o; o.x = cvtpk(y[0], y[1]); o.y = cvtpk(y[2], y[3]); o.z = cvtpk(y[4], y[5]); o.w = cvtpk(y[6], y[7]);
                *(LAS v4u*)(lds + D1_KROW + c * ROWP + ch0 * 2) = o;
#pragma unroll
                for (int e = 0; e < 8; ++e) *(LAS bf16*)(lds + D1_KT + TSW(ch0 + e, c * 2)) = f2bf1(y[e]);
            } else {
#pragma unroll
                for (int e = 0; e < 8; ++e) *(LAS bf16*)(lds + D1_VT + TSW(ch0 + e, c * 2)) = f2bf1(y[e]);
            }
        }
    }
    __syncthreads();
    for (int rep2 = 0; rep2 < (DUP_D1 == 2 ? 2 : 1); ++rep2) {
        const int r32 = lane & 31, hi = lane >> 5;
#pragma unroll 1
        for (int k = wave; k < 12; k += 8) {
            const int d = k / 6, sel = k % 6;
            int ta, tb; int boff;
            if (sel < 3) { ta = (sel >= 1); tb = (sel == 2); boff = D1_KROW; }
            else { ta = (sel == 5); tb = (sel >= 4); boff = D1_QROW; }
            const int ra = 32 * ta + r32, rb = 32 * tb + r32;
            const int rowa = d ? 63 - ra : ra, rowb = d ? 63 - rb : rb;
            const LAS unsigned char* pa = lds + D1_KROW + rowa * ROWP + hi * 16; const LAS unsigned char* pb = lds + boff + rowb * ROWP + hi * 16;
            f32x16 acc = {0.f, 0.f, 0.f, 0.f, 0.f, 0.f, 0.f, 0.f, 0.f, 0.f, 0.f, 0.f, 0.f, 0.f, 0.f, 0.f};
#pragma unroll
            for (int s = 0; s < 8; ++s) acc = MFMA32(*(const LAS bf16x8*)(pa + s * 32), *(const LAS bf16x8*)(pb + s * 32), acc);
            const int colp = 32 * tb + r32;
            const float gcc = GC[d * 64 + colp];
            if (sel < 3) {
                LAS float* Lm = (LAS float*)(lds + D1_LM + d * 17408);
#pragma unroll
                for (int r = 0; r < 16; ++r) { const int rp = 32 * ta + crow(r, hi);
                    const float v = (rp > colp) ? BETA[d * 64 + rp] * acc[r] * __expf(GC[d * 64 + rp] - gcc) : 0.f;
                    Lm[rp * (LMP / 4) + colp] = v; }
            } else {
                float v[16];
#pragma unroll
                for (int r = 0; r < 16; ++r) { const int cp = 32 * ta + crow(r, hi);
                    v[r] = (colp >= cp) ? acc[r] * __expf(gcc - GC[d * 64 + cp]) : 0.f; }
                unsigned char* fb = gdn_rec(ws, d, ci, h) + REC_FQK + (((tb * 2 + ta) * 2) * 64 + lane) * 16;
                v4u o0, o1; o0.x = cvtpk(v[0], v[1]); o0.y = cvtpk(v[2], v[3]); o0.z = cvtpk(v[4], v[5]); o0.w = cvtpk(v[6], v[7]);
                o1.x = cvtpk(v[8], v[9]); o1.y = cvtpk(v[10], v[11]); o1.z = cvtpk(v[12], v[13]); o1.w = cvtpk(v[14], v[15]);
                *(v4u*)fb = o0; *(v4u*)(fb + 1024) = o1;
            }
        }
    }
    __syncthreads();
    constexpr int D1_TS = D1_QROW;
    for (int rep3 = 0; rep3 < (DUP_D1 == 3 ? 2 : 1); ++rep3)
    if (wave < 4) {
        const int d = wave >> 1, blk = wave & 1, j = lane & 31, jp = 32 * blk + j;
        const LAS float* Lm = (const LAS float*)(lds + D1_LM + d * 17408) + (32 * blk) * (LMP / 4) + 32 * blk;
        const float bj = BETA[d * 64 + jp], bgj = bj * __expf(GC[d * 64 + jp]);
        const int col = d ? 63 - jp : jp;
        LAS unsigned char* tb = lds + D1_TB + d * 18432 + (32 * blk) * TBP + col * 2;
        LAS float* ts = (LAS float*)(lds + D1_TS + (d * 2 + blk) * 4352) + j;
        if (lane < 32) {
            float t[32];
#pragma unroll
            for (int r = 0; r < 32; ++r) {
                float a4[4] = {(r == j) ? 1.f : 0.f, 0.f, 0.f, 0.f};
#pragma unroll
                for (int m4 = 0; m4 < (r + 3) / 4; ++m4) { const f32x4 lv = *(const LAS f32x4*)(Lm + r * (LMP / 4) + m4 * 4);
#pragma unroll
                    for (int e = 0; e < 4; ++e) if (m4 * 4 + e < r) a4[e] -= lv[e] * t[m4 * 4 + e]; }
                const float a = (a4[0] + a4[1]) + (a4[2] + a4[3]);
                t[r] = a; ts[r * 33] = a;
                *(LAS bf16*)(tb + r * TBP) = f2bf1(a * bj); *(LAS bf16*)(tb + 9216 + r * TBP) = f2bf1(a * bgj);
            }
        } else if (blk == 0) {
            const int colz = d ? 63 - (32 + j) : 32 + j; LAS unsigned char* tz = lds + D1_TB + d * 18432 + colz * 2;
#pragma unroll
            for (int r = 0; r < 32; ++r) { *(LAS bf16*)(tz + r * TBP) = (bf16)0; *(LAS bf16*)(tz + 9216 + r * TBP) = (bf16)0; }
        }
    } else {
        const int rr = lane & 31, hh = lane >> 5;
#pragma unroll 1
        for (int f = wave - 4; f < 32; f += 4) {
            const int d = f >> 4, t = (f >> 2) & 3, ip = (f >> 1) & 1, s = f & 1;
            const int c0 = 32 * ip + 16 * s + 4 * hh;
            const float gl = GC[d * 64 + 63];
            const int ktr = 32 * t + rr; const LAS unsigned char* kt = lds + D1_KT;
            float ea[4], eb[4];
#pragma unroll
            for (int x = 0; x < 4; ++x) { ea[x] = __expf(gl - GC[d * 64 + c0 + x]); eb[x] = __expf(gl - GC[d * 64 + c0 + 8 + x]); }
            float ka[4], kb[4];
            if (d == 0) { const v2u wa = *(const LAS v2u*)(kt + TSW(ktr, c0 * 2)), wb = *(const LAS v2u*)(kt + TSW(ktr, (c0 + 8) * 2));
                ka[0] = bflo(wa.x); ka[1] = bfhi(wa.x); ka[2] = bflo(wa.y); ka[3] = bfhi(wa.y); kb[0] = bflo(wb.x); kb[1] = bfhi(wb.x); kb[2] = bflo(wb.y); kb[3] = bfhi(wb.y); }
            else { const v2u wa = *(const LAS v2u*)(kt + TSW(ktr, (60 - c0) * 2)), wb = *(const LAS v2u*)(kt + TSW(ktr, (52 - c0) * 2));
                ka[3] = bflo(wa.x); ka[2] = bfhi(wa.x); ka[1] = bflo(wa.y); ka[0] = bfhi(wa.y); kb[3] = bflo(wb.x); kb[2] = bfhi(wb.x); kb[1] = bflo(wb.y); kb[0] = bfhi(wb.y); }
            v4u o; o.x = cvtpk(ka[0] * ea[0], ka[1] * ea[1]); o.y = cvtpk(ka[2] * ea[2], ka[3] * ea[3]); o.z = cvtpk(kb[0] * eb[0], kb[1] * eb[1]); o.w = cvtpk(kb[2] * eb[2], kb[3] * eb[3]);
            *(v4u*)(gdn_rec(ws, d, ci, h) + REC_FK + (((t * 2 + ip) * 2 + s) * 64 + lane) * 16) = o;
        }
    }
    __syncthreads();
    if (wave < 2) {
        const int d = wave, i = lane & 31, hh = lane >> 5;
        const LAS float* L21 = (const LAS float*)(lds + D1_LM + d * 17408) + (32 + i) * (LMP / 4);
        const LAS float* T11 = (const LAS float*)(lds + D1_TS + (d * 2 + 0) * 4352);
        const LAS float* T22 = (const LAS float*)(lds + D1_TS + (d * 2 + 1) * 4352);
        f32x16 P = {0.f, 0.f, 0.f, 0.f, 0.f, 0.f, 0.f, 0.f, 0.f, 0.f, 0.f, 0.f, 0.f, 0.f, 0.f, 0.f};
#pragma unroll
        for (int s = 0; s < 16; ++s) P = __builtin_amdgcn_mfma_f32_32x32x2f32(L21[2 * s + hh], T11[(2 * s + hh) * 33 + i], P, 0, 0, 0);
        f32x16 R = {0.f, 0.f, 0.f, 0.f, 0.f, 0.f, 0.f, 0.f, 0.f, 0.f, 0.f, 0.f, 0.f, 0.f, 0.f, 0.f};
#pragma unroll
        for (int s = 0; s < 16; ++s) R = __builtin_amdgcn_mfma_f32_32x32x2f32(T22[i * 33 + crow(s, hh)], P[s], R, 0, 0, 0);
        const float bj = BETA[d * 64 + i], bgj = bj * __expf(GC[d * 64 + i]);
        const int col = d ? 63 - i : i;
        LAS unsigned char* tb = lds + D1_TB + d * 18432 + 32 * TBP + col * 2;
#pragma unroll
        for (int r = 0; r < 16; ++r) { const float a = -R[r]; const int row = crow(r, hh);
            *(LAS bf16*)(tb + row * TBP) = f2bf1(a * bj); *(LAS bf16*)(tb + 9216 + row * TBP) = f2bf1(a * bgj); }
    }
    __syncthreads();
    for (int rep4 = 0; rep4 < (DUP_D1 == 4 ? 2 : 1); ++rep4) {
        const int r32 = lane & 31, hi = lane >> 5;
#pragma unroll 1
        for (int f = wave; f < 32; f += 8) {
            const int d = f >> 4, kind = (f >> 3) & 1, idx = f & 7;
            const LAS unsigned char* pa; const LAS unsigned char* pb; int xa = 0, xb = 0;
            if (kind == 0) { const int i = idx >> 2, w = idx & 3;
                pa = lds + D1_TB + d * 18432 + (32 * i + r32) * TBP; pb = lds + D1_VT + (32 * w + r32) * TRP; xb = (((32 * w + r32) >> 3) & 7) << 4; }
            else { const int t = idx >> 1, i = idx & 1;
                pa = lds + D1_KT + (32 * t + r32) * TRP; xa = (((32 * t + r32) >> 3) & 7) << 4; pb = lds + D1_TB + d * 18432 + 9216 + (32 * i + r32) * TBP; }
            f32x16 acc = {0.f, 0.f, 0.f, 0.f, 0.f, 0.f, 0.f, 0.f, 0.f, 0.f, 0.f, 0.f, 0.f, 0.f, 0.f, 0.f};
#pragma unroll
            for (int s = 0; s < 4; ++s) acc = MFMA32(*(const LAS bf16x8*)(pa + ((s * 32 + hi * 16) ^ xa)), *(const LAS bf16x8*)(pb + ((s * 32 + hi * 16) ^ xb)), acc);
            const float sg = kind ? -1.f : 1.f;
            v4u o0, o1; o0.x = cvtpk(sg * acc[0], sg * acc[1]); o0.y = cvtpk(sg * acc[2], sg * acc[3]); o0.z = cvtpk(sg * acc[4], sg * acc[5]); o0.w = cvtpk(sg * acc[6], sg * acc[7]);
            o1.x = cvtpk(sg * acc[8], sg * acc[9]); o1.y = cvtpk(sg * acc[10], sg * acc[11]); o1.z = cvtpk(sg * acc[12], sg * acc[13]); o1.w = cvtpk(sg * acc[14], sg * acc[15]);
            if (kind == 0) { const int i = idx >> 2, w = idx & 3; unsigned char* fb = gdn_rec(ws, d, ci, h) + REC_FU + ((w * 2 + i) * 64 + lane) * 32; *(v4u*)fb = o0; *(v4u*)(fb + 16) = o1; }
            else { const int t = idx >> 1, i = idx & 1; unsigned char* fb = gdn_rec(ws, d, ci, h) + REC_FW + (((i * 4 + t) * 2) * 64 + lane) * 16; *(v4u*)fb = o0; *(v4u*)(fb + 1024) = o1; }
        }
    }
    __syncthreads();
}
__device__ __forceinline__ bf16x8 pack8(const f32x16& v, int s) {
    v4u w; w.x = cvtpk(v[8 * s + 0], v[8 * s + 1]); w.y = cvtpk(v[8 * s + 2], v[8 * s + 3]); w.z = cvtpk(v[8 * s + 4], v[8 * s + 5]); w.w = cvtpk(v[8 * s + 6], v[8 * s + 7]);
    return __builtin_bit_cast(bf16x8, w);
}
#define SCAN_BAR() do { asm volatile("s_waitcnt lgkmcnt(0)" ::: "memory"); __builtin_amdgcn_s_barrier(); asm volatile("" ::: "memory"); } while (0)
constexpr int SC_BUF = REC_BYTES;
__device__ __forceinline__ void gdn_scan_unit(LAS unsigned char* lds, unsigned char* ws, int Tp, int sq, int h, int d, int half, int tid, int wave, int lane) {
    const int Nc = Tp / 64, cb = sq * Nc;
    bf16* ODIR = (bf16*)(ws + WS_ODIR) + (size_t)d * PASS_ROWS * 1024;
#define SC_SRC(n) ((const unsigned char*)gdn_rec(ws, d, cb + (d ? Nc - 1 - (n) : (n)), h))
    if (wave >= 2) {
        const int lt = tid - 128;
#define SC_LOAD(st, n) do { const unsigned char* src_ = SC_SRC(n); _Pragma("unroll") for (int k = 0; k < 12; ++k) st[k] = *(const v4u*)(src_ + (lt + 384 * k) * 16); } while (0)
#define SC_WRITE(st, b) do { _Pragma("unroll") for (int k = 0; k < 12; ++k) *(LAS v4u*)(lds + (b) * SC_BUF + (lt + 384 * k) * 16) = st[k]; } while (0)
        v4u s0[12], s1[12];
        SC_LOAD(s0, 0); SC_WRITE(s0, 0);
        if (1 < Nc) SC_LOAD(s1, 1);
        if (2 < Nc) SC_LOAD(s0, 2);
        SCAN_BAR();
#define SC_STEP(n, st) do { if ((n) < Nc) { if ((n) + 1 < Nc) SC_WRITE(st, ((n) + 1) & 1); if ((n) + 3 < Nc) SC_LOAD(st, (n) + 3); SCAN_BAR(); } } while (0)
#pragma unroll 1
        for (int n = 0; n < Nc; n += 2) { SC_STEP(n, s1); SC_STEP(n + 1, s0); }
#undef SC_STEP
#undef SC_WRITE
#undef SC_LOAD
    } else {
        const int w = half * 2 + wave, r32 = lane & 31, hi = lane >> 5;
        f32x16 S[4];
#pragma unroll
        for (int t = 0; t < 4; ++t)
#pragma unroll
            for (int r = 0; r < 16; ++r) S[t][r] = 0.f;
        const __amdgpu_buffer_rsrc_t orsrc = __builtin_amdgcn_make_buffer_rsrc((void*)(ODIR + (size_t)(sq * Tp) * 1024 + h * 128 + 32 * w), 0, 0x7fffffff, 0x00020000);
        SCAN_BAR();
#pragma unroll 1
        for (int n = 0; n < Nc; ++n) {
            const LAS unsigned char* buf = lds + (n & 1) * SC_BUF + lane * 16;
            const float gam = *(const LAS float*)(lds + (n & 1) * SC_BUF + REC_GAM);
#define LDF(off) (*(const LAS bf16x8*)(buf + (off)))
#define FWO(i, t, s) (REC_FW + (((i) * 4 + (t)) * 2 + (s)) * 1024)
#define FQO(i, t, s) (REC_FQ + (((i) * 4 + (t)) * 2 + (s)) * 1024)
#define FKO(t, ip, s) (REC_FK + (((t) * 2 + (ip)) * 2 + (s)) * 1024)
#define FQKO(i, ip, s) (REC_FQK + (((i) * 2 + (ip)) * 2 + (s)) * 1024)
            bf16x8 A[8], B[8];
#pragma unroll
            for (int e = 0; e < 8; ++e) { A[e] = LDF(FWO(e & 1, e >> 2, (e >> 1) & 1)); B[e] = LDF(FWO(e & 1, 2 + (e >> 2), (e >> 1) & 1)); }
            v4u ua[2], ub[2];
#pragma unroll
            for (int i = 0; i < 2; ++i) { const LAS v4u* pu = (const LAS v4u*)(lds + (n & 1) * SC_BUF + REC_FU + ((w * 2 + i) * 64 + lane) * 32); ua[i] = pu[0]; ub[i] = pu[1]; }
            __builtin_amdgcn_sched_barrier(0);
            bf16x8 Sf[4][2];
#pragma unroll
            for (int t = 0; t < 4; ++t) { Sf[t][0] = pack8(S[t], 0); Sf[t][1] = pack8(S[t], 1); }
            f32x16 V[2];
#pragma unroll
            for (int i = 0; i < 2; ++i) { const v4u a = ua[i], b = ub[i];
                V[i][0] = bflo(a.x); V[i][1] = bfhi(a.x); V[i][2] = bflo(a.y); V[i][3] = bfhi(a.y); V[i][4] = bflo(a.z); V[i][5] = bfhi(a.z); V[i][6] = bflo(a.w); V[i][7] = bfhi(a.w);
                V[i][8] = bflo(b.x); V[i][9] = bfhi(b.x); V[i][10] = bflo(b.y); V[i][11] = bfhi(b.y); V[i][12] = bflo(b.z); V[i][13] = bfhi(b.z); V[i][14] = bflo(b.w); V[i][15] = bfhi(b.w); }
            __builtin_amdgcn_sched_barrier(0);
#pragma unroll
            for (int e = 0; e < 8; ++e) V[e & 1] = MFMA32(A[e], Sf[e >> 2][(e >> 1) & 1], V[e & 1]);
            __builtin_amdgcn_sched_barrier(0);
#pragma unroll
            for (int e = 0; e < 8; ++e) A[e] = LDF(FQO(e & 1, e >> 2, (e >> 1) & 1));
            __builtin_amdgcn_sched_barrier(0);
#pragma unroll
            for (int e = 0; e < 8; ++e) V[e & 1] = MFMA32(B[e], Sf[2 + (e >> 2)][(e >> 1) & 1], V[e & 1]);
            __builtin_amdgcn_sched_barrier(0);
#pragma unroll
            for (int e = 0; e < 8; ++e) B[e] = LDF(FQO(e & 1, 2 + (e >> 2), (e >> 1) & 1));
            __builtin_amdgcn_sched_barrier(0);
            f32x16 O[2];
#pragma unroll
            for (int i = 0; i < 2; ++i)
#pragma unroll
                for (int r = 0; r < 16; ++r) O[i][r] = 0.f;
#pragma unroll
            for (int e = 0; e < 8; ++e) O[e & 1] = MFMA32(A[e], Sf[e >> 2][(e >> 1) & 1], O[e & 1]);
            __builtin_amdgcn_sched_barrier(0);
#pragma unroll
            for (int e = 0; e < 8; ++e) A[e] = LDF(FKO(e & 3, 0, e >> 2));
            bf16x8 Vf[2][2];
#pragma unroll
            for (int i = 0; i < 2; ++i) { Vf[i][0] = pack8(V[i], 0); Vf[i][1] = pack8(V[i], 1); }
#pragma unroll
            for (int t = 0; t < 4; ++t)
#pragma unroll
                for (int r = 0; r < 16; ++r) S[t][r] *= gam;
            __builtin_amdgcn_sched_barrier(0);
#pragma unroll
            for (int e = 0; e < 8; ++e) O[e & 1] = MFMA32(B[e], Sf[2 + (e >> 2)][(e >> 1) & 1], O[e & 1]);
            __builtin_amdgcn_sched_barrier(0);
#pragma unroll
            for (int e = 0; e < 8; ++e) B[e] = LDF(FKO(e & 3, 1, e >> 2));
            __builtin_amdgcn_sched_barrier(0);
#pragma unroll
            for (int e = 0; e < 8; ++e) S[e & 3] = MFMA32(A[e], Vf[0][e >> 2], S[e & 3]);
            __builtin_amdgcn_sched_barrier(0);
            A[0] = LDF(FQKO(0, 0, 0)); A[1] = LDF(FQKO(1, 0, 0)); A[2] = LDF(FQKO(0, 0, 1)); A[3] = LDF(FQKO(1, 0, 1)); A[4] = LDF(FQKO(1, 1, 0)); A[5] = LDF(FQKO(1, 1, 1));
            __builtin_amdgcn_sched_barrier(0);
#pragma unroll
            for (int e = 0; e < 8; ++e) S[e & 3] = MFMA32(B[e], Vf[1][e >> 2], S[e & 3]);
            __builtin_amdgcn_sched_barrier(0);
            O[0] = MFMA32(A[0], Vf[0][0], O[0]); O[1] = MFMA32(A[1], Vf[0][0], O[1]); O[0] = MFMA32(A[2], Vf[0][1], O[0]); O[1] = MFMA32(A[3], Vf[0][1], O[1]);
            O[1] = MFMA32(A[4], Vf[1][0], O[1]); O[1] = MFMA32(A[5], Vf[1][1], O[1]);
#undef LDF
#undef FWO
#undef FQO
#undef FKO
#undef FQKO
            { const int tau0 = 64 * n + 4 * hi;
#pragma unroll
              for (int i = 0; i < 2; ++i)
#pragma unroll
                for (int r = 0; r < 16; ++r) { const int tau = tau0 + 32 * i + (r & 3) + 8 * (r >> 2); const int trow = d ? Tp - 1 - tau : tau;
                    __builtin_amdgcn_raw_buffer_store_b16((short)f2bf1(O[i][r]), orsrc, (trow * 1024 + r32) * 2, 0, 0); } }
            SCAN_BAR();
        }
    }
#undef SC_SRC
}
#define KSWZ(row, colB) ((row) * 256 + ((colB) ^ (((row) & 7) << 4)))
#define SBAR() __builtin_amdgcn_sched_barrier(0)
constexpr int AT_V = 0, AT_K = 32768, AT_OST = 0, AT_OST_W = 16896, AT_WS = 8 * AT_OST_W;
constexpr float ATT_THR = 11.5f;
__device__ __forceinline__ int v_st(int k, int c) { const int kk = (k & ~0xC) | ((k & 4) << 1) | ((k & 8) >> 1); return ((kk >> 3) * 4 + (c >> 5)) * 512 + ((kk & 7) * 32 + (c & 31)) * 2; }
__device__ __forceinline__ int v_rd_base(int lane) { return ((lane & 3) << 3) | (((lane >> 2) & 3) << 6) | (((lane >> 4) & 1) << 5) | (((lane >> 5) & 1) << 8); }
constexpr int v_rd_off(int d0, int ks, int half) { return d0 * 512 + ks * 4096 + half * 2048; }
template <int OFF> __device__ __forceinline__ s16x4 tr_read(int vb) {
    s16x4 r; asm volatile("ds_read_b64_tr_b16 %0, %1 offset:%2" : "=&v"(r) : "v"(vb), "i"(OFF) : "memory"); return r;
}
template <int D0> __device__ __forceinline__ void pv_one(f32x16& od, int vb, bf16x8 pa0, bf16x8 pa1, bf16x8 pa2, bf16x8 pa3) {
    const s16x4 l0 = tr_read<v_rd_off(D0, 0, 0)>(vb), h0 = tr_read<v_rd_off(D0, 0, 1)>(vb), l1 = tr_read<v_rd_off(D0, 1, 0)>(vb), h1 = tr_read<v_rd_off(D0, 1, 1)>(vb);
    const s16x4 l2 = tr_read<v_rd_off(D0, 2, 0)>(vb), h2 = tr_read<v_rd_off(D0, 2, 1)>(vb), l3 = tr_read<v_rd_off(D0, 3, 0)>(vb), h3 = tr_read<v_rd_off(D0, 3, 1)>(vb);
    asm volatile("s_waitcnt lgkmcnt(0)" ::: "memory"); SBAR();
#define PK(L, H) (bf16x8){L[0], L[1], L[2], L[3], H[0], H[1], H[2], H[3]}
    od = MFMA32(pa0, PK(l0, h0), od); od = MFMA32(pa1, PK(l1, h1), od); od = MFMA32(pa2, PK(l2, h2), od); od = MFMA32(pa3, PK(l3, h3), od);
#undef PK
}
__device__ __forceinline__ void pv_d0(f32x16* o, int vb, bf16x8 pa0, bf16x8 pa1, bf16x8 pa2, bf16x8 pa3) {
    pv_one<0>(o[0], vb, pa0, pa1, pa2, pa3); pv_one<1>(o[1], vb, pa0, pa1, pa2, pa3); pv_one<2>(o[2], vb, pa0, pa1, pa2, pa3); pv_one<3>(o[3], vb, pa0, pa1, pa2, pa3);
}
template <bool FIXED>
__device__ __forceinline__ float softmax_tile(f32x16& p0, f32x16& p1, float& m_reg, float& l_reg, bf16x8& pa0, bf16x8& pa1, bf16x8& pa2, bf16x8& pa3) {
    float alpha = 1.f;
    if (!FIXED) {
        float pmax = p0[0];
#pragma unroll
        for (int r = 1; r < 16; ++r) pmax = fmaxf(pmax, p0[r]);
#pragma unroll
        for (int r = 0; r < 16; ++r) pmax = fmaxf(pmax, p1[r]);
        pmax = half_max(pmax);
        if (!__all(pmax - m_reg <= ATT_THR)) { const float mn = fmaxf(m_reg, pmax); alpha = __builtin_amdgcn_exp2f(m_reg - mn); m_reg = mn; }
        const float mn = m_reg;
#pragma unroll
        for (int r = 0; r < 16; ++r) { p0[r] = __builtin_amdgcn_exp2f(p0[r] - mn); p1[r] = __builtin_amdgcn_exp2f(p1[r] - mn); }
    } else {
#pragma unroll
        for (int r = 0; r < 16; ++r) { p0[r] = __builtin_amdgcn_exp2f(p0[r]); p1[r] = __builtin_amdgcn_exp2f(p1[r]); }
    }
    float ps = 0.f;
#pragma unroll
    for (int r = 0; r < 16; ++r) ps += p0[r];
#pragma unroll
    for (int r = 0; r < 16; ++r) ps += p1[r];
    ps = half_sum(ps);
    l_reg = l_reg * alpha + ps;
#define PK4(P, BASE, OUT) do { unsigned a0 = cvtpk(P[BASE + 0], P[BASE + 1]), a1 = cvtpk(P[BASE + 2], P[BASE + 3]);   \
    unsigned b0 = cvtpk(P[BASE + 4], P[BASE + 5]), b1 = cvtpk(P[BASE + 6], P[BASE + 7]);                              \
    auto r0 = __builtin_amdgcn_permlane32_swap(a0, b0, false, false); auto r1 = __builtin_amdgcn_permlane32_swap(a1, b1, false, false); \
    v4u w = {r0[0], r1[0], r0[1], r1[1]}; OUT = __builtin_bit_cast(bf16x8, w); } while (0)
    PK4(p0, 0, pa0); PK4(p0, 8, pa1); PK4(p1, 0, pa2); PK4(p1, 8, pa3);
#undef PK4
    return alpha;
}

__device__ __forceinline__ int diff_radius(float bnat, int h) {
    const float slope_n = exp2f(-(float)(h + 1));
    const float dn = (2.0f * bnat + logf(2.0f / (1.0f - expf(-slope_n))) + 22.18f) / slope_n;
    return (dn < 1.0e6f) ? (int)dn + 1 : 1000000;
}
struct AttnParams { const float* q_gain; const float* sink; const float* lam; const float* norm_gain; float bnat; };
#define KSWZ64(row, colB) ((row) * 128 + ((colB) ^ ((((row) >> 1) & 7) << 4)))

template <int MODE, bool FIXED>
__device__ __forceinline__ void attn_unit(LAS unsigned char* lds, unsigned char* ws, const AttnParams& P, int l, int Tp, int sq, int h, int qb, int part, int np, int pslot, int tid, int wave, int lane) {
    constexpr int NPASS_M = MODE ? 2 : 1, NDD = MODE ? 4 : 8;
    const bf16* PROJ = (const bf16*)(ws + WS_PROJ);
    const int r32 = lane & 31, hi = lane >> 5;
    const int seq0 = sq * Tp, q0 = qb * 256;
    const int qcol = MODE ? C_DQ + h * 128 : C_SQ + h * 128;
    const int kcol = MODE ? C_DK + h * 128 : C_SKV + (h >> 2) * 128;
    const int vcol = MODE ? C_DV + h * 128 : C_SKV + 256 + (h >> 2) * 128;
    const int zcol = MODE ? C_DZ + h * 128 : C_SZ + h * 128;
    int jlo = 0, jhi = Tp / 64;
    const float slope_n = exp2f(-(float)(h + 1)), slope2 = slope_n * LOG2E;
    if (MODE == 0) { jlo = (q0 - 128) / 64; if (jlo < 0) jlo = 0; const int e = (q0 + 384) / 64; if (e < jhi) jhi = e; }
    else {
        float bn = P.bnat; asm volatile("" : "+v"(bn));
        float smin = 1.0e30f;
        { const bf16* qp = PROJ + (size_t)(seq0 + q0 + wave * 32 + r32) * LDP + qcol + hi * 8; const bf16* kp = PROJ + (size_t)(seq0 + q0 + wave * 32 + r32) * LDP + kcol + hi * 8;
#pragma unroll
          for (int mq = 0; mq < 2; ++mq) { float dot = 0.f;
#pragma unroll
              for (int d0 = 0; d0 < 4; ++d0) { const v4u wq = *(const v4u*)(qp + mq * 64 + d0 * 16), wk = *(const v4u*)(kp + mq * 64 + d0 * 16);
                  const float q8[8] = {bflo(wq.x), bfhi(wq.x), bflo(wq.y), bfhi(wq.y), bflo(wq.z), bfhi(wq.z), bflo(wq.w), bfhi(wq.w)};
                  const float k8[8] = {bflo(wk.x), bfhi(wk.x), bflo(wk.y), bfhi(wk.y), bflo(wk.z), bfhi(wk.z), bflo(wk.w), bfhi(wk.w)};
#pragma unroll
                  for (int e = 0; e < 8; ++e) dot += q8[e] * k8[e]; }
              dot = half_sum(dot);
              smin = fminf(smin, dot * (1.0f / LOG2E)); }
          smin = -wave_max(-smin);
          LAS float* sm = (LAS float*)(lds + AT_WS) + 512;
          if (lane == 0) sm[wave] = smin;
          asm volatile("s_waitcnt lgkmcnt(0)" ::: "memory"); __builtin_amdgcn_s_barrier(); asm volatile("" ::: "memory");
          smin = fminf(fminf(fminf(sm[0], sm[1]), fminf(sm[2], sm[3])), fminf(fminf(sm[4], sm[5]), fminf(sm[6], sm[7]))); }
        float beff = 0.5f * (bn - smin + 0.1f); if (!(beff < bn)) beff = bn;
        const int dk = diff_radius(beff, h);
        const int a = q0 - dk; jlo = a > 0 ? (a >> 6) : 0; const int e = ((q0 + 255 + dk) >> 6) + 1; if (e < jhi) jhi = e;
        if (np > 1) { const int len = (jhi - jlo + np - 1) / np; jlo += part * len; const int e2 = jlo + len; if (e2 < jhi) jhi = e2; }
    }
    LAS unsigned char* V_lds = lds + AT_V; LAS unsigned char* K_lds = lds + AT_K;
    LAS float* wsf = (LAS float*)(lds + AT_WS) + wave * 64; LAS float* li_l = wsf; LAS float* al_l = wsf + 32;
    float* park = (float*)(ws + WS_PARK) + (size_t)(blockIdx.x * NWAVES + wave) * 4096 + lane * 4;
    const float qposh = (float)(q0 + wave * 32 + r32 - 4 * hi), qposf = (float)(q0 + wave * 32 + r32);
    const int vb0 = (int)(uintptr_t)V_lds + v_rd_base(lane);
    const int sr = tid >> 4, sc = (tid & 15) * 8, vst0 = v_st(sr, sc), vst1 = v_st(32 + sr, sc);
    const int kr1 = tid >> 3, kc1 = (tid & 7) * 8;
    f32x16 o[4]; float l_reg = 0.f;
#pragma unroll 1
    for (int mp = 0; mp < NPASS_M; ++mp) {
        bf16x8 qr[NDD];
        if (MODE == 1) {
            const bf16* qp = PROJ + (size_t)(seq0 + q0 + wave * 32 + r32) * LDP + qcol + mp * 64 + hi * 8;
#pragma unroll
            for (int d0 = 0; d0 < NDD; ++d0) qr[d0] = *(const bf16x8*)(qp + d0 * 16);
        } else {
            const bf16* qp = PROJ + (size_t)(seq0 + q0 + wave * 32 + r32) * LDP + qcol + mp * 64 + hi * 8;
            float qf[NDD][8]; float ss = 0.f;
#pragma unroll
            for (int d0 = 0; d0 < NDD; ++d0) { const v4u w = *(const v4u*)(qp + d0 * 16);
                qf[d0][0] = bflo(w.x); qf[d0][1] = bfhi(w.x); qf[d0][2] = bflo(w.y); qf[d0][3] = bfhi(w.y); qf[d0][4] = bflo(w.z); qf[d0][5] = bfhi(w.z); qf[d0][6] = bflo(w.w); qf[d0][7] = bfhi(w.w);
#pragma unroll
                for (int e = 0; e < 8; ++e) ss += qf[d0][e] * qf[d0][e]; }
            ss = half_sum(ss);
            const float rs = MODE ? (1.0f / sqrtf(ss * (1.0f / 64.0f) + NORM_EPS)) * (0.125f * LOG2E) : (1.0f / sqrtf(ss * (1.0f / 128.0f) + NORM_EPS)) * (0.08838834764831845f * LOG2E);
#pragma unroll
            for (int d0 = 0; d0 < NDD; ++d0) { const float* g = P.q_gain + d0 * 16 + hi * 8;
                const f32x4 ga = *(const f32x4*)g, gb = *(const f32x4*)(g + 4);
                v4u w; w.x = cvtpk(qf[d0][0] * rs * ga.x, qf[d0][1] * rs * ga.y); w.y = cvtpk(qf[d0][2] * rs * ga.z, qf[d0][3] * rs * ga.w);
                w.z = cvtpk(qf[d0][4] * rs * gb.x, qf[d0][5] * rs * gb.y); w.w = cvtpk(qf[d0][6] * rs * gb.z, qf[d0][7] * rs * gb.w);
                qr[d0] = __builtin_bit_cast(bf16x8, w); }
        }
        float m_reg = (MODE == 0) ? P.sink[h] * LOG2E : -1e30f; l_reg = (MODE == 0) ? (FIXED ? exp2f(P.sink[h] * LOG2E) : 1.f) : 0.f;
#pragma unroll
        for (int d = 0; d < 4; ++d)
#pragma unroll
            for (int r = 0; r < 16; ++r) o[d][r] = 0.f;
        const bf16* Vg = PROJ + (size_t)seq0 * LDP + vcol + sc;
        const bf16* Kg = MODE ? PROJ + (size_t)(seq0 + kr1) * LDP + kcol + mp * 64 + kc1 : PROJ + (size_t)seq0 * LDP + kcol + sc;
        constexpr int DEPTH = 1;
        struct Stg { v4u vs0, vs1, ks0, ks1; };
        Stg sA, sB;
#define SLOAD(S, k0) do { S.vs0 = *(const v4u*)(Vg + (size_t)((k0) + sr) * LDP); S.vs1 = *(const v4u*)(Vg + (size_t)((k0) + 32 + sr) * LDP); \
        if (MODE) { S.ks0 = *(const v4u*)(Kg + (size_t)(k0) * LDP); } \
        else { S.ks0 = *(const v4u*)(Kg + (size_t)((k0) + sr) * LDP); S.ks1 = *(const v4u*)(Kg + (size_t)((k0) + 32 + sr) * LDP); } } while (0)
#define SWRITE(S, b) do { *(LAS v4u*)(V_lds + (b) * 16384 + vst0) = S.vs0; *(LAS v4u*)(V_lds + (b) * 16384 + vst1) = S.vs1; \
        if (MODE) { *(LAS v4u*)(K_lds + (b) * 16384 + KSWZ64(kr1, kc1 * 2)) = S.ks0; } \
        else { *(LAS v4u*)(K_lds + (b) * 16384 + KSWZ(sr, sc * 2)) = S.ks0; *(LAS v4u*)(K_lds + (b) * 16384 + KSWZ(32 + sr, sc * 2)) = S.ks1; } } while (0)
#define TILE(S, jj) do { const int j_ = (jj); const int b_ = (j_ - jlo) & 1; \
            SWRITE(S, b_); \
            if (j_ + DEPTH < jhi) SLOAD(S, (j_ + DEPTH) * 64); \
            asm volatile("s_waitcnt lgkmcnt(0)" ::: "memory"); __builtin_amdgcn_s_barrier(); asm volatile("" ::: "memory"); \
              \
            if (MODE == 1 || (j_ * 64 + 63 >= q0 + wave * 32 - 128 && j_ * 64 <= q0 + wave * 32 + 31 + 128)) { \
            const LAS unsigned char* Kb = K_lds + b_ * 16384; const int vb = vb0 + b_ * 16384; \
            const float fi = qposh - (float)(j_ * 64);                 \
            f32x16 p0, p1; \
            _Pragma("unroll") for (int r = 0; r < 16; ++r) { p0[r] = 0.f; p1[r] = 0.f; } \
            _Pragma("unroll") for (int dd = 0; dd < NDD; ++dd) { const int cb = (dd * 16 + hi * 8) * 2; \
                const bf16x8 b0 = MODE ? *(const LAS bf16x8*)(Kb + KSWZ64(r32, cb)) : *(const LAS bf16x8*)(Kb + KSWZ(r32, cb)); \
                const bf16x8 b1 = MODE ? *(const LAS bf16x8*)(Kb + KSWZ64(32 + r32, cb)) : *(const LAS bf16x8*)(Kb + KSWZ(32 + r32, cb)); \
                p0 = MFMA32(b0, qr[dd], p0); p1 = MFMA32(b1, qr[dd], p1); } \
              \
            const bool lin_ = (MODE == 1) && FIXED && (j_ * 64 + 63 < q0 + wave * 32 || j_ * 64 > q0 + wave * 32 + 31); \
            if (lin_) { const float sg = (j_ * 64 + 63 < q0 + wave * 32) ? 1.f : -1.f, slv = sg * slope2, lcv = -slv * (qposf - (float)(j_ * 64)); \
                const unsigned hw = cvtpk(lcv, slv), lw = cvtpk(lcv - bflo(hw), slv - bfhi(hw)); \
                v4u qx = {(hw & 0xffffu) | (lw << 16), (hw >> 16) | (lw & 0xffff0000u), 0u, 0u}; if (hi) qx = (v4u){0u, 0u, 0u, 0u}; \
                const LAS unsigned char* Kx = K_lds + 8192 + hi * 16; \
                p0 = MFMA32(*(const LAS bf16x8*)(Kx + r32 * 32), __builtin_bit_cast(bf16x8, qx), p0); p1 = MFMA32(*(const LAS bf16x8*)(Kx + (32 + r32) * 32), __builtin_bit_cast(bf16x8, qx), p1); } \
            if (!lin_) { \
            _Pragma("unroll") for (int r = 0; r < 16; ++r) { const float dd0 = fabsf(fi - (float)((r & 3) + 8 * (r >> 2))), dd1 = fabsf(fi - (float)(32 + (r & 3) + 8 * (r >> 2))); \
                p0[r] = fmaf(-slope2, dd0, p0[r]); p1[r] = fmaf(-slope2, dd1, p1[r]); \
                if (MODE == 0) { if (dd0 > 128.f) p0[r] = -INFINITY; if (dd1 > 128.f) p1[r] = -INFINITY; } } } \
            bf16x8 pa0, pa1, pa2, pa3; \
            const float alpha = softmax_tile<FIXED>(p0, p1, m_reg, l_reg, pa0, pa1, pa2, pa3); \
            if (!FIXED && __any(alpha < 1.f)) { if (hi == 0) al_l[r32] = alpha; asm volatile("s_waitcnt lgkmcnt(0)" ::: "memory"); \
                _Pragma("unroll") for (int r = 0; r < 16; ++r) { const float a = al_l[crow(r, hi)]; \
                    _Pragma("unroll") for (int d = 0; d < 4; ++d) o[d][r] *= a; } } \
            SBAR(); pv_d0(o, vb, pa0, pa1, pa2, pa3); } } while (0)
        if (MODE == 1 && tid < 64) {
            const unsigned one2 = 0x3F803F80u, cw = cvtpk((float)tid, (float)tid);
            *(LAS v4u*)(K_lds + 8192 + tid * 32) = (v4u){one2, cw, 0u, 0u}; *(LAS v4u*)(K_lds + 8192 + tid * 32 + 16) = (v4u){0u, 0u, 0u, 0u}; }
        if (jlo < jhi) SLOAD(sA, jlo * 64);
        if (DEPTH == 2 && jlo + 1 < jhi) SLOAD(sB, (jlo + 1) * 64);
#pragma unroll 1
        for (int j = jlo; j < jhi; j += 2) {
            TILE(sA, j);
            if (j + 1 < jhi) { if (DEPTH == 2) TILE(sB, j + 1); else TILE(sA, j + 1); }
        }
#undef TILE
#undef SLOAD
#undef SWRITE
        asm volatile("s_waitcnt lgkmcnt(0)" ::: "memory"); __builtin_amdgcn_s_barrier(); asm volatile("" ::: "memory");
        if (MODE == 1 && pslot >= 0) {
            float* po = (float*)(ws + WS_PART) + ((size_t)(pslot * 2 + mp) * 256 + wave * 32 + 4 * hi) * 128 + r32;
#pragma unroll
            for (int g = 0; g < 4; ++g) { float* pg = po + g * 8 * 128; asm volatile("" : "+v"(pg));
#pragma unroll
                for (int e = 0; e < 4; ++e)
#pragma unroll
                    for (int d = 0; d < 4; ++d) pg[e * 128 + d * 32] = o[d][4 * g + e]; }
            if (hi == 0) ((float*)(ws + WS_PARTL))[(pslot * 2 + mp) * 256 + wave * 32 + r32] = l_reg;
        } else
        if (MODE == 1 && mp == 0) {
            if (hi == 0) li_l[r32] = l_reg;
            asm volatile("s_waitcnt lgkmcnt(0)" ::: "memory");
#pragma unroll
            for (int r4 = 0; r4 < 4; ++r4) { float rl[4];
#pragma unroll
                for (int e = 0; e < 4; ++e) rl[e] = __builtin_amdgcn_rcpf(li_l[crow(4 * r4 + e, hi)]);
#pragma unroll
                for (int d = 0; d < 4; ++d) { f32x4 t; t.x = o[d][4 * r4] * rl[0]; t.y = o[d][4 * r4 + 1] * rl[1]; t.z = o[d][4 * r4 + 2] * rl[2]; t.w = o[d][4 * r4 + 3] * rl[3];
                    *(f32x4*)(park + (d * 4 + r4) * 256) = t; } }
            asm volatile("s_waitcnt lgkmcnt(0)" ::: "memory");
        }
    }
    if (MODE == 1 && pslot >= 0) return;
    float lam = 0.f; int ll_ = l; asm volatile("" : "+s"(ll_)); const float lin = 0.8f - 0.6f * expf(-0.3f * (float)ll_);
    if (MODE == 1) { const float a = P.lam[lane] * P.lam[64 + lane], bq = P.lam[128 + lane] * P.lam[192 + lane]; lam = expf(wave_sum(a)) - expf(wave_sum(bq)) + lin; }
    LAS float* ost = (LAS float*)(lds + AT_OST + wave * AT_OST_W);
    {
        if (hi == 0) li_l[r32] = l_reg;
        asm volatile("s_waitcnt lgkmcnt(0)" ::: "memory");
#pragma unroll
        for (int r4 = 0; r4 < 4; ++r4) { float rl[4];
#pragma unroll
            for (int e = 0; e < 4; ++e) rl[e] = __builtin_amdgcn_rcpf(li_l[crow(4 * r4 + e, hi)]);
#pragma unroll
            for (int d = 0; d < 4; ++d) { f32x4 pk = {0.f, 0.f, 0.f, 0.f}; if (MODE == 1) pk = *(const f32x4*)(park + (d * 4 + r4) * 256);
#pragma unroll
                for (int e = 0; e < 4; ++e) { float v = o[d][4 * r4 + e] * rl[e]; if (MODE == 1) v = pk[e] - lam * v;
                    ost[crow(4 * r4 + e, hi) * 132 + d * 32 + r32] = v; } } }
    }
    asm volatile("s_waitcnt lgkmcnt(0)" ::: "memory");
    {
        const int row = lane >> 1, half = lane & 1;
        const LAS f32x4* src = (const LAS f32x4*)(ost + row * 132 + half * 64);
        float v[64];
#pragma unroll
        for (int k = 0; k < 16; ++k) { const f32x4 t = src[k]; v[4 * k] = t.x; v[4 * k + 1] = t.y; v[4 * k + 2] = t.z; v[4 * k + 3] = t.w; }
        const size_t grow = (size_t)(seq0 + q0 + wave * 32 + row);
        float rs = 1.f;
        if (MODE == 1) { float ss = 0.f;
#pragma unroll
            for (int e = 0; e < 64; ++e) ss += v[e] * v[e];
            ss += xshfl<1>(ss); rs = (1.0f / sqrtf(ss * (1.0f / 128.0f) + NORM_EPS)) * (1.0f - lin); }
        const v4u* zp = (const v4u*)(PROJ + grow * LDP + zcol + half * 64);
        bf16* yb = (bf16*)(ws + WS_Y + (MODE ? 2 : 1) * SZ_Y1) + grow * 1024 + h * 128 + half * 64;
#pragma unroll
        for (int k = 0; k < 8; ++k) { const v4u zw = zp[k];
            const float z[8] = {bflo(zw.x), bfhi(zw.x), bflo(zw.y), bfhi(zw.y), bflo(zw.z), bfhi(zw.z), bflo(zw.w), bfhi(zw.w)};
            float y[8];
#pragma unroll
            for (int e = 0; e < 8; ++e) { float g = 1.f; if (MODE == 1) g = P.norm_gain[half * 64 + 8 * k + e]; y[e] = v[8 * k + e] * rs * g * z[e]; }
            v4u w; w.x = cvtpk(y[0], y[1]); w.y = cvtpk(y[2], y[3]); w.z = cvtpk(y[4], y[5]); w.w = cvtpk(y[6], y[7]);
            *(v4u*)(yb + 8 * k) = w; }
    }
    asm volatile("s_waitcnt lgkmcnt(0)" ::: "memory"); __builtin_amdgcn_s_barrier(); asm volatile("" ::: "memory");
}
#ifndef ONLY_PHASE
#define ONLY_PHASE -1
#endif
#ifndef ONLY_SUB
#define ONLY_SUB -1
#endif
#define PH4_ON(k) (ONLY_SUB < 0 || ONLY_SUB == (k))
#define PH_ON(k) (ONLY_PHASE < 0 || ONLY_PHASE == (k))
#ifndef DUP_PHASE
#define DUP_PHASE -1
#endif
#define NREP(k) ((DUP_PHASE == (k)) ? 2 : 1)
#ifndef DUP_PASSES
#define DUP_PASSES 15
#endif
#ifndef SPLIT_TILES
#define SPLIT_TILES 128
#endif
#ifndef SPLIT_MAX
#define SPLIT_MAX 2
#endif
#ifndef B_SKEW_NS
#define B_SKEW_NS 0
#endif
#ifndef MK_PER_PHASE
#define MK_PER_PHASE 0
#endif
constexpr int N_ITER = DEPTH * NPASS, PH_PER_IT = 7, N_PHASES = 1 + N_ITER * PH_PER_IT;
struct Args { const float* in[17]; float* out; unsigned char* ws; int ph_lo, ph_hi; };
#define WG_SYNC_LDS() do { asm volatile("s_waitcnt lgkmcnt(0)" ::: "memory"); __builtin_amdgcn_s_barrier(); asm volatile("" ::: "memory"); } while (0)

__global__ void __launch_bounds__(NTHREADS, 2) fwd_kernel(Args args) {
    extern __shared__ __attribute__((aligned(16))) unsigned char lds_raw[];
    LAS unsigned char* lds = (LAS unsigned char*)lds_raw;
    volatile LAS unsigned* MISC = (volatile LAS unsigned*)(lds + MISC_OFF);
    const int tid0 = threadIdx.x;
    const int G = gridDim.x, bx = blockIdx.x, ngw = G * NWAVES;
    unsigned char* ws = args.ws;
    unsigned* ctl = (unsigned*)(ws + WS_CTL);
    if (tid0 < 128) MISC[tid0] = 0u;
    __syncthreads();
    XcdBarrier bar; bar.bar = ctl + CW_BAR; bar.x = 0; bar.st = nullptr;
    if (!MK_PER_PHASE) bar = xcd_barrier_post(ctl + CW_BAR, MISC + 8);
    const int lo = args.ph_lo, hi = args.ph_hi;
#define IN(k) (lo <= (k) && (k) < hi)
#define LAUNDER_TID() int tid = tid0; asm volatile("" : "+v"(tid)); const int lane = tid & 63, wave = __builtin_amdgcn_readfirstlane(tid >> 6), gw = bx * NWAVES + wave; (void)lane; (void)gw
#define TBR(i) __builtin_amdgcn_readfirstlane((int)TB[i])
#define T_GT 0
#define T_PB 32
#define T_NPH 40
#define T_NDF 48
#define T_LEN 56
#define DIFF_TABLE(bd_, fixd_) volatile LAS int* TB = (volatile LAS int*)(MISC + 16); do { const int per_ = nseq * (Tp / 256); \
        if (tid0 == 0) { int ps = 0; \
            for (int hh = 7; hh >= 0; --hh) { const int dk = diff_radius((bd_), hh); int ntm = (255 + 2 * dk) / 64 + 2; if (ntm > Tp / 64) ntm = Tp / 64; \
                int np = (fixd_) ? (ntm + SPLIT_TILES - 1) / SPLIT_TILES : 1; if (np > SPLIT_MAX) np = SPLIT_MAX; if (np > 1 && ps + np * per_ > PART_SLOTS) np = 1; \
                TB[T_NPH + hh] = np; TB[T_PB + hh] = (np > 1) ? ps : -1; if (np > 1) ps += np * per_; TB[T_LEN + hh] = (ntm + np - 1) / np; } \
              \
            int g = 0; unsigned done_ = 0u; \
            for (int k = 0; k < 8; ++k) { int best = -1, bl = -1; for (int hh = 7; hh >= 0; --hh) if (!((done_ >> hh) & 1u) && TB[T_LEN + hh] > bl) { bl = TB[T_LEN + hh]; best = hh; } \
                done_ |= 1u << best; const int np = TB[T_NPH + best]; for (int p = 0; p < np; ++p) TB[T_GT + g++] = best | (p << 8) | (np << 16); } \
            TB[T_NDF] = g * per_; } \
        __syncthreads(); } while (0)
#define DIFF_BOUND(bd_) float bd_; { int ln_ = tid0; asm volatile("" : "+v"(ln_)); const int ln = ln_ & 63; const float* dqg_ = diff_q_gain + l * 64; const float* dkg_ = diff_k_gain + l * 64; \
        float gq = fabsf(dqg_[ln]), gk = fabsf(dkg_[ln]); \
        gq = wave_max(gq); gk = wave_max(gk); \
        bd_ = 8.0f * gq * gk * 1.02f; }
#define SEAM(k) do { if (!MK_PER_PHASE && IN(k) && IN((k) + 1)) xcd_barrier(bar); } while (0)

    const __attribute__((address_space(4))) unsigned char* kargs = (const __attribute__((address_space(4))) unsigned char*)__builtin_amdgcn_kernarg_segment_ptr();
#define INP(k) ([&]() { const __attribute__((address_space(4))) unsigned char* kp_ = kargs; asm volatile("" : "+s"(kp_)); return *(const float* const __attribute__((address_space(4)))*)(kp_ + 8 * (k)); }())
#define x_prompt INP(0)
#define x_sample INP(1)
#define norm_gain INP(2)
#define w_in INP(3)
#define conv_w INP(4)
#define a_log INP(5)
#define dt_bias INP(6)
#define gdn_norm_gain INP(7)
#define swa_q_gain INP(8)
#define swa_k_gain INP(9)
#define swa_sink INP(10)
#define diff_q_gain INP(11)
#define diff_k_gain INP(12)
#define diff_lambda INP(13)
#define diff_norm_gain INP(14)
#define w_branch INP(15)
#define w_out INP(16)

    if (PH_ON(0) && IN(0)) for (int rep = 0; rep < NREP(12); ++rep) { LAUNDER_TID(); phase_prologue(lds, w_in, w_branch, w_out, ws, gw, ngw, wave, lane); __syncthreads(); }
    SEAM(0);

    bf16* HN = (bf16*)(ws + WS_HN); bf16* PROJ = (bf16*)(ws + WS_PROJ); bf16* MRG = (bf16*)(ws + WS_MRG);
#pragma unroll 1
    for (int it = 0; it < N_ITER; ++it) {
        const int l = it >> 2, p = it & 3, pb = 1 + it * PH_PER_IT;
        const int Tp = (p < 2) ? 16384 : 4096, nseq = PASS_ROWS / Tp;
#define XIN() ((l == 0) ? ((p < 2) ? x_prompt + (size_t)p * PASS_ROWS * DM : x_sample + (size_t)(p - 2) * PASS_ROWS * DM) : (const float*)args.out + (size_t)p * PASS_ROWS * DM)

        bf16* HNp = HN + (size_t)p * PASS_ROWS * DM; float* RSp = (float*)(ws + WS_ROWSS) + (size_t)l * NTOK + (size_t)p * PASS_ROWS;
        if (PH_ON(1) && IN(pb + 0) && l == 0) { LAUNDER_TID(); const float* xin = XIN(); const float* ng = norm_gain; for (int m = gw; m < PASS_ROWS; m += ngw) rms_row(xin + (size_t)m * DM, ng, HNp + (size_t)m * DM, RSp + m, lane); }
        if (l == 0) SEAM(pb + 0);
        if (PH_ON(2) && IN(pb + 1)) for (int rep = 0; rep < ((DUP_PHASE == 2 || DUP_PHASE == 14 || DUP_PHASE == 16 || DUP_PHASE == 17) ? 2 : 1); ++rep) {
            if (rep) xcd_barrier(bar);
#if B_SKEW_NS > 0
            { const unsigned long long t0 = __builtin_amdgcn_s_memrealtime(), dl = (unsigned long long)((bx >> 3) & 3) * (unsigned long long)(B_SKEW_NS / 10); while (__builtin_amdgcn_s_memrealtime() - t0 < dl) __builtin_amdgcn_s_sleep(4); }
#endif
            pg8::Gemm g{HNp, (const bf16*)(ws + WS_WIN + (size_t)l * SZ_WIN_L), PASS_ROWS, NPROJ, DM}; pg8::StaticOrder S; S.init(PASS_ROWS, NPROJ, G, bx);
#if DUP_PHASE == 14
            if (rep == 1) { pg8::EpiNull EN{}; pg8::gemm_phase<pg8::EpiNull, pg8::StaticOrder, true, true>(lds, g, S, EN); } else
#endif
            {
#if DUP_PHASE == 17
            pg8::EpiProj E{PROJ, LDP, 0, 0, RSp, 1.0f / DM, NORM_EPS, 0, C_DK / 256, C_DK / 256 + 4, diff_k_gain + l * 64};
            if (rep == 0) { E.ldc = 256; E.tstride = (size_t)PASS_ROWS * 256 - 256; }
#else
            pg8::EpiProj E{PROJ, LDP, C_GATE / 256, C_GATE / 256 + 24, RSp, 1.0f / DM, NORM_EPS, C_GATE, C_BA / 256, (0xFull << (C_GZ / 256)) | (0xFull << (C_SZ / 256)) | (0xFull << (C_DZ / 256)), C_DQ / 256, C_DQ / 256 + 4, diff_q_gain + l * 64, 0.125f * LOG2E, C_DK / 256, C_DK / 256 + 4, diff_k_gain + l * 64};
#endif
#if DUP_PHASE == 16
            if (rep == 1) { E.O = (bf16*)(ws + WS_MTMP); E.ldc = 0; }
#endif
            pg8::gemm_phase<pg8::EpiProj, pg8::StaticOrder, true, true>(lds, g, S, E);
            }
        }
        SEAM(pb + 1);
        if (PH_ON(3) && IN(pb + 2)) {
            LAUNDER_TID();
            { const float* cw = conv_w; const float* al = a_log; const float* db = dt_bias;
              for (int rep = 0; rep < NREP(3); ++rep) {
                  unsigned pre_ba = 0u;
                  if (tid < 128 && bx < 2048) { const int d = tid >> 6, r = tid & 63, c = d ? 63 - r : r; const bf16* pn = PROJ + (size_t)((bx >> 3) * 64 + c) * LDP + C_BA;
                      pre_ba = (unsigned)pn[d * 8 + (bx & 7)] | ((unsigned)pn[16 + d * 8 + (bx & 7)] << 16); }
                  for (int u = bx; u < 2048; u += G) { const int un = u + G; gdn_prep_unit(lds, ws, cw, al, db, l, Tp, u >> 3, u & 7, un < 2048 ? (un >> 3) : -1, un & 7, pre_ba, tid, wave, lane); } } }
            { const float* skg = swa_k_gain + l * 128; const float* dkg = diff_k_gain + l * 64;
              for (int m = gw; m < PASS_ROWS; m += ngw) knorm_row<false>(PROJ + (size_t)m * LDP, skg, dkg, lane); }
        }
        SEAM(pb + 2);
#if DUP_PHASE == 10
        for (int xb = 0; xb < 5; ++xb) xcd_barrier(bar);
#endif
        if (PH_ON(4) && IN(pb + 3)) for (int rep = 0; rep < (((DUP_PHASE == 4 || DUP_PHASE == 5 || DUP_PHASE == 8 || DUP_PHASE == 9 || DUP_PHASE == 11) && (DUP_PASSES >> p & 1)) ? 2 : 1); ++rep) {
            if (rep) xcd_barrier(bar);
            const int nchain = nseq * 32, nqb = Tp / 256, nblk = nseq * 8 * nqb;
            float bd, bs;
            const float* dqg = diff_q_gain + l * 64; const float* sqg = swa_q_gain + l * 128;
            { int ln_ = tid0; asm volatile("" : "+v"(ln_)); const int ln = ln_ & 63; const float* dkg = diff_k_gain + l * 64; const float* skg = swa_k_gain + l * 128;
              float gq = fabsf(dqg[ln]), gk = fabsf(dkg[ln]);
              float sq_ = fmaxf(fabsf(sqg[ln]), fabsf(sqg[64 + ln])), sk_ = fmaxf(fabsf(skg[ln]), fabsf(skg[64 + ln]));
              gq = wave_max(gq); gk = wave_max(gk); sq_ = wave_max(sq_); sk_ = wave_max(sk_);
              bd = 8.0f * gq * gk * 1.02f; bs = 11.3137085f * sq_ * sk_ * 1.02f; }
            const bool fixd = (bd * LOG2E < 60.f) && (bd == bd), fixs = (bs * LOG2E < 60.f) && (bs == bs);
#define UNIFORM_F(x) __builtin_bit_cast(float, __builtin_amdgcn_readfirstlane(__builtin_bit_cast(int, (float)(x))))
            AttnParams PD{dqg, nullptr, diff_lambda + l * 256, diff_norm_gain + l * 128, UNIFORM_F(bd)};
            AttnParams PS{sqg, swa_sink + l * 8, nullptr, nullptr, UNIFORM_F(bs)};
            DIFF_TABLE(bd, fixd);
            const int ndiff = TBR(T_NDF);
            const int item_lo = (rep == 1 && (DUP_PHASE == 8 || DUP_PHASE == 11)) ? nchain : ((rep == 1 && DUP_PHASE == 9) ? nchain + ndiff : 0);
            const int total = (rep == 1 && DUP_PHASE == 5) ? nchain : ((rep == 1 && (DUP_PHASE == 8 || DUP_PHASE == 11)) ? nchain + ndiff : nchain + ndiff + nblk);
#pragma unroll 1
            for (;;) {
                LAUNDER_TID();
                if (tid == 0) MISC[0] = __hip_atomic_fetch_add(ctl + CW_QUEUE + it * 64 + rep * 32, 1u, __ATOMIC_RELAXED, __HIP_MEMORY_SCOPE_AGENT);
                __syncthreads();
                const int item = __builtin_amdgcn_readfirstlane((int)MISC[0]) + item_lo;
                __syncthreads();
                if (item >= total) break;
                if (PH4_ON(0) && item < nchain) { gdn_scan_unit(lds, ws, Tp, item >> 5, (item >> 2) & 7, (item >> 1) & 1, item & 1, tid, wave, lane); }
                else if (PH4_ON(1) && item < nchain + ndiff) { const int u = item - nchain, per = nseq * nqb;
                    const int g = u / per, un = u - g * per, e = TBR(T_GT + g), hh = e & 0xff, part = (e >> 8) & 0xff, np = e >> 16, sq = un / nqb, qb = un - sq * nqb;
                    const int pslot = (np > 1) ? TBR(T_PB + hh) + un * np + part : -1;
                    const bool pe_ = (DUP_PHASE == 11 && rep == 1);
                    if (fixd) attn_unit<1, true>(lds, ws, PD, l, Tp, sq, hh, qb, pe_ ? 999999 : part, pe_ ? 1000000 : np, pe_ ? PART_SLOTS - 1 : pslot, tid, wave, lane); else if (DUP_PHASE < 0) attn_unit<1, false>(lds, ws, PD, l, Tp, sq, hh, qb, 0, 1, -1, tid, wave, lane); }
                else if (PH4_ON(2)) { const int u = item - nchain - ndiff;
                    if (fixs) attn_unit<0, true>(lds, ws, PS, l, Tp, u / (8 * nqb), (u / nqb) & 7, u % nqb, 0, 1, -1, tid, wave, lane); else attn_unit<0, false>(lds, ws, PS, l, Tp, u / (8 * nqb), (u / nqb) & 7, u % nqb, 0, 1, -1, tid, wave, lane); }
                __syncthreads();
            }
        }
        SEAM(pb + 3);
        if (PH_ON(5) && IN(pb + 4)) for (int rep = 0; rep < NREP(13); ++rep) {
            if (rep) xcd_barrier(bar);
            LAUNDER_TID();
            const bf16* OD = (const bf16*)(ws + WS_ODIR);
            const float* gng = gdn_norm_gain + l * 128;
            for (int m = gw; m < PASS_ROWS; m += ngw)
                gdn_final_row(OD + (size_t)m * 1024, OD + (size_t)(PASS_ROWS + m) * 1024, PROJ + (size_t)m * LDP + C_GZ, gng, (bf16*)(ws + WS_Y) + (size_t)m * 1024, lane);
            { DIFF_BOUND(bdf); const bool fixf = (bdf * LOG2E < 60.f) && (bdf == bdf);
              DIFF_TABLE(bdf, fixf);
              const float* dl = diff_lambda + l * 256; const float* dng = diff_norm_gain + l * 128;
              const float lin = 0.8f - 0.6f * expf(-0.3f * (float)l);
              const float lam = expf(wave_sum(dl[lane] * dl[64 + lane])) - expf(wave_sum(dl[128 + lane] * dl[192 + lane])) + lin;
              const int nqb = Tp / 256;
              for (int hh = 7; hh >= 0; --hh) { const int np = TBR(T_NPH + hh); if (np <= 1) continue; const int pb0 = TBR(T_PB + hh);
                  for (int m = gw; m < PASS_ROWS; m += ngw) { const int sq = m / Tp, t = m - sq * Tp, qb = t >> 8, rr = t & 255;
                      diff_final_row(ws, pb0 + (sq * nqb + qb) * np, np, rr, lam, lin, PROJ + (size_t)m * LDP + C_DZ + hh * 128, dng, (bf16*)(ws + WS_Y + 2 * SZ_Y1) + (size_t)m * 1024 + hh * 128, lane); } } }
        }
        SEAM(pb + 4);
        if (PH_ON(6) && IN(pb + 5)) for (int rep = 0; rep < ((DUP_PHASE == 6 || DUP_PHASE == 15) ? 2 : 1); ++rep) {
            if (rep) xcd_barrier(bar);
            pg8::MergeOrder S; S.S.init(PASS_ROWS, DM, G, bx);
            pg8::Gemm g{(const bf16*)(ws + WS_Y), (const bf16*)(ws + WS_WBR + (size_t)(l * 3) * SZ_WBR_1), 3 * PASS_ROWS, 3 * DM, 1024};
#if DUP_PHASE == 15
            if (rep == 1) { pg8::EpiNull EN{}; pg8::gemm_phase<pg8::EpiNull, pg8::MergeOrder, true, true>(lds, g, S, EN); } else
#endif
            { pg8::EpiMerge E{(const unsigned char*)(PROJ + C_GATE), LDP * 2, (bf16*)(ws + WS_MTMP), DM, MRG, DM};
              pg8::gemm_phase<pg8::EpiMerge, pg8::MergeOrder, true, true>(lds, g, S, E); }
        }
        SEAM(pb + 5);
        if (PH_ON(7) && IN(pb + 6)) for (int rep = 0; rep < ((l == 0) ? NREP(7) : 1); ++rep) {
            if (rep) xcd_barrier(bar);
            pg8::Gemm g{MRG, (const bf16*)(ws + WS_WOUT + (size_t)l * SZ_WOUT_L), PASS_ROWS, DM, DM}; pg8::StaticOrder S; S.init(PASS_ROWS, DM, G, bx);
            pg8::EpiOut E{XIN(), args.out + (size_t)p * PASS_ROWS * DM, DM, (l + 1 < DEPTH) ? norm_gain + (l + 1) * DM : (const float*)nullptr, HNp, (float*)(ws + WS_ROWSS) + (size_t)(l + 1 < DEPTH ? l + 1 : l) * NTOK + (size_t)p * PASS_ROWS};
            pg8::gemm_phase<pg8::EpiOut, pg8::StaticOrder, true, true>(lds, g, S, E);
        }
    }
#undef IN
#undef SEAM
#undef TBR
#undef T_GT
#undef T_PB
#undef T_NPH
#undef T_NDF
#undef T_LEN
#undef DIFF_TABLE
#undef DIFF_BOUND
#undef XIN
#undef x_prompt
#undef x_sample
#undef norm_gain
#undef w_in
#undef conv_w
#undef a_log
#undef dt_bias
#undef gdn_norm_gain
#undef swa_q_gain
#undef swa_k_gain
#undef swa_sink
#undef diff_q_gain
#undef diff_k_gain
#undef diff_lambda
#undef diff_norm_gain
#undef w_branch
#undef w_out
#undef INP
}

extern "C" void kernel_launch(void* const* d_in, const int* in_sizes, int n_in, void* d_out, int out_size, void* d_ws, size_t ws_size, hipStream_t stream) {
    static int grid = 0;
    if (grid == 0) {
        if (n_in != 17 || in_sizes[0] != 2 * 16384 * DM || in_sizes[1] != 8 * 4096 * DM || out_size != NTOK * DM || ws_size < WS_END) {
            fprintf(stderr, "kernel_launch: shape mismatch (n_in %d, in0 %d, in1 %d, out %d, ws %zu, need %zu); nothing launched\n", n_in, n_in > 0 ? in_sizes[0] : -1, n_in > 1 ? in_sizes[1] : -1, out_size, ws_size, (size_t)WS_END);
            grid = -1; return; }
        int dev = 0, cus = 0, per_cu = 0;
        if (hipGetDevice(&dev) != hipSuccess || hipDeviceGetAttribute(&cus, hipDeviceAttributeMultiprocessorCount, dev) != hipSuccess) { fprintf(stderr, "kernel_launch: device query failed\n"); grid = -1; return; }
        if (hipFuncSetAttribute((const void*)fwd_kernel, hipFuncAttributeMaxDynamicSharedMemorySize, LDS_BYTES) != hipSuccess) { fprintf(stderr, "kernel_launch: hipFuncSetAttribute(%d B LDS) failed\n", LDS_BYTES); grid = -1; return; }
        if (hipOccupancyMaxActiveBlocksPerMultiprocessor(&per_cu, (const void*)fwd_kernel, NTHREADS, LDS_BYTES) != hipSuccess || per_cu < 1)
            fprintf(stderr, "kernel_launch: note: occupancy query reports %d workgroups per CU\n", per_cu);
        (void)hipGetLastError();
        grid = cus;
    }
    if (grid < 0) return;
    if (hipMemsetAsync((char*)d_ws + WS_CTL, 0, CTL_ZERO_BYTES, stream) != hipSuccess) { fprintf(stderr, "kernel_launch: memset failed\n"); return; }
    Args a{};
    for (int i = 0; i < 17; ++i) a.in[i] = (const float*)d_in[i];
    a.out = (float*)d_out; a.ws = (unsigned char*)d_ws;
#if MK_PER_PHASE
    for (int k = 0; k < N_PHASES; ++k) { a.ph_lo = k; a.ph_hi = k + 1; hipLaunchKernelGGL(fwd_kernel, dim3(grid), dim3(NTHREADS), LDS_BYTES, stream, a); }
#else
    a.ph_lo = 0; a.ph_hi = N_PHASES;
    hipLaunchKernelGGL(fwd_kernel, dim3(grid), dim3(NTHREADS), LDS_BYTES, stream, a);
#endif
    const hipError_t le = hipPeekAtLastError();
    if (le != hipSuccess) fprintf(stderr, "kernel_launch: launch failed: %s\n", hipGetErrorName(le));
}
```

```cpp
#include <hip/hip_runtime.h>
#include <cstdio>
#include <cstdint>
namespace pg8 {
#define PG8_LAS __attribute__((address_space(3)))
typedef unsigned short bf16_t;
typedef short bf16x8 __attribute__((ext_vector_type(8)));
typedef float f32x4 __attribute__((ext_vector_type(4)));
typedef unsigned u32x4 __attribute__((ext_vector_type(4)));
constexpr int BM = 256, BK = 64, HALF = 128, HTB = HALF * BK * 2  , STAGE_BYTES = 8 * HTB, NXCD = 8, WGM = 4;

__host__ __device__ __forceinline__ int lds_byte(int r, int c) { const int st = (r >> 4) * 2 + (c >> 5), rr = r & 15, cc = c & 31, ob = rr * 64 + cc * 2; return st * 1024 + (ob ^ (((ob >> 9) & 1) << 5)); }
__host__ __device__ __forceinline__ void stage_rc(int b, int& R, int& C) { const int st = b / 1024, sb = b % 1024, swz = sb ^ (((sb >> 9) & 1) << 5); R = (st >> 1) * 16 + swz / 64; C = (st & 1) * 32 + (swz % 64) / 2; }
__host__ __device__ __forceinline__ int perm32(int rho) { const int n = rho >> 4, i = rho & 15; return 8 * (i >> 2) + 4 * n + (i & 3); }

struct Unit { int pm, pn; };
struct Gemm { const bf16_t* A; const bf16_t* Bt; int M, N, K; };

struct StaticOrder {
    int nM, nN, nwg, G, c;
    __host__ __device__ void init(int M, int N, int G_, int c_) { nM = M / BM; nN = N / BM; nwg = nM * nN; G = G_; c = c_; }
    __host__ __device__ bool next(int i, Unit& u) const {
        const long L = (long)i * G + c; if (L >= nwg) return false;
        int wgid = (int)L; { const int q = nwg / NXCD, r = nwg % NXCD, xcd = wgid % NXCD, off = wgid / NXCD; wgid = (xcd < r ? xcd * (q + 1) : r * (q + 1) + (xcd - r) * q) + off; }
        const int nig = WGM * nN, gid = wgid / nig, fm = gid * WGM, gsz = (nM - fm) < WGM ? (nM - fm) : WGM;
        u.pm = fm + ((wgid % nig) % gsz); u.pn = (wgid % nig) / gsz; return true;
    }
    __device__ __forceinline__ void a_ready(const Unit&) const {}
    __device__ __forceinline__ void done(const Unit&) const {}
};

typedef float f32x2_c __attribute__((ext_vector_type(2)));
typedef unsigned u32x2 __attribute__((ext_vector_type(2)));
typedef __bf16 bf16x2_c __attribute__((ext_vector_type(2)));
__device__ __forceinline__ unsigned cvt_pk_bf16(float lo, float hi) { const f32x2_c v = {lo, hi}; const bf16x2_c b = __builtin_convertvector(v, bf16x2_c); return __builtin_bit_cast(unsigned, b); }
__device__ __forceinline__ float sigmoid_f(float v) { return __builtin_amdgcn_rcpf(1.0f + __builtin_amdgcn_exp2f(-1.4426950408889634f * v)); }
__device__ __forceinline__ float bflo(unsigned w) { return __uint_as_float(w << 16); }
__device__ __forceinline__ float bfhi(unsigned w) { return __uint_as_float(w & 0xffff0000u); }

struct EpiProj {
    static constexpr bool PERM = true, AFTER_DRAIN = false;
    bf16_t* O; int ldc; int sig_lo, sig_hi; const float* rowss; float inv_d, eps;
#if DUP_PHASE == 17
    size_t tstride;
#endif
    int sig_col0;
    int ba_tile;
    unsigned long long ztiles;
    int qn_lo, qn_hi; const float* qgain; float qscale;
    int kn_lo, kn_hi; const float* kgain;
    __device__ __forceinline__ void operator()(const f32x4 (&acc)[2][2][4][2], const Unit& u, int wr, int wc, int fr, int fq) const {
        const int row0 = u.pm * BM + wr * 64 + fr, col0 = u.pn * BM + wc * 64 + 8 * fq;
        const bool sig = (u.pn >= sig_lo) && (u.pn < sig_hi);
        const bool qn = (u.pn >= qn_lo) && (u.pn < qn_hi);
        const bool kn = qn || ((u.pn >= kn_lo) && (u.pn < kn_hi));
        const float* ngain = qn ? qgain : kgain; const float nsc = qn ? qscale : 1.0f;
        const bool zt = (u.pn < 64) && ((ztiles >> u.pn) & 1ull);
        const bool ba = (u.pn == ba_tile);
        if (ba && wc != 0) return;
        f32x4 kg[2][2];
#pragma unroll
        for (int bj = 0; bj < 2; ++bj)
#pragma unroll
            for (int n = 0; n < 2; ++n) kg[bj][n] = kn ? *(const f32x4*)(ngain + bj * 32 + 8 * fq + 4 * n) * nsc : (f32x4){1.f, 1.f, 1.f, 1.f};
        float rs[2][4];
#pragma unroll
        for (int ai = 0; ai < 2; ++ai)
#pragma unroll
            for (int m = 0; m < 4; ++m) rs[ai][m] = rowss[row0 + ai * HALF + m * 16];
#pragma unroll
        for (int ai = 0; ai < 2; ++ai)
#pragma unroll
            for (int m = 0; m < 4; ++m) { const int row = row0 + ai * HALF + m * 16; bf16_t* rowp = O + (size_t)row * ldc + col0;
#if DUP_PHASE == 17
                rowp += (size_t)u.pn * tstride;
#endif
                const float rstd = __builtin_amdgcn_rsqf(rs[ai][m] * inv_d + eps);
                f32x4 v[2][2];
#pragma unroll
                for (int bj = 0; bj < 2; ++bj) { v[bj][0] = acc[ai][bj][m][0] * rstd; v[bj][1] = acc[ai][bj][m][1] * rstd; }
                if (kn) {
                    float ss = 0.f;
#pragma unroll
                    for (int bj = 0; bj < 2; ++bj)
#pragma unroll
                        for (int n = 0; n < 2; ++n)
#pragma unroll
                            for (int j = 0; j < 4; ++j) ss += v[bj][n][j] * v[bj][n][j];
                    ss += __builtin_bit_cast(float, __builtin_amdgcn_ds_swizzle(__builtin_bit_cast(int, ss), 0x1F | (16 << 10)));
                    ss += __shfl_xor(ss, 32);
                    const float rk = __builtin_amdgcn_rsqf(ss * (1.0f / 64.0f) + eps);
#pragma unroll
                    for (int bj = 0; bj < 2; ++bj)
#pragma unroll
                        for (int n = 0; n < 2; ++n) v[bj][n] = v[bj][n] * rk * kg[bj][n];
                }
                if (zt) {
#pragma unroll
                    for (int bj = 0; bj < 2; ++bj)
#pragma unroll
                        for (int n = 0; n < 2; ++n)
#pragma unroll
                            for (int j = 0; j < 4; ++j) v[bj][n][j] *= sigmoid_f(v[bj][n][j]);
                }
                if (sig) {
                    unsigned char* rowb = (unsigned char*)(O + (size_t)row * ldc + sig_col0) + (u.pn * BM + wc * 64 + 16 * fq - sig_col0);
                    u32x4 w;
#pragma unroll
                    for (int bj = 0; bj < 2; ++bj)
#pragma unroll
                        for (int n = 0; n < 2; ++n) { unsigned pk = 0u;
#pragma unroll
                            for (int j = 0; j < 4; ++j) pk = __builtin_amdgcn_cvt_pk_u8_f32(__builtin_floorf(sigmoid_f(v[bj][n][j]) * 255.0f + 0.5f), j, pk);
                            w[bj * 2 + n] = pk; }
                    __builtin_nontemporal_store(w, (u32x4*)rowb);
                } else {
#pragma unroll
                for (int bj = 0; bj < 2; ++bj) { f32x4 v0 = v[bj][0], v1 = v[bj][1];
                    if (ba && bj == 1) continue;
                    u32x4 w; w.x = cvt_pk_bf16(v0[0], v0[1]); w.y = cvt_pk_bf16(v0[2], v0[3]); w.z = cvt_pk_bf16(v1[0], v1[1]); w.w = cvt_pk_bf16(v1[2], v1[3]);
                    __builtin_nontemporal_store(w, (u32x4*)(rowp + bj * 32)); } } }
    }
};
struct EpiNull {
    static constexpr bool PERM = true, AFTER_DRAIN = false;
    __device__ __forceinline__ void operator()(const f32x4 (&acc)[2][2][4][2], const Unit& u, int wr, int wc, int fr, int fq) const {
        float s = 0.f;
#pragma unroll
        for (int a = 0; a < 2; ++a)
#pragma unroll
            for (int b = 0; b < 2; ++b)
#pragma unroll
                for (int m = 0; m < 4; ++m)
#pragma unroll
                    for (int n = 0; n < 2; ++n) s += acc[a][b][m][n][0];
        asm volatile("" :: "v"(s));
    }
};
struct EpiMerge {
    static constexpr bool PERM = true, AFTER_DRAIN = false;
    static constexpr int MB = 4;
    const unsigned char* G; int ldg; bf16_t* T; int ldt; bf16_t* O; int ldo;
    __device__ __forceinline__ void operator()(const f32x4 (&acc)[2][2][4][2], const Unit& u, int wr, int wc, int fr, int fq) const {
        const int n = u.pm >> 6, pm = u.pm & 63, pn = u.pn & 7;
        const int row0 = pm * BM + wr * 64 + fr, col0 = pn * BM + wc * 32 + 8 * fq;
        const unsigned char* Gn = G + n * 2048;
#pragma unroll
        for (int ai = 0; ai < 2; ++ai)
#pragma unroll
            for (int m2 = 0; m2 < 4; m2 += MB) {
                u32x2 gw[MB][2]; u32x4 tw[MB][2];
#pragma unroll
                for (int mm = 0; mm < MB; ++mm)
#pragma unroll
                    for (int bj = 0; bj < 2; ++bj) { const size_t row = (size_t)(row0 + ai * HALF + (m2 + mm) * 16); const int col = col0 + bj * HALF;
                        gw[mm][bj] = *(const u32x2*)(Gn + row * ldg + col); if (n >= 1) tw[mm][bj] = *(const u32x4*)(T + row * ldt + col); else tw[mm][bj] = (u32x4){0u, 0u, 0u, 0u}; }
#pragma unroll
                for (int mm = 0; mm < MB; ++mm)
#pragma unroll
                    for (int bj = 0; bj < 2; ++bj) { const int m = m2 + mm; const size_t row = (size_t)(row0 + ai * HALF + m * 16); const int col = col0 + bj * HALF;
                        const u32x2 g = gw[mm][bj]; const u32x4 t = tw[mm][bj];
                        const float qs = 1.0f / 255.0f;
                        f32x4 v0 = acc[ai][bj][m][0], v1 = acc[ai][bj][m][1];
                        v0[0] = v0[0] * ((float)(g.x & 0xffu) * qs) + bflo(t.x); v0[1] = v0[1] * ((float)((g.x >> 8) & 0xffu) * qs) + bfhi(t.x); v0[2] = v0[2] * ((float)((g.x >> 16) & 0xffu) * qs) + bflo(t.y); v0[3] = v0[3] * ((float)(g.x >> 24) * qs) + bfhi(t.y);
                        v1[0] = v1[0] * ((float)(g.y & 0xffu) * qs) + bflo(t.z); v1[1] = v1[1] * ((float)((g.y >> 8) & 0xffu) * qs) + bfhi(t.z); v1[2] = v1[2] * ((float)((g.y >> 16) & 0xffu) * qs) + bflo(t.w); v1[3] = v1[3] * ((float)(g.y >> 24) * qs) + bfhi(t.w);
                        u32x4 w; w.x = cvt_pk_bf16(v0[0], v0[1]); w.y = cvt_pk_bf16(v0[2], v0[3]); w.z = cvt_pk_bf16(v1[0], v1[1]); w.w = cvt_pk_bf16(v1[2], v1[3]);
                        if (n <= 1) *(u32x4*)(T + row * ldt + col) = w; else *(u32x4*)(O + row * ldo + col) = w; }
                asm volatile("" ::: "memory"); }
    }
};
struct MergeOrder {
    StaticOrder S;
    __device__ __forceinline__ bool next(int i, Unit& u) const { const int ou = i / 3, n = i - ou * 3; Unit v; if (!S.next(ou, v)) return false; u.pm = n * 64 + v.pm; u.pn = n * 8 + v.pn; return true; }
    __device__ __forceinline__ void a_ready(const Unit&) const {}
    __device__ __forceinline__ void done(const Unit&) const {}
};
struct EpiOut {
    static constexpr bool PERM = false, AFTER_DRAIN = false;
    const float* base; float* out; int ldc; const float* gain_next; bf16_t* hn; float* rowss;
    __device__ __forceinline__ void operator()(const f32x4 (&acc)[2][2][4][2], const Unit& u, int wr, int wc, int fr, int fq) const {
        const int row0 = u.pm * BM + wr * 64 + fr, col0 = u.pn * BM + wc * 32 + 4 * fq;
        f32x4 gn[2][2];
        if (gain_next) {
#pragma unroll
            for (int bj = 0; bj < 2; ++bj)
#pragma unroll
                for (int n = 0; n < 2; ++n) gn[bj][n] = *(const f32x4*)(gain_next + col0 + bj * HALF + n * 16); }
#pragma unroll
        for (int ai = 0; ai < 2; ++ai)
#pragma unroll
            for (int m2 = 0; m2 < 4; m2 += 2) {
                f32x4 bb[2][2][2];
#pragma unroll
                for (int mm = 0; mm < 2; ++mm)
#pragma unroll
                    for (int bj = 0; bj < 2; ++bj)
#pragma unroll
                        for (int n = 0; n < 2; ++n) bb[mm][bj][n] = *(const f32x4*)(base + (size_t)(row0 + ai * HALF + (m2 + mm) * 16) * ldc + col0 + bj * HALF + n * 16);
#pragma unroll
                for (int mm = 0; mm < 2; ++mm) { const int m = m2 + mm; const int row = row0 + ai * HALF + m * 16; const size_t off = (size_t)row * ldc + col0; float ss = 0.f;
#pragma unroll
                    for (int bj = 0; bj < 2; ++bj)
#pragma unroll
                        for (int n = 0; n < 2; ++n) { const f32x4 x = bb[mm][bj][n] + acc[ai][bj][m][n]; *(f32x4*)(out + off + bj * HALF + n * 16) = x;
                            if (gain_next) { const f32x4 g = gn[bj][n]; ss += (x[0] * x[0] + x[1] * x[1]) + (x[2] * x[2] + x[3] * x[3]);
                                u32x2 w; w.x = cvt_pk_bf16(x[0] * g[0], x[1] * g[1]); w.y = cvt_pk_bf16(x[2] * g[2], x[3] * g[3]); *(u32x2*)(hn + off + bj * HALF + n * 16) = w; } }
                    if (gain_next) {
                        ss += __builtin_bit_cast(float, __builtin_amdgcn_ds_swizzle(__builtin_bit_cast(int, ss), 0x1F | (16 << 10)));
                        ss += __shfl_xor(ss, 32);
                        if (fq == 0) __hip_atomic_fetch_add(rowss + row, ss, __ATOMIC_RELAXED, __HIP_MEMORY_SCOPE_AGENT); } }
                asm volatile("" ::: "memory"); }
    }
};

template <class Epi, class Sched, bool ALIGN_EPI = false, bool SP2 = false>
__device__ __forceinline__ void gemm_phase(PG8_LAS unsigned char* lds, const Gemm g, const Sched& S, const Epi& E) {
    int tid_ = threadIdx.x; asm volatile("" : "+v"(tid_));
    const int tid = tid_, wid = __builtin_amdgcn_readfirstlane(tid >> 6), lane = tid & 63, wr = wid >> 2, wc = wid & 3, fr = lane & 15, fq = lane >> 4;
    const int K = g.K, nt = K / BK;
    unsigned voffA[2], voffB[2];
#pragma unroll
    for (int i = 0; i < 2; ++i) { int R, C; stage_rc(tid * 16 + i * 8192, R, C); const int Rb = Epi::PERM ? ((R & ~31) + perm32(R & 31)) : R;
        voffA[i] = (unsigned)(R * K + C) * 2u; voffB[i] = (unsigned)(Rb * K + C) * 2u; }
    const size_t kstep = (size_t)(BK * 2);
    const size_t hstep = (size_t)HALF * K * 2;
    const size_t tstep = 2 * hstep;
    const unsigned ldsw = (unsigned)wid * 1024u;
    const int aoff = lds_byte(wr * 64 + fr, fq * 8), boff = lds_byte(wc * 32 + fr, fq * 8);
#define PG8_SA(b, h) (((b) * 2 + (h)) * HTB)
#define PG8_SB(b, h) ((4 + (b) * 2 + (h)) * HTB)
#define PG8_STAGE(bufoff, gbase, voff) do { _Pragma("unroll") for (int _i = 0; _i < 2; ++_i) \
        __builtin_amdgcn_global_load_lds((const unsigned*)((const char*)(gbase) + (voff)[_i]), (PG8_LAS unsigned*)(lds + (bufoff) + ldsw + _i * 8192), 16, 0, 0); } while (0)
#define PG8_LDA(dst, b, h) do { _Pragma("unroll") for (int m = 0; m < 4; ++m) _Pragma("unroll") for (int k = 0; k < 2; ++k) dst[m][k] = *(const PG8_LAS bf16x8*)(lds + PG8_SA(b, h) + aoff + m * 2048 + k * 1024); } while (0)
#define PG8_LDB(dst, b, h) do { _Pragma("unroll") for (int n = 0; n < 2; ++n) _Pragma("unroll") for (int k = 0; k < 2; ++k) dst[n][k] = *(const PG8_LAS bf16x8*)(lds + PG8_SB(b, h) + boff + n * 2048 + k * 1024); } while (0)
#define PG8_MMA(ai, bj, At, Bt) do { __builtin_amdgcn_s_setprio(1); _Pragma("unroll") for (int m = 0; m < 4; ++m) _Pragma("unroll") for (int n = 0; n < 2; ++n) _Pragma("unroll") for (int k = 0; k < 2; ++k) \
        acc[ai][bj][m][n] = __builtin_amdgcn_mfma_f32_16x16x32_bf16(Bt[n][k], At[m][k], acc[ai][bj][m][n], 0, 0, 0); __builtin_amdgcn_s_setprio(0); } while (0)
#define PG8_WAIT_V(n) asm volatile("s_waitcnt vmcnt(" #n ")" ::: "memory")
#define PG8_WAIT_L(n) asm volatile("s_waitcnt lgkmcnt(" #n ")" ::: "memory")
#define PG8_BAR __builtin_amdgcn_s_barrier()
#define PG8_SCHED __builtin_amdgcn_sched_barrier(0)
    Unit cur, nxt; int ui = 0;
    if (!S.next(0, cur)) return;
    f32x4 acc[2][2][4][2];
#pragma unroll
    for (int a = 0; a < 2; ++a)
#pragma unroll
        for (int b = 0; b < 2; ++b)
#pragma unroll
            for (int m = 0; m < 4; ++m)
#pragma unroll
                for (int n = 0; n < 2; ++n) acc[a][b][m][n] = (f32x4){0.f, 0.f, 0.f, 0.f};
    bf16x8 At[4][2], B0[2][2], B1[2][2];
    const char* cA = (const char*)g.A + (size_t)cur.pm * tstep; const char* cB = (const char*)g.Bt + (size_t)cur.pn * tstep;
    S.a_ready(cur);
    if constexpr (SP2) {
        PG8_STAGE(PG8_SB(0, 0), cB, voffB); PG8_STAGE(PG8_SB(0, 1), cB + hstep, voffB); PG8_STAGE(PG8_SA(0, 0), cA, voffA); PG8_STAGE(PG8_SA(0, 1), cA + hstep, voffA);
        if (wr == 1) PG8_BAR;
        PG8_WAIT_V(2); PG8_BAR;
        PG8_STAGE(PG8_SB(1, 0), cB + kstep, voffB); PG8_STAGE(PG8_SA(1, 0), cA + kstep, voffA); PG8_STAGE(PG8_SB(1, 1), cB + hstep + kstep, voffB);
        PG8_WAIT_V(6); PG8_BAR;
    } else {
        PG8_STAGE(PG8_SB(0, 0), cB, voffB); PG8_STAGE(PG8_SA(0, 0), cA, voffA); PG8_STAGE(PG8_SB(0, 1), cB + hstep, voffB); PG8_STAGE(PG8_SA(0, 1), cA + hstep, voffA);
        if (wr == 1) PG8_BAR;
        PG8_WAIT_V(4); PG8_BAR;
        PG8_STAGE(PG8_SB(1, 0), cB + kstep, voffB); PG8_STAGE(PG8_SA(1, 0), cA + kstep, voffA); PG8_STAGE(PG8_SB(1, 1), cB + hstep + kstep, voffB);
        PG8_WAIT_V(6); PG8_BAR;
    }
    for (;;) {
        const bool has_next = S.next(ui + 1, nxt);
        const char* nA = has_next ? (const char*)g.A + (size_t)nxt.pm * tstep : cA; const char* nB = has_next ? (const char*)g.Bt + (size_t)nxt.pn * tstep : cB;
        for (int t = 0; t < nt; t += 2) {
            const bool last = (t == nt - 2);
            const char* a1 = cA + (size_t)(t + 1) * kstep;
            const char* a2 = last ? nA : cA + (size_t)(t + 2) * kstep; const char* b2 = last ? nB : cB + (size_t)(t + 2) * kstep;
            const char* a3 = a2 + kstep; const char* b3 = b2 + kstep;
            if (last && has_next) S.a_ready(nxt);
            if constexpr (SP2) {
            PG8_LDB(B0, 0, 0); PG8_LDB(B1, 0, 1); PG8_SCHED; PG8_LDA(At, 0, 0); PG8_STAGE(PG8_SA(1, 1), a1 + hstep, voffA);
            PG8_WAIT_V(8); PG8_WAIT_L(0); PG8_BAR; PG8_MMA(0, 0, At, B0); PG8_MMA(0, 1, At, B1); PG8_BAR; PG8_SCHED;
            PG8_LDA(At, 0, 1); PG8_STAGE(PG8_SB(0, 0), b2, voffB); PG8_STAGE(PG8_SB(0, 1), b2 + hstep, voffB); PG8_STAGE(PG8_SA(0, 0), a2, voffA);
            PG8_WAIT_V(8); PG8_WAIT_L(0); PG8_BAR; PG8_MMA(1, 0, At, B0); PG8_MMA(1, 1, At, B1); PG8_BAR; PG8_SCHED;
            PG8_LDB(B0, 1, 0); PG8_LDB(B1, 1, 1); PG8_SCHED; PG8_LDA(At, 1, 0); PG8_STAGE(PG8_SA(0, 1), a2 + hstep, voffA);
            PG8_WAIT_V(8); PG8_WAIT_L(0); PG8_BAR; PG8_MMA(0, 0, At, B0); PG8_MMA(0, 1, At, B1); PG8_BAR; PG8_SCHED;
            PG8_LDA(At, 1, 1); PG8_STAGE(PG8_SB(1, 0), b3, voffB); PG8_STAGE(PG8_SB(1, 1), b3 + hstep, voffB); PG8_STAGE(PG8_SA(1, 0), a3, voffA);
            PG8_WAIT_V(8); PG8_WAIT_L(0); PG8_BAR; PG8_MMA(1, 0, At, B0); PG8_MMA(1, 1, At, B1); PG8_BAR; PG8_SCHED;
            } else {
            PG8_LDB(B0, 0, 0); PG8_SCHED; PG8_LDA(At, 0, 0); PG8_STAGE(PG8_SA(1, 1), a1 + hstep, voffA);
            PG8_WAIT_L(8); PG8_BAR; PG8_WAIT_L(0); PG8_MMA(0, 0, At, B0); PG8_BAR; PG8_SCHED;
            PG8_LDB(B1, 0, 1); PG8_STAGE(PG8_SB(0, 0), b2, voffB);
            PG8_BAR; PG8_WAIT_L(0); PG8_MMA(0, 1, At, B1); PG8_BAR;
            PG8_LDA(At, 0, 1); PG8_STAGE(PG8_SA(0, 0), a2, voffA);
            PG8_BAR; PG8_WAIT_L(0); PG8_MMA(1, 0, At, B0); PG8_BAR; PG8_SCHED;
            PG8_STAGE(PG8_SB(0, 1), b2 + hstep, voffB);
            PG8_WAIT_V(6); PG8_BAR; PG8_MMA(1, 1, At, B1); PG8_BAR;
            PG8_LDB(B0, 1, 0); PG8_SCHED; PG8_LDA(At, 1, 0); PG8_STAGE(PG8_SA(0, 1), a2 + hstep, voffA);
            PG8_WAIT_L(8); PG8_BAR; PG8_WAIT_L(0); PG8_MMA(0, 0, At, B0); PG8_BAR; PG8_SCHED;
            PG8_LDB(B1, 1, 1); PG8_STAGE(PG8_SB(1, 0), b3, voffB);
            PG8_BAR; PG8_WAIT_L(0); PG8_MMA(0, 1, At, B1); PG8_BAR;
            PG8_LDA(At, 1, 1); PG8_STAGE(PG8_SA(1, 0), a3, voffA);
            PG8_BAR; PG8_WAIT_L(0); PG8_MMA(1, 0, At, B0); PG8_BAR; PG8_SCHED;
            PG8_STAGE(PG8_SB(1, 1), b3 + hstep, voffB);
            PG8_WAIT_V(6); PG8_BAR; PG8_MMA(1, 1, At, B1); PG8_BAR;
            }
        }
        if constexpr (ALIGN_EPI) { if (wr == 0) PG8_BAR; }
        if constexpr (!Epi::AFTER_DRAIN) { E(acc, cur, wr, wc, fr, fq); S.done(cur); }
        if (!has_next) break;
#pragma unroll
        for (int a = 0; a < 2; ++a)
#pragma unroll
            for (int b = 0; b < 2; ++b)
#pragma unroll
                for (int m = 0; m < 4; ++m)
#pragma unroll
                    for (int n = 0; n < 2; ++n) acc[a][b][m][n] = (f32x4){0.f, 0.f, 0.f, 0.f};
        cur = nxt; cA = nA; cB = nB; ++ui;
        if constexpr (ALIGN_EPI) { if (wr == 1) PG8_BAR; }
    }
    PG8_WAIT_V(0);
    if constexpr (!ALIGN_EPI) { if (wr == 0) PG8_BAR; }
    PG8_BAR;
    if constexpr (Epi::AFTER_DRAIN) { E.fused(acc, cur, wr, wc, fr, fq, lds, wid, lane); S.done(cur); }
#undef PG8_SA
#undef PG8_SB
#undef PG8_STAGE
#undef PG8_LDA
#undef PG8_LDB
#undef PG8_MMA
#undef PG8_WAIT_V
#undef PG8_WAIT_L
#undef PG8_BAR
#undef PG8_SCHED
}
}

#define GAS __attribute__((address_space(1)))
#define LAS __attribute__((address_space(3)))
typedef unsigned short bf16;
typedef unsigned v4u __attribute__((ext_vector_type(4)));
typedef unsigned v2u __attribute__((ext_vector_type(2)));
typedef float f32x4 __attribute__((ext_vector_type(4)));
typedef float f32x16 __attribute__((ext_vector_type(16)));
typedef short bf16x8 __attribute__((ext_vector_type(8)));
typedef short s16x4 __attribute__((ext_vector_type(4)));

constexpr int DM = 2048, DEPTH = 4, NTOK = 65536, PASS_ROWS = 16384, NPASS = 4;
constexpr int IN_REAL = 16928, NPROJ = 17152, LDP = NPROJ;
constexpr int C_GQKV = 0, C_GZ = 3072, C_SQ = 4096, C_SKV = 5120, C_SZ = 5632, C_DQ = 6656, C_DK = 7680, C_DV = 8704, C_DZ = 9728, C_GATE = 10752, C_BA = 16896;
constexpr float NORM_EPS = 1e-6f, LOG2E = 1.4426950408889634f;
constexpr int NWAVES = 8, NTHREADS = 512;

constexpr size_t MiB = 1u << 20;
constexpr size_t WS_CTL = 0, CTL_ZERO_BYTES = 2 * MiB;
constexpr size_t WS_ROWSS = 1 * MiB;
constexpr size_t WS_WIN = 2 * MiB;
constexpr size_t SZ_WIN_L = (size_t)NPROJ * DM * 2;
constexpr size_t WS_WBR = WS_WIN + 4 * SZ_WIN_L;
constexpr size_t SZ_WBR_1 = (size_t)2048 * 1024 * 2;
constexpr size_t WS_WOUT = WS_WBR + 12 * SZ_WBR_1;
constexpr size_t SZ_WOUT_L = (size_t)DM * DM * 2;
constexpr size_t WS_HN = WS_WOUT + 4 * SZ_WOUT_L;
constexpr size_t WS_PROJ = WS_HN + (size_t)NTOK * DM * 2;
constexpr size_t WS_Y = WS_PROJ + (size_t)PASS_ROWS * NPROJ * 2;
constexpr size_t SZ_Y1 = (size_t)PASS_ROWS * 1024 * 2;
constexpr size_t WS_GDN = WS_Y + 3 * SZ_Y1;
constexpr int REC_BYTES = 73728, REC_FW = 0, REC_FQ = 16384, REC_FK = 32768, REC_FQK = 49152, REC_FU = 57344, REC_LOAD = 57344, REC_GAM = REC_FQK + 2048;
constexpr size_t WS_GAM = WS_GDN + (size_t)2 * 256 * 8 * REC_BYTES;
constexpr size_t WS_ODIR = WS_GAM + 16384;
constexpr size_t WS_MTMP = WS_ODIR + 2 * SZ_Y1;
constexpr size_t WS_MRG = WS_MTMP + (size_t)PASS_ROWS * DM * 2;
constexpr size_t WS_PARK = WS_MRG + (size_t)PASS_ROWS * DM * 2;
constexpr size_t WS_PART = WS_PARK + (size_t)256 * 8 * 64 * 64 * 4;
constexpr int PART_SLOTS = 640;
constexpr size_t WS_PARTL = WS_PART + (size_t)PART_SLOTS * 2 * 256 * 128 * 4;
constexpr size_t WS_END = WS_PARTL + (size_t)PART_SLOTS * 2 * 256 * 4;
constexpr int CW_BAR = 4096;
constexpr int CW_DEP = 32768;
constexpr int CW_QUEUE = 16384;

constexpr int LDS_BYTES = 159744;
constexpr int MISC_OFF = LDS_BYTES - 512;

#define LDS_WAIT() asm volatile("s_waitcnt lgkmcnt(0)" ::: "memory")
#define VM_WAIT() asm volatile("s_waitcnt vmcnt(0)" ::: "memory")
__device__ __forceinline__ float bf2f(bf16 b) { return __uint_as_float(((unsigned)b) << 16); }
__device__ __forceinline__ float bflo(unsigned w) { return __uint_as_float(w << 16); }
__device__ __forceinline__ float bfhi(unsigned w) { return __uint_as_float(w & 0xffff0000u); }
typedef float f32x2_t __attribute__((ext_vector_type(2)));
typedef __bf16 bf16x2_t __attribute__((ext_vector_type(2)));
__device__ __forceinline__ unsigned cvtpk(float lo, float hi) { const f32x2_t v = {lo, hi}; const bf16x2_t b = __builtin_convertvector(v, bf16x2_t); return __builtin_bit_cast(unsigned, b); }
__device__ __forceinline__ bf16 f2bf1(float f) { return (bf16)(cvtpk(f, 0.f) & 0xffffu); }
template <int O> __device__ __forceinline__ float xshfl(float v) {
    static_assert(O >= 1 && O <= 16, "xshfl: in-half xor only");
    return __builtin_bit_cast(float, __builtin_amdgcn_ds_swizzle(__builtin_bit_cast(int, v), 0x1F | (O << 10)));
}
__device__ __forceinline__ float half_sum(float v) {
    unsigned a = __float_as_uint(v), b = a; asm volatile("" : "+v"(b));
    auto rr = __builtin_amdgcn_permlane32_swap(a, b, false, false); return __uint_as_float(rr[0]) + __uint_as_float(rr[1]); }
__device__ __forceinline__ float half_max(float v) {
    unsigned a = __float_as_uint(v), b = a; asm volatile("" : "+v"(b));
    auto rr = __builtin_amdgcn_permlane32_swap(a, b, false, false); return fmaxf(__uint_as_float(rr[0]), __uint_as_float(rr[1])); }
__device__ __forceinline__ float wave_sum(float v) { v += xshfl<1>(v); v += xshfl<2>(v); v += xshfl<4>(v); v += xshfl<8>(v); v += xshfl<16>(v); return half_sum(v); }
__device__ __forceinline__ float wave_max(float v) { v = fmaxf(v, xshfl<1>(v)); v = fmaxf(v, xshfl<2>(v)); v = fmaxf(v, xshfl<4>(v)); v = fmaxf(v, xshfl<8>(v)); v = fmaxf(v, xshfl<16>(v)); return half_max(v); }
__device__ __forceinline__ float silu_f(float v) { return v * __builtin_amdgcn_rcpf(1.0f + __expf(-v)); }
__device__ __forceinline__ int crow(int r, int hi) { return (r & 3) + 8 * (r >> 2) + 4 * hi; }
#define MFMA32(a, b, c) __builtin_amdgcn_mfma_f32_32x32x16_bf16((a), (b), (c), 0, 0, 0)
#define XB_TMO      128
#define XB_XCNT(j)  (256  + 64 * (j))
#define XB_XSUB(j)  (1280 + 64 * (j))
#define XB_XGEN(j)  (2304 + 64 * (j))
#define XB_TOP      3328
#define XB_TOPGEN   3392
#define XCD_BAR_WORDS 3456
#define XB_SPIN_CAP (1u << 18)

__device__ __forceinline__ unsigned xb_ld(unsigned* p)              { return __hip_atomic_load(p, __ATOMIC_RELAXED, __HIP_MEMORY_SCOPE_AGENT); }
__device__ __forceinline__ unsigned xb_add(unsigned* p, unsigned v) { return __hip_atomic_fetch_add(p, v, __ATOMIC_RELAXED, __HIP_MEMORY_SCOPE_AGENT); }
__device__ __forceinline__ unsigned xb_xcc_id() { return (unsigned)__builtin_amdgcn_s_getreg((3 << 11) | 20) & 0xFu; }
#define XB_SPIN(cond, bar) do { unsigned _sp = 0; while (cond) { __builtin_amdgcn_s_sleep(1); \
    if ((++_sp & 255u) == 0u) { if (xb_ld(&(bar)[XB_TMO])) break; if (_sp > XB_SPIN_CAP) { atomicAdd(&(bar)[XB_TMO], 1u); break; } } } } while (0)

struct XcdBarrier {
    unsigned* bar; unsigned x;
    volatile LAS unsigned* st;
};

__device__ __forceinline__ XcdBarrier xcd_barrier_post(unsigned* bar, volatile LAS unsigned* st) {
    XcdBarrier b; b.bar = bar; b.x = xb_xcc_id(); b.st = st;
    if (threadIdx.x == 0) (void)xb_add(&bar[XB_XCNT(b.x)], 1u);
    return b;
}
__device__ __forceinline__ void xcd_barrier_complete(unsigned* bar, unsigned x, unsigned& nloc, unsigned& nx) {
    const unsigned G = gridDim.x * gridDim.y * gridDim.z;
    unsigned sum, cnt, mine, sp = 0u;
    for (;;) {
        sum = 0u; cnt = 0u; mine = 0u;
#pragma unroll
        for (unsigned j = 0; j < 16; ++j) { const unsigned c = xb_ld(&bar[XB_XCNT(j)]); sum += c; cnt += (c > 0u) ? 1u : 0u; mine = (j == x) ? c : mine; }
        if (sum == G) break;
        __builtin_amdgcn_s_sleep(1);
        if ((++sp & 255u) == 0u) { if (xb_ld(&bar[XB_TMO])) break; if (sp > XB_SPIN_CAP) { atomicAdd(&bar[XB_TMO], 1u); break; } }
    }
    nloc = mine > 0u ? mine : 1u; nx = cnt > 0u ? cnt : 1u;
}

__device__ __forceinline__ void xcd_barrier(const XcdBarrier& b) {
    asm volatile("s_waitcnt vmcnt(0)" ::: "memory");
    __syncthreads();
    if (threadIdx.x == 0) {
        unsigned* bar = b.bar;
        __builtin_amdgcn_s_waitcnt(0);
        unsigned nloc = b.st[0], nx = b.st[1];
        if (nloc == 0u) { xcd_barrier_complete(bar, b.x, nloc, nx); b.st[0] = nloc; b.st[1] = nx; }
        const unsigned old = xb_add(&bar[XB_XSUB(b.x)], 1u);
        const unsigned gen = old / nloc;
        if (old + 1u == (gen + 1u) * nloc) {
            __builtin_amdgcn_fence(__ATOMIC_RELEASE, "agent");
            asm volatile("s_waitcnt vmcnt(0)" ::: "memory");
            const unsigned og = xb_add(&bar[XB_TOP], 1u);
            const unsigned tg = og / nx;
            if (og + 1u == (tg + 1u) * nx) xb_add(&bar[XB_TOPGEN], 1u);
            else XB_SPIN(xb_ld(&bar[XB_TOPGEN]) == tg, bar);
            __builtin_amdgcn_fence(__ATOMIC_ACQUIRE, "agent");
            xb_add(&bar[XB_XGEN(b.x)], 1u);
            asm volatile("s_waitcnt vmcnt(0)" ::: "memory");
        } else {
            XB_SPIN(xb_ld(&bar[XB_XGEN(b.x)]) == gen, bar);
            __builtin_amdgcn_fence(__ATOMIC_ACQUIRE, "agent");
            asm volatile("s_waitcnt vmcnt(0)" ::: "memory");
        }
    }
    __syncthreads();
}
__device__ __forceinline__ int win_row(int dl) {
    const int L = dl & 255;
    const int p = (dl >= C_GATE && dl < C_GATE + 6144) ? (((L >> 3) & 1) * 128 + (L >> 6) * 32 + ((L >> 4) & 3) * 8 + (L & 7)) : (((L >> 5) & 1) * 128 + (L >> 6) * 32 + (L & 31));
    return (dl & ~255) + p;
}
template <bool MAPW = false>
__device__ __forceinline__ void transpose_item(const float* W, int K, int N, bf16* WT, int k0, int n0, int drow0, LAS float* scr, int lane) {
#pragma unroll 8
    for (int i = 0; i < 32; ++i) { const int kk = 2 * i + (lane >> 5); scr[kk * 33 + (lane & 31)] = W[(size_t)(k0 + kk) * N + n0 + (lane & 31)]; }
    LDS_WAIT(); asm volatile("" ::: "memory");
    const int c = lane & 7;
#pragma unroll
    for (int j = 0; j < 4; ++j) { const int n = (lane >> 3) + 8 * j; const LAS float* s = scr + (8 * c) * 33 + n;
        v4u o; o.x = cvtpk(s[0 * 33], s[1 * 33]); o.y = cvtpk(s[2 * 33], s[3 * 33]); o.z = cvtpk(s[4 * 33], s[5 * 33]); o.w = cvtpk(s[6 * 33], s[7 * 33]);
        *(v4u*)(WT + (size_t)(MAPW ? win_row(drow0 + n) : drow0 + n) * K + k0 + 8 * c) = o; }
    LDS_WAIT(); asm volatile("" ::: "memory");
}
__device__ __forceinline__ void phase_prologue(LAS unsigned char* lds, const float* w_in, const float* w_branch, const float* w_out, unsigned char* ws, int gw, int ngw, int wave, int lane) {
    LAS float* scr = (LAS float*)(lds + wave * 16384);
    constexpr int NB_IN = IN_REAL / 32;
    constexpr int I_IN = 32 * NB_IN;
    constexpr int I_BR = 16 * 64;
    constexpr int I_OUT = 32 * 64;
    constexpr int TOT = 4 * I_IN + 12 * I_BR + 4 * I_OUT;
    for (int it = gw; it < TOT; it += ngw) {
        int r = it;
        if (r < 4 * I_IN) { const int l = r / I_IN; r -= l * I_IN; const int kb = r / NB_IN, nb = r % NB_IN, n0 = nb * 32;
            const int drow = (n0 < 4096) ? n0 : ((n0 < 4128) ? (C_BA + (n0 - 4096)) : (n0 - 32));
            transpose_item<true>(w_in + (size_t)l * DM * IN_REAL, DM, IN_REAL, (bf16*)(ws + WS_WIN + (size_t)l * SZ_WIN_L), kb * 64, n0, drow, scr, lane); continue; }
        r -= 4 * I_IN;
        if (r < 12 * I_BR) { const int m = r / I_BR; r -= m * I_BR; const int kb = r / 64, nb = r % 64;
            transpose_item(w_branch + (size_t)m * 1024 * 2048, 1024, 2048, (bf16*)(ws + WS_WBR + (size_t)m * SZ_WBR_1), kb * 64, nb * 32, nb * 32, scr, lane); continue; }
        r -= 12 * I_BR;
        { const int l = r / I_OUT; r -= l * I_OUT; const int kb = r / 64, nb = r % 64;
            transpose_item(w_out + (size_t)l * DM * DM, DM, DM, (bf16*)(ws + WS_WOUT + (size_t)l * SZ_WOUT_L), kb * 64, nb * 32, nb * 32, scr, lane); }
    }
    const v4u z = {0u, 0u, 0u, 0u};
    for (int i = gw * 64 + lane; i < 4 * 57344; i += ngw * 64) { const int l = i / 57344, q = i % 57344;
        *(v4u*)(ws + WS_WIN + (size_t)l * SZ_WIN_L + (size_t)IN_REAL * DM * 2 + (size_t)q * 16) = z; }
}
__device__ __forceinline__ void rms_row(const float* xrow, const float* gain, bf16* orow, float* rowss, int lane) {
    const f32x4* xr = (const f32x4*)xrow + lane; const f32x4* gr = (const f32x4*)gain + lane;
    f32x4 v[8]; float s = 0.f;
#pragma unroll
    for (int j = 0; j < 8; ++j) { v[j] = xr[64 * j]; s += (v[j].x * v[j].x + v[j].y * v[j].y) + (v[j].z * v[j].z + v[j].w * v[j].w); }
    s = wave_sum(s);
    if (lane == 0) *rowss = s;
    v2u* o8 = (v2u*)orow + lane;
#pragma unroll
    for (int j = 0; j < 8; ++j) { const f32x4 g = gr[64 * j]; v2u o; o.x = cvtpk(v[j].x * g.x, v[j].y * g.y); o.y = cvtpk(v[j].z * g.z, v[j].w * g.w); o8[64 * j] = o; }
}
template <bool DIFF>
__device__ __forceinline__ void knorm_row(bf16* prow, const float* swa_k_gain, const float* diff_k_gain, int lane) {
    {
        v2u* p = (v2u*)(prow + C_SKV) + lane; const v2u w = *p;
        float a = bflo(w.x), b = bfhi(w.x), c = bflo(w.y), d = bfhi(w.y);
        float ss = (a * a + b * b) + (c * c + d * d);
        ss += xshfl<1>(ss); ss += xshfl<2>(ss); ss += xshfl<4>(ss); ss += xshfl<8>(ss); ss += xshfl<16>(ss);
        const float rs = 1.0f / sqrtf(ss * (1.0f / 128.0f) + NORM_EPS);
        const f32x4 g = *((const f32x4*)swa_k_gain + (lane & 31));
        v2u o; o.x = cvtpk(a * rs * g.x, b * rs * g.y); o.y = cvtpk(c * rs * g.z, d * rs * g.w); *p = o;
    }
    if (DIFF) {
        v4u* p = (v4u*)(prow + C_DK) + 2 * lane; const v4u w0 = p[0], w1 = p[1];
        float x[16] = {bflo(w0.x), bfhi(w0.x), bflo(w0.y), bfhi(w0.y), bflo(w0.z), bfhi(w0.z), bflo(w0.w), bfhi(w0.w),
                       bflo(w1.x), bfhi(w1.x), bflo(w1.y), bfhi(w1.y), bflo(w1.z), bfhi(w1.z), bflo(w1.w), bfhi(w1.w)};
        float ss = 0.f;
#pragma unroll
        for (int e = 0; e < 16; ++e) ss += x[e] * x[e];
        ss += xshfl<1>(ss); ss += xshfl<2>(ss);
        const float rs = 1.0f / sqrtf(ss * (1.0f / 64.0f) + NORM_EPS);
        const float* g = diff_k_gain + 16 * (lane & 3);
#pragma unroll
        for (int e = 0; e < 16; ++e) x[e] *= rs * g[e];
        v4u o0, o1; o0.x = cvtpk(x[0], x[1]); o0.y = cvtpk(x[2], x[3]); o0.z = cvtpk(x[4], x[5]); o0.w = cvtpk(x[6], x[7]);
        o1.x = cvtpk(x[8], x[9]); o1.y = cvtpk(x[10], x[11]); o1.z = cvtpk(x[12], x[13]); o1.w = cvtpk(x[14], x[15]);
        p[0] = o0; p[1] = o1;
    }
}
__device__ __forceinline__ void gdn_final_row(const bf16* of, const bf16* ob, const bf16* zrow, const float* gain, bf16* yrow, int lane) {
    const v4u* pf = (const v4u*)of + 2 * lane; const v4u* pb = (const v4u*)ob + 2 * lane; const v4u* pz = (const v4u*)zrow + 2 * lane;
    float x[16], z[16];
#pragma unroll
    for (int q = 0; q < 2; ++q) { const v4u a = pf[q], b = pb[q], c = pz[q];
        x[8 * q + 0] = bflo(a.x) + bflo(b.x); x[8 * q + 1] = bfhi(a.x) + bfhi(b.x); x[8 * q + 2] = bflo(a.y) + bflo(b.y); x[8 * q + 3] = bfhi(a.y) + bfhi(b.y);
        x[8 * q + 4] = bflo(a.z) + bflo(b.z); x[8 * q + 5] = bfhi(a.z) + bfhi(b.z); x[8 * q + 6] = bflo(a.w) + bflo(b.w); x[8 * q + 7] = bfhi(a.w) + bfhi(b.w);
        z[8 * q + 0] = bflo(c.x); z[8 * q + 1] = bfhi(c.x); z[8 * q + 2] = bflo(c.y); z[8 * q + 3] = bfhi(c.y);
        z[8 * q + 4] = bflo(c.z); z[8 * q + 5] = bfhi(c.z); z[8 * q + 6] = bflo(c.w); z[8 * q + 7] = bfhi(c.w); }
    float ss = 0.f;
#pragma unroll
    for (int e = 0; e < 16; ++e) ss += x[e] * x[e];
    ss += xshfl<1>(ss); ss += xshfl<2>(ss); ss += xshfl<4>(ss);
    const float rs = 1.0f / sqrtf(ss * (1.0f / 128.0f) + NORM_EPS);
    const float* g = gain + 16 * (lane & 7);
#pragma unroll
    for (int e = 0; e < 16; ++e) x[e] = x[e] * rs * g[e] * z[e];
    v4u o0, o1; o0.x = cvtpk(x[0], x[1]); o0.y = cvtpk(x[2], x[3]); o0.z = cvtpk(x[4], x[5]); o0.w = cvtpk(x[6], x[7]);
    o1.x = cvtpk(x[8], x[9]); o1.y = cvtpk(x[10], x[11]); o1.z = cvtpk(x[12], x[13]); o1.w = cvtpk(x[14], x[15]);
    v4u* py = (v4u*)yrow + 2 * lane; py[0] = o0; py[1] = o1;
}
__device__ __forceinline__ void diff_final_row(const unsigned char* ws, int slot0, int np, int rr, float lam, float lambda_init, const bf16* zrow, const float* gain, bf16* yrow, int lane) {
    typedef float f32x2v __attribute__((ext_vector_type(2)));
    const float* PO = (const float*)(ws + WS_PART); const float* PL = (const float*)(ws + WS_PARTL);
    f32x2v o0 = {0.f, 0.f}, o1 = {0.f, 0.f}; float l0 = 0.f, l1 = 0.f;
    for (int p = 0; p < np; ++p) { const int s = slot0 + p;
        o0 += *(const f32x2v*)(PO + ((size_t)(s * 2 + 0) * 256 + rr) * 128 + 2 * lane); o1 += *(const f32x2v*)(PO + ((size_t)(s * 2 + 1) * 256 + rr) * 128 + 2 * lane);
        l0 += PL[(s * 2 + 0) * 256 + rr]; l1 += PL[(s * 2 + 1) * 256 + rr]; }
    const float r0 = 1.0f / l0, r1 = lam / l1;
    const float a = o0.x * r0 - o1.x * r1, b = o0.y * r0 - o1.y * r1;
    const float rs = (1.0f / sqrtf(wave_sum(a * a + b * b) * (1.0f / 128.0f) + NORM_EPS)) * (1.0f - lambda_init);
    const unsigned zw = *(const unsigned*)(zrow + 2 * lane);
    const float ya = a * rs * gain[2 * lane] * bflo(zw), yb = b * rs * gain[2 * lane + 1] * bfhi(zw);
    *(unsigned*)(yrow + 2 * lane) = cvtpk(ya, yb);
}
constexpr int D1_QROW = 0, D1_KROW = 17408, D1_KT = 34816, D1_VT = 53248, D1_LM = 71680, D1_TB = 106496, D1_BETA = 143360, D1_GC = 143872, D1_END = 144384;
constexpr int ROWP = 272, TRP = 144, LMP = 272, TBP = 144;
#define TSW(rw, boff) ((rw) * TRP + ((boff) ^ ((((rw) >> 3) & 7) << 4)))
__device__ __forceinline__ unsigned char* gdn_rec(unsigned char* ws, int d, int ci, int h) { return ws + WS_GDN + (((size_t)d * 256 + ci) * 8 + h) * REC_BYTES; }

#ifndef DUP_D1
#define DUP_D1 0
#endif
__device__ __forceinline__ void gdn_prep_unit(LAS unsigned char* lds, unsigned char* ws, const float* conv_w, const float* a_log, const float* dt_bias,
                                              int l, int Tp, int ci, int h, int nci, int nh, unsigned& pre_ba, int tid, int wave, int lane) {
    const bf16* PROJ = (const bf16*)(ws + WS_PROJ);
    const int row0 = ci * 64, tin = row0 % Tp; const bool first = (tin == 0), last = (tin + 64 == Tp);
    LAS float* BETA = (LAS float*)(lds + D1_BETA); LAS float* GC = (LAS float*)(lds + D1_GC);
    if (tid < 128) {
        const int d = tid >> 6, r = tid & 63, c = d ? 63 - r : r;
        const float braw = bflo(pre_ba), araw = bfhi(pre_ba);
        if (nci >= 0) { const bf16* pn = PROJ + (size_t)(nci * 64 + c) * LDP + C_BA; pre_ba = (unsigned)pn[d * 8 + nh] | ((unsigned)pn[16 + d * 8 + nh] << 16); }
        const float beta = __builtin_amdgcn_rcpf(1.0f + __expf(-braw));
        const float x = araw + dt_bias[(l * 2 + d) * 8 + h];
        const float sp = fmaxf(x, 0.f) + log1pf(__expf(-fabsf(x)));
        float gcv = -__expf(a_log[(l * 2 + d) * 8 + h]) * sp;
#pragma unroll
        for (int off = 1; off < 64; off <<= 1) { const float t = __shfl_up(gcv, off); if (r >= off) gcv += t; }
        BETA[d * 64 + r] = beta; GC[d * 64 + r] = gcv;
        if (r == 63) *(float*)(gdn_rec(ws, d, ci, h) + REC_GAM) = __expf(gcv);
    }
    __syncthreads();
    for (int rep1 = 0; rep1 < (DUP_D1 == 1 ? 2 : 1); ++rep1) {
        const int sub = tid & 15, ch0 = sub * 8;
#pragma unroll 3
        for (int rnd = 0; rnd < 6; ++rnd) {
            const int it = rnd * 32 + (tid >> 4), mat = it >> 6, c = it & 63;
            const int chan = mat * 1024 + h * 128 + ch0;
            const bf16* px = PROJ + (size_t)(row0 + c) * LDP + C_GQKV + chan;
            const v4u zz = {0u, 0u, 0u, 0u};
            const v4u x1 = *(const v4u*)px;
            const v4u x0 = (c == 0 && first) ? zz : *(const v4u*)(px - LDP);
            const v4u x2 = (c == 63 && last) ? zz : *(const v4u*)(px + LDP);
            const float* cw = conv_w + (size_t)l * 3 * 3072 + chan;
            const f32x4 w0a = *(const f32x4*)cw, w0b = *(const f32x4*)(cw + 4), w1a = *(const f32x4*)(cw + 3072), w1b = *(const f32x4*)(cw + 3072 + 4), w2a = *(const f32x4*)(cw + 6144), w2b = *(const f32x4*)(cw + 6144 + 4);
            const float w0[8] = {w0a.x, w0a.y, w0a.z, w0a.w, w0b.x, w0b.y, w0b.z, w0b.w}, w1[8] = {w1a.x, w1a.y, w1a.z, w1a.w, w1b.x, w1b.y, w1b.z, w1b.w}, w2[8] = {w2a.x, w2a.y, w2a.z, w2a.w, w2b.x, w2b.y, w2b.z, w2b.w};
            const float a0[8] = {bflo(x0.x), bfhi(x0.x), bflo(x0.y), bfhi(x0.y), bflo(x0.z), bfhi(x0.z), bflo(x0.w), bfhi(x0.w)};
            const float a1[8] = {bflo(x1.x), bfhi(x1.x), bflo(x1.y), bfhi(x1.y), bflo(x1.z), bfhi(x1.z), bflo(x1.w), bfhi(x1.w)};
            const float a2[8] = {bflo(x2.x), bfhi(x2.x), bflo(x2.y), bfhi(x2.y), bflo(x2.z), bfhi(x2.z), bflo(x2.w), bfhi(x2.w)};
            float y[8]; float ss = 0.f;
#pragma unroll
            for (int e = 0; e < 8; ++e) { const float a = a0[e] * w0[e] + a1[e] * w1[e] + a2[e] * w2[e]; y[e] = a * __builtin_amdgcn_rcpf(1.0f + __expf(-a)); ss += y[e] * y[e]; }
            if (mat < 2) {
                ss += xshfl<1>(ss); ss += xshfl<2>(ss); ss += xshfl<4>(ss); ss += xshfl<8>(ss);
                float rs = __builtin_amdgcn_rsqf(ss + NORM_EPS); if (mat == 0) rs *= 0.08838834764831845f;
#pragma unroll
                for (int e = 0; e < 8; ++e) y[e] *= rs;
            }
            if (mat == 0) {
                v4u o; o.x = cvtpk(y[0], y[1]); o.y = cvtpk(y[2], y[3]); o.z = cvtpk(y[4], y[5]); o.w = cvtpk(y[6], y[7]);
                *(LAS v4u*)(lds + D1_QROW + c * ROWP + ch0 * 2) = o;
                const int t = ch0 >> 5, kk = ch0 & 31, s = kk >> 4, b = (kk >> 3) & 1;
#pragma unroll
                for (int d = 0; d < 2; ++d) { const int r = d ? 63 - c : c; const float e = __expf(GC[d * 64 + r]); const int i = r >> 5, rr = r & 31;
                    unsigned char* fb = gdn_rec(ws, d, ci, h) + REC_FQ + (((i * 4 + t) * 2 + s) * 64) * 16 + b * 8;
                    v2u lo, hi2; lo.x = cvtpk(y[0] * e, y[1] * e); lo.y = cvtpk(y[2] * e, y[3] * e); hi2.x = cvtpk(y[4] * e, y[5] * e); hi2.y = cvtpk(y[6] * e, y[7] * e);
                    *(v2u*)(fb + rr * 16) = lo; *(v2u*)(fb + (rr + 32) * 16) = hi2; }
            } else if (mat == 1) {
                v4u o; o.x = cvtpk(y[0], y[1]); o.y = cvtpk(y[2], y[3]); o.z = cvtpk(y[4], y[5]); o.w = cvtpk(y[6], y[7]);
                *(LAS v4u*)(lds + D1_KROW + c * ROWP + ch0 * 2) = o;
#pragma unroll
                for (int e = 0; e < 8; ++e) *(LAS bf16*)(lds + D1_KT + TSW(ch0 + e, c * 2)) = f2bf1(y[e]);
            } else {
#pragma unroll
                for (int e = 0; e < 8; ++e) *(LAS bf16*)(lds + D1_VT + TSW(ch0 + e, c * 2)) = f2bf1(y[e]);
            }
        }
    }
    __syncthreads();
    for (int rep2 = 0; rep2 < (DUP_D1 == 2 ? 2 : 1); ++rep2) {
        const int r32 = lane & 31, hi = lane >> 5;
#pragma unroll 1
        for (int k = wave; k < 12; k += 8) {
            const int d = k / 6, sel = k % 6;
            int ta, tb; int boff;
            if (sel < 3) { ta = (sel >= 1); tb = (sel == 2); boff = D1_KROW; }
            else { ta = (sel == 5); tb = (sel >= 4); boff = D1_QROW; }
            const int ra = 32 * ta + r32, rb = 32 * tb + r32;
            const int rowa = d ? 63 - ra : ra, rowb = d ? 63 - rb : rb;
            const LAS unsigned char* pa = lds + D1_KROW + rowa * ROWP + hi * 16; const LAS unsigned char* pb = lds + boff + rowb * ROWP + hi * 16;
            f32x16 acc = {0.f, 0.f, 0.f, 0.f, 0.f, 0.f, 0.f, 0.f, 0.f, 0.f, 0.f, 0.f, 0.f, 0.f, 0.f, 0.f};
#pragma unroll
            for (int s = 0; s < 8; ++s) acc = MFMA32(*(const LAS bf16x8*)(pa + s * 32), *(const LAS bf16x8*)(pb + s * 32), acc);
            const int colp = 32 * tb + r32;
            const float gcc = GC[d * 64 + colp];
            if (sel < 3) {
                LAS float* Lm = (LAS float*)(lds + D1_LM + d * 17408);
#pragma unroll
                for (int r = 0; r < 16; ++r) { const int rp = 32 * ta + crow(r, hi);
                    const float v = (rp > colp) ? BETA[d * 64 + rp] * acc[r] * __expf(GC[d * 64 + rp] - gcc) : 0.f;
                    Lm[rp * (LMP / 4) + colp] = v; }
            } else {
                float v[16];
#pragma unroll
                for (int r = 0; r < 16; ++r) { const int cp = 32 * ta + crow(r, hi);
                    v[r] = (colp >= cp) ? acc[r] * __expf(gcc - GC[d * 64 + cp]) : 0.f; }
                unsigned char* fb = gdn_rec(ws, d, ci, h) + REC_FQK + (((tb * 2 + ta) * 2) * 64 + lane) * 16;
                v4u o0, o1; o0.x = cvtpk(v[0], v[1]); o0.y = cvtpk(v[2], v[3]); o0.z = cvtpk(v[4], v[5]); o0.w = cvtpk(v[6], v[7]);
                o1.x = cvtpk(v[8], v[9]); o1.y = cvtpk(v[10], v[11]); o1.z = cvtpk(v[12], v[13]); o1.w = cvtpk(v[14], v[15]);
                *(v4u*)fb = o0; *(v4u*)(fb + 1024) = o1;
            }
        }
    }
    __syncthreads();
    constexpr int D1_TS = D1_QROW;
    for (int rep3 = 0; rep3 < (DUP_D1 == 3 ? 2 : 1); ++rep3)
    if (wave < 4) {
        const int d = wave >> 1, blk = wave & 1, j = lane & 31, jp = 32 * blk + j;
        const LAS float* Lm = (const LAS float*)(lds + D1_LM + d * 17408) + (32 * blk) * (LMP / 4) + 32 * blk;
        const float bj = BETA[d * 64 + jp], bgj = bj * __expf(GC[d * 64 + jp]);
        const int col = d ? 63 - jp : jp;
        LAS unsigned char* tb = lds + D1_TB + d * 18432 + (32 * blk) * TBP + col * 2;
        LAS float* ts = (LAS float*)(lds + D1_TS + (d * 2 + blk) * 4352) + j;
        if (lane < 32) {
            float t[32];
#pragma unroll
            for (int r = 0; r < 32; ++r) {
                float a4[4] = {(r == j) ? 1.f : 0.f, 0.f, 0.f, 0.f};
#pragma unroll
                for (int m4 = 0; m4 < (r + 3) / 4; ++m4) { const f32x4 lv = *(const LAS f32x4*)(Lm + r * (LMP / 4) + m4 * 4);
#pragma unroll
                    for (int e = 0; e < 4; ++e) if (m4 * 4 + e < r) a4[e] -= lv[e] * t[m4 * 4 + e]; }
                const float a = (a4[0] + a4[1]) + (a4[2] + a4[3]);
                t[r] = a; ts[r * 33] = a;
                *(LAS bf16*)(tb + r * TBP) = f2bf1(a * bj); *(LAS bf16*)(tb + 9216 + r * TBP) = f2bf1(a * bgj);
            }
        } else if (blk == 0) {
            const int colz = d ? 63 - (32 + j) : 32 + j; LAS unsigned char* tz = lds + D1_TB + d * 18432 + colz * 2;
#pragma unroll
            for (int r = 0; r < 32; ++r) { *(LAS bf16*)(tz + r * TBP) = (bf16)0; *(LAS bf16*)(tz + 9216 + r * TBP) = (bf16)0; }
        }
    } else {
        const int rr = lane & 31, hh = lane >> 5;
#pragma unroll 1
        for (int f = wave - 4; f < 32; f += 4) {
            const int d = f >> 4, t = (f >> 2) & 3, ip = (f >> 1) & 1, s = f & 1;
            const int c0 = 32 * ip + 16 * s + 4 * hh;
            const float gl = GC[d * 64 + 63];
            const int ktr = 32 * t + rr; const LAS unsigned char* kt = lds + D1_KT;
            float ea[4], eb[4];
#pragma unroll
            for (int x = 0; x < 4; ++x) { ea[x] = __expf(gl - GC[d * 64 + c0 + x]); eb[x] = __expf(gl - GC[d * 64 + c0 + 8 + x]); }
            float ka[4], kb[4];
            if (d == 0) { const v2u wa = *(const LAS v2u*)(kt + TSW(ktr, c0 * 2)), wb = *(const LAS v2u*)(kt + TSW(ktr, (c0 + 8) * 2));
                ka[0] = bflo(wa.x); ka[1] = bfhi(wa.x); ka[2] = bflo(wa.y); ka[3] = bfhi(wa.y); kb[0] = bflo(wb.x); kb[1] = bfhi(wb.x); kb[2] = bflo(wb.y); kb[3] = bfhi(wb.y); }
            else { const v2u wa = *(const LAS v2u*)(kt + TSW(ktr, (60 - c0) * 2)), wb = *(const LAS v2u*)(kt + TSW(ktr, (52 - c0) * 2));
                ka[3] = bflo(wa.x); ka[2] = bfhi(wa.x); ka[1] = bflo(wa.y); ka[0] = bfhi(wa.y); kb[3] = bflo(wb.x); kb[2] = bfhi(wb.x); kb[1] = bflo(wb.y); kb[0] = bfhi(wb.y); }
            v4u o; o.x = cvtpk(ka[0] * ea[0], ka[1] * ea[1]); o.y = cvtpk(ka[2] * ea[2], ka[3] * ea[3]); o.z = cvtpk(kb[0] * eb[0], kb[1] * eb[1]); o.w = cvtpk(kb[2] * eb[2], kb[3] * eb[3]);
            *(v4u*)(gdn_rec(ws, d, ci, h) + REC_FK + (((t * 2 + ip) * 2 + s) * 64 + lane) * 16) = o;
        }
    }
    __syncthreads();
    if (wave < 2) {
        const int d = wave, i = lane & 31, hh = lane >> 5;
        const LAS float* L21 = (const LAS float*)(lds + D1_LM + d * 17408) + (32 + i) * (LMP / 4);
        const LAS float* T11 = (const LAS float*)(lds + D1_TS + (d * 2 + 0) * 4352);
        const LAS float* T22 = (const LAS float*)(lds + D1_TS + (d * 2 + 1) * 4352);
        f32x16 P = {0.f, 0.f, 0.f, 0.f, 0.f, 0.f, 0.f, 0.f, 0.f, 0.f, 0.f, 0.f, 0.f, 0.f, 0.f, 0.f};
#pragma unroll
        for (int s = 0; s < 16; ++s) P = __builtin_amdgcn_mfma_f32_32x32x2f32(L21[2 * s + hh], T11[(2 * s + hh) * 33 + i], P, 0, 0, 0);
        f32x16 R = {0.f, 0.f, 0.f, 0.f, 0.f, 0.f, 0.f, 0.f, 0.f, 0.f, 0.f, 0.f, 0.f, 0.f, 0.f, 0.f};
#pragma unroll
        for (int s = 0; s < 16; ++s) R = __builtin_amdgcn_mfma_f32_32x32x2f32(T22[i * 33 + crow(s, hh)], P[s], R, 0, 0, 0);
        const float bj = BETA[d * 64 + i], bgj = bj * __expf(GC[d * 64 + i]);
        const int col = d ? 63 - i : i;
        LAS unsigned char* tb = lds + D1_TB + d * 18432 + 32 * TBP + col * 2;
#pragma unroll
        for (int r = 0; r < 16; ++r) { const float a = -R[r]; const int row = crow(r, hh);
            *(LAS bf16*)(tb + row * TBP) = f2bf1(a * bj); *(LAS bf16*)(tb + 9216 + row * TBP) = f2bf1(a * bgj); }
    }
    __syncthreads();
    for (int rep4 = 0; rep4 < (DUP_D1 == 4 ? 2 : 1); ++rep4) {
        const int r32 = lane & 31, hi = lane >> 5;
#pragma unroll 1
        for (int f = wave; f < 32; f += 8) {
            const int d = f >> 4, kind = (f >> 3) & 1, idx = f & 7;
            const LAS unsigned char* pa; const LAS unsigned char* pb; int xa = 0, xb = 0;
            if (kind == 0) { const int i = idx >> 2, w = idx & 3;
                pa = lds + D1_TB + d * 18432 + (32 * i + r32) * TBP; pb = lds + D1_VT + (32 * w + r32) * TRP; xb = (((32 * w + r32) >> 3) & 7) << 4; }
            else { const int t = idx >> 1, i = idx & 1;
                pa = lds + D1_KT + (32 * t + r32) * TRP; xa = (((32 * t + r32) >> 3) & 7) << 4; pb = lds + D1_TB + d * 18432 + 9216 + (32 * i + r32) * TBP; }
            f32x16 acc = {0.f, 0.f, 0.f, 0.f, 0.f, 0.f, 0.f, 0.f, 0.f, 0.f, 0.f, 0.f, 0.f, 0.f, 0.f, 0.f};
#pragma unroll
            for (int s = 0; s < 4; ++s) acc = MFMA32(*(const LAS bf16x8*)(pa + ((s * 32 + hi * 16) ^ xa)), *(const LAS bf16x8*)(pb + ((s * 32 + hi * 16) ^ xb)), acc);
            const float sg = kind ? -1.f : 1.f;
            v4u o0, o1; o0.x = cvtpk(sg * acc[0], sg * acc[1]); o0.y = cvtpk(sg * acc[2], sg * acc[3]); o0.z = cvtpk(sg * acc[4], sg * acc[5]); o0.w = cvtpk(sg * acc[6], sg * acc[7]);
            o1.x = cvtpk(sg * acc[8], sg * acc[9]); o1.y = cvtpk(sg * acc[10], sg * acc[11]); o1.z = cvtpk(sg * acc[12], sg * acc[13]); o1.w = cvtpk(sg * acc[14], sg * acc[15]);
            if (kind == 0) { const int i = idx >> 2, w = idx & 3; unsigned char* fb = gdn_rec(ws, d, ci, h) + REC_FU + ((w * 2 + i) * 64 + lane) * 32; *(v4u*)fb = o0; *(v4u*)(fb + 16) = o1; }
            else { const int t = idx >> 1, i = idx & 1; unsigned char* fb = gdn_rec(ws, d, ci, h) + REC_FW + (((i * 4 + t) * 2) * 64 + lane) * 16; *(v4u*)fb = o0; *(v4u*)(fb + 1024) = o1; }
        }
    }
    __syncthreads();
}
__device__ __forceinline__ bf16x8 pack8(const f32x16& v, int s) {
    v4u w; w.x = cvtpk(v[8 * s + 0], v[8 * s + 1]); w.y = cvtpk(v[8 * s + 2], v[8 * s + 3]); w.z = cvtpk(v[8 * s + 4], v[8 * s + 5]); w.w = cvtpk(v[8 * s + 6], v[8 * s + 7]);
    return __builtin_bit_cast(bf16x8, w);
}
#define SCAN_BAR() do { asm volatile("s_waitcnt lgkmcnt(0)" ::: "memory"); __builtin_amdgcn_s_barrier(); asm volatile("" ::: "memory"); } while (0)
constexpr int SC_BUF = REC_BYTES;
__device__ __forceinline__ void gdn_scan_unit(LAS unsigned char* lds, unsigned char* ws, int Tp, int sq, int h, int d, int half, int tid, int wave, int lane) {
    const int Nc = Tp / 64, cb = sq * Nc;
    bf16* ODIR = (bf16*)(ws + WS_ODIR) + (size_t)d * PASS_ROWS * 1024;
#define SC_SRC(n) ((const unsigned char*)gdn_rec(ws, d, cb + (d ? Nc - 1 - (n) : (n)), h))
    if (wave >= 2) {
        const int lt = tid - 128;
#define SC_LOAD(st, n) do { const unsigned char* src_ = SC_SRC(n); _Pragma("unroll") for (int k = 0; k < 12; ++k) st[k] = *(const v4u*)(src_ + (lt + 384 * k) * 16); } while (0)
#define SC_WRITE(st, b) do { _Pragma("unroll") for (int k = 0; k < 12; ++k) *(LAS v4u*)(lds + (b) * SC_BUF + (lt + 384 * k) * 16) = st[k]; } while (0)
        v4u s0[12], s1[12];
        SC_LOAD(s0, 0); SC_WRITE(s0, 0);
        if (1 < Nc) SC_LOAD(s1, 1);
        if (2 < Nc) SC_LOAD(s0, 2);
        SCAN_BAR();
#define SC_STEP(n, st) do { if ((n) < Nc) { if ((n) + 1 < Nc) SC_WRITE(st, ((n) + 1) & 1); if ((n) + 3 < Nc) SC_LOAD(st, (n) + 3); SCAN_BAR(); } } while (0)
#pragma unroll 1
        for (int n = 0; n < Nc; n += 2) { SC_STEP(n, s1); SC_STEP(n + 1, s0); }
#undef SC_STEP
#undef SC_WRITE
#undef SC_LOAD
    } else {
        const int w = half * 2 + wave, r32 = lane & 31, hi = lane >> 5;
        f32x16 S[4];
#pragma unroll
        for (int t = 0; t < 4; ++t)
#pragma unroll
            for (int r = 0; r < 16; ++r) S[t][r] = 0.f;
        const __amdgpu_buffer_rsrc_t orsrc = __builtin_amdgcn_make_buffer_rsrc((void*)(ODIR + (size_t)(sq * Tp) * 1024 + h * 128 + 32 * w), 0, 0x7fffffff, 0x00020000);
        SCAN_BAR();
#pragma unroll 1
        for (int n = 0; n < Nc; ++n) {
            const LAS unsigned char* buf = lds + (n & 1) * SC_BUF + lane * 16;
            const float gam = *(const LAS float*)(lds + (n & 1) * SC_BUF + REC_GAM);
#define LDF(off) (*(const LAS bf16x8*)(buf + (off)))
#define FWO(i, t, s) (REC_FW + (((i) * 4 + (t)) * 2 + (s)) * 1024)
#define FQO(i, t, s) (REC_FQ + (((i) * 4 + (t)) * 2 + (s)) * 1024)
#define FKO(t, ip, s) (REC_FK + (((t) * 2 + (ip)) * 2 + (s)) * 1024)
#define FQKO(i, ip, s) (REC_FQK + (((i) * 2 + (ip)) * 2 + (s)) * 1024)
            bf16x8 A[8], B[8];
#pragma unroll
            for (int e = 0; e < 8; ++e) { A[e] = LDF(FWO(e & 1, e >> 2, (e >> 1) & 1)); B[e] = LDF(FWO(e & 1, 2 + (e >> 2), (e >> 1) & 1)); }
            v4u ua[2], ub[2];
#pragma unroll
            for (int i = 0; i < 2; ++i) { const LAS v4u* pu = (const LAS v4u*)(lds + (n & 1) * SC_BUF + REC_FU + ((w * 2 + i) * 64 + lane) * 32); ua[i] = pu[0]; ub[i] = pu[1]; }
            __builtin_amdgcn_sched_barrier(0);
            bf16x8 Sf[4][2];
#pragma unroll
            for (int t = 0; t < 4; ++t) { Sf[t][0] = pack8(S[t], 0); Sf[t][1] = pack8(S[t], 1); }
            f32x16 V[2];
#pragma unroll
            for (int i = 0; i < 2; ++i) { const v4u a = ua[i], b = ub[i];
                V[i][0] = bflo(a.x); V[i][1] = bfhi(a.x); V[i][2] = bflo(a.y); V[i][3] = bfhi(a.y); V[i][4] = bflo(a.z); V[i][5] = bfhi(a.z); V[i][6] = bflo(a.w); V[i][7] = bfhi(a.w);
                V[i][8] = bflo(b.x); V[i][9] = bfhi(b.x); V[i][10] = bflo(b.y); V[i][11] = bfhi(b.y); V[i][12] = bflo(b.z); V[i][13] = bfhi(b.z); V[i][14] = bflo(b.w); V[i][15] = bfhi(b.w); }
            __builtin_amdgcn_sched_barrier(0);
#pragma unroll
            for (int e = 0; e < 8; ++e) V[e & 1] = MFMA32(A[e], Sf[e >> 2][(e >> 1) & 1], V[e & 1]);
            __builtin_amdgcn_sched_barrier(0);
#pragma unroll
            for (int e = 0; e < 8; ++e) A[e] = LDF(FQO(e & 1, e >> 2, (e >> 1) & 1));
            __builtin_amdgcn_sched_barrier(0);
#pragma unroll
            for (int e = 0; e < 8; ++e) V[e & 1] = MFMA32(B[e], Sf[2 + (e >> 2)][(e >> 1) & 1], V[e & 1]);
            __builtin_amdgcn_sched_barrier(0);
#pragma unroll
            for (int e = 0; e < 8; ++e) B[e] = LDF(FQO(e & 1, 2 + (e >> 2), (e >> 1) & 1));
            __builtin_amdgcn_sched_barrier(0);
            f32x16 O[2];
#pragma unroll
            for (int i = 0; i < 2; ++i)
#pragma unroll
                for (int r = 0; r < 16; ++r) O[i][r] = 0.f;
#pragma unroll
            for (int e = 0; e < 8; ++e) O[e & 1] = MFMA32(A[e], Sf[e >> 2][(e >> 1) & 1], O[e & 1]);
            __builtin_amdgcn_sched_barrier(0);
#pragma unroll
            for (int e = 0; e < 8; ++e) A[e] = LDF(FKO(e & 3, 0, e >> 2));
            bf16x8 Vf[2][2];
#pragma unroll
            for (int i = 0; i < 2; ++i) { Vf[i][0] = pack8(V[i], 0); Vf[i][1] = pack8(V[i], 1); }
#pragma unroll
            for (int t = 0; t < 4; ++t)
#pragma unroll
                for (int r = 0; r < 16; ++r) S[t][r] *= gam;
            __builtin_amdgcn_sched_barrier(0);
#pragma unroll
            for (int e = 0; e < 8; ++e) O[e & 1] = MFMA32(B[e], Sf[2 + (e >> 2)][(e >> 1) & 1], O[e & 1]);
            __builtin_amdgcn_sched_barrier(0);
#pragma unroll
            for (int e = 0; e < 8; ++e) B[e] = LDF(FKO(e & 3, 1, e >> 2));
            __builtin_amdgcn_sched_barrier(0);
#pragma unroll
            for (int e = 0; e < 8; ++e) S[e & 3] = MFMA32(A[e], Vf[0][e >> 2], S[e & 3]);
            __builtin_amdgcn_sched_barrier(0);
            A[0] = LDF(FQKO(0, 0, 0)); A[1] = LDF(FQKO(1, 0, 0)); A[2] = LDF(FQKO(0, 0, 1)); A[3] = LDF(FQKO(1, 0, 1)); A[4] = LDF(FQKO(1, 1, 0)); A[5] = LDF(FQKO(1, 1, 1));
            __builtin_amdgcn_sched_barrier(0);
#pragma unroll
            for (int e = 0; e < 8; ++e) S[e & 3] = MFMA32(B[e], Vf[1][e >> 2], S[e & 3]);
            __builtin_amdgcn_sched_barrier(0);
            O[0] = MFMA32(A[0], Vf[0][0], O[0]); O[1] = MFMA32(A[1], Vf[0][0], O[1]); O[0] = MFMA32(A[2], Vf[0][1], O[0]); O[1] = MFMA32(A[3], Vf[0][1], O[1]);
            O[1] = MFMA32(A[4], Vf[1][0], O[1]); O[1] = MFMA32(A[5], Vf[1][1], O[1]);
#undef LDF
#undef FWO
#undef FQO
#undef FKO
#undef FQKO
            { const int tau0 = 64 * n + 4 * hi;
#pragma unroll
              for (int i = 0; i < 2; ++i)
#pragma unroll
                for (int r = 0; r < 16; ++r) { const int tau = tau0 + 32 * i + (r & 3) + 8 * (r >> 2); const int trow = d ? Tp - 1 - tau : tau;
                    __builtin_amdgcn_raw_buffer_store_b16((short)f2bf1(O[i][r]), orsrc, (trow * 1024 + r32) * 2, 0, 0); } }
            SCAN_BAR();
        }
    }
#undef SC_SRC
}
#define KSWZ(row, colB) ((row) * 256 + ((colB) ^ (((row) & 7) << 4)))
#define SBAR() __builtin_amdgcn_sched_barrier(0)
constexpr int AT_V = 0, AT_K = 32768, AT_OST = 0, AT_OST_W = 16896, AT_WS = 8 * AT_OST_W;
constexpr float ATT_THR = 11.5f;
__device__ __forceinline__ int v_st(int k, int c) { const int kk = (k & ~0xC) | ((k & 4) << 1) | ((k & 8) >> 1); return ((kk >> 3) * 4 + (c >> 5)) * 512 + ((kk & 7) * 32 + (c & 31)) * 2; }
__device__ __forceinline__ int v_rd_base(int lane) { return ((lane & 3) << 3) | (((lane >> 2) & 3) << 6) | (((lane >> 4) & 1) << 5) | (((lane >> 5) & 1) << 8); }
constexpr int v_rd_off(int d0, int ks, int half) { return d0 * 512 + ks * 4096 + half * 2048; }
template <int OFF> __device__ __forceinline__ s16x4 tr_read(int vb) {
    s16x4 r; asm volatile("ds_read_b64_tr_b16 %0, %1 offset:%2" : "=&v"(r) : "v"(vb), "i"(OFF) : "memory"); return r;
}
template <int D0> __device__ __forceinline__ void pv_one(f32x16& od, int vb, bf16x8 pa0, bf16x8 pa1, bf16x8 pa2, bf16x8 pa3) {
    const s16x4 l0 = tr_read<v_rd_off(D0, 0, 0)>(vb), h0 = tr_read<v_rd_off(D0, 0, 1)>(vb), l1 = tr_read<v_rd_off(D0, 1, 0)>(vb), h1 = tr_read<v_rd_off(D0, 1, 1)>(vb);
    const s16x4 l2 = tr_read<v_rd_off(D0, 2, 0)>(vb), h2 = tr_read<v_rd_off(D0, 2, 1)>(vb), l3 = tr_read<v_rd_off(D0, 3, 0)>(vb), h3 = tr_read<v_rd_off(D0, 3, 1)>(vb);
    asm volatile("s_waitcnt lgkmcnt(0)" ::: "memory"); SBAR();
#define PK(L, H) (bf16x8){L[0], L[1], L[2], L[3], H[0], H[1], H[2], H[3]}
    od = MFMA32(pa0, PK(l0, h0), od); od = MFMA32(pa1, PK(l1, h1), od); od = MFMA32(pa2, PK(l2, h2), od); od = MFMA32(pa3, PK(l3, h3), od);
#undef PK
}
__device__ __forceinline__ void pv_d0(f32x16* o, int vb, bf16x8 pa0, bf16x8 pa1, bf16x8 pa2, bf16x8 pa3) {
    pv_one<0>(o[0], vb, pa0, pa1, pa2, pa3); pv_one<1>(o[1], vb, pa0, pa1, pa2, pa3); pv_one<2>(o[2], vb, pa0, pa1, pa2, pa3); pv_one<3>(o[3], vb, pa0, pa1, pa2, pa3);
}
template <bool FIXED>
__device__ __forceinline__ float softmax_tile(f32x16& p0, f32x16& p1, float& m_reg, float& l_reg, bf16x8& pa0, bf16x8& pa1, bf16x8& pa2, bf16x8& pa3) {
    float alpha = 1.f;
    if (!FIXED) {
        float pmax = p0[0];
#pragma unroll
        for (int r = 1; r < 16; ++r) pmax = fmaxf(pmax, p0[r]);
#pragma unroll
        for (int r = 0; r < 16; ++r) pmax = fmaxf(pmax, p1[r]);
        pmax = half_max(pmax);
        if (!__all(pmax - m_reg <= ATT_THR)) { const float mn = fmaxf(m_reg, pmax); alpha = __builtin_amdgcn_exp2f(m_reg - mn); m_reg = mn; }
        const float mn = m_reg;
#pragma unroll
        for (int r = 0; r < 16; ++r) { p0[r] = __builtin_amdgcn_exp2f(p0[r] - mn); p1[r] = __builtin_amdgcn_exp2f(p1[r] - mn); }
    } else {
#pragma unroll
        for (int r = 0; r < 16; ++r) { p0[r] = __builtin_amdgcn_exp2f(p0[r]); p1[r] = __builtin_amdgcn_exp2f(p1[r]); }
    }
    float ps = 0.f;
#pragma unroll
    for (int r = 0; r < 16; ++r) ps += p0[r];
#pragma unroll
    for (int r = 0; r < 16; ++r) ps += p1[r];
    ps = half_sum(ps);
    l_reg = l_reg * alpha + ps;
#define PK4(P, BASE, OUT) do { unsigned a0 = cvtpk(P[BASE + 0], P[BASE + 1]), a1 = cvtpk(P[BASE + 2], P[BASE + 3]);   \
    unsigned b0 = cvtpk(P[BASE + 4], P[BASE + 5]), b1 = cvtpk(P[BASE + 6], P[BASE + 7]);                              \
    auto r0 = __builtin_amdgcn_permlane32_swap(a0, b0, false, false); auto r1 = __builtin_amdgcn_permlane32_swap(a1, b1, false, false); \
    v4u w = {r0[0], r1[0], r0[1], r1[1]}; OUT = __builtin_bit_cast(bf16x8, w); } while (0)
    PK4(p0, 0, pa0); PK4(p0, 8, pa1); PK4(p1, 0, pa2); PK4(p1, 8, pa3);
#undef PK4
    return alpha;
}

__device__ __forceinline__ int diff_radius(float bnat, int h) {
    const float slope_n = exp2f(-(float)(h + 1));
    const float dn = (2.0f * bnat + logf(2.0f / (1.0f - expf(-slope_n))) + 22.18f) / slope_n;
    return (dn < 1.0e6f) ? (int)dn + 1 : 1000000;
}
struct AttnParams { const float* q_gain; const float* sink; const float* lam; const float* norm_gain; float bnat; };
#define KSWZ64(row, colB) ((row) * 128 + ((colB) ^ ((((row) >> 1) & 7) << 4)))

template <int MODE, bool FIXED>
__device__ __forceinline__ void attn_unit(LAS unsigned char* lds, unsigned char* ws, const AttnParams& P, int l, int Tp, int sq, int h, int qb, int part, int np, int pslot, int tid, int wave, int lane) {
    constexpr int NPASS_M = MODE ? 2 : 1, NDD = MODE ? 4 : 8;
    const bf16* PROJ = (const bf16*)(ws + WS_PROJ);
    const int r32 = lane & 31, hi = lane >> 5;
    const int seq0 = sq * Tp, q0 = qb * 256;
    const int qcol = MODE ? C_DQ + h * 128 : C_SQ + h * 128;
    const int kcol = MODE ? C_DK + h * 128 : C_SKV + (h >> 2) * 128;
    const int vcol = MODE ? C_DV + h * 128 : C_SKV + 256 + (h >> 2) * 128;
    const int zcol = MODE ? C_DZ + h * 128 : C_SZ + h * 128;
    int jlo = 0, jhi = Tp / 64;
    const float slope_n = exp2f(-(float)(h + 1)), slope2 = slope_n * LOG2E;
    if (MODE == 0) { jlo = (q0 - 128) / 64; if (jlo < 0) jlo = 0; const int e = (q0 + 384) / 64; if (e < jhi) jhi = e; }
    else {
        float bn = P.bnat; asm volatile("" : "+v"(bn));
        float smin = 1.0e30f;
        { const bf16* qp = PROJ + (size_t)(seq0 + q0 + wave * 32 + r32) * LDP + qcol + hi * 8; const bf16* kp = PROJ + (size_t)(seq0 + q0 + wave * 32 + r32) * LDP + kcol + hi * 8;
#pragma unroll
          for (int mq = 0; mq < 2; ++mq) { float dot = 0.f;
#pragma unroll
              for (int d0 = 0; d0 < 4; ++d0) { const v4u wq = *(const v4u*)(qp + mq * 64 + d0 * 16), wk = *(const v4u*)(kp + mq * 64 + d0 * 16);
                  const float q8[8] = {bflo(wq.x), bfhi(wq.x), bflo(wq.y), bfhi(wq.y), bflo(wq.z), bfhi(wq.z), bflo(wq.w), bfhi(wq.w)};
                  const float k8[8] = {bflo(wk.x), bfhi(wk.x), bflo(wk.y), bfhi(wk.y), bflo(wk.z), bfhi(wk.z), bflo(wk.w), bfhi(wk.w)};
#pragma unroll
                  for (int e = 0; e < 8; ++e) dot += q8[e] * k8[e]; }
              dot = half_sum(dot);
              smin = fminf(smin, dot * (1.0f / LOG2E)); }
          smin = -wave_max(-smin);
          LAS float* sm = (LAS float*)(lds + AT_WS) + 512;
          if (lane == 0) sm[wave] = smin;
          asm volatile("s_waitcnt lgkmcnt(0)" ::: "memory"); __builtin_amdgcn_s_barrier(); asm volatile("" ::: "memory");
          smin = fminf(fminf(fminf(sm[0], sm[1]), fminf(sm[2], sm[3])), fminf(fminf(sm[4], sm[5]), fminf(sm[6], sm[7]))); }
        float beff = 0.5f * (bn - smin + 0.1f); if (!(beff < bn)) beff = bn;
        const int dk = diff_radius(beff, h);
        const int a = q0 - dk; jlo = a > 0 ? (a >> 6) : 0; const int e = ((q0 + 255 + dk) >> 6) + 1; if (e < jhi) jhi = e;
        if (np > 1) { const int len = (jhi - jlo + np - 1) / np; jlo += part * len; const int e2 = jlo + len; if (e2 < jhi) jhi = e2; }
    }
    LAS unsigned char* V_lds = lds + AT_V; LAS unsigned char* K_lds = lds + AT_K;
    LAS float* wsf = (LAS float*)(lds + AT_WS) + wave * 64; LAS float* li_l = wsf; LAS float* al_l = wsf + 32;
    float* park = (float*)(ws + WS_PARK) + (size_t)(blockIdx.x * NWAVES + wave) * 4096 + lane * 4;
    const float qposh = (float)(q0 + wave * 32 + r32 - 4 * hi), qposf = (float)(q0 + wave * 32 + r32);
    const int vb0 = (int)(uintptr_t)V_lds + v_rd_base(lane);
    const int sr = tid >> 4, sc = (tid & 15) * 8, vst0 = v_st(sr, sc), vst1 = v_st(32 + sr, sc);
    const int kr1 = tid >> 3, kc1 = (tid & 7) * 8;
    f32x16 o[4]; float l_reg = 0.f;
#pragma unroll 1
    for (int mp = 0; mp < NPASS_M; ++mp) {
        bf16x8 qr[NDD];
        if (MODE == 1) {
            const bf16* qp = PROJ + (size_t)(seq0 + q0 + wave * 32 + r32) * LDP + qcol + mp * 64 + hi * 8;
#pragma unroll
            for (int d0 = 0; d0 < NDD; ++d0) qr[d0] = *(const bf16x8*)(qp + d0 * 16);
        } else {
            const bf16* qp = PROJ + (size_t)(seq0 + q0 + wave * 32 + r32) * LDP + qcol + mp * 64 + hi * 8;
            float qf[NDD][8]; float ss = 0.f;
#pragma unroll
            for (int d0 = 0; d0 < NDD; ++d0) { const v4u w = *(const v4u*)(qp + d0 * 16);
                qf[d0][0] = bflo(w.x); qf[d0][1] = bfhi(w.x); qf[d0][2] = bflo(w.y); qf[d0][3] = bfhi(w.y); qf[d0][4] = bflo(w.z); qf[d0][5] = bfhi(w.z); qf[d0][6] = bflo(w.w); qf[d0][7] = bfhi(w.w);
#pragma unroll
                for (int e = 0; e < 8; ++e) ss += qf[d0][e] * qf[d0][e]; }
            ss = half_sum(ss);
            const float rs = MODE ? (1.0f / sqrtf(ss * (1.0f / 64.0f) + NORM_EPS)) * (0.125f * LOG2E) : (1.0f / sqrtf(ss * (1.0f / 128.0f) + NORM_EPS)) * (0.08838834764831845f * LOG2E);
#pragma unroll
            for (int d0 = 0; d0 < NDD; ++d0) { const float* g = P.q_gain + d0 * 16 + hi * 8;
                const f32x4 ga = *(const f32x4*)g, gb = *(const f32x4*)(g + 4);
                v4u w; w.x = cvtpk(qf[d0][0] * rs * ga.x, qf[d0][1] * rs * ga.y); w.y = cvtpk(qf[d0][2] * rs * ga.z, qf[d0][3] * rs * ga.w);
                w.z = cvtpk(qf[d0][4] * rs * gb.x, qf[d0][5] * rs * gb.y); w.w = cvtpk(qf[d0][6] * rs * gb.z, qf[d0][7] * rs * gb.w);
                qr[d0] = __builtin_bit_cast(bf16x8, w); }
        }
        float m_reg = (MODE == 0) ? P.sink[h] * LOG2E : -1e30f; l_reg = (MODE == 0) ? (FIXED ? exp2f(P.sink[h] * LOG2E) : 1.f) : 0.f;
#pragma unroll
        for (int d = 0; d < 4; ++d)
#pragma unroll
            for (int r = 0; r < 16; ++r) o[d][r] = 0.f;
        const bf16* Vg = PROJ + (size_t)seq0 * LDP + vcol + sc;
        const bf16* Kg = MODE ? PROJ + (size_t)(seq0 + kr1) * LDP + kcol + mp * 64 + kc1 : PROJ + (size_t)seq0 * LDP + kcol + sc;
        constexpr int DEPTH = 1;
        struct Stg { v4u vs0, vs1, ks0, ks1; };
        Stg sA, sB;
#define SLOAD(S, k0) do { S.vs0 = *(const v4u*)(Vg + (size_t)((k0) + sr) * LDP); S.vs1 = *(const v4u*)(Vg + (size_t)((k0) + 32 + sr) * LDP); \
        if (MODE) { S.ks0 = *(const v4u*)(Kg + (size_t)(k0) * LDP); } \
        else { S.ks0 = *(const v4u*)(Kg + (size_t)((k0) + sr) * LDP); S.ks1 = *(const v4u*)(Kg + (size_t)((k0) + 32 + sr) * LDP); } } while (0)
#define SWRITE(S, b) do { *(LAS v4u*)(V_lds + (b) * 16384 + vst0) = S.vs0; *(LAS v4u*)(V_lds + (b) * 16384 + vst1) = S.vs1; \
        if (MODE) { *(LAS v4u*)(K_lds + (b) * 16384 + KSWZ64(kr1, kc1 * 2)) = S.ks0; } \
        else { *(LAS v4u*)(K_lds + (b) * 16384 + KSWZ(sr, sc * 2)) = S.ks0; *(LAS v4u*)(K_lds + (b) * 16384 + KSWZ(32 + sr, sc * 2)) = S.ks1; } } while (0)
#define TILE(S, jj) do { const int j_ = (jj); const int b_ = (j_ - jlo) & 1; \
            SWRITE(S, b_); \
            if (j_ + DEPTH < jhi) SLOAD(S, (j_ + DEPTH) * 64); \
            asm volatile("s_waitcnt lgkmcnt(0)" ::: "memory"); __builtin_amdgcn_s_barrier(); asm volatile("" ::: "memory"); \
              \
            if (MODE == 1 || (j_ * 64 + 63 >= q0 + wave * 32 - 128 && j_ * 64 <= q0 + wave * 32 + 31 + 128)) { \
            const LAS unsigned char* Kb = K_lds + b_ * 16384; const int vb = vb0 + b_ * 16384; \
            const float fi = qposh - (float)(j_ * 64);                 \
            f32x16 p0, p1; \
            _Pragma("unroll") for (int r = 0; r < 16; ++r) { p0[r] = 0.f; p1[r] = 0.f; } \
            _Pragma("unroll") for (int dd = 0; dd < NDD; ++dd) { const int cb = (dd * 16 + hi * 8) * 2; \
                const bf16x8 b0 = MODE ? *(const LAS bf16x8*)(Kb + KSWZ64(r32, cb)) : *(const LAS bf16x8*)(Kb + KSWZ(r32, cb)); \
                const bf16x8 b1 = MODE ? *(const LAS bf16x8*)(Kb + KSWZ64(32 + r32, cb)) : *(const LAS bf16x8*)(Kb + KSWZ(32 + r32, cb)); \
                p0 = MFMA32(b0, qr[dd], p0); p1 = MFMA32(b1, qr[dd], p1); } \
              \
            const bool lin_ = (MODE == 1) && FIXED && (j_ * 64 + 63 < q0 + wave * 32 || j_ * 64 > q0 + wave * 32 + 31); \
            if (lin_) { const float sg = (j_ * 64 + 63 < q0 + wave * 32) ? 1.f : -1.f, slv = sg * slope2, lcv = -slv * (qposf - (float)(j_ * 64)); \
                const unsigned hw = cvtpk(lcv, slv), lw = cvtpk(lcv - bflo(hw), slv - bfhi(hw)); \
                v4u qx = {(hw & 0xffffu) | (lw << 16), (hw >> 16) | (lw & 0xffff0000u), 0u, 0u}; if (hi) qx = (v4u){0u, 0u, 0u, 0u}; \
                const LAS unsigned char* Kx = K_lds + 8192 + hi * 16; \
                p0 = MFMA32(*(const LAS bf16x8*)(Kx + r32 * 32), __builtin_bit_cast(bf16x8, qx), p0); p1 = MFMA32(*(const LAS bf16x8*)(Kx + (32 + r32) * 32), __builtin_bit_cast(bf16x8, qx), p1); } \
            if (!lin_) { \
            _Pragma("unroll") for (int r = 0; r < 16; ++r) { const float dd0 = fabsf(fi - (float)((r & 3) + 8 * (r >> 2))), dd1 = fabsf(fi - (float)(32 + (r & 3) + 8 * (r >> 2))); \
                p0[r] = fmaf(-slope2, dd0, p0[r]); p1[r] = fmaf(-slope2, dd1, p1[r]); \
                if (MODE == 0) { if (dd0 > 128.f) p0[r] = -INFINITY; if (dd1 > 128.f) p1[r] = -INFINITY; } } } \
            bf16x8 pa0, pa1, pa2, pa3; \
            const float alpha = softmax_tile<FIXED>(p0, p1, m_reg, l_reg, pa0, pa1, pa2, pa3); \
            if (!FIXED && __any(alpha < 1.f)) { if (hi == 0) al_l[r32] = alpha; asm volatile("s_waitcnt lgkmcnt(0)" ::: "memory"); \
                _Pragma("unroll") for (int r = 0; r < 16; ++r) { const float a = al_l[crow(r, hi)]; \
                    _Pragma("unroll") for (int d = 0; d < 4; ++d) o[d][r] *= a; } } \
            SBAR(); pv_d0(o, vb, pa0, pa1, pa2, pa3); } } while (0)
        if (MODE == 1 && tid < 64) {
            const unsigned one2 = 0x3F803F80u, cw = cvtpk((float)tid, (float)tid);
            *(LAS v4u*)(K_lds + 8192 + tid * 32) = (v4u){one2, cw, 0u, 0u}; *(LAS v4u*)(K_lds + 8192 + tid * 32 + 16) = (v4u){0u, 0u, 0u, 0u}; }
        if (jlo < jhi) SLOAD(sA, jlo * 64);
        if (DEPTH == 2 && jlo + 1 < jhi) SLOAD(sB, (jlo + 1) * 64);
#pragma unroll 1
        for (int j = jlo; j < jhi; j += 2) {
            TILE(sA, j);
            if (j + 1 < jhi) { if (DEPTH == 2) TILE(sB, j + 1); else TILE(sA, j + 1); }
        }
#undef TILE
#undef SLOAD
#undef SWRITE
        asm volatile("s_waitcnt lgkmcnt(0)" ::: "memory"); __builtin_amdgcn_s_barrier(); asm volatile("" ::: "memory");
        if (MODE == 1 && pslot >= 0) {
            float* po = (float*)(ws + WS_PART) + ((size_t)(pslot * 2 + mp) * 256 + wave * 32 + 4 * hi) * 128 + r32;
#pragma unroll
            for (int g = 0; g < 4; ++g) { float* pg = po + g * 8 * 128; asm volatile("" : "+v"(pg));
#pragma unroll
                for (int e = 0; e < 4; ++e)
#pragma unroll
                    for (int d = 0; d < 4; ++d) pg[e * 128 + d * 32] = o[d][4 * g + e]; }
            if (hi == 0) ((float*)(ws + WS_PARTL))[(pslot * 2 + mp) * 256 + wave * 32 + r32] = l_reg;
        } else
        if (MODE == 1 && mp == 0) {
            if (hi == 0) li_l[r32] = l_reg;
            asm volatile("s_waitcnt lgkmcnt(0)" ::: "memory");
#pragma unroll
            for (int r4 = 0; r4 < 4; ++r4) { float rl[4];
#pragma unroll
                for (int e = 0; e < 4; ++e) rl[e] = __builtin_amdgcn_rcpf(li_l[crow(4 * r4 + e, hi)]);
#pragma unroll
                for (int d = 0; d < 4; ++d) { f32x4 t; t.x = o[d][4 * r4] * rl[0]; t.y = o[d][4 * r4 + 1] * rl[1]; t.z = o[d][4 * r4 + 2] * rl[2]; t.w = o[d][4 * r4 + 3] * rl[3];
                    *(f32x4*)(park + (d * 4 + r4) * 256) = t; } }
            asm volatile("s_waitcnt lgkmcnt(0)" ::: "memory");
        }
    }
    if (MODE == 1 && pslot >= 0) return;
    float lam = 0.f; int ll_ = l; asm volatile("" : "+s"(ll_)); const float lin = 0.8f - 0.6f * expf(-0.3f * (float)ll_);
    if (MODE == 1) { const float a = P.lam[lane] * P.lam[64 + lane], bq = P.lam[128 + lane] * P.lam[192 + lane]; lam = expf(wave_sum(a)) - expf(wave_sum(bq)) + lin; }
    LAS float* ost = (LAS float*)(lds + AT_OST + wave * AT_OST_W);
    {
        if (hi == 0) li_l[r32] = l_reg;
        asm volatile("s_waitcnt lgkmcnt(0)" ::: "memory");
#pragma unroll
        for (int r4 = 0; r4 < 4; ++r4) { float rl[4];
#pragma unroll
            for (int e = 0; e < 4; ++e) rl[e] = __builtin_amdgcn_rcpf(li_l[crow(4 * r4 + e, hi)]);
#pragma unroll
            for (int d = 0; d < 4; ++d) { f32x4 pk = {0.f, 0.f, 0.f, 0.f}; if (MODE == 1) pk = *(const f32x4*)(park + (d * 4 + r4) * 256);
#pragma unroll
                for (int e = 0; e < 4; ++e) { float v = o[d][4 * r4 + e] * rl[e]; if (MODE == 1) v = pk[e] - lam * v;
                    ost[crow(4 * r4 + e, hi) * 132 + d * 32 + r32] = v; } } }
    }
    asm volatile("s_waitcnt lgkmcnt(0)" ::: "memory");
    {
        const int row = lane >> 1, half = lane & 1;
        const LAS f32x4* src = (const LAS f32x4*)(ost + row * 132 + half * 64);
        float v[64];
#pragma unroll
        for (int k = 0; k < 16; ++k) { const f32x4 t = src[k]; v[4 * k] = t.x; v[4 * k + 1] = t.y; v[4 * k + 2] = t.z; v[4 * k + 3] = t.w; }
        const size_t grow = (size_t)(seq0 + q0 + wave * 32 + row);
        float rs = 1.f;
        if (MODE == 1) { float ss = 0.f;
#pragma unroll
            for (int e = 0; e < 64; ++e) ss += v[e] * v[e];
            ss += xshfl<1>(ss); rs = (1.0f / sqrtf(ss * (1.0f / 128.0f) + NORM_EPS)) * (1.0f - lin); }
        const v4u* zp = (const v4u*)(PROJ + grow * LDP + zcol + half * 64);
        bf16* yb = (bf16*)(ws + WS_Y + (MODE ? 2 : 1) * SZ_Y1) + grow * 1024 + h * 128 + half * 64;
#pragma unroll
        for (int k = 0; k < 8; ++k) { const v4u zw = zp[k];
            const float z[8] = {bflo(zw.x), bfhi(zw.x), bflo(zw.y), bfhi(zw.y), bflo(zw.z), bfhi(zw.z), bflo(zw.w), bfhi(zw.w)};
            float y[8];
#pragma unroll
            for (int e = 0; e < 8; ++e) { float g = 1.f; if (MODE == 1) g = P.norm_gain[half * 64 + 8 * k + e]; y[e] = v[8 * k + e] * rs * g * z[e]; }
            v4u w; w.x = cvtpk(y[0], y[1]); w.y = cvtpk(y[2], y[3]); w.z = cvtpk(y[4], y[5]); w.w = cvtpk(y[6], y[7]);
            *(v4u*)(yb + 8 * k) = w; }
    }
    asm volatile("s_waitcnt lgkmcnt(0)" ::: "memory"); __builtin_amdgcn_s_barrier(); asm volatile("" ::: "memory");
}
#ifndef ONLY_PHASE
#define ONLY_PHASE -1
#endif
#ifndef ONLY_SUB
#define ONLY_SUB -1
#endif
#define PH4_ON(k) (ONLY_SUB < 0 || ONLY_SUB == (k))
#define PH_ON(k) (ONLY_PHASE < 0 || ONLY_PHASE == (k))
#ifndef DUP_PHASE
#define DUP_PHASE -1
#endif
#define NREP(k) ((DUP_PHASE == (k)) ? 2 : 1)
#ifndef DUP_PASSES
#define DUP_PASSES 15
#endif
#ifndef SPLIT_TILES
#define SPLIT_TILES 128
#endif
#ifndef SPLIT_MAX
#define SPLIT_MAX 2
#endif
#ifndef B_SKEW_NS
#define B_SKEW_NS 0
#endif
#ifndef MK_PER_PHASE
#define MK_PER_PHASE 0
#endif
constexpr int N_ITER = DEPTH * NPASS, PH_PER_IT = 7, N_PHASES = 1 + N_ITER * PH_PER_IT;
struct Args { const float* in[17]; float* out; unsigned char* ws; int ph_lo, ph_hi; };
#define WG_SYNC_LDS() do { asm volatile("s_waitcnt lgkmcnt(0)" ::: "memory"); __builtin_amdgcn_s_barrier(); asm volatile("" ::: "memory"); } while (0)

__global__ void __launch_bounds__(NTHREADS, 2) fwd_kernel(Args args) {
    extern __shared__ __attribute__((aligned(16))) unsigned char lds_raw[];
    LAS unsigned char* lds = (LAS unsigned char*)lds_raw;
    volatile LAS unsigned* MISC = (volatile LAS unsigned*)(lds + MISC_OFF);
    const int tid0 = threadIdx.x;
    const int G = gridDim.x, bx = blockIdx.x, ngw = G * NWAVES;
    unsigned char* ws = args.ws;
    unsigned* ctl = (unsigned*)(ws + WS_CTL);
    if (tid0 < 128) MISC[tid0] = 0u;
    __syncthreads();
    XcdBarrier bar; bar.bar = ctl + CW_BAR; bar.x = 0; bar.st = nullptr;
    if (!MK_PER_PHASE) bar = xcd_barrier_post(ctl + CW_BAR, MISC + 8);
    const int lo = args.ph_lo, hi = args.ph_hi;
#define IN(k) (lo <= (k) && (k) < hi)
#define LAUNDER_TID() int tid = tid0; asm volatile("" : "+v"(tid)); const int lane = tid & 63, wave = __builtin_amdgcn_readfirstlane(tid >> 6), gw = bx * NWAVES + wave; (void)lane; (void)gw
#define TBR(i) __builtin_amdgcn_readfirstlane((int)TB[i])
#define T_GT 0
#define T_PB 32
#define T_NPH 40
#define T_NDF 48
#define T_LEN 56
#define DIFF_TABLE(bd_, fixd_) volatile LAS int* TB = (volatile LAS int*)(MISC + 16); do { const int per_ = nseq * (Tp / 256); \
        if (tid0 == 0) { int ps = 0; \
            for (int hh = 7; hh >= 0; --hh) { const int dk = diff_radius((bd_), hh); int ntm = (255 + 2 * dk) / 64 + 2; if (ntm > Tp / 64) ntm = Tp / 64; \
                int np = (fixd_) ? (ntm + SPLIT_TILES - 1) / SPLIT_TILES : 1; if (np > SPLIT_MAX) np = SPLIT_MAX; if (np > 1 && ps + np * per_ > PART_SLOTS) np = 1; \
                TB[T_NPH + hh] = np; TB[T_PB + hh] = (np > 1) ? ps : -1; if (np > 1) ps += np * per_; TB[T_LEN + hh] = (ntm + np - 1) / np; } \
              \
            int g = 0; unsigned done_ = 0u; \
            for (int k = 0; k < 8; ++k) { int best = -1, bl = -1; for (int hh = 7; hh >= 0; --hh) if (!((done_ >> hh) & 1u) && TB[T_LEN + hh] > bl) { bl = TB[T_LEN + hh]; best = hh; } \
                done_ |= 1u << best; const int np = TB[T_NPH + best]; for (int p = 0; p < np; ++p) TB[T_GT + g++] = best | (p << 8) | (np << 16); } \
            TB[T_NDF] = g * per_; } \
        __syncthreads(); } while (0)
#define DIFF_BOUND(bd_) float bd_; { int ln_ = tid0; asm volatile("" : "+v"(ln_)); const int ln = ln_ & 63; const float* dqg_ = diff_q_gain + l * 64; const float* dkg_ = diff_k_gain + l * 64; \
        float gq = fabsf(dqg_[ln]), gk = fabsf(dkg_[ln]); \
        gq = wave_max(gq); gk = wave_max(gk); \
        bd_ = 8.0f * gq * gk * 1.02f; }
#define SEAM(k) do { if (!MK_PER_PHASE && IN(k) && IN((k) + 1)) xcd_barrier(bar); } while (0)

    const __attribute__((address_space(4))) unsigned char* kargs = (const __attribute__((address_space(4))) unsigned char*)__builtin_amdgcn_kernarg_segment_ptr();
#define INP(k) ([&]() { const __attribute__((address_space(4))) unsigned char* kp_ = kargs; asm volatile("" : "+s"(kp_)); return *(const float* const __attribute__((address_space(4)))*)(kp_ + 8 * (k)); }())
#define x_prompt INP(0)
#define x_sample INP(1)
#define norm_gain INP(2)
#define w_in INP(3)
#define conv_w INP(4)
#define a_log INP(5)
#define dt_bias INP(6)
#define gdn_norm_gain INP(7)
#define swa_q_gain INP(8)
#define swa_k_gain INP(9)
#define swa_sink INP(10)
#define diff_q_gain INP(11)
#define diff_k_gain INP(12)
#define diff_lambda INP(13)
#define diff_norm_gain INP(14)
#define w_branch INP(15)
#define w_out INP(16)

    if (PH_ON(0) && IN(0)) for (int rep = 0; rep < NREP(12); ++rep) { LAUNDER_TID(); phase_prologue(lds, w_in, w_branch, w_out, ws, gw, ngw, wave, lane); __syncthreads(); }
    SEAM(0);

    bf16* HN = (bf16*)(ws + WS_HN); bf16* PROJ = (bf16*)(ws + WS_PROJ); bf16* MRG = (bf16*)(ws + WS_MRG);
#pragma unroll 1
    for (int it = 0; it < N_ITER; ++it) {
        const int l = it >> 2, p = it & 3, pb = 1 + it * PH_PER_IT;
        const int Tp = (p < 2) ? 16384 : 4096, nseq = PASS_ROWS / Tp;
#define XIN() ((l == 0) ? ((p < 2) ? x_prompt + (size_t)p * PASS_ROWS * DM : x_sample + (size_t)(p - 2) * PASS_ROWS * DM) : (const float*)args.out + (size_t)p * PASS_ROWS * DM)

        bf16* HNp = HN + (size_t)p * PASS_ROWS * DM; float* RSp = (float*)(ws + WS_ROWSS) + (size_t)l * NTOK + (size_t)p * PASS_ROWS;
        if (PH_ON(1) && IN(pb + 0) && l == 0) { LAUNDER_TID(); const float* xin = XIN(); const float* ng = norm_gain; for (int m = gw; m < PASS_ROWS; m += ngw) rms_row(xin + (size_t)m * DM, ng, HNp + (size_t)m * DM, RSp + m, lane); }
        if (l == 0) SEAM(pb + 0);
        if (PH_ON(2) && IN(pb + 1)) for (int rep = 0; rep < ((DUP_PHASE == 2 || DUP_PHASE == 14 || DUP_PHASE == 16 || DUP_PHASE == 17) ? 2 : 1); ++rep) {
            if (rep) xcd_barrier(bar);
#if B_SKEW_NS > 0
            { const unsigned long long t0 = __builtin_amdgcn_s_memrealtime(), dl = (unsigned long long)((bx >> 3) & 3) * (unsigned long long)(B_SKEW_NS / 10); while (__builtin_amdgcn_s_memrealtime() - t0 < dl) __builtin_amdgcn_s_sleep(4); }
#endif
            pg8::Gemm g{HNp, (const bf16*)(ws + WS_WIN + (size_t)l * SZ_WIN_L), PASS_ROWS, NPROJ, DM}; pg8::StaticOrder S; S.init(PASS_ROWS, NPROJ, G, bx);
#if DUP_PHASE == 14
            if (rep == 1) { pg8::EpiNull EN{}; pg8::gemm_phase<pg8::EpiNull, pg8::StaticOrder, true, true>(lds, g, S, EN); } else
#endif
            {
#if DUP_PHASE == 17
            pg8::EpiProj E{PROJ, LDP, 0, 0, RSp, 1.0f / DM, NORM_EPS, 0, C_DK / 256, C_DK / 256 + 4, diff_k_gain + l * 64};
            if (rep == 0) { E.ldc = 256; E.tstride = (size_t)PASS_ROWS * 256 - 256; }
#else
            pg8::EpiProj E{PROJ, LDP, C_GATE / 256, C_GATE / 256 + 24, RSp, 1.0f / DM, NORM_EPS, C_GATE, C_BA / 256, (0xFull << (C_GZ / 256)) | (0xFull << (C_SZ / 256)) | (0xFull << (C_DZ / 256)), C_DQ / 256, C_DQ / 256 + 4, diff_q_gain + l * 64, 0.125f * LOG2E, C_DK / 256, C_DK / 256 + 4, diff_k_gain + l * 64};
#endif
#if DUP_PHASE == 16
            if (rep == 1) { E.O = (bf16*)(ws + WS_MTMP); E.ldc = 0; }
#endif
            pg8::gemm_phase<pg8::EpiProj, pg8::StaticOrder, true, true>(lds, g, S, E);
            }
        }
        SEAM(pb + 1);
        if (PH_ON(3) && IN(pb + 2)) {
            LAUNDER_TID();
            { const float* cw = conv_w; const float* al = a_log; const float* db = dt_bias;
              for (int rep = 0; rep < NREP(3); ++rep) {
                  unsigned pre_ba = 0u;
                  if (tid < 128 && bx < 2048) { const int d = tid >> 6, r = tid & 63, c = d ? 63 - r : r; const bf16* pn = PROJ + (size_t)((bx >> 3) * 64 + c) * LDP + C_BA;
                      pre_ba = (unsigned)pn[d * 8 + (bx & 7)] | ((unsigned)pn[16 + d * 8 + (bx & 7)] << 16); }
                  for (int u = bx; u < 2048; u += G) { const int un = u + G; gdn_prep_unit(lds, ws, cw, al, db, l, Tp, u >> 3, u & 7, un < 2048 ? (un >> 3) : -1, un & 7, pre_ba, tid, wave, lane); } } }
            { const float* skg = swa_k_gain + l * 128; const float* dkg = diff_k_gain + l * 64;
              for (int m = gw; m < PASS_ROWS; m += ngw) knorm_row<false>(PROJ + (size_t)m * LDP, skg, dkg, lane); }
        }
        SEAM(pb + 2);
#if DUP_PHASE == 10
        for (int xb = 0; xb < 5; ++xb) xcd_barrier(bar);
#endif
        if (PH_ON(4) && IN(pb + 3)) for (int rep = 0; rep < (((DUP_PHASE == 4 || DUP_PHASE == 5 || DUP_PHASE == 8 || DUP_PHASE == 9 || DUP_PHASE == 11) && (DUP_PASSES >> p & 1)) ? 2 : 1); ++rep) {
            if (rep) xcd_barrier(bar);
            const int nchain = nseq * 32, nqb = Tp / 256, nblk = nseq * 8 * nqb;
            float bd, bs;
            const float* dqg = diff_q_gain + l * 64; const float* sqg = swa_q_gain + l * 128;
            { int ln_ = tid0; asm volatile("" : "+v"(ln_)); const int ln = ln_ & 63; const float* dkg = diff_k_gain + l * 64; const float* skg = swa_k_gain + l * 128;
              float gq = fabsf(dqg[ln]), gk = fabsf(dkg[ln]);
              float sq_ = fmaxf(fabsf(sqg[ln]), fabsf(sqg[64 + ln])), sk_ = fmaxf(fabsf(skg[ln]), fabsf(skg[64 + ln]));
              gq = wave_max(gq); gk = wave_max(gk); sq_ = wave_max(sq_); sk_ = wave_max(sk_);
              bd = 8.0f * gq * gk * 1.02f; bs = 11.3137085f * sq_ * sk_ * 1.02f; }
            const bool fixd = (bd * LOG2E < 60.f) && (bd == bd), fixs = (bs * LOG2E < 60.f) && (bs == bs);
#define UNIFORM_F(x) __builtin_bit_cast(float, __builtin_amdgcn_readfirstlane(__builtin_bit_cast(int, (float)(x))))
            AttnParams PD{dqg, nullptr, diff_lambda + l * 256, diff_norm_gain + l * 128, UNIFORM_F(bd)};
            AttnParams PS{sqg, swa_sink + l * 8, nullptr, nullptr, UNIFORM_F(bs)};
            DIFF_TABLE(bd, fixd);
            const int ndiff = TBR(T_NDF);
            const int item_lo = (rep == 1 && (DUP_PHASE == 8 || DUP_PHASE == 11)) ? nchain : ((rep == 1 && DUP_PHASE == 9) ? nchain + ndiff : 0);
            const int total = (rep == 1 && DUP_PHASE == 5) ? nchain : ((rep == 1 && (DUP_PHASE == 8 || DUP_PHASE == 11)) ? nchain + ndiff : nchain + ndiff + nblk);
#pragma unroll 1
            for (;;) {
                LAUNDER_TID();
                if (tid == 0) MISC[0] = __hip_atomic_fetch_add(ctl + CW_QUEUE + it * 64 + rep * 32, 1u, __ATOMIC_RELAXED, __HIP_MEMORY_SCOPE_AGENT);
                __syncthreads();
                const int item = __builtin_amdgcn_readfirstlane((int)MISC[0]) + item_lo;
                __syncthreads();
                if (item >= total) break;
                if (PH4_ON(0) && item < nchain) { gdn_scan_unit(lds, ws, Tp, item >> 5, (item >> 2) & 7, (item >> 1) & 1, item & 1, tid, wave, lane); }
                else if (PH4_ON(1) && item < nchain + ndiff) { const int u = item - nchain, per = nseq * nqb;
                    const int g = u / per, un = u - g * per, e = TBR(T_GT + g), hh = e & 0xff, part = (e >> 8) & 0xff, np = e >> 16, sq = un / nqb, qb = un - sq * nqb;
                    const int pslot = (np > 1) ? TBR(T_PB + hh) + un * np + part : -1;
                    const bool pe_ = (DUP_PHASE == 11 && rep == 1);
                    if (fixd) attn_unit<1, true>(lds, ws, PD, l, Tp, sq, hh, qb, pe_ ? 999999 : part, pe_ ? 1000000 : np, pe_ ? PART_SLOTS - 1 : pslot, tid, wave, lane); else if (DUP_PHASE < 0) attn_unit<1, false>(lds, ws, PD, l, Tp, sq, hh, qb, 0, 1, -1, tid, wave, lane); }
                else if (PH4_ON(2)) { const int u = item - nchain - ndiff;
                    if (fixs) attn_unit<0, true>(lds, ws, PS, l, Tp, u / (8 * nqb), (u / nqb) & 7, u % nqb, 0, 1, -1, tid, wave, lane); else attn_unit<0, false>(lds, ws, PS, l, Tp, u / (8 * nqb), (u / nqb) & 7, u % nqb, 0, 1, -1, tid, wave, lane); }
                __syncthreads();
            }
        }
        SEAM(pb + 3);
        if (PH_ON(5) && IN(pb + 4)) for (int rep = 0; rep < NREP(13); ++rep) {
            if (rep) xcd_barrier(bar);
            LAUNDER_TID();
            const bf16* OD = (const bf16*)(ws + WS_ODIR);
            const float* gng = gdn_norm_gain + l * 128;
            for (int m = gw; m < PASS_ROWS; m += ngw)
                gdn_final_row(OD + (size_t)m * 1024, OD + (size_t)(PASS_ROWS + m) * 1024, PROJ + (size_t)m * LDP + C_GZ, gng, (bf16*)(ws + WS_Y) + (size_t)m * 1024, lane);
            { DIFF_BOUND(bdf); const bool fixf = (bdf * LOG2E < 60.f) && (bdf == bdf);
              DIFF_TABLE(bdf, fixf);
              const float* dl = diff_lambda + l * 256; const float* dng = diff_norm_gain + l * 128;
              const float lin = 0.8f - 0.6f * expf(-0.3f * (float)l);
              const float lam = expf(wave_sum(dl[lane] * dl[64 + lane])) - expf(wave_sum(dl[128 + lane] * dl[192 + lane])) + lin;
              const int nqb = Tp / 256;
              for (int hh = 7; hh >= 0; --hh) { const int np = TBR(T_NPH + hh); if (np <= 1) continue; const int pb0 = TBR(T_PB + hh);
                  for (int m = gw; m < PASS_ROWS; m += ngw) { const int sq = m / Tp, t = m - sq * Tp, qb = t >> 8, rr = t & 255;
                      diff_final_row(ws, pb0 + (sq * nqb + qb) * np, np, rr, lam, lin, PROJ + (size_t)m * LDP + C_DZ + hh * 128, dng, (bf16*)(ws + WS_Y + 2 * SZ_Y1) + (size_t)m * 1024 + hh * 128, lane); } } }
        }
        SEAM(pb + 4);
        if (PH_ON(6) && IN(pb + 5)) for (int rep = 0; rep < ((DUP_PHASE == 6 || DUP_PHASE == 15) ? 2 : 1); ++rep) {
            if (rep) xcd_barrier(bar);
            pg8::MergeOrder S; S.S.init(PASS_ROWS, DM, G, bx);
            pg8::Gemm g{(const bf16*)(ws + WS_Y), (const bf16*)(ws + WS_WBR + (size_t)(l * 3) * SZ_WBR_1), 3 * PASS_ROWS, 3 * DM, 1024};
#if DUP_PHASE == 15
            if (rep == 1) { pg8::EpiNull EN{}; pg8::gemm_phase<pg8::EpiNull, pg8::MergeOrder, true, true>(lds, g, S, EN); } else
#endif
            { pg8::EpiMerge E{(const unsigned char*)(PROJ + C_GATE), LDP * 2, (bf16*)(ws + WS_MTMP), DM, MRG, DM};
              pg8::gemm_phase<pg8::EpiMerge, pg8::MergeOrder, true, true>(lds, g, S, E); }
        }
        SEAM(pb + 5);
        if (PH_ON(7) && IN(pb + 6)) for (int rep = 0; rep < ((l == 0) ? NREP(7) : 1); ++rep) {
            if (rep) xcd_barrier(bar);
            pg8::Gemm g{MRG, (const bf16*)(ws + WS_WOUT + (size_t)l * SZ_WOUT_L), PASS_ROWS, DM, DM}; pg8::StaticOrder S; S.init(PASS_ROWS, DM, G, bx);
            pg8::EpiOut E{XIN(), args.out + (size_t)p * PASS_ROWS * DM, DM, (l + 1 < DEPTH) ? norm_gain + (l + 1) * DM : (const float*)nullptr, HNp, (float*)(ws + WS_ROWSS) + (size_t)(l + 1 < DEPTH ? l + 1 : l) * NTOK + (size_t)p * PASS_ROWS};
            pg8::gemm_phase<pg8::EpiOut, pg8::StaticOrder, true, true>(lds, g, S, E);
        }
    }
#undef IN
#undef SEAM
#undef TBR
#undef T_GT
#undef T_PB
#undef T_NPH
#undef T_NDF
#undef T_LEN
#undef DIFF_TABLE
#undef DIFF_BOUND
#undef XIN
#undef x_prompt
#undef x_sample
#undef norm_gain
#undef w_in
#undef conv_w
#undef a_log
#undef dt_bias
#undef gdn_norm_gain
#undef swa_q_gain
#undef swa_k_gain
#undef swa_sink
#undef diff_q_gain
#undef diff_k_gain
#undef diff_lambda
#undef diff_norm_gain
#undef w_branch
#undef w_out
#undef INP
}

extern "C" void kernel_launch(void* const* d_in, const int* in_sizes, int n_in, void* d_out, int out_size, void* d_ws, size_t ws_size, hipStream_t stream) {
    static int grid = 0;
    if (grid == 0) {
        if (n_in != 17 || in_sizes[0] != 2 * 16384 * DM || in_sizes[1] != 8 * 4096 * DM || out_size != NTOK * DM || ws_size < WS_END) {
            fprintf(stderr, "kernel_launch: shape mismatch (n_in %d, in0 %d, in1 %d, out %d, ws %zu, need %zu); nothing launched\n", n_in, n_in > 0 ? in_sizes[0] : -1, n_in > 1 ? in_sizes[1] : -1, out_size, ws_size, (size_t)WS_END);
            grid = -1; return; }
        int dev = 0, cus = 0, per_cu = 0;
        if (hipGetDevice(&dev) != hipSuccess || hipDeviceGetAttribute(&cus, hipDeviceAttributeMultiprocessorCount, dev) != hipSuccess) { fprintf(stderr, "kernel_launch: device query failed\n"); grid = -1; return; }
        if (hipFuncSetAttribute((const void*)fwd_kernel, hipFuncAttributeMaxDynamicSharedMemorySize, LDS_BYTES) != hipSuccess) { fprintf(stderr, "kernel_launch: hipFuncSetAttribute(%d B LDS) failed\n", LDS_BYTES); grid = -1; return; }
        if (hipOccupancyMaxActiveBlocksPerMultiprocessor(&per_cu, (const void*)fwd_kernel, NTHREADS, LDS_BYTES) != hipSuccess || per_cu < 1)
            fprintf(stderr, "kernel_launch: note: occupancy query reports %d workgroups per CU\n", per_cu);
        (void)hipGetLastError();
        grid = cus;
    }
    if (grid < 0) return;
    if (hipMemsetAsync((char*)d_ws + WS_CTL, 0, CTL_ZERO_BYTES, stream) != hipSuccess) { fprintf(stderr, "kernel_launch: memset failed\n"); return; }
    Args a{};
    for (int i = 0; i < 17; ++i) a.in[i] = (const float*)d_in[i];
    a.out = (float*)d_out; a.ws = (unsigned char*)d_ws;
#if MK_PER_PHASE
    for (int k = 0; k < N_PHASES; ++k) { a.ph_lo = k; a.ph_hi = k + 1; hipLaunchKernelGGL(fwd_kernel, dim3(grid), dim3(NTHREADS), LDS_BYTES, stream, a); }
#else
    a.ph_lo = 0; a.ph_hi = N_PHASES;
    hipLaunchKernelGGL(fwd_kernel, dim3(grid), dim3(NTHREADS), LDS_BYTES, stream, a);
#endif
    const hipError_t le = hipPeekAtLastError();
    if (le != hipSuccess) fprintf(stderr, "kernel_launch: launch failed: %s\n", hipGetErrorName(le));
}
```

```cpp
#include <hip/hip_runtime.h>
#include <cstdio>
#include <cstdint>
namespace pg8 {
#define PG8_LAS __attribute__((address_space(3)))
typedef unsigned short bf16_t;
typedef short bf16x8 __attribute__((ext_vector_type(8)));
typedef float f32x4 __attribute__((ext_vector_type(4)));
typedef unsigned u32x4 __attribute__((ext_vector_type(4)));
constexpr int BM = 256, BK = 64, HALF = 128, HTB = HALF * BK * 2  , STAGE_BYTES = 8 * HTB, NXCD = 8, WGM = 4;

__host__ __device__ __forceinline__ int lds_byte(int r, int c) { const int st = (r >> 4) * 2 + (c >> 5), rr = r & 15, cc = c & 31, ob = rr * 64 + cc * 2; return st * 1024 + (ob ^ (((ob >> 9) & 1) << 5)); }
__host__ __device__ __forceinline__ void stage_rc(int b, int& R, int& C) { const int st = b / 1024, sb = b % 1024, swz = sb ^ (((sb >> 9) & 1) << 5); R = (st >> 1) * 16 + swz / 64; C = (st & 1) * 32 + (swz % 64) / 2; }
__host__ __device__ __forceinline__ int perm32(int rho) { const int n = rho >> 4, i = rho & 15; return 8 * (i >> 2) + 4 * n + (i & 3); }

struct Unit { int pm, pn; };
struct Gemm { const bf16_t* A; const bf16_t* Bt; int M, N, K; };

struct StaticOrder {
    int nM, nN, nwg, G, c;
    __host__ __device__ void init(int M, int N, int G_, int c_) { nM = M / BM; nN = N / BM; nwg = nM * nN; G = G_; c = c_; }
    __host__ __device__ bool next(int i, Unit& u) const {
        const long L = (long)i * G + c; if (L >= nwg) return false;
        int wgid = (int)L; { const int q = nwg / NXCD, r = nwg % NXCD, xcd = wgid % NXCD, off = wgid / NXCD; wgid = (xcd < r ? xcd * (q + 1) : r * (q + 1) + (xcd - r) * q) + off; }
        const int nig = WGM * nN, gid = wgid / nig, fm = gid * WGM, gsz = (nM - fm) < WGM ? (nM - fm) : WGM;
        u.pm = fm + ((wgid % nig) % gsz); u.pn = (wgid % nig) / gsz; return true;
    }
    __device__ __forceinline__ void a_ready(const Unit&) const {}
    __device__ __forceinline__ void done(const Unit&) const {}
};

typedef float f32x2_c __attribute__((ext_vector_type(2)));
typedef unsigned u32x2 __attribute__((ext_vector_type(2)));
typedef __bf16 bf16x2_c __attribute__((ext_vector_type(2)));
__device__ __forceinline__ unsigned cvt_pk_bf16(float lo, float hi) { const f32x2_c v = {lo, hi}; const bf16x2_c b = __builtin_convertvector(v, bf16x2_c); return __builtin_bit_cast(unsigned, b); }
__device__ __forceinline__ float sigmoid_f(float v) { return __builtin_amdgcn_rcpf(1.0f + __builtin_amdgcn_exp2f(-1.4426950408889634f * v)); }
__device__ __forceinline__ float bflo(unsigned w) { return __uint_as_float(w << 16); }
__device__ __forceinline__ float bfhi(unsigned w) { return __uint_as_float(w & 0xffff0000u); }

struct EpiProj {
    static constexpr bool PERM = true, AFTER_DRAIN = false;
    bf16_t* O; int ldc; int sig_lo, sig_hi; const float* rowss; float inv_d, eps;
#if DUP_PHASE == 17
    size_t tstride;
#endif
    int sig_col0;
    int ba_tile;
    unsigned long long ztiles;
    int qn_lo, qn_hi; const float* qgain; float qscale;
    int kn_lo, kn_hi; const float* kgain;
    __device__ __forceinline__ void operator()(const f32x4 (&acc)[2][2][4][2], const Unit& u, int wr, int wc, int fr, int fq) const {
        const int row0 = u.pm * BM + wr * 64 + fr, col0 = u.pn * BM + wc * 64 + 8 * fq;
        const bool sig = (u.pn >= sig_lo) && (u.pn < sig_hi);
        const bool qn = (u.pn >= qn_lo) && (u.pn < qn_hi);
        const bool kn = qn || ((u.pn >= kn_lo) && (u.pn < kn_hi));
        const float* ngain = qn ? qgain : kgain; const float nsc = qn ? qscale : 1.0f;
        const bool zt = (u.pn < 64) && ((ztiles >> u.pn) & 1ull);
        const bool ba = (u.pn == ba_tile);
        if (ba && wc != 0) return;
        f32x4 kg[2][2];
#pragma unroll
        for (int bj = 0; bj < 2; ++bj)
#pragma unroll
            for (int n = 0; n < 2; ++n) kg[bj][n] = kn ? *(const f32x4*)(ngain + bj * 32 + 8 * fq + 4 * n) * nsc : (f32x4){1.f, 1.f, 1.f, 1.f};
        float rs[2][4];
#pragma unroll
        for (int ai = 0; ai < 2; ++ai)
#pragma unroll
            for (int m = 0; m < 4; ++m) rs[ai][m] = rowss[row0 + ai * HALF + m * 16];
#pragma unroll
        for (int ai = 0; ai < 2; ++ai)
#pragma unroll
            for (int m = 0; m < 4; ++m) { const int row = row0 + ai * HALF + m * 16; bf16_t* rowp = O + (size_t)row * ldc + col0;
#if DUP_PHASE == 17
                rowp += (size_t)u.pn * tstride;
#endif
                const float rstd = __builtin_amdgcn_rsqf(rs[ai][m] * inv_d + eps);
                f32x4 v[2][2];
#pragma unroll
                for (int bj = 0; bj < 2; ++bj) { v[bj][0] = acc[ai][bj][m][0] * rstd; v[bj][1] = acc[ai][bj][m][1] * rstd; }
                if (kn) {
                    float ss = 0.f;
#pragma unroll
                    for (int bj = 0; bj < 2; ++bj)
#pragma unroll
                        for (int n = 0; n < 2; ++n)
#pragma unroll
                            for (int j = 0; j < 4; ++j) ss += v[bj][n][j] * v[bj][n][j];
                    ss += __builtin_bit_cast(float, __builtin_amdgcn_ds_swizzle(__builtin_bit_cast(int, ss), 0x1F | (16 << 10)));
                    ss += __shfl_xor(ss, 32);
                    const float rk = __builtin_amdgcn_rsqf(ss * (1.0f / 64.0f) + eps);
#pragma unroll
                    for (int bj = 0; bj < 2; ++bj)
#pragma unroll
                        for (int n = 0; n < 2; ++n) v[bj][n] = v[bj][n] * rk * kg[bj][n];
                }
                if (zt) {
#pragma unroll
                    for (int bj = 0; bj < 2; ++bj)
#pragma unroll
                        for (int n = 0; n < 2; ++n)
#pragma unroll
                            for (int j = 0; j < 4; ++j) v[bj][n][j] *= sigmoid_f(v[bj][n][j]);
                }
                if (sig) {
                    unsigned char* rowb = (unsigned char*)(O + (size_t)row * ldc + sig_col0) + (u.pn * BM + wc * 64 + 16 * fq - sig_col0);
                    u32x4 w;
#pragma unroll
                    for (int bj = 0; bj < 2; ++bj)
#pragma unroll
                        for (int n = 0; n < 2; ++n) { unsigned pk = 0u;
#pragma unroll
                            for (int j = 0; j < 4; ++j) pk = __builtin_amdgcn_cvt_pk_u8_f32(__builtin_floorf(sigmoid_f(v[bj][n][j]) * 255.0f + 0.5f), j, pk);
                            w[bj * 2 + n] = pk; }
                    __builtin_nontemporal_store(w, (u32x4*)rowb);
                } else {
#pragma unroll
                for (int bj = 0; bj < 2; ++bj) { f32x4 v0 = v[bj][0], v1 = v[bj][1];
                    if (ba && bj == 1) continue;
                    u32x4 w; w.x = cvt_pk_bf16(v0[0], v0[1]); w.y = cvt_pk_bf16(v0[2], v0[3]); w.z = cvt_pk_bf16(v1[0], v1[1]); w.w = cvt_pk_bf16(v1[2], v1[3]);
                    __builtin_nontemporal_store(w, (u32x4*)(rowp + bj * 32)); } } }
    }
};
struct EpiNull {
    static constexpr bool PERM = true, AFTER_DRAIN = false;
    __device__ __forceinline__ void operator()(const f32x4 (&acc)[2][2][4][2], const Unit& u, int wr, int wc, int fr, int fq) const {
        float s = 0.f;
#pragma unroll
        for (int a = 0; a < 2; ++a)
#pragma unroll
            for (int b = 0; b < 2; ++b)
#pragma unroll
                for (int m = 0; m < 4; ++m)
#pragma unroll
                    for (int n = 0; n < 2; ++n) s += acc[a][b][m][n][0];
        asm volatile("" :: "v"(s));
    }
};
struct EpiMerge {
    static constexpr bool PERM = true, AFTER_DRAIN = false;
    static constexpr int MB = 4;
    const unsigned char* G; int ldg; bf16_t* T; int ldt; bf16_t* O; int ldo;
    __device__ __forceinline__ void operator()(const f32x4 (&acc)[2][2][4][2], const Unit& u, int wr, int wc, int fr, int fq) const {
        const int n = u.pm >> 6, pm = u.pm & 63, pn = u.pn & 7;
        const int row0 = pm * BM + wr * 64 + fr, col0 = pn * BM + wc * 32 + 8 * fq;
        const unsigned char* Gn = G + n * 2048;
#pragma unroll
        for (int ai = 0; ai < 2; ++ai)
#pragma unroll
            for (int m2 = 0; m2 < 4; m2 += MB) {
                u32x2 gw[MB][2]; u32x4 tw[MB][2];
#pragma unroll
                for (int mm = 0; mm < MB; ++mm)
#pragma unroll
                    for (int bj = 0; bj < 2; ++bj) { const size_t row = (size_t)(row0 + ai * HALF + (m2 + mm) * 16); const int col = col0 + bj * HALF;
                        gw[mm][bj] = *(const u32x2*)(Gn + row * ldg + col); if (n >= 1) tw[mm][bj] = *(const u32x4*)(T + row * ldt + col); else tw[mm][bj] = (u32x4){0u, 0u, 0u, 0u}; }
#pragma unroll
                for (int mm = 0; mm < MB; ++mm)
#pragma unroll
                    for (int bj = 0; bj < 2; ++bj) { const int m = m2 + mm; const size_t row = (size_t)(row0 + ai * HALF + m * 16); const int col = col0 + bj * HALF;
                        const u32x2 g = gw[mm][bj]; const u32x4 t = tw[mm][bj];
                        const float qs = 1.0f / 255.0f;
                        f32x4 v0 = acc[ai][bj][m][0], v1 = acc[ai][bj][m][1];
                        v0[0] = v0[0] * ((float)(g.x & 0xffu) * qs) + bflo(t.x); v0[1] = v0[1] * ((float)((g.x >> 8) & 0xffu) * qs) + bfhi(t.x); v0[2] = v0[2] * ((float)((g.x >> 16) & 0xffu) * qs) + bflo(t.y); v0[3] = v0[3] * ((float)(g.x >> 24) * qs) + bfhi(t.y);
                        v1[0] = v1[0] * ((float)(g.y & 0xffu) * qs) + bflo(t.z); v1[1] = v1[1] * ((float)((g.y >> 8) & 0xffu) * qs) + bfhi(t.z); v1[2] = v1[2] * ((float)((g.y >> 16) & 0xffu) * qs) + bflo(t.w); v1[3] = v1[3] * ((float)(g.y >> 24) * qs) + bfhi(t.w);
                        u32x4 w; w.x = cvt_pk_bf16(v0[0], v0[1]); w.y = cvt_pk_bf16(v0[2], v0[3]); w.z = cvt_pk_bf16(v1[0], v1[1]); w.w = cvt_pk_bf16(v1[2], v1[3]);
                        if (n <= 1) *(u32x4*)(T + row * ldt + col) = w; else *(u32x4*)(O + row * ldo + col) = w; }
                asm volatile("" ::: "memory"); }
    }
};
struct MergeOrder {
    StaticOrder S;
    __device__ __forceinline__ bool next(int i, Unit& u) const { const int ou = i / 3, n = i - ou * 3; Unit v; if (!S.next(ou, v)) return false; u.pm = n * 64 + v.pm; u.pn = n * 8 + v.pn; return true; }
    __device__ __forceinline__ void a_ready(const Unit&) const {}
    __device__ __forceinline__ void done(const Unit&) const {}
};
struct EpiOut {
    static constexpr bool PERM = false, AFTER_DRAIN = false;
    const float* base; float* out; int ldc; const float* gain_next; bf16_t* hn; float* rowss;
    __device__ __forceinline__ void operator()(const f32x4 (&acc)[2][2][4][2], const Unit& u, int wr, int wc, int fr, int fq) const {
        const int row0 = u.pm * BM + wr * 64 + fr, col0 = u.pn * BM + wc * 32 + 4 * fq;
        f32x4 gn[2][2];
        if (gain_next) {
#pragma unroll
            for (int bj = 0; bj < 2; ++bj)
#pragma unroll
                for (int n = 0; n < 2; ++n) gn[bj][n] = *(const f32x4*)(gain_next + col0 + bj * HALF + n * 16); }
#pragma unroll
        for (int ai = 0; ai < 2; ++ai)
#pragma unroll
            for (int m2 = 0; m2 < 4; m2 += 2) {
                f32x4 bb[2][2][2];
#pragma unroll
                for (int mm = 0; mm < 2; ++mm)
#pragma unroll
                    for (int bj = 0; bj < 2; ++bj)
#pragma unroll
                        for (int n = 0; n < 2; ++n) bb[mm][bj][n] = *(const f32x4*)(base + (size_t)(row0 + ai * HALF + (m2 + mm) * 16) * ldc + col0 + bj * HALF + n * 16);
#pragma unroll
                for (int mm = 0; mm < 2; ++mm) { const int m = m2 + mm; const int row = row0 + ai * HALF + m * 16; const size_t off = (size_t)row * ldc + col0; float ss = 0.f;
#pragma unroll
                    for (int bj = 0; bj < 2; ++bj)
#pragma unroll
                        for (int n = 0; n < 2; ++n) { const f32x4 x = bb[mm][bj][n] + acc[ai][bj][m][n]; *(f32x4*)(out + off + bj * HALF + n * 16) = x;
                            if (gain_next) { const f32x4 g = gn[bj][n]; ss += (x[0] * x[0] + x[1] * x[1]) + (x[2] * x[2] + x[3] * x[3]);
                                u32x2 w; w.x = cvt_pk_bf16(x[0] * g[0], x[1] * g[1]); w.y = cvt_pk_bf16(x[2] * g[2], x[3] * g[3]); *(u32x2*)(hn + off + bj * HALF + n * 16) = w; } }
                    if (gain_next) {
                        ss += __builtin_bit_cast(float, __builtin_amdgcn_ds_swizzle(__builtin_bit_cast(int, ss), 0x1F | (16 << 10)));
                        ss += __shfl_xor(ss, 32);
                        if (fq == 0) __hip_atomic_fetch_add(rowss + row, ss, __ATOMIC_RELAXED, __HIP_MEMORY_SCOPE_AGENT); } }
                asm volatile("" ::: "memory"); }
    }
};

template <class Epi, class Sched, bool ALIGN_EPI = false, bool SP2 = false>
__device__ __forceinline__ void gemm_phase(PG8_LAS unsigned char* lds, const Gemm g, const Sched& S, const Epi& E) {
    int tid_ = threadIdx.x; asm volatile("" : "+v"(tid_));
    const int tid = tid_, wid = __builtin_amdgcn_readfirstlane(tid >> 6), lane = tid & 63, wr = wid >> 2, wc = wid & 3, fr = lane & 15, fq = lane >> 4;
    const int K = g.K, nt = K / BK;
    unsigned voffA[2], voffB[2];
#pragma unroll
    for (int i = 0; i < 2; ++i) { int R, C; stage_rc(tid * 16 + i * 8192, R, C); const int Rb = Epi::PERM ? ((R & ~31) + perm32(R & 31)) : R;
        voffA[i] = (unsigned)(R * K + C) * 2u; voffB[i] = (unsigned)(Rb * K + C) * 2u; }
    const size_t kstep = (size_t)(BK * 2);
    const size_t hstep = (size_t)HALF * K * 2;
    const size_t tstep = 2 * hstep;
    const unsigned ldsw = (unsigned)wid * 1024u;
    const int aoff = lds_byte(wr * 64 + fr, fq * 8), boff = lds_byte(wc * 32 + fr, fq * 8);
#define PG8_SA(b, h) (((b) * 2 + (h)) * HTB)
#define PG8_SB(b, h) ((4 + (b) * 2 + (h)) * HTB)
#define PG8_STAGE(bufoff, gbase, voff) do { _Pragma("unroll") for (int _i = 0; _i < 2; ++_i) \
        __builtin_amdgcn_global_load_lds((const unsigned*)((const char*)(gbase) + (voff)[_i]), (PG8_LAS unsigned*)(lds + (bufoff) + ldsw + _i * 8192), 16, 0, 0); } while (0)
#define PG8_LDA(dst, b, h) do { _Pragma("unroll") for (int m = 0; m < 4; ++m) _Pragma("unroll") for (int k = 0; k < 2; ++k) dst[m][k] = *(const PG8_LAS bf16x8*)(lds + PG8_SA(b, h) + aoff + m * 2048 + k * 1024); } while (0)
#define PG8_LDB(dst, b, h) do { _Pragma("unroll") for (int n = 0; n < 2; ++n) _Pragma("unroll") for (int k = 0; k < 2; ++k) dst[n][k] = *(const PG8_LAS bf16x8*)(lds + PG8_SB(b, h) + boff + n * 2048 + k * 1024); } while (0)
#define PG8_MMA(ai, bj, At, Bt) do { __builtin_amdgcn_s_setprio(1); _Pragma("unroll") for (int m = 0; m < 4; ++m) _Pragma("unroll") for (int n = 0; n < 2; ++n) _Pragma("unroll") for (int k = 0; k < 2; ++k) \
        acc[ai][bj][m][n] = __builtin_amdgcn_mfma_f32_16x16x32_bf16(Bt[n][k], At[m][k], acc[ai][bj][m][n], 0, 0, 0); __builtin_amdgcn_s_setprio(0); } while (0)
#define PG8_WAIT_V(n) asm volatile("s_waitcnt vmcnt(" #n ")" ::: "memory")
#define PG8_WAIT_L(n) asm volatile("s_waitcnt lgkmcnt(" #n ")" ::: "memory")
#define PG8_BAR __builtin_amdgcn_s_barrier()
#define PG8_SCHED __builtin_amdgcn_sched_barrier(0)
    Unit cur, nxt; int ui = 0;
    if (!S.next(0, cur)) return;
    f32x4 acc[2][2][4][2];
#pragma unroll
    for (int a = 0; a < 2; ++a)
#pragma unroll
        for (int b = 0; b < 2; ++b)
#pragma unroll
            for (int m = 0; m < 4; ++m)
#pragma unroll
                for (int n = 0; n < 2; ++n) acc[a][b][m][n] = (f32x4){0.f, 0.f, 0.f, 0.f};
    bf16x8 At[4][2], B0[2][2], B1[2][2];
    const char* cA = (const char*)g.A + (size_t)cur.pm * tstep; const char* cB = (const char*)g.Bt + (size_t)cur.pn * tstep;
    S.a_ready(cur);
    if constexpr (SP2) {
        PG8_STAGE(PG8_SB(0, 0), cB, voffB); PG8_STAGE(PG8_SB(0, 1), cB + hstep, voffB); PG8_STAGE(PG8_SA(0, 0), cA, voffA); PG8_STAGE(PG8_SA(0, 1), cA + hstep, voffA);
        if (wr == 1) PG8_BAR;
        PG8_WAIT_V(2); PG8_BAR;
        PG8_STAGE(PG8_SB(1, 0), cB + kstep, voffB); PG8_STAGE(PG8_SA(1, 0), cA + kstep, voffA); PG8_STAGE(PG8_SB(1, 1), cB + hstep + kstep, voffB);
        PG8_WAIT_V(6); PG8_BAR;
    } else {
        PG8_STAGE(PG8_SB(0, 0), cB, voffB); PG8_STAGE(PG8_SA(0, 0), cA, voffA); PG8_STAGE(PG8_SB(0, 1), cB + hstep, voffB); PG8_STAGE(PG8_SA(0, 1), cA + hstep, voffA);
        if (wr == 1) PG8_BAR;
        PG8_WAIT_V(4); PG8_BAR;
        PG8_STAGE(PG8_SB(1, 0), cB + kstep, voffB); PG8_STAGE(PG8_SA(1, 0), cA + kstep, voffA); PG8_STAGE(PG8_SB(1, 1), cB + hstep + kstep, voffB);
        PG8_WAIT_V(6); PG8_BAR;
    }
    for (;;) {
        const bool has_next = S.next(ui + 1, nxt);
        const char* nA = has_next ? (const char*)g.A + (size_t)nxt.pm * tstep : cA; const char* nB = has_next ? (const char*)g.Bt + (size_t)nxt.pn * tstep : cB;
        for (int t = 0; t < nt; t += 2) {
            const bool last = (t == nt - 2);
            const char* a1 = cA + (size_t)(t + 1) * kstep;
            const char* a2 = last ? nA : cA + (size_t)(t + 2) * kstep; const char* b2 = last ? nB : cB + (size_t)(t + 2) * kstep;
            const char* a3 = a2 + kstep; const char* b3 = b2 + kstep;
            if (last && has_next) S.a_ready(nxt);
            if constexpr (SP2) {
            PG8_LDB(B0, 0, 0); PG8_LDB(B1, 0, 1); PG8_SCHED; PG8_LDA(At, 0, 0); PG8_STAGE(PG8_SA(1, 1), a1 + hstep, voffA);
            PG8_WAIT_V(8); PG8_WAIT_L(0); PG8_BAR; PG8_MMA(0, 0, At, B0); PG8_MMA(0, 1, At, B1); PG8_BAR; PG8_SCHED;
            PG8_LDA(At, 0, 1); PG8_STAGE(PG8_SB(0, 0), b2, voffB); PG8_STAGE(PG8_SB(0, 1), b2 + hstep, voffB); PG8_STAGE(PG8_SA(0, 0), a2, voffA);
            PG8_WAIT_V(8); PG8_WAIT_L(0); PG8_BAR; PG8_MMA(1, 0, At, B0); PG8_MMA(1, 1, At, B1); PG8_BAR; PG8_SCHED;
            PG8_LDB(B0, 1, 0); PG8_LDB(B1, 1, 1); PG8_SCHED; PG8_LDA(At, 1, 0); PG8_STAGE(PG8_SA(0, 1), a2 + hstep, voffA);
            PG8_WAIT_V(8); PG8_WAIT_L(0); PG8_BAR; PG8_MMA(0, 0, At, B0); PG8_MMA(0, 1, At, B1); PG8_BAR; PG8_SCHED;
            PG8_LDA(At, 1, 1); PG8_STAGE(PG8_SB(1, 0), b3, voffB); PG8_STAGE(PG8_SB(1, 1), b3 + hstep, voffB); PG8_STAGE(PG8_SA(1, 0), a3, voffA);
            PG8_WAIT_V(8); PG8_WAIT_L(0); PG8_BAR; PG8_MMA(1, 0, At, B0); PG8_MMA(1, 1, At, B1); PG8_BAR; PG8_SCHED;
            } else {
            PG8_LDB(B0, 0, 0); PG8_SCHED; PG8_LDA(At, 0, 0); PG8_STAGE(PG8_SA(1, 1), a1 + hstep, voffA);
            PG8_WAIT_L(8); PG8_BAR; PG8_WAIT_L(0); PG8_MMA(0, 0, At, B0); PG8_BAR; PG8_SCHED;
            PG8_LDB(B1, 0, 1); PG8_STAGE(PG8_SB(0, 0), b2, voffB);
            PG8_BAR; PG8_WAIT_L(0); PG8_MMA(0, 1, At, B1); PG8_BAR;
            PG8_LDA(At, 0, 1); PG8_STAGE(PG8_SA(0, 0), a2, voffA);
            PG8_BAR; PG8_WAIT_L(0); PG8_MMA(1, 0, At, B0); PG8_BAR; PG8_SCHED;
            PG8_STAGE(PG8_SB(0, 1), b2 + hstep, voffB);
            PG8_WAIT_V(6); PG8_BAR; PG8_MMA(1, 1, At, B1); PG8_BAR;
            PG8_LDB(B0, 1, 0); PG8_SCHED; PG8_LDA(At, 1, 0); PG8_STAGE(PG8_SA(0, 1), a2 + hstep, voffA);
            PG8_WAIT_L(8); PG8_BAR; PG8_WAIT_L(0); PG8_MMA(0, 0, At, B0); PG8_BAR; PG8_SCHED;
            PG8_LDB(B1, 1, 1); PG8_STAGE(PG8_SB(1, 0), b3, voffB);
            PG8_BAR; PG8_WAIT_L(0); PG8_MMA(0, 1, At, B1); PG8_BAR;
            PG8_LDA(At, 1, 1); PG8_STAGE(PG8_SA(1, 0), a3, voffA);
            PG8_BAR; PG8_WAIT_L(0); PG8_MMA(1, 0, At, B0); PG8_BAR; PG8_SCHED;
            PG8_STAGE(PG8_SB(1, 1), b3 + hstep, voffB);
            PG8_WAIT_V(6); PG8_BAR; PG8_MMA(1, 1, At, B1); PG8_BAR;
            }
        }
        if constexpr (ALIGN_EPI) { if (wr == 0) PG8_BAR; }
        if constexpr (!Epi::AFTER_DRAIN) { E(acc, cur, wr, wc, fr, fq); S.done(cur); }
        if (!has_next) break;
#pragma unroll
        for (int a = 0; a < 2; ++a)
#pragma unroll
            for (int b = 0; b < 2; ++b)
#pragma unroll
                for (int m = 0; m < 4; ++m)
#pragma unroll
                    for (int n = 0; n < 2; ++n) acc[a][b][m][n] = (f32x4){0.f, 0.f, 0.f, 0.f};
        cur = nxt; cA = nA; cB = nB; ++ui;
        if constexpr (ALIGN_EPI) { if (wr == 1) PG8_BAR; }
    }
    PG8_WAIT_V(0);
    if constexpr (!ALIGN_EPI) { if (wr == 0) PG8_BAR; }
    PG8_BAR;
    if constexpr (Epi::AFTER_DRAIN) { E.fused(acc, cur, wr, wc, fr, fq, lds, wid, lane); S.done(cur); }
#undef PG8_SA
#undef PG8_SB
#undef PG8_STAGE
#undef PG8_LDA
#undef PG8_LDB
#undef PG8_MMA
#undef PG8_WAIT_V
#undef PG8_WAIT_L
#undef PG8_BAR
#undef PG8_SCHED
}
}

#define GAS __attribute__((address_space(1)))
#define LAS __attribute__((address_space(3)))
typedef unsigned short bf16;
typedef unsigned v4u __attribute__((ext_vector_type(4)));
typedef unsigned v2u __attribute__((ext_vector_type(2)));
typedef float f32x4 __attribute__((ext_vector_type(4)));
typedef float f32x16 __attribute__((ext_vector_type(16)));
typedef short bf16x8 __attribute__((ext_vector_type(8)));
typedef short s16x4 __attribute__((ext_vector_type(4)));

constexpr int DM = 2048, DEPTH = 4, NTOK = 65536, PASS_ROWS = 16384, NPASS = 4;
constexpr int IN_REAL = 16928, NPROJ = 17152, LDP = NPROJ;
constexpr int C_GQKV = 0, C_GZ = 3072, C_SQ = 4096, C_SKV = 5120, C_SZ = 5632, C_DQ = 6656, C_DK = 7680, C_DV = 8704, C_DZ = 9728, C_GATE = 10752, C_BA = 16896;
constexpr float NORM_EPS = 1e-6f, LOG2E = 1.4426950408889634f;
constexpr int NWAVES = 8, NTHREADS = 512;

constexpr size_t MiB = 1u << 20;
constexpr size_t WS_CTL = 0, CTL_ZERO_BYTES = 2 * MiB;
constexpr size_t WS_ROWSS = 1 * MiB;
constexpr size_t WS_WIN = 2 * MiB;
constexpr size_t SZ_WIN_L = (size_t)NPROJ * DM * 2;
constexpr size_t WS_WBR = WS_WIN + 4 * SZ_WIN_L;
constexpr size_t SZ_WBR_1 = (size_t)2048 * 1024 * 2;
constexpr size_t WS_WOUT = WS_WBR + 12 * SZ_WBR_1;
constexpr size_t SZ_WOUT_L = (size_t)DM * DM * 2;
constexpr size_t WS_HN = WS_WOUT + 4 * SZ_WOUT_L;
constexpr size_t WS_PROJ = WS_HN + (size_t)NTOK * DM * 2;
constexpr size_t WS_Y = WS_PROJ + (size_t)PASS_ROWS * NPROJ * 2;
constexpr size_t SZ_Y1 = (size_t)PASS_ROWS * 1024 * 2;
constexpr size_t WS_GDN = WS_Y + 3 * SZ_Y1;
constexpr int REC_BYTES = 73728, REC_FW = 0, REC_FQ = 16384, REC_FK = 32768, REC_FQK = 49152, REC_FU = 57344, REC_LOAD = 57344, REC_GAM = REC_FQK + 2048;
constexpr size_t WS_GAM = WS_GDN + (size_t)2 * 256 * 8 * REC_BYTES;
constexpr size_t WS_ODIR = WS_GAM + 16384;
constexpr size_t WS_MTMP = WS_ODIR + 2 * SZ_Y1;
constexpr size_t WS_MRG = WS_MTMP + (size_t)PASS_ROWS * DM * 2;
constexpr size_t WS_PARK = WS_MRG + (size_t)PASS_ROWS * DM * 2;
constexpr size_t WS_PART = WS_PARK + (size_t)256 * 8 * 64 * 64 * 4;
constexpr int PART_SLOTS = 640;
constexpr size_t WS_PARTL = WS_PART + (size_t)PART_SLOTS * 2 * 256 * 128 * 4;
constexpr size_t WS_END = WS_PARTL + (size_t)PART_SLOTS * 2 * 256 * 4;
constexpr int CW_BAR = 4096;
constexpr int CW_DEP = 32768;
constexpr int CW_QUEUE = 16384;

constexpr int LDS_BYTES = 159744;
constexpr int MISC_OFF = LDS_BYTES - 512;

#define LDS_WAIT() asm volatile("s_waitcnt lgkmcnt(0)" ::: "memory")
#define VM_WAIT() asm volatile("s_waitcnt vmcnt(0)" ::: "memory")
__device__ __forceinline__ float bf2f(bf16 b) { return __uint_as_float(((unsigned)b) << 16); }
__device__ __forceinline__ float bflo(unsigned w) { return __uint_as_float(w << 16); }
__device__ __forceinline__ float bfhi(unsigned w) { return __uint_as_float(w & 0xffff0000u); }
typedef float f32x2_t __attribute__((ext_vector_type(2)));
typedef __bf16 bf16x2_t __attribute__((ext_vector_type(2)));
__device__ __forceinline__ unsigned cvtpk(float lo, float hi) { const f32x2_t v = {lo, hi}; const bf16x2_t b = __builtin_convertvector(v, bf16x2_t); return __builtin_bit_cast(unsigned, b); }
__device__ __forceinline__ bf16 f2bf1(float f) { return (bf16)(cvtpk(f, 0.f) & 0xffffu); }
template <int O> __device__ __forceinline__ float xshfl(float v) {
    static_assert(O >= 1 && O <= 16, "xshfl: in-half xor only");
    return __builtin_bit_cast(float, __builtin_amdgcn_ds_swizzle(__builtin_bit_cast(int, v), 0x1F | (O << 10)));
}
__device__ __forceinline__ float half_sum(float v) {
    unsigned a = __float_as_uint(v), b = a; asm volatile("" : "+v"(b));
    auto rr = __builtin_amdgcn_permlane32_swap(a, b, false, false); return __uint_as_float(rr[0]) + __uint_as_float(rr[1]); }
__device__ __forceinline__ float half_max(float v) {
    unsigned a = __float_as_uint(v), b = a; asm volatile("" : "+v"(b));
    auto rr = __builtin_amdgcn_permlane32_swap(a, b, false, false); return fmaxf(__uint_as_float(rr[0]), __uint_as_float(rr[1])); }
__device__ __forceinline__ float wave_sum(float v) { v += xshfl<1>(v); v += xshfl<2>(v); v += xshfl<4>(v); v += xshfl<8>(v); v += xshfl<16>(v); return half_sum(v); }
__device__ __forceinline__ float wave_max(float v) { v = fmaxf(v, xshfl<1>(v)); v = fmaxf(v, xshfl<2>(v)); v = fmaxf(v, xshfl<4>(v)); v = fmaxf(v, xshfl<8>(v)); v = fmaxf(v, xshfl<16>(v)); return half_max(v); }
__device__ __forceinline__ float silu_f(float v) { return v * __builtin_amdgcn_rcpf(1.0f + __expf(-v)); }
__device__ __forceinline__ int crow(int r, int hi) { return (r & 3) + 8 * (r >> 2) + 4 * hi; }
#define MFMA32(a, b, c) __builtin_amdgcn_mfma_f32_32x32x16_bf16((a), (b), (c), 0, 0, 0)
#define XB_TMO      128
#define XB_XCNT(j)  (256  + 64 * (j))
#define XB_XSUB(j)  (1280 + 64 * (j))
#define XB_XGEN(j)  (2304 + 64 * (j))
#define XB_TOP      3328
#define XB_TOPGEN   3392
#define XCD_BAR_WORDS 3456
#define XB_SPIN_CAP (1u << 18)

__device__ __forceinline__ unsigned xb_ld(unsigned* p)              { return __hip_atomic_load(p, __ATOMIC_RELAXED, __HIP_MEMORY_SCOPE_AGENT); }
__device__ __forceinline__ unsigned xb_add(unsigned* p, unsigned v) { return __hip_atomic_fetch_add(p, v, __ATOMIC_RELAXED, __HIP_MEMORY_SCOPE_AGENT); }
__device__ __forceinline__ unsigned xb_xcc_id() { return (unsigned)__builtin_amdgcn_s_getreg((3 << 11) | 20) & 0xFu; }
#define XB_SPIN(cond, bar) do { unsigned _sp = 0; while (cond) { __builtin_amdgcn_s_sleep(1); \
    if ((++_sp & 255u) == 0u) { if (xb_ld(&(bar)[XB_TMO])) break; if (_sp > XB_SPIN_CAP) { atomicAdd(&(bar)[XB_TMO], 1u); break; } } } } while (0)

struct XcdBarrier {
    unsigned* bar; unsigned x;
    volatile LAS unsigned* st;
};

__device__ __forceinline__ XcdBarrier xcd_barrier_post(unsigned* bar, volatile LAS unsigned* st) {
    XcdBarrier b; b.bar = bar; b.x = xb_xcc_id(); b.st = st;
    if (threadIdx.x == 0) (void)xb_add(&bar[XB_XCNT(b.x)], 1u);
    return b;
}
__device__ __forceinline__ void xcd_barrier_complete(unsigned* bar, unsigned x, unsigned& nloc, unsigned& nx) {
    const unsigned G = gridDim.x * gridDim.y * gridDim.z;
    unsigned sum, cnt, mine, sp = 0u;
    for (;;) {
        sum = 0u; cnt = 0u; mine = 0u;
#pragma unroll
        for (unsigned j = 0; j < 16; ++j) { const unsigned c = xb_ld(&bar[XB_XCNT(j)]); sum += c; cnt += (c > 0u) ? 1u : 0u; mine = (j == x) ? c : mine; }
        if (sum == G) break;
        __builtin_amdgcn_s_sleep(1);
        if ((++sp & 255u) == 0u) { if (xb_ld(&bar[XB_TMO])) break; if (sp > XB_SPIN_CAP) { atomicAdd(&bar[XB_TMO], 1u); break; } }
    }
    nloc = mine > 0u ? mine : 1u; nx = cnt > 0u ? cnt : 1u;
}

__device__ __forceinline__ void xcd_barrier(const XcdBarrier& b) {
    asm volatile("s_waitcnt vmcnt(0)" ::: "memory");
    __syncthreads();
    if (threadIdx.x == 0) {
        unsigned* bar = b.bar;
        __builtin_amdgcn_s_waitcnt(0);
        unsigned nloc = b.st[0], nx = b.st[1];
        if (nloc == 0u) { xcd_barrier_complete(bar, b.x, nloc, nx); b.st[0] = nloc; b.st[1] = nx; }
        const unsigned old = xb_add(&bar[XB_XSUB(b.x)], 1u);
        const unsigned gen = old / nloc;
        if (old + 1u == (gen + 1u) * nloc) {
            __builtin_amdgcn_fence(__ATOMIC_RELEASE, "agent");
            asm volatile("s_waitcnt vmcnt(0)" ::: "memory");
            const unsigned og = xb_add(&bar[XB_TOP], 1u);
            const unsigned tg = og / nx;
            if (og + 1u == (tg + 1u) * nx) xb_add(&bar[XB_TOPGEN], 1u);
            else XB_SPIN(xb_ld(&bar[XB_TOPGEN]) == tg, bar);
            __builtin_amdgcn_fence(__ATOMIC_ACQUIRE, "agent");
            xb_add(&bar[XB_XGEN(b.x)], 1u);
            asm volatile("s_waitcnt vmcnt(0)" ::: "memory");
        } else {
            XB_SPIN(xb_ld(&bar[XB_XGEN(b.x)]) == gen, bar);
            __builtin_amdgcn_fence(__ATOMIC_ACQUIRE, "agent");
            asm volatile("s_waitcnt vmcnt(0)" ::: "memory");
        }
    }
    __syncthreads();
}
__device__ __forceinline__ int win_row(int dl) {
    const int L = dl & 255;
    const int p = (dl >= C_GATE && dl < C_GATE + 6144) ? (((L >> 3) & 1) * 128 + (L >> 6) * 32 + ((L >> 4) & 3) * 8 + (L & 7)) : (((L >> 5) & 1) * 128 + (L >> 6) * 32 + (L & 31));
    return (dl & ~255) + p;
}
template <bool MAPW = false>
__device__ __forceinline__ void transpose_item(const float* W, int K, int N, bf16* WT, int k0, int n0, int drow0, LAS float* scr, int lane) {
#pragma unroll 8
    for (int i = 0; i < 32; ++i) { const int kk = 2 * i + (lane >> 5); scr[kk * 33 + (lane & 31)] = W[(size_t)(k0 + kk) * N + n0 + (lane & 31)]; }
    LDS_WAIT(); asm volatile("" ::: "memory");
    const int c = lane & 7;
#pragma unroll
    for (int j = 0; j < 4; ++j) { const int n = (lane >> 3) + 8 * j; const LAS float* s = scr + (8 * c) * 33 + n;
        v4u o; o.x = cvtpk(s[0 * 33], s[1 * 33]); o.y = cvtpk(s[2 * 33], s[3 * 33]); o.z = cvtpk(s[4 * 33], s[5 * 33]); o.w = cvtpk(s[6 * 33], s[7 * 33]);
        *(v4u*)(WT + (size_t)(MAPW ? win_row(drow0 + n) : drow0 + n) * K + k0 + 8 * c) = o; }
    LDS_WAIT(); asm volatile("" ::: "memory");
}
__device__ __forceinline__ void phase_prologue(LAS unsigned char* lds, const float* w_in, const float* w_branch, const float* w_out, unsigned char* ws, int gw, int ngw, int wave, int lane) {
    LAS float* scr = (LAS float*)(lds + wave * 16384);
    constexpr int NB_IN = IN_REAL / 32;
    constexpr int I_IN = 32 * NB_IN;
    constexpr int I_BR = 16 * 64;
    constexpr int I_OUT = 32 * 64;
    constexpr int TOT = 4 * I_IN + 12 * I_BR + 4 * I_OUT;
    for (int it = gw; it < TOT; it += ngw) {
        int r = it;
        if (r < 4 * I_IN) { const int l = r / I_IN; r -= l * I_IN; const int kb = r / NB_IN, nb = r % NB_IN, n0 = nb * 32;
            const int drow = (n0 < 4096) ? n0 : ((n0 < 4128) ? (C_BA + (n0 - 4096)) : (n0 - 32));
            transpose_item<true>(w_in + (size_t)l * DM * IN_REAL, DM, IN_REAL, (bf16*)(ws + WS_WIN + (size_t)l * SZ_WIN_L), kb * 64, n0, drow, scr, lane); continue; }
        r -= 4 * I_IN;
        if (r < 12 * I_BR) { const int m = r / I_BR; r -= m * I_BR; const int kb = r / 64, nb = r % 64;
            transpose_item(w_branch + (size_t)m * 1024 * 2048, 1024, 2048, (bf16*)(ws + WS_WBR + (size_t)m * SZ_WBR_1), kb * 64, nb * 32, nb * 32, scr, lane); continue; }
        r -= 12 * I_BR;
        { const int l = r / I_OUT; r -= l * I_OUT; const int kb = r / 64, nb = r % 64;
            transpose_item(w_out + (size_t)l * DM * DM, DM, DM, (bf16*)(ws + WS_WOUT + (size_t)l * SZ_WOUT_L), kb * 64, nb * 32, nb * 32, scr, lane); }
    }
    const v4u z = {0u, 0u, 0u, 0u};
    for (int i = gw * 64 + lane; i < 4 * 57344; i += ngw * 64) { const int l = i / 57344, q = i % 57344;
        *(v4u*)(ws + WS_WIN + (size_t)l * SZ_WIN_L + (size_t)IN_REAL * DM * 2 + (size_t)q * 16) = z; }
}
__device__ __forceinline__ void rms_row(const float* xrow, const float* gain, bf16* orow, float* rowss, int lane) {
    const f32x4* xr = (const f32x4*)xrow + lane; const f32x4* gr = (const f32x4*)gain + lane;
    f32x4 v[8]; float s = 0.f;
#pragma unroll
    for (int j = 0; j < 8; ++j) { v[j] = xr[64 * j]; s += (v[j].x * v[j].x + v[j].y * v[j].y) + (v[j].z * v[j].z + v[j].w * v[j].w); }
    s = wave_sum(s);
    if (lane == 0) *rowss = s;
    v2u* o8 = (v2u*)orow + lane;
#pragma unroll
    for (int j = 0; j < 8; ++j) { const f32x4 g = gr[64 * j]; v2u o; o.x = cvtpk(v[j].x * g.x, v[j].y * g.y); o.y = cvtpk(v[j].z * g.z, v[j].w * g.w); o8[64 * j] = o; }
}
template <bool DIFF>
__device__ __forceinline__ void knorm_row(bf16* prow, const float* swa_k_gain, const float* diff_k_gain, int lane) {
    {
        v2u* p = (v2u*)(prow + C_SKV) + lane; const v2u w = *p;
        float a = bflo(w.x), b = bfhi(w.x), c = bflo(w.y), d = bfhi(w.y);
        float ss = (a * a + b * b) + (c * c + d * d);
        ss += xshfl<1>(ss); ss += xshfl<2>(ss); ss += xshfl<4>(ss); ss += xshfl<8>(ss); ss += xshfl<16>(ss);
        const float rs = 1.0f / sqrtf(ss * (1.0f / 128.0f) + NORM_EPS);
        const f32x4 g = *((const f32x4*)swa_k_gain + (lane & 31));
        v2u o; o.x = cvtpk(a * rs * g.x, b * rs * g.y); o.y = cvtpk(c * rs * g.z, d * rs * g.w); *p = o;
    }
    if (DIFF) {
        v4u* p = (v4u*)(prow + C_DK) + 2 * lane; const v4u w0 = p[0], w1 = p[1];
        float x[16] = {bflo(w0.x), bfhi(w0.x), bflo(w0.y), bfhi(w0.y), bflo(w0.z), bfhi(w0.z), bflo(w0.w), bfhi(w0.w),
                       bflo(w1.x), bfhi(w1.x), bflo(w1.y), bfhi(w1.y), bflo(w1.z), bfhi(w1.z), bflo(w1.w), bfhi(w1.w)};
        float ss = 0.f;
#pragma unroll
        for (int e = 0; e < 16; ++e) ss += x[e] * x[e];
        ss += xshfl<1>(ss); ss += xshfl<2>(ss);
        const float rs = 1.0f / sqrtf(ss * (1.0f / 64.0f) + NORM_EPS);
        const float* g = diff_k_gain + 16 * (lane & 3);
#pragma unroll
        for (int e = 0; e < 16; ++e) x[e] *= rs * g[e];
        v4u o0, o1; o0.x = cvtpk(x[0], x[1]); o0.y = cvtpk(x[2], x[3]); o0.z = cvtpk(x[4], x[5]); o0.w = cvtpk(x[6], x[7]);
        o1.x = cvtpk(x[8], x[9]); o1.y = cvtpk(x[10], x[11]); o1.z = cvtpk(x[12], x[13]); o1.w = cvtpk(x[14], x[15]);
        p[0] = o0; p[1] = o1;
    }
}
__device__ __forceinline__ void gdn_final_row(const bf16* of, const bf16* ob, const bf16* zrow, const float* gain, bf16* yrow, int lane) {
    const v4u* pf = (const v4u*)of + 2 * lane; const v4u* pb = (const v4u*)ob + 2 * lane; const v4u* pz = (const v4u*)zrow + 2 * lane;
    float x[16], z[16];
#pragma unroll
    for (int q = 0; q < 2; ++q) { const v4u a = pf[q], b = pb[q], c = pz[q];
        x[8 * q + 0] = bflo(a.x) + bflo(b.x); x[8 * q + 1] = bfhi(a.x) + bfhi(b.x); x[8 * q + 2] = bflo(a.y) + bflo(b.y); x[8 * q + 3] = bfhi(a.y) + bfhi(b.y);
        x[8 * q + 4] = bflo(a.z) + bflo(b.z); x[8 * q + 5] = bfhi(a.z) + bfhi(b.z); x[8 * q + 6] = bflo(a.w) + bflo(b.w); x[8 * q + 7] = bfhi(a.w) + bfhi(b.w);
        z[8 * q + 0] = bflo(c.x); z[8 * q + 1] = bfhi(c.x); z[8 * q + 2] = bflo(c.y); z[8 * q + 3] = bfhi(c.y);
        z[8 * q + 4] = bflo(c.z); z[8 * q + 5] = bfhi(c.z); z[8 * q + 6] = bflo(c.w); z[8 * q + 7] = bfhi(c.w); }
    float ss = 0.f;
#pragma unroll
    for (int e = 0; e < 16; ++e) ss += x[e] * x[e];
    ss += xshfl<1>(ss); ss += xshfl<2>(ss); ss += xshfl<4>(ss);
    const float rs = 1.0f / sqrtf(ss * (1.0f / 128.0f) + NORM_EPS);
    const float* g = gain + 16 * (lane & 7);
#pragma unroll
    for (int e = 0; e < 16; ++e) x[e] = x[e] * rs * g[e] * z[e];
    v4u o0, o1; o0.x = cvtpk(x[0], x[1]); o0.y = cvtpk(x[2], x[3]); o0.z = cvtpk(x[4], x[5]); o0.w = cvtpk(x[6], x[7]);
    o1.x = cvtpk(x[8], x[9]); o1.y = cvtpk(x[10], x[11]); o1.z = cvtpk(x[12], x[13]); o1.w = cvtpk(x[14], x[15]);
    v4u* py = (v4u*)yrow + 2 * lane; py[0] = o0; py[1] = o1;
}
__device__ __forceinline__ void diff_final_row(const unsigned char* ws, int slot0, int np, int rr, float lam, float lambda_init, const bf16* zrow, const float* gain, bf16* yrow, int lane) {
    typedef float f32x2v __attribute__((ext_vector_type(2)));
    const float* PO = (const float*)(ws + WS_PART); const float* PL = (const float*)(ws + WS_PARTL);
    f32x2v o0 = {0.f, 0.f}, o1 = {0.f, 0.f}; float l0 = 0.f, l1 = 0.f;
    for (int p = 0; p < np; ++p) { const int s = slot0 + p;
        o0 += *(const f32x2v*)(PO + ((size_t)(s * 2 + 0) * 256 + rr) * 128 + 2 * lane); o1 += *(const f32x2v*)(PO + ((size_t)(s * 2 + 1) * 256 + rr) * 128 + 2 * lane);
        l0 += PL[(s * 2 + 0) * 256 + rr]; l1 += PL[(s * 2 + 1) * 256 + rr]; }
    const float r0 = 1.0f / l0, r1 = lam / l1;
    const float a = o0.x * r0 - o1.x * r1, b = o0.y * r0 - o1.y * r1;
    const float rs = (1.0f / sqrtf(wave_sum(a * a + b * b) * (1.0f / 128.0f) + NORM_EPS)) * (1.0f - lambda_init);
    const unsigned zw = *(const unsigned*)(zrow + 2 * lane);
    const float ya = a * rs * gain[2 * lane] * bflo(zw), yb = b * rs * gain[2 * lane + 1] * bfhi(zw);
    *(unsigned*)(yrow + 2 * lane) = cvtpk(ya, yb);
}
constexpr int D1_QROW = 0, D1_KROW = 17408, D1_KT = 34816, D1_VT = 53248, D1_LM = 71680, D1_TB = 106496, D1_BETA = 143360, D1_GC = 143872, D1_END = 144384;
constexpr int ROWP = 272, TRP = 144, LMP = 272, TBP = 144;
#define TSW(rw, boff) ((rw) * TRP + ((boff) ^ ((((rw) >> 3) & 7) << 4)))
__device__ __forceinline__ unsigned char* gdn_rec(unsigned char* ws, int d, int ci, int h) { return ws + WS_GDN + (((size_t)d * 256 + ci) * 8 + h) * REC_BYTES; }

#ifndef DUP_D1
#define DUP_D1 0
#endif
__device__ __forceinline__ void gdn_prep_unit(LAS unsigned char* lds, unsigned char* ws, const float* conv_w, const float* a_log, const float* dt_bias,
                                              int l, int Tp, int ci, int h, int nci, int nh, unsigned& pre_ba, int tid, int wave, int lane) {
    const bf16* PROJ = (const bf16*)(ws + WS_PROJ);
    const int row0 = ci * 64, tin = row0 % Tp; const bool first = (tin == 0), last = (tin + 64 == Tp);
    LAS float* BETA = (LAS float*)(lds + D1_BETA); LAS float* GC = (LAS float*)(lds + D1_GC);
    if (tid < 128) {
        const int d = tid >> 6, r = tid & 63, c = d ? 63 - r : r;
        const float braw = bflo(pre_ba), araw = bfhi(pre_ba);
        if (nci >= 0) { const bf16* pn = PROJ + (size_t)(nci * 64 + c) * LDP + C_BA; pre_ba = (unsigned)pn[d * 8 + nh] | ((unsigned)pn[16 + d * 8 + nh] << 16); }
        const float beta = __builtin_amdgcn_rcpf(1.0f + __expf(-braw));
        const float x = araw + dt_bias[(l * 2 + d) * 8 + h];
        const float sp = fmaxf(x, 0.f) + log1pf(__expf(-fabsf(x)));
        float gcv = -__expf(a_log[(l * 2 + d) * 8 + h]) * sp;
#pragma unroll
        for (int off = 1; off < 64; off <<= 1) { const float t = __shfl_up(gcv, off); if (r >= off) gcv += t; }
        BETA[d * 64 + r] = beta; GC[d * 64 + r] = gcv;
        if (r == 63) *(float*)(gdn_rec(ws, d, ci, h) + REC_GAM) = __expf(gcv);
    }
    __syncthreads();
    for (int rep1 = 0; rep1 < (DUP_D1 == 1 ? 2 : 1); ++rep1) {
        const int sub = tid & 15, ch0 = sub * 8;
#pragma unroll 6
        for (int rnd = 0; rnd < 6; ++rnd) {
            const int it = rnd * 32 + (tid >> 4), mat = it >> 6, c = it & 63;
            const int chan = mat * 1024 + h * 128 + ch0;
            const bf16* px = PROJ + (size_t)(row0 + c) * LDP + C_GQKV + chan;
            const v4u zz = {0u, 0u, 0u, 0u};
            const v4u x1 = *(const v4u*)px;
            const v4u x0 = (c == 0 && first) ? zz : *(const v4u*)(px - LDP);
            const v4u x2 = (c == 63 && last) ? zz : *(const v4u*)(px + LDP);
            const float* cw = conv_w + (size_t)l * 3 * 3072 + chan;
            const f32x4 w0a = *(const f32x4*)cw, w0b = *(const f32x4*)(cw + 4), w1a = *(const f32x4*)(cw + 3072), w1b = *(const f32x4*)(cw + 3072 + 4), w2a = *(const f32x4*)(cw + 6144), w2b = *(const f32x4*)(cw + 6144 + 4);
            const float w0[8] = {w0a.x, w0a.y, w0a.z, w0a.w, w0b.x, w0b.y, w0b.z, w0b.w}, w1[8] = {w1a.x, w1a.y, w1a.z, w1a.w, w1b.x, w1b.y, w1b.z, w1b.w}, w2[8] = {w2a.x, w2a.y, w2a.z, w2a.w, w2b.x, w2b.y, w2b.z, w2b.w};
            const float a0[8] = {bflo(x0.x), bfhi(x0.x), bflo(x0.y), bfhi(x0.y), bflo(x0.z), bfhi(x0.z), bflo(x0.w), bfhi(x0.w)};
            const float a1[8] = {bflo(x1.x), bfhi(x1.x), bflo(x1.y), bfhi(x1.y), bflo(x1.z), bfhi(x1.z), bflo(x1.w), bfhi(x1.w)};
            const float a2[8] = {bflo(x2.x), bfhi(x2.x), bflo(x2.y), bfhi(x2.y), bflo(x2.z), bfhi(x2.z), bflo(x2.w), bfhi(x2.w)};
            float y[8]; float ss = 0.f;
#pragma unroll
            for (int e = 0; e < 8; ++e) { const float a = a0[e] * w0[e] + a1[e] * w1[e] + a2[e] * w2[e]; y[e] = a * __builtin_amdgcn_rcpf(1.0f + __expf(-a)); ss += y[e] * y[e]; }
            if (mat < 2) {
                ss += xshfl<1>(ss); ss += xshfl<2>(ss); ss += xshfl<4>(ss); ss += xshfl<8>(ss);
                float rs = __builtin_amdgcn_rsqf(ss + NORM_EPS); if (mat == 0) rs *= 0.08838834764831845f;
#pragma unroll
                for (int e = 0; e < 8; ++e) y[e] *= rs;
            }
            if (mat == 0) {
                v4u o; o.x = cvtpk(y[0], y[1]); o.y = cvtpk(y[2], y[3]); o.z = cvtpk(y[4], y[5]); o.w = cvtpk(y[6], y[7]);
                *(LAS v4u*)(lds + D1_QROW + c * ROWP + ch0 * 2) = o;
                const int t = ch0 >> 5, kk = ch0 & 31, s = kk >> 4, b = (kk >> 3) & 1;
#pragma unroll
                for (int d = 0; d < 2; ++d) { const int r = d ? 63 - c : c; const float e = __expf(GC[d * 64 + r]); const int i = r >> 5, rr = r & 31;
                    unsigned char* fb = gdn_rec(ws, d, ci, h) + REC_FQ + (((i * 4 + t) * 2 + s) * 64) * 16 + b * 8;
                    v2u lo, hi2; lo.x = cvtpk(y[0] * e, y[1] * e); lo.y = cvtpk(y[2] * e, y[3] * e); hi2.x = cvtpk(y[4] * e, y[5] * e); hi2.y = cvtpk(y[6] * e, y[7] * e);
                    *(v2u*)(fb + rr * 16) = lo; *(v2u*)(fb + (rr + 32) * 16) = hi2; }
            } else if (mat == 1) {
                v4u o; o.x = cvtpk(y[0], y[1]); o.y = cvtpk(y[2], y[3]); o.z = cvtpk(y[4], y[5]); o.w = cvtpk(y[6], y[7]);
                *(LAS v4u*)(lds + D1_KROW + c * ROWP + ch0 * 2) = o;
#pragma unroll
                for (int e = 0; e < 8; ++e) *(LAS bf16*)(lds + D1_KT + TSW(ch0 + e, c * 2)) = f2bf1(y[e]);
            } else {
#pragma unroll
                for (int e = 0; e < 8; ++e) *(LAS bf16*)(lds + D1_VT + TSW(ch0 + e, c * 2)) = f2bf1(y[e]);
            }
        }
    }
    __syncthreads();
    for (int rep2 = 0; rep2 < (DUP_D1 == 2 ? 2 : 1); ++rep2) {
        const int r32 = lane & 31, hi = lane >> 5;
#pragma unroll 1
        for (int k = wave; k < 12; k += 8) {
            const int d = k / 6, sel = k % 6;
            int ta, tb; int boff;
            if (sel < 3) { ta = (sel >= 1); tb = (sel == 2); boff = D1_KROW; }
            else { ta = (sel == 5); tb = (sel >= 4); boff = D1_QROW; }
            const int ra = 32 * ta + r32, rb = 32 * tb + r32;
            const int rowa = d ? 63 - ra : ra, rowb = d ? 63 - rb : rb;
            const LAS unsigned char* pa = lds + D1_KROW + rowa * ROWP + hi * 16; const LAS unsigned char* pb = lds + boff + rowb * ROWP + hi * 16;
            f32x16 acc = {0.f, 0.f, 0.f, 0.f, 0.f, 0.f, 0.f, 0.f, 0.f, 0.f, 0.f, 0.f, 0.f, 0.f, 0.f, 0.f};
#pragma unroll
            for (int s = 0; s < 8; ++s) acc = MFMA32(*(const LAS bf16x8*)(pa + s * 32), *(const LAS bf16x8*)(pb + s * 32), acc);
            const int colp = 32 * tb + r32;
            const float gcc = GC[d * 64 + colp];
            if (sel < 3) {
                LAS float* Lm = (LAS float*)(lds + D1_LM + d * 17408);
#pragma unroll
                for (int r = 0; r < 16; ++r) { const int rp = 32 * ta + crow(r, hi);
                    const float v = (rp > colp) ? BETA[d * 64 + rp] * acc[r] * __expf(GC[d * 64 + rp] - gcc) : 0.f;
                    Lm[rp * (LMP / 4) + colp] = v; }
            } else {
                float v[16];
#pragma unroll
                for (int r = 0; r < 16; ++r) { const int cp = 32 * ta + crow(r, hi);
                    v[r] = (colp >= cp) ? acc[r] * __expf(gcc - GC[d * 64 + cp]) : 0.f; }
                unsigned char* fb = gdn_rec(ws, d, ci, h) + REC_FQK + (((tb * 2 + ta) * 2) * 64 + lane) * 16;
                v4u o0, o1; o0.x = cvtpk(v[0], v[1]); o0.y = cvtpk(v[2], v[3]); o0.z = cvtpk(v[4], v[5]); o0.w = cvtpk(v[6], v[7]);
                o1.x = cvtpk(v[8], v[9]); o1.y = cvtpk(v[10], v[11]); o1.z = cvtpk(v[12], v[13]); o1.w = cvtpk(v[14], v[15]);
                *(v4u*)fb = o0; *(v4u*)(fb + 1024) = o1;
            }
        }
    }
    __syncthreads();
    constexpr int D1_TS = D1_QROW;
    for (int rep3 = 0; rep3 < (DUP_D1 == 3 ? 2 : 1); ++rep3)
    if (wave < 4) {
        const int d = wave >> 1, blk = wave & 1, j = lane & 31, jp = 32 * blk + j;
        const LAS float* Lm = (const LAS float*)(lds + D1_LM + d * 17408) + (32 * blk) * (LMP / 4) + 32 * blk;
        const float bj = BETA[d * 64 + jp], bgj = bj * __expf(GC[d * 64 + jp]);
        const int col = d ? 63 - jp : jp;
        LAS unsigned char* tb = lds + D1_TB + d * 18432 + (32 * blk) * TBP + col * 2;
        LAS float* ts = (LAS float*)(lds + D1_TS + (d * 2 + blk) * 4352) + j;
        if (lane < 32) {
            float t[32];
#pragma unroll
            for (int r = 0; r < 32; ++r) {
                float a4[4] = {(r == j) ? 1.f : 0.f, 0.f, 0.f, 0.f};
#pragma unroll
                for (int m4 = 0; m4 < (r + 3) / 4; ++m4) { const f32x4 lv = *(const LAS f32x4*)(Lm + r * (LMP / 4) + m4 * 4);
#pragma unroll
                    for (int e = 0; e < 4; ++e) if (m4 * 4 + e < r) a4[e] -= lv[e] * t[m4 * 4 + e]; }
                const float a = (a4[0] + a4[1]) + (a4[2] + a4[3]);
                t[r] = a; ts[r * 33] = a;
                *(LAS bf16*)(tb + r * TBP) = f2bf1(a * bj); *(LAS bf16*)(tb + 9216 + r * TBP) = f2bf1(a * bgj);
            }
        } else if (blk == 0) {
            const int colz = d ? 63 - (32 + j) : 32 + j; LAS unsigned char* tz = lds + D1_TB + d * 18432 + colz * 2;
#pragma unroll
            for (int r = 0; r < 32; ++r) { *(LAS bf16*)(tz + r * TBP) = (bf16)0; *(LAS bf16*)(tz + 9216 + r * TBP) = (bf16)0; }
        }
    } else {
        const int rr = lane & 31, hh = lane >> 5;
#pragma unroll 1
        for (int f = wave - 4; f < 32; f += 4) {
            const int d = f >> 4, t = (f >> 2) & 3, ip = (f >> 1) & 1, s = f & 1;
            const int c0 = 32 * ip + 16 * s + 4 * hh;
            const float gl = GC[d * 64 + 63];
            const int ktr = 32 * t + rr; const LAS unsigned char* kt = lds + D1_KT;
            float ea[4], eb[4];
#pragma unroll
            for (int x = 0; x < 4; ++x) { ea[x] = __expf(gl - GC[d * 64 + c0 + x]); eb[x] = __expf(gl - GC[d * 64 + c0 + 8 + x]); }
            float ka[4], kb[4];
            if (d == 0) { const v2u wa = *(const LAS v2u*)(kt + TSW(ktr, c0 * 2)), wb = *(const LAS v2u*)(kt + TSW(ktr, (c0 + 8) * 2));
                ka[0] = bflo(wa.x); ka[1] = bfhi(wa.x); ka[2] = bflo(wa.y); ka[3] = bfhi(wa.y); kb[0] = bflo(wb.x); kb[1] = bfhi(wb.x); kb[2] = bflo(wb.y); kb[3] = bfhi(wb.y); }
            else { const v2u wa = *(const LAS v2u*)(kt + TSW(ktr, (60 - c0) * 2)), wb = *(const LAS v2u*)(kt + TSW(ktr, (52 - c0) * 2));
                ka[3] = bflo(wa.x); ka[2] = bfhi(wa.x); ka[1] = bflo(wa.y); ka[0] = bfhi(wa.y); kb[3] = bflo(wb.x); kb[2] = bfhi(wb.x); kb[1] = bflo(wb.y); kb[0] = bfhi(wb.y); }
            v4u o; o.x = cvtpk(ka[0] * ea[0], ka[1] * ea[1]); o.y = cvtpk(ka[2] * ea[2], ka[3] * ea[3]); o.z = cvtpk(kb[0] * eb[0], kb[1] * eb[1]); o.w = cvtpk(kb[2] * eb[2], kb[3] * eb[3]);
            *(v4u*)(gdn_rec(ws, d, ci, h) + REC_FK + (((t * 2 + ip) * 2 + s) * 64 + lane) * 16) = o;
        }
    }
    __syncthreads();
    if (wave < 2) {
        const int d = wave, i = lane & 31, hh = lane >> 5;
        const LAS float* L21 = (const LAS float*)(lds + D1_LM + d * 17408) + (32 + i) * (LMP / 4);
        const LAS float* T11 = (const LAS float*)(lds + D1_TS + (d * 2 + 0) * 4352);
        const LAS float* T22 = (const LAS float*)(lds + D1_TS + (d * 2 + 1) * 4352);
        f32x16 P = {0.f, 0.f, 0.f, 0.f, 0.f, 0.f, 0.f, 0.f, 0.f, 0.f, 0.f, 0.f, 0.f, 0.f, 0.f, 0.f};
#pragma unroll
        for (int s = 0; s < 16; ++s) P = __builtin_amdgcn_mfma_f32_32x32x2f32(L21[2 * s + hh], T11[(2 * s + hh) * 33 + i], P, 0, 0, 0);
        f32x16 R = {0.f, 0.f, 0.f, 0.f, 0.f, 0.f, 0.f, 0.f, 0.f, 0.f, 0.f, 0.f, 0.f, 0.f, 0.f, 0.f};
#pragma unroll
        for (int s = 0; s < 16; ++s) R = __builtin_amdgcn_mfma_f32_32x32x2f32(T22[i * 33 + crow(s, hh)], P[s], R, 0, 0, 0);
        const float bj = BETA[d * 64 + i], bgj = bj * __expf(GC[d * 64 + i]);
        const int col = d ? 63 - i : i;
        LAS unsigned char* tb = lds + D1_TB + d * 18432 + 32 * TBP + col * 2;
#pragma unroll
        for (int r = 0; r < 16; ++r) { const float a = -R[r]; const int row = crow(r, hh);
            *(LAS bf16*)(tb + row * TBP) = f2bf1(a * bj); *(LAS bf16*)(tb + 9216 + row * TBP) = f2bf1(a * bgj); }
    }
    __syncthreads();
    for (int rep4 = 0; rep4 < (DUP_D1 == 4 ? 2 : 1); ++rep4) {
        const int r32 = lane & 31, hi = lane >> 5;
#pragma unroll 1
        for (int f = wave; f < 32; f += 8) {
            const int d = f >> 4, kind = (f >> 3) & 1, idx = f & 7;
            const LAS unsigned char* pa; const LAS unsigned char* pb; int xa = 0, xb = 0;
            if (kind == 0) { const int i = idx >> 2, w = idx & 3;
                pa = lds + D1_TB + d * 18432 + (32 * i + r32) * TBP; pb = lds + D1_VT + (32 * w + r32) * TRP; xb = (((32 * w + r32) >> 3) & 7) << 4; }
            else { const int t = idx >> 1, i = idx & 1;
                pa = lds + D1_KT + (32 * t + r32) * TRP; xa = (((32 * t + r32) >> 3) & 7) << 4; pb = lds + D1_TB + d * 18432 + 9216 + (32 * i + r32) * TBP; }
            f32x16 acc = {0.f, 0.f, 0.f, 0.f, 0.f, 0.f, 0.f, 0.f, 0.f, 0.f, 0.f, 0.f, 0.f, 0.f, 0.f, 0.f};
#pragma unroll
            for (int s = 0; s < 4; ++s) acc = MFMA32(*(const LAS bf16x8*)(pa + ((s * 32 + hi * 16) ^ xa)), *(const LAS bf16x8*)(pb + ((s * 32 + hi * 16) ^ xb)), acc);
            const float sg = kind ? -1.f : 1.f;
            v4u o0, o1; o0.x = cvtpk(sg * acc[0], sg * acc[1]); o0.y = cvtpk(sg * acc[2], sg * acc[3]); o0.z = cvtpk(sg * acc[4], sg * acc[5]); o0.w = cvtpk(sg * acc[6], sg * acc[7]);
            o1.x = cvtpk(sg * acc[8], sg * acc[9]); o1.y = cvtpk(sg * acc[10], sg * acc[11]); o1.z = cvtpk(sg * acc[12], sg * acc[13]); o1.w = cvtpk(sg * acc[14], sg * acc[15]);
            if (kind == 0) { const int i = idx >> 2, w = idx & 3; unsigned char* fb = gdn_rec(ws, d, ci, h) + REC_FU + ((w * 2 + i) * 64 + lane) * 32; *(v4u*)fb = o0; *(v4u*)(fb + 16) = o1; }
            else { const int t = idx >> 1, i = idx & 1; unsigned char* fb = gdn_rec(ws, d, ci, h) + REC_FW + (((i * 4 + t) * 2) * 64 + lane) * 16; *(v4u*)fb = o0; *(v4u*)(fb + 1024) = o1; }
        }
    }
    __syncthreads();
}
__device__ __forceinline__ bf16x8 pack8(const f32x16& v, int s) {
    v4u w; w.x = cvtpk(v[8 * s + 0], v[8 * s + 1]); w.y = cvtpk(v[8 * s + 2], v[8 * s + 3]); w.z = cvtpk(v[8 * s + 4], v[8 * s + 5]); w.w = cvtpk(v[8 * s + 6], v[8 * s + 7]);
    return __builtin_bit_cast(bf16x8, w);
}
#define SCAN_BAR() do { asm volatile("s_waitcnt lgkmcnt(0)" ::: "memory"); __builtin_amdgcn_s_barrier(); asm volatile("" ::: "memory"); } while (0)
constexpr int SC_BUF = REC_BYTES;
__device__ __forceinline__ void gdn_scan_unit(LAS unsigned char* lds, unsigned char* ws, int Tp, int sq, int h, int d, int half, int tid, int wave, int lane) {
    const int Nc = Tp / 64, cb = sq * Nc;
    bf16* ODIR = (bf16*)(ws + WS_ODIR) + (size_t)d * PASS_ROWS * 1024;
#define SC_SRC(n) ((const unsigned char*)gdn_rec(ws, d, cb + (d ? Nc - 1 - (n) : (n)), h))
    if (wave >= 2) {
        const int lt = tid - 128;
#define SC_LOAD(st, n) do { const unsigned char* src_ = SC_SRC(n); _Pragma("unroll") for (int k = 0; k < 12; ++k) st[k] = *(const v4u*)(src_ + (lt + 384 * k) * 16); } while (0)
#define SC_WRITE(st, b) do { _Pragma("unroll") for (int k = 0; k < 12; ++k) *(LAS v4u*)(lds + (b) * SC_BUF + (lt + 384 * k) * 16) = st[k]; } while (0)
        v4u s0[12], s1[12];
        SC_LOAD(s0, 0); SC_WRITE(s0, 0);
        if (1 < Nc) SC_LOAD(s1, 1);
        if (2 < Nc) SC_LOAD(s0, 2);
        SCAN_BAR();
#define SC_STEP(n, st) do { if ((n) < Nc) { if ((n) + 1 < Nc) SC_WRITE(st, ((n) + 1) & 1); if ((n) + 3 < Nc) SC_LOAD(st, (n) + 3); SCAN_BAR(); } } while (0)
#pragma unroll 1
        for (int n = 0; n < Nc; n += 2) { SC_STEP(n, s1); SC_STEP(n + 1, s0); }
#undef SC_STEP
#undef SC_WRITE
#undef SC_LOAD
    } else {
        const int w = half * 2 + wave, r32 = lane & 31, hi = lane >> 5;
        f32x16 S[4];
#pragma unroll
        for (int t = 0; t < 4; ++t)
#pragma unroll
            for (int r = 0; r < 16; ++r) S[t][r] = 0.f;
        const __amdgpu_buffer_rsrc_t orsrc = __builtin_amdgcn_make_buffer_rsrc((void*)(ODIR + (size_t)(sq * Tp) * 1024 + h * 128 + 32 * w), 0, 0x7fffffff, 0x00020000);
        SCAN_BAR();
#pragma unroll 1
        for (int n = 0; n < Nc; ++n) {
            const LAS unsigned char* buf = lds + (n & 1) * SC_BUF + lane * 16;
            const float gam = *(const LAS float*)(lds + (n & 1) * SC_BUF + REC_GAM);
#define LDF(off) (*(const LAS bf16x8*)(buf + (off)))
#define FWO(i, t, s) (REC_FW + (((i) * 4 + (t)) * 2 + (s)) * 1024)
#define FQO(i, t, s) (REC_FQ + (((i) * 4 + (t)) * 2 + (s)) * 1024)
#define FKO(t, ip, s) (REC_FK + (((t) * 2 + (ip)) * 2 + (s)) * 1024)
#define FQKO(i, ip, s) (REC_FQK + (((i) * 2 + (ip)) * 2 + (s)) * 1024)
            bf16x8 A[8], B[8];
#pragma unroll
            for (int e = 0; e < 8; ++e) { A[e] = LDF(FWO(e & 1, e >> 2, (e >> 1) & 1)); B[e] = LDF(FWO(e & 1, 2 + (e >> 2), (e >> 1) & 1)); }
            v4u ua[2], ub[2];
#pragma unroll
            for (int i = 0; i < 2; ++i) { const LAS v4u* pu = (const LAS v4u*)(lds + (n & 1) * SC_BUF + REC_FU + ((w * 2 + i) * 64 + lane) * 32); ua[i] = pu[0]; ub[i] = pu[1]; }
            __builtin_amdgcn_sched_barrier(0);
            bf16x8 Sf[4][2];
#pragma unroll
            for (int t = 0; t < 4; ++t) { Sf[t][0] = pack8(S[t], 0); Sf[t][1] = pack8(S[t], 1); }
            f32x16 V[2];
#pragma unroll
            for (int i = 0; i < 2; ++i) { const v4u a = ua[i], b = ub[i];
                V[i][0] = bflo(a.x); V[i][1] = bfhi(a.x); V[i][2] = bflo(a.y); V[i][3] = bfhi(a.y); V[i][4] = bflo(a.z); V[i][5] = bfhi(a.z); V[i][6] = bflo(a.w); V[i][7] = bfhi(a.w);
                V[i][8] = bflo(b.x); V[i][9] = bfhi(b.x); V[i][10] = bflo(b.y); V[i][11] = bfhi(b.y); V[i][12] = bflo(b.z); V[i][13] = bfhi(b.z); V[i][14] = bflo(b.w); V[i][15] = bfhi(b.w); }
            __builtin_amdgcn_sched_barrier(0);
#pragma unroll
            for (int e = 0; e < 8; ++e) V[e & 1] = MFMA32(A[e], Sf[e >> 2][(e >> 1) & 1], V[e & 1]);
            __builtin_amdgcn_sched_barrier(0);
#pragma unroll
            for (int e = 0; e < 8; ++e) A[e] = LDF(FQO(e & 1, e >> 2, (e >> 1) & 1));
            __builtin_amdgcn_sched_barrier(0);
#pragma unroll
            for (int e = 0; e < 8; ++e) V[e & 1] = MFMA32(B[e], Sf[2 + (e >> 2)][(e >> 1) & 1], V[e & 1]);
            __builtin_amdgcn_sched_barrier(0);
#pragma unroll
            for (int e = 0; e < 8; ++e) B[e] = LDF(FQO(e & 1, 2 + (e >> 2), (e >> 1) & 1));
            __builtin_amdgcn_sched_barrier(0);
            f32x16 O[2];
#pragma unroll
            for (int i = 0; i < 2; ++i)
#pragma unroll
                for (int r = 0; r < 16; ++r) O[i][r] = 0.f;
#pragma unroll
            for (int e = 0; e < 8; ++e) O[e & 1] = MFMA32(A[e], Sf[e >> 2][(e >> 1) & 1], O[e & 1]);
            __builtin_amdgcn_sched_barrier(0);
#pragma unroll
            for (int e = 0; e < 8; ++e) A[e] = LDF(FKO(e & 3, 0, e >> 2));
            bf16x8 Vf[2][2];
#pragma unroll
            for (int i = 0; i < 2; ++i) { Vf[i][0] = pack8(V[i], 0); Vf[i][1] = pack8(V[i], 1); }
#pragma unroll
            for (int t = 0; t < 4; ++t)
#pragma unroll
                for (int r = 0; r < 16; ++r) S[t][r] *= gam;
            __builtin_amdgcn_sched_barrier(0);
#pragma unroll
            for (int e = 0; e < 8; ++e) O[e & 1] = MFMA32(B[e], Sf[2 + (e >> 2)][(e >> 1) & 1], O[e & 1]);
            __builtin_amdgcn_sched_barrier(0);
#pragma unroll
            for (int e = 0; e < 8; ++e) B[e] = LDF(FKO(e & 3, 1, e >> 2));
            __builtin_amdgcn_sched_barrier(0);
#pragma unroll
            for (int e = 0; e < 8; ++e) S[e & 3] = MFMA32(A[e], Vf[0][e >> 2], S[e & 3]);
            __builtin_amdgcn_sched_barrier(0);
            A[0] = LDF(FQKO(0, 0, 0)); A[1] = LDF(FQKO(1, 0, 0)); A[2] = LDF(FQKO(0, 0, 1)); A[3] = LDF(FQKO(1, 0, 1)); A[4] = LDF(FQKO(1, 1, 0)); A[5] = LDF(FQKO(1, 1, 1));
            __builtin_amdgcn_sched_barrier(0);
#pragma unroll
            for (int e = 0; e < 8; ++e) S[e & 3] = MFMA32(B[e], Vf[1][e >> 2], S[e & 3]);
            __builtin_amdgcn_sched_barrier(0);
            O[0] = MFMA32(A[0], Vf[0][0], O[0]); O[1] = MFMA32(A[1], Vf[0][0], O[1]); O[0] = MFMA32(A[2], Vf[0][1], O[0]); O[1] = MFMA32(A[3], Vf[0][1], O[1]);
            O[1] = MFMA32(A[4], Vf[1][0], O[1]); O[1] = MFMA32(A[5], Vf[1][1], O[1]);
#undef LDF
#undef FWO
#undef FQO
#undef FKO
#undef FQKO
            { const int tau0 = 64 * n + 4 * hi;
#pragma unroll
              for (int i = 0; i < 2; ++i)
#pragma unroll
                for (int r = 0; r < 16; ++r) { const int tau = tau0 + 32 * i + (r & 3) + 8 * (r >> 2); const int trow = d ? Tp - 1 - tau : tau;
                    __builtin_amdgcn_raw_buffer_store_b16((short)f2bf1(O[i][r]), orsrc, (trow * 1024 + r32) * 2, 0, 0); } }
            SCAN_BAR();
        }
    }
#undef SC_SRC
}
#define KSWZ(row, colB) ((row) * 256 + ((colB) ^ (((row) & 7) << 4)))
#define SBAR() __builtin_amdgcn_sched_barrier(0)
constexpr int AT_V = 0, AT_K = 32768, AT_OST = 0, AT_OST_W = 16896, AT_WS = 8 * AT_OST_W;
constexpr float ATT_THR = 11.5f;
__device__ __forceinline__ int v_st(int k, int c) { const int kk = (k & ~0xC) | ((k & 4) << 1) | ((k & 8) >> 1); return ((kk >> 3) * 4 + (c >> 5)) * 512 + ((kk & 7) * 32 + (c & 31)) * 2; }
__device__ __forceinline__ int v_rd_base(int lane) { return ((lane & 3) << 3) | (((lane >> 2) & 3) << 6) | (((lane >> 4) & 1) << 5) | (((lane >> 5) & 1) << 8); }
constexpr int v_rd_off(int d0, int ks, int half) { return d0 * 512 + ks * 4096 + half * 2048; }
template <int OFF> __device__ __forceinline__ s16x4 tr_read(int vb) {
    s16x4 r; asm volatile("ds_read_b64_tr_b16 %0, %1 offset:%2" : "=&v"(r) : "v"(vb), "i"(OFF) : "memory"); return r;
}
template <int D0> __device__ __forceinline__ void pv_one(f32x16& od, int vb, bf16x8 pa0, bf16x8 pa1, bf16x8 pa2, bf16x8 pa3) {
    const s16x4 l0 = tr_read<v_rd_off(D0, 0, 0)>(vb), h0 = tr_read<v_rd_off(D0, 0, 1)>(vb), l1 = tr_read<v_rd_off(D0, 1, 0)>(vb), h1 = tr_read<v_rd_off(D0, 1, 1)>(vb);
    const s16x4 l2 = tr_read<v_rd_off(D0, 2, 0)>(vb), h2 = tr_read<v_rd_off(D0, 2, 1)>(vb), l3 = tr_read<v_rd_off(D0, 3, 0)>(vb), h3 = tr_read<v_rd_off(D0, 3, 1)>(vb);
    asm volatile("s_waitcnt lgkmcnt(0)" ::: "memory"); SBAR();
#define PK(L, H) (bf16x8){L[0], L[1], L[2], L[3], H[0], H[1], H[2], H[3]}
    od = MFMA32(pa0, PK(l0, h0), od); od = MFMA32(pa1, PK(l1, h1), od); od = MFMA32(pa2, PK(l2, h2), od); od = MFMA32(pa3, PK(l3, h3), od);
#undef PK
}
__device__ __forceinline__ void pv_d0(f32x16* o, int vb, bf16x8 pa0, bf16x8 pa1, bf16x8 pa2, bf16x8 pa3) {
    pv_one<0>(o[0], vb, pa0, pa1, pa2, pa3); pv_one<1>(o[1], vb, pa0, pa1, pa2, pa3); pv_one<2>(o[2], vb, pa0, pa1, pa2, pa3); pv_one<3>(o[3], vb, pa0, pa1, pa2, pa3);
}
template <bool FIXED>
__device__ __forceinline__ float softmax_tile(f32x16& p0, f32x16& p1, float& m_reg, float& l_reg, bf16x8& pa0, bf16x8& pa1, bf16x8& pa2, bf16x8& pa3) {
    float alpha = 1.f;
    if (!FIXED) {
        float pmax = p0[0];
#pragma unroll
        for (int r = 1; r < 16; ++r) pmax = fmaxf(pmax, p0[r]);
#pragma unroll
        for (int r = 0; r < 16; ++r) pmax = fmaxf(pmax, p1[r]);
        pmax = half_max(pmax);
        if (!__all(pmax - m_reg <= ATT_THR)) { const float mn = fmaxf(m_reg, pmax); alpha = __builtin_amdgcn_exp2f(m_reg - mn); m_reg = mn; }
        const float mn = m_reg;
#pragma unroll
        for (int r = 0; r < 16; ++r) { p0[r] = __builtin_amdgcn_exp2f(p0[r] - mn); p1[r] = __builtin_amdgcn_exp2f(p1[r] - mn); }
    } else {
#pragma unroll
        for (int r = 0; r < 16; ++r) { p0[r] = __builtin_amdgcn_exp2f(p0[r]); p1[r] = __builtin_amdgcn_exp2f(p1[r]); }
    }
    float ps = 0.f;
#pragma unroll
    for (int r = 0; r < 16; ++r) ps += p0[r];
#pragma unroll
    for (int r = 0; r < 16; ++r) ps += p1[r];
    ps = half_sum(ps);
    l_reg = l_reg * alpha + ps;
#define PK4(P, BASE, OUT) do { unsigned a0 = cvtpk(P[BASE + 0], P[BASE + 1]), a1 = cvtpk(P[BASE + 2], P[BASE + 3]);   \
    unsigned b0 = cvtpk(P[BASE + 4], P[BASE + 5]), b1 = cvtpk(P[BASE + 6], P[BASE + 7]);                              \
    auto r0 = __builtin_amdgcn_permlane32_swap(a0, b0, false, false); auto r1 = __builtin_amdgcn_permlane32_swap(a1, b1, false, false); \
    v4u w = {r0[0], r1[0], r0[1], r1[1]}; OUT = __builtin_bit_cast(bf16x8, w); } while (0)
    PK4(p0, 0, pa0); PK4(p0, 8, pa1); PK4(p1, 0, pa2); PK4(p1, 8, pa3);
#undef PK4
    return alpha;
}

__device__ __forceinline__ int diff_radius(float bnat, int h) {
    const float slope_n = exp2f(-(float)(h + 1));
    const float dn = (2.0f * bnat + logf(2.0f / (1.0f - expf(-slope_n))) + 22.18f) / slope_n;
    return (dn < 1.0e6f) ? (int)dn + 1 : 1000000;
}
struct AttnParams { const float* q_gain; const float* sink; const float* lam; const float* norm_gain; float bnat; };
#define KSWZ64(row, colB) ((row) * 128 + ((colB) ^ ((((row) >> 1) & 7) << 4)))

template <int MODE, bool FIXED>
__device__ __forceinline__ void attn_unit(LAS unsigned char* lds, unsigned char* ws, const AttnParams& P, int l, int Tp, int sq, int h, int qb, int part, int np, int pslot, int tid, int wave, int lane) {
    constexpr int NPASS_M = MODE ? 2 : 1, NDD = MODE ? 4 : 8;
    const bf16* PROJ = (const bf16*)(ws + WS_PROJ);
    const int r32 = lane & 31, hi = lane >> 5;
    const int seq0 = sq * Tp, q0 = qb * 256;
    const int qcol = MODE ? C_DQ + h * 128 : C_SQ + h * 128;
    const int kcol = MODE ? C_DK + h * 128 : C_SKV + (h >> 2) * 128;
    const int vcol = MODE ? C_DV + h * 128 : C_SKV + 256 + (h >> 2) * 128;
    const int zcol = MODE ? C_DZ + h * 128 : C_SZ + h * 128;
    int jlo = 0, jhi = Tp / 64;
    const float slope_n = exp2f(-(float)(h + 1)), slope2 = slope_n * LOG2E;
    if (MODE == 0) { jlo = (q0 - 128) / 64; if (jlo < 0) jlo = 0; const int e = (q0 + 384) / 64; if (e < jhi) jhi = e; }
    else {
        float bn = P.bnat; asm volatile("" : "+v"(bn));
        float smin = 1.0e30f;
        { const bf16* qp = PROJ + (size_t)(seq0 + q0 + wave * 32 + r32) * LDP + qcol + hi * 8; const bf16* kp = PROJ + (size_t)(seq0 + q0 + wave * 32 + r32) * LDP + kcol + hi * 8;
#pragma unroll
          for (int mq = 0; mq < 2; ++mq) { float dot = 0.f;
#pragma unroll
              for (int d0 = 0; d0 < 4; ++d0) { const v4u wq = *(const v4u*)(qp + mq * 64 + d0 * 16), wk = *(const v4u*)(kp + mq * 64 + d0 * 16);
                  const float q8[8] = {bflo(wq.x), bfhi(wq.x), bflo(wq.y), bfhi(wq.y), bflo(wq.z), bfhi(wq.z), bflo(wq.w), bfhi(wq.w)};
                  const float k8[8] = {bflo(wk.x), bfhi(wk.x), bflo(wk.y), bfhi(wk.y), bflo(wk.z), bfhi(wk.z), bflo(wk.w), bfhi(wk.w)};
#pragma unroll
                  for (int e = 0; e < 8; ++e) dot += q8[e] * k8[e]; }
              dot = half_sum(dot);
              smin = fminf(smin, dot * (1.0f / LOG2E)); }
          smin = -wave_max(-smin);
          LAS float* sm = (LAS float*)(lds + AT_WS) + 512;
          if (lane == 0) sm[wave] = smin;
          asm volatile("s_waitcnt lgkmcnt(0)" ::: "memory"); __builtin_amdgcn_s_barrier(); asm volatile("" ::: "memory");
          smin = fminf(fminf(fminf(sm[0], sm[1]), fminf(sm[2], sm[3])), fminf(fminf(sm[4], sm[5]), fminf(sm[6], sm[7]))); }
        float beff = 0.5f * (bn - smin + 0.1f); if (!(beff < bn)) beff = bn;
        const int dk = diff_radius(beff, h);
        const int a = q0 - dk; jlo = a > 0 ? (a >> 6) : 0; const int e = ((q0 + 255 + dk) >> 6) + 1; if (e < jhi) jhi = e;
        if (np > 1) { const int len = (jhi - jlo + np - 1) / np; jlo += part * len; const int e2 = jlo + len; if (e2 < jhi) jhi = e2; }
    }
    LAS unsigned char* V_lds = lds + AT_V; LAS unsigned char* K_lds = lds + AT_K;
    LAS float* wsf = (LAS float*)(lds + AT_WS) + wave * 64; LAS float* li_l = wsf; LAS float* al_l = wsf + 32;
    float* park = (float*)(ws + WS_PARK) + (size_t)(blockIdx.x * NWAVES + wave) * 4096 + lane * 4;
    const float qposh = (float)(q0 + wave * 32 + r32 - 4 * hi), qposf = (float)(q0 + wave * 32 + r32);
    const int vb0 = (int)(uintptr_t)V_lds + v_rd_base(lane);
    const int sr = tid >> 4, sc = (tid & 15) * 8, vst0 = v_st(sr, sc), vst1 = v_st(32 + sr, sc);
    const int kr1 = tid >> 3, kc1 = (tid & 7) * 8;
    f32x16 o[4]; float l_reg = 0.f;
#pragma unroll 1
    for (int mp = 0; mp < NPASS_M; ++mp) {
        bf16x8 qr[NDD];
        if (MODE == 1) {
            const bf16* qp = PROJ + (size_t)(seq0 + q0 + wave * 32 + r32) * LDP + qcol + mp * 64 + hi * 8;
#pragma unroll
            for (int d0 = 0; d0 < NDD; ++d0) qr[d0] = *(const bf16x8*)(qp + d0 * 16);
        } else {
            const bf16* qp = PROJ + (size_t)(seq0 + q0 + wave * 32 + r32) * LDP + qcol + mp * 64 + hi * 8;
            float qf[NDD][8]; float ss = 0.f;
#pragma unroll
            for (int d0 = 0; d0 < NDD; ++d0) { const v4u w = *(const v4u*)(qp + d0 * 16);
                qf[d0][0] = bflo(w.x); qf[d0][1] = bfhi(w.x); qf[d0][2] = bflo(w.y); qf[d0][3] = bfhi(w.y); qf[d0][4] = bflo(w.z); qf[d0][5] = bfhi(w.z); qf[d0][6] = bflo(w.w); qf[d0][7] = bfhi(w.w);
#pragma unroll
                for (int e = 0; e < 8; ++e) ss += qf[d0][e] * qf[d0][e]; }
            ss = half_sum(ss);
            const float rs = MODE ? (1.0f / sqrtf(ss * (1.0f / 64.0f) + NORM_EPS)) * (0.125f * LOG2E) : (1.0f / sqrtf(ss * (1.0f / 128.0f) + NORM_EPS)) * (0.08838834764831845f * LOG2E);
#pragma unroll
            for (int d0 = 0; d0 < NDD; ++d0) { const float* g = P.q_gain + d0 * 16 + hi * 8;
                const f32x4 ga = *(const f32x4*)g, gb = *(const f32x4*)(g + 4);
                v4u w; w.x = cvtpk(qf[d0][0] * rs * ga.x, qf[d0][1] * rs * ga.y); w.y = cvtpk(qf[d0][2] * rs * ga.z, qf[d0][3] * rs * ga.w);
                w.z = cvtpk(qf[d0][4] * rs * gb.x, qf[d0][5] * rs * gb.y); w.w = cvtpk(qf[d0][6] * rs * gb.z, qf[d0][7] * rs * gb.w);
                qr[d0] = __builtin_bit_cast(bf16x8, w); }
        }
        float m_reg = (MODE == 0) ? P.sink[h] * LOG2E : -1e30f; l_reg = (MODE == 0) ? (FIXED ? exp2f(P.sink[h] * LOG2E) : 1.f) : 0.f;
#pragma unroll
        for (int d = 0; d < 4; ++d)
#pragma unroll
            for (int r = 0; r < 16; ++r) o[d][r] = 0.f;
        const bf16* Vg = PROJ + (size_t)seq0 * LDP + vcol + sc;
        const bf16* Kg = MODE ? PROJ + (size_t)(seq0 + kr1) * LDP + kcol + mp * 64 + kc1 : PROJ + (size_t)seq0 * LDP + kcol + sc;
        constexpr int DEPTH = 1;
        struct Stg { v4u vs0, vs1, ks0, ks1; };
        Stg sA, sB;
#define SLOAD(S, k0) do { S.vs0 = *(const v4u*)(Vg + (size_t)((k0) + sr) * LDP); S.vs1 = *(const v4u*)(Vg + (size_t)((k0) + 32 + sr) * LDP); \
        if (MODE) { S.ks0 = *(const v4u*)(Kg + (size_t)(k0) * LDP); } \
        else { S.ks0 = *(const v4u*)(Kg + (size_t)((k0) + sr) * LDP); S.ks1 = *(const v4u*)(Kg + (size_t)((k0) + 32 + sr) * LDP); } } while (0)
#define SWRITE(S, b) do { *(LAS v4u*)(V_lds + (b) * 16384 + vst0) = S.vs0; *(LAS v4u*)(V_lds + (b) * 16384 + vst1) = S.vs1; \
        if (MODE) { *(LAS v4u*)(K_lds + (b) * 16384 + KSWZ64(kr1, kc1 * 2)) = S.ks0; } \
        else { *(LAS v4u*)(K_lds + (b) * 16384 + KSWZ(sr, sc * 2)) = S.ks0; *(LAS v4u*)(K_lds + (b) * 16384 + KSWZ(32 + sr, sc * 2)) = S.ks1; } } while (0)
#define TILE(S, jj) do { const int j_ = (jj); const int b_ = (j_ - jlo) & 1; \
            SWRITE(S, b_); \
            if (j_ + DEPTH < jhi) SLOAD(S, (j_ + DEPTH) * 64); \
            asm volatile("s_waitcnt lgkmcnt(0)" ::: "memory"); __builtin_amdgcn_s_barrier(); asm volatile("" ::: "memory"); \
              \
            if (MODE == 1 || (j_ * 64 + 63 >= q0 + wave * 32 - 128 && j_ * 64 <= q0 + wave * 32 + 31 + 128)) { \
            const LAS unsigned char* Kb = K_lds + b_ * 16384; const int vb = vb0 + b_ * 16384; \
            const float fi = qposh - (float)(j_ * 64);                 \
            f32x16 p0, p1; \
            _Pragma("unroll") for (int r = 0; r < 16; ++r) { p0[r] = 0.f; p1[r] = 0.f; } \
            _Pragma("unroll") for (int dd = 0; dd < NDD; ++dd) { const int cb = (dd * 16 + hi * 8) * 2; \
                const bf16x8 b0 = MODE ? *(const LAS bf16x8*)(Kb + KSWZ64(r32, cb)) : *(const LAS bf16x8*)(Kb + KSWZ(r32, cb)); \
                const bf16x8 b1 = MODE ? *(const LAS bf16x8*)(Kb + KSWZ64(32 + r32, cb)) : *(const LAS bf16x8*)(Kb + KSWZ(32 + r32, cb)); \
                p0 = MFMA32(b0, qr[dd], p0); p1 = MFMA32(b1, qr[dd], p1); } \
              \
            const bool lin_ = (MODE == 1) && FIXED && (j_ * 64 + 63 < q0 + wave * 32 || j_ * 64 > q0 + wave * 32 + 31); \
            if (lin_) { const float sg = (j_ * 64 + 63 < q0 + wave * 32) ? 1.f : -1.f, slv = sg * slope2, lcv = -slv * (qposf - (float)(j_ * 64)); \
                const unsigned hw = cvtpk(lcv, slv), lw = cvtpk(lcv - bflo(hw), slv - bfhi(hw)); \
                v4u qx = {(hw & 0xffffu) | (lw << 16), (hw >> 16) | (lw & 0xffff0000u), 0u, 0u}; if (hi) qx = (v4u){0u, 0u, 0u, 0u}; \
                const LAS unsigned char* Kx = K_lds + 8192 + hi * 16; \
                p0 = MFMA32(*(const LAS bf16x8*)(Kx + r32 * 32), __builtin_bit_cast(bf16x8, qx), p0); p1 = MFMA32(*(const LAS bf16x8*)(Kx + (32 + r32) * 32), __builtin_bit_cast(bf16x8, qx), p1); } \
            if (!lin_) { \
            _Pragma("unroll") for (int r = 0; r < 16; ++r) { const float dd0 = fabsf(fi - (float)((r & 3) + 8 * (r >> 2))), dd1 = fabsf(fi - (float)(32 + (r & 3) + 8 * (r >> 2))); \
                p0[r] = fmaf(-slope2, dd0, p0[r]); p1[r] = fmaf(-slope2, dd1, p1[r]); \
                if (MODE == 0) { if (dd0 > 128.f) p0[r] = -INFINITY; if (dd1 > 128.f) p1[r] = -INFINITY; } } } \
            bf16x8 pa0, pa1, pa2, pa3; \
            const float alpha = softmax_tile<FIXED>(p0, p1, m_reg, l_reg, pa0, pa1, pa2, pa3); \
            if (!FIXED && __any(alpha < 1.f)) { if (hi == 0) al_l[r32] = alpha; asm volatile("s_waitcnt lgkmcnt(0)" ::: "memory"); \
                _Pragma("unroll") for (int r = 0; r < 16; ++r) { const float a = al_l[crow(r, hi)]; \
                    _Pragma("unroll") for (int d = 0; d < 4; ++d) o[d][r] *= a; } } \
            SBAR(); pv_d0(o, vb, pa0, pa1, pa2, pa3); } } while (0)
        if (MODE == 1 && tid < 64) {
            const unsigned one2 = 0x3F803F80u, cw = cvtpk((float)tid, (float)tid);
            *(LAS v4u*)(K_lds + 8192 + tid * 32) = (v4u){one2, cw, 0u, 0u}; *(LAS v4u*)(K_lds + 8192 + tid * 32 + 16) = (v4u){0u, 0u, 0u, 0u}; }
        if (jlo < jhi) SLOAD(sA, jlo * 64);
        if (DEPTH == 2 && jlo + 1 < jhi) SLOAD(sB, (jlo + 1) * 64);
#pragma unroll 1
        for (int j = jlo; j < jhi; j += 2) {
            TILE(sA, j);
            if (j + 1 < jhi) { if (DEPTH == 2) TILE(sB, j + 1); else TILE(sA, j + 1); }
        }
#undef TILE
#undef SLOAD
#undef SWRITE
        asm volatile("s_waitcnt lgkmcnt(0)" ::: "memory"); __builtin_amdgcn_s_barrier(); asm volatile("" ::: "memory");
        if (MODE == 1 && pslot >= 0) {
            float* po = (float*)(ws + WS_PART) + ((size_t)(pslot * 2 + mp) * 256 + wave * 32 + 4 * hi) * 128 + r32;
#pragma unroll
            for (int g = 0; g < 4; ++g) { float* pg = po + g * 8 * 128; asm volatile("" : "+v"(pg));
#pragma unroll
                for (int e = 0; e < 4; ++e)
#pragma unroll
                    for (int d = 0; d < 4; ++d) pg[e * 128 + d * 32] = o[d][4 * g + e]; }
            if (hi == 0) ((float*)(ws + WS_PARTL))[(pslot * 2 + mp) * 256 + wave * 32 + r32] = l_reg;
        } else
        if (MODE == 1 && mp == 0) {
            if (hi == 0) li_l[r32] = l_reg;
            asm volatile("s_waitcnt lgkmcnt(0)" ::: "memory");
#pragma unroll
            for (int r4 = 0; r4 < 4; ++r4) { float rl[4];
#pragma unroll
                for (int e = 0; e < 4; ++e) rl[e] = __builtin_amdgcn_rcpf(li_l[crow(4 * r4 + e, hi)]);
#pragma unroll
                for (int d = 0; d < 4; ++d) { f32x4 t; t.x = o[d][4 * r4] * rl[0]; t.y = o[d][4 * r4 + 1] * rl[1]; t.z = o[d][4 * r4 + 2] * rl[2]; t.w = o[d][4 * r4 + 3] * rl[3];
                    *(f32x4*)(park + (d * 4 + r4) * 256) = t; } }
            asm volatile("s_waitcnt lgkmcnt(0)" ::: "memory");
        }
    }
    if (MODE == 1 && pslot >= 0) return;
    float lam = 0.f; int ll_ = l; asm volatile("" : "+s"(ll_)); const float lin = 0.8f - 0.6f * expf(-0.3f * (float)ll_);
    if (MODE == 1) { const float a = P.lam[lane] * P.lam[64 + lane], bq = P.lam[128 + lane] * P.lam[192 + lane]; lam = expf(wave_sum(a)) - expf(wave_sum(bq)) + lin; }
    LAS float* ost = (LAS float*)(lds + AT_OST + wave * AT_OST_W);
    {
        if (hi == 0) li_l[r32] = l_reg;
        asm volatile("s_waitcnt lgkmcnt(0)" ::: "memory");
#pragma unroll
        for (int r4 = 0; r4 < 4; ++r4) { float rl[4];
#pragma unroll
            for (int e = 0; e < 4; ++e) rl[e] = __builtin_amdgcn_rcpf(li_l[crow(4 * r4 + e, hi)]);
#pragma unroll
            for (int d = 0; d < 4; ++d) { f32x4 pk = {0.f, 0.f, 0.f, 0.f}; if (MODE == 1) pk = *(const f32x4*)(park + (d * 4 + r4) * 256);
#pragma unroll
                for (int e = 0; e < 4; ++e) { float v = o[d][4 * r4 + e] * rl[e]; if (MODE == 1) v = pk[e] - lam * v;
                    ost[crow(4 * r4 + e, hi) * 132 + d * 32 + r32] = v; } } }
    }
    asm volatile("s_waitcnt lgkmcnt(0)" ::: "memory");
    {
        const int row = lane >> 1, half = lane & 1;
        const LAS f32x4* src = (const LAS f32x4*)(ost + row * 132 + half * 64);
        float v[64];
#pragma unroll
        for (int k = 0; k < 16; ++k) { const f32x4 t = src[k]; v[4 * k] = t.x; v[4 * k + 1] = t.y; v[4 * k + 2] = t.z; v[4 * k + 3] = t.w; }
        const size_t grow = (size_t)(seq0 + q0 + wave * 32 + row);
        float rs = 1.f;
        if (MODE == 1) { float ss = 0.f;
#pragma unroll
            for (int e = 0; e < 64; ++e) ss += v[e] * v[e];
            ss += xshfl<1>(ss); rs = (1.0f / sqrtf(ss * (1.0f / 128.0f) + NORM_EPS)) * (1.0f - lin); }
        const v4u* zp = (const v4u*)(PROJ + grow * LDP + zcol + half * 64);
        bf16* yb = (bf16*)(ws + WS_Y + (MODE ? 2 : 1) * SZ_Y1) + grow * 1024 + h * 128 + half * 64;
#pragma unroll
        for (int k = 0; k < 8; ++k) { const v4u zw = zp[k];
            const float z[8] = {bflo(zw.x), bfhi(zw.x), bflo(zw.y), bfhi(zw.y), bflo(zw.z), bfhi(zw.z), bflo(zw.w), bfhi(zw.w)};
            float y[8];
#pragma unroll
            for (int e = 0; e < 8; ++e) { float g = 1.f; if (MODE == 1) g = P.norm_gain[half * 64 + 8 * k + e]; y[e] = v[8 * k + e] * rs * g * z[e]; }
            v4u w; w.x = cvtpk(y[0], y[1]); w.y = cvtpk(y[2], y[3]); w.z = cvtpk(y[4], y[5]); w.w = cvtpk(y[6], y[7]);
            *(v4u*)(yb + 8 * k) = w; }
    }
    asm volatile("s_waitcnt lgkmcnt(0)" ::: "memory"); __builtin_amdgcn_s_barrier(); asm volatile("" ::: "memory");
}
#ifndef ONLY_PHASE
#define ONLY_PHASE -1
#endif
#ifndef ONLY_SUB
#define ONLY_SUB -1
#endif
#define PH4_ON(k) (ONLY_SUB < 0 || ONLY_SUB == (k))
#define PH_ON(k) (ONLY_PHASE < 0 || ONLY_PHASE == (k))
#ifndef DUP_PHASE
#define DUP_PHASE -1
#endif
#define NREP(k) ((DUP_PHASE == (k)) ? 2 : 1)
#ifndef DUP_PASSES
#define DUP_PASSES 15
#endif
#ifndef SPLIT_TILES
#define SPLIT_TILES 128
#endif
#ifndef SPLIT_MAX
#define SPLIT_MAX 2
#endif
#ifndef B_SKEW_NS
#define B_SKEW_NS 0
#endif
#ifndef MK_PER_PHASE
#define MK_PER_PHASE 0
#endif
constexpr int N_ITER = DEPTH * NPASS, PH_PER_IT = 7, N_PHASES = 1 + N_ITER * PH_PER_IT;
struct Args { const float* in[17]; float* out; unsigned char* ws; int ph_lo, ph_hi; };
#define WG_SYNC_LDS() do { asm volatile("s_waitcnt lgkmcnt(0)" ::: "memory"); __builtin_amdgcn_s_barrier(); asm volatile("" ::: "memory"); } while (0)

__global__ void __launch_bounds__(NTHREADS, 2) fwd_kernel(Args args) {
    extern __shared__ __attribute__((aligned(16))) unsigned char lds_raw[];
    LAS unsigned char* lds = (LAS unsigned char*)lds_raw;
    volatile LAS unsigned* MISC = (volatile LAS unsigned*)(lds + MISC_OFF);
    const int tid0 = threadIdx.x;
    const int G = gridDim.x, bx = blockIdx.x, ngw = G * NWAVES;
    unsigned char* ws = args.ws;
    unsigned* ctl = (unsigned*)(ws + WS_CTL);
    if (tid0 < 128) MISC[tid0] = 0u;
    __syncthreads();
    XcdBarrier bar; bar.bar = ctl + CW_BAR; bar.x = 0; bar.st = nullptr;
    if (!MK_PER_PHASE) bar = xcd_barrier_post(ctl + CW_BAR, MISC + 8);
    const int lo = args.ph_lo, hi = args.ph_hi;
#define IN(k) (lo <= (k) && (k) < hi)
#define LAUNDER_TID() int tid = tid0; asm volatile("" : "+v"(tid)); const int lane = tid & 63, wave = __builtin_amdgcn_readfirstlane(tid >> 6), gw = bx * NWAVES + wave; (void)lane; (void)gw
#define TBR(i) __builtin_amdgcn_readfirstlane((int)TB[i])
#define T_GT 0
#define T_PB 32
#define T_NPH 40
#define T_NDF 48
#define T_LEN 56
#define DIFF_TABLE(bd_, fixd_) volatile LAS int* TB = (volatile LAS int*)(MISC + 16); do { const int per_ = nseq * (Tp / 256); \
        if (tid0 == 0) { int ps = 0; \
            for (int hh = 7; hh >= 0; --hh) { const int dk = diff_radius((bd_), hh); int ntm = (255 + 2 * dk) / 64 + 2; if (ntm > Tp / 64) ntm = Tp / 64; \
                int np = (fixd_) ? (ntm + SPLIT_TILES - 1) / SPLIT_TILES : 1; if (np > SPLIT_MAX) np = SPLIT_MAX; if (np > 1 && ps + np * per_ > PART_SLOTS) np = 1; \
                TB[T_NPH + hh] = np; TB[T_PB + hh] = (np > 1) ? ps : -1; if (np > 1) ps += np * per_; TB[T_LEN + hh] = (ntm + np - 1) / np; } \
              \
            int g = 0; unsigned done_ = 0u; \
            for (int k = 0; k < 8; ++k) { int best = -1, bl = -1; for (int hh = 7; hh >= 0; --hh) if (!((done_ >> hh) & 1u) && TB[T_LEN + hh] > bl) { bl = TB[T_LEN + hh]; best = hh; } \
                done_ |= 1u << best; const int np = TB[T_NPH + best]; for (int p = 0; p < np; ++p) TB[T_GT + g++] = best | (p << 8) | (np << 16); } \
            TB[T_NDF] = g * per_; } \
        __syncthreads(); } while (0)
#define DIFF_BOUND(bd_) float bd_; { int ln_ = tid0; asm volatile("" : "+v"(ln_)); const int ln = ln_ & 63; const float* dqg_ = diff_q_gain + l * 64; const float* dkg_ = diff_k_gain + l * 64; \
        float gq = fabsf(dqg_[ln]), gk = fabsf(dkg_[ln]); \
        gq = wave_max(gq); gk = wave_max(gk); \
        bd_ = 8.0f * gq * gk * 1.02f; }
#define SEAM(k) do { if (!MK_PER_PHASE && IN(k) && IN((k) + 1)) xcd_barrier(bar); } while (0)

    const __attribute__((address_space(4))) unsigned char* kargs = (const __attribute__((address_space(4))) unsigned char*)__builtin_amdgcn_kernarg_segment_ptr();
#define INP(k) ([&]() { const __attribute__((address_space(4))) unsigned char* kp_ = kargs; asm volatile("" : "+s"(kp_)); return *(const float* const __attribute__((address_space(4)))*)(kp_ + 8 * (k)); }())
#define x_prompt INP(0)
#define x_sample INP(1)
#define norm_gain INP(2)
#define w_in INP(3)
#define conv_w INP(4)
#define a_log INP(5)
#define dt_bias INP(6)
#define gdn_norm_gain INP(7)
#define swa_q_gain INP(8)
#define swa_k_gain INP(9)
#define swa_sink INP(10)
#define diff_q_gain INP(11)
#define diff_k_gain INP(12)
#define diff_lambda INP(13)
#define diff_norm_gain INP(14)
#define w_branch INP(15)
#define w_out INP(16)

    if (PH_ON(0) && IN(0)) for (int rep = 0; rep < NREP(12); ++rep) { LAUNDER_TID(); phase_prologue(lds, w_in, w_branch, w_out, ws, gw, ngw, wave, lane); __syncthreads(); }
    SEAM(0);

    bf16* HN = (bf16*)(ws + WS_HN); bf16* PROJ = (bf16*)(ws + WS_PROJ); bf16* MRG = (bf16*)(ws + WS_MRG);
#pragma unroll 1
    for (int it = 0; it < N_ITER; ++it) {
        const int l = it >> 2, p = it & 3, pb = 1 + it * PH_PER_IT;
        const int Tp = (p < 2) ? 16384 : 4096, nseq = PASS_ROWS / Tp;
#define XIN() ((l == 0) ? ((p < 2) ? x_prompt + (size_t)p * PASS_ROWS * DM : x_sample + (size_t)(p - 2) * PASS_ROWS * DM) : (const float*)args.out + (size_t)p * PASS_ROWS * DM)

        bf16* HNp = HN + (size_t)p * PASS_ROWS * DM; float* RSp = (float*)(ws + WS_ROWSS) + (size_t)l * NTOK + (size_t)p * PASS_ROWS;
        if (PH_ON(1) && IN(pb + 0) && l == 0) { LAUNDER_TID(); const float* xin = XIN(); const float* ng = norm_gain; for (int m = gw; m < PASS_ROWS; m += ngw) rms_row(xin + (size_t)m * DM, ng, HNp + (size_t)m * DM, RSp + m, lane); }
        if (l == 0) SEAM(pb + 0);
        if (PH_ON(2) && IN(pb + 1)) for (int rep = 0; rep < ((DUP_PHASE == 2 || DUP_PHASE == 14 || DUP_PHASE == 16 || DUP_PHASE == 17) ? 2 : 1); ++rep) {
            if (rep) xcd_barrier(bar);
#if B_SKEW_NS > 0
            { const unsigned long long t0 = __builtin_amdgcn_s_memrealtime(), dl = (unsigned long long)((bx >> 3) & 3) * (unsigned long long)(B_SKEW_NS / 10); while (__builtin_amdgcn_s_memrealtime() - t0 < dl) __builtin_amdgcn_s_sleep(4); }
#endif
            pg8::Gemm g{HNp, (const bf16*)(ws + WS_WIN + (size_t)l * SZ_WIN_L), PASS_ROWS, NPROJ, DM}; pg8::StaticOrder S; S.init(PASS_ROWS, NPROJ, G, bx);
#if DUP_PHASE == 14
            if (rep == 1) { pg8::EpiNull EN{}; pg8::gemm_phase<pg8::EpiNull, pg8::StaticOrder, true, true>(lds, g, S, EN); } else
#endif
            {
#if DUP_PHASE == 17
            pg8::EpiProj E{PROJ, LDP, 0, 0, RSp, 1.0f / DM, NORM_EPS, 0, C_DK / 256, C_DK / 256 + 4, diff_k_gain + l * 64};
            if (rep == 0) { E.ldc = 256; E.tstride = (size_t)PASS_ROWS * 256 - 256; }
#else
            pg8::EpiProj E{PROJ, LDP, C_GATE / 256, C_GATE / 256 + 24, RSp, 1.0f / DM, NORM_EPS, C_GATE, C_BA / 256, (0xFull << (C_GZ / 256)) | (0xFull << (C_SZ / 256)) | (0xFull << (C_DZ / 256)), C_DQ / 256, C_DQ / 256 + 4, diff_q_gain + l * 64, 0.125f * LOG2E, C_DK / 256, C_DK / 256 + 4, diff_k_gain + l * 64};
#endif
#if DUP_PHASE == 16
            if (rep == 1) { E.O = (bf16*)(ws + WS_MTMP); E.ldc = 0; }
#endif
            pg8::gemm_phase<pg8::EpiProj, pg8::StaticOrder, true, true>(lds, g, S, E);
            }
        }
        SEAM(pb + 1);
        if (PH_ON(3) && IN(pb + 2)) {
            LAUNDER_TID();
            { const float* cw = conv_w; const float* al = a_log; const float* db = dt_bias;
              for (int rep = 0; rep < NREP(3); ++rep) {
                  unsigned pre_ba = 0u;
                  if (tid < 128 && bx < 2048) { const int d = tid >> 6, r = tid & 63, c = d ? 63 - r : r; const bf16* pn = PROJ + (size_t)((bx >> 3) * 64 + c) * LDP + C_BA;
                      pre_ba = (unsigned)pn[d * 8 + (bx & 7)] | ((unsigned)pn[16 + d * 8 + (bx & 7)] << 16); }
                  for (int u = bx; u < 2048; u += G) { const int un = u + G; gdn_prep_unit(lds, ws, cw, al, db, l, Tp, u >> 3, u & 7, un < 2048 ? (un >> 3) : -1, un & 7, pre_ba, tid, wave, lane); } } }
            { const float* skg = swa_k_gain + l * 128; const float* dkg = diff_k_gain + l * 64;
              for (int m = gw; m < PASS_ROWS; m += ngw) knorm_row<false>(PROJ + (size_t)m * LDP, skg, dkg, lane); }
        }
        SEAM(pb + 2);
#if DUP_PHASE == 10
        for (int xb = 0; xb < 5; ++xb) xcd_barrier(bar);
#endif
        if (PH_ON(4) && IN(pb + 3)) for (int rep = 0; rep < (((DUP_PHASE == 4 || DUP_PHASE == 5 || DUP_PHASE == 8 || DUP_PHASE == 9 || DUP_PHASE == 11) && (DUP_PASSES >> p & 1)) ? 2 : 1); ++rep) {
            if (rep) xcd_barrier(bar);
            const int nchain = nseq * 32, nqb = Tp / 256, nblk = nseq * 8 * nqb;
            float bd, bs;
            const float* dqg = diff_q_gain + l * 64; const float* sqg = swa_q_gain + l * 128;
            { int ln_ = tid0; asm volatile("" : "+v"(ln_)); const int ln = ln_ & 63; const float* dkg = diff_k_gain + l * 64; const float* skg = swa_k_gain + l * 128;
              float gq = fabsf(dqg[ln]), gk = fabsf(dkg[ln]);
              float sq_ = fmaxf(fabsf(sqg[ln]), fabsf(sqg[64 + ln])), sk_ = fmaxf(fabsf(skg[ln]), fabsf(skg[64 + ln]));
              gq = wave_max(gq); gk = wave_max(gk); sq_ = wave_max(sq_); sk_ = wave_max(sk_);
              bd = 8.0f * gq * gk * 1.02f; bs = 11.3137085f * sq_ * sk_ * 1.02f; }
            const bool fixd = (bd * LOG2E < 60.f) && (bd == bd), fixs = (bs * LOG2E < 60.f) && (bs == bs);
#define UNIFORM_F(x) __builtin_bit_cast(float, __builtin_amdgcn_readfirstlane(__builtin_bit_cast(int, (float)(x))))
            AttnParams PD{dqg, nullptr, diff_lambda + l * 256, diff_norm_gain + l * 128, UNIFORM_F(bd)};
            AttnParams PS{sqg, swa_sink + l * 8, nullptr, nullptr, UNIFORM_F(bs)};
            DIFF_TABLE(bd, fixd);
            const int ndiff = TBR(T_NDF);
            const int item_lo = (rep == 1 && (DUP_PHASE == 8 || DUP_PHASE == 11)) ? nchain : ((rep == 1 && DUP_PHASE == 9) ? nchain + ndiff : 0);
            const int total = (rep == 1 && DUP_PHASE == 5) ? nchain : ((rep == 1 && (DUP_PHASE == 8 || DUP_PHASE == 11)) ? nchain + ndiff : nchain + ndiff + nblk);
#pragma unroll 1
            for (;;) {
                LAUNDER_TID();
                if (tid == 0) MISC[0] = __hip_atomic_fetch_add(ctl + CW_QUEUE + it * 64 + rep * 32, 1u, __ATOMIC_RELAXED, __HIP_MEMORY_SCOPE_AGENT);
                __syncthreads();
                const int item = __builtin_amdgcn_readfirstlane((int)MISC[0]) + item_lo;
                __syncthreads();
                if (item >= total) break;
                if (PH4_ON(0) && item < nchain) { gdn_scan_unit(lds, ws, Tp, item >> 5, (item >> 2) & 7, (item >> 1) & 1, item & 1, tid, wave, lane); }
                else if (PH4_ON(1) && item < nchain + ndiff) { const int u = item - nchain, per = nseq * nqb;
                    const int g = u / per, un = u - g * per, e = TBR(T_GT + g), hh = e & 0xff, part = (e >> 8) & 0xff, np = e >> 16, sq = un / nqb, qb = un - sq * nqb;
                    const int pslot = (np > 1) ? TBR(T_PB + hh) + un * np + part : -1;
                    const bool pe_ = (DUP_PHASE == 11 && rep == 1);
                    if (fixd) attn_unit<1, true>(lds, ws, PD, l, Tp, sq, hh, qb, pe_ ? 999999 : part, pe_ ? 1000000 : np, pe_ ? PART_SLOTS - 1 : pslot, tid, wave, lane); else if (DUP_PHASE < 0) attn_unit<1, false>(lds, ws, PD, l, Tp, sq, hh, qb, 0, 1, -1, tid, wave, lane); }
                else if (PH4_ON(2)) { const int u = item - nchain - ndiff;
                    if (fixs) attn_unit<0, true>(lds, ws, PS, l, Tp, u / (8 * nqb), (u / nqb) & 7, u % nqb, 0, 1, -1, tid, wave, lane); else attn_unit<0, false>(lds, ws, PS, l, Tp, u / (8 * nqb), (u / nqb) & 7, u % nqb, 0, 1, -1, tid, wave, lane); }
                __syncthreads();
            }
        }
        SEAM(pb + 3);
        if (PH_ON(5) && IN(pb + 4)) for (int rep = 0; rep < NREP(13); ++rep) {
            if (rep) xcd_barrier(bar);
            LAUNDER_TID();
            const bf16* OD = (const bf16*)(ws + WS_ODIR);
            const float* gng = gdn_norm_gain + l * 128;
            for (int m = gw; m < PASS_ROWS; m += ngw)
                gdn_final_row(OD + (size_t)m * 1024, OD + (size_t)(PASS_ROWS + m) * 1024, PROJ + (size_t)m * LDP + C_GZ, gng, (bf16*)(ws + WS_Y) + (size_t)m * 1024, lane);
            { DIFF_BOUND(bdf); const bool fixf = (bdf * LOG2E < 60.f) && (bdf == bdf);
              DIFF_TABLE(bdf, fixf);
              const float* dl = diff_lambda + l * 256; const float* dng = diff_norm_gain + l * 128;
              const float lin = 0.8f - 0.6f * expf(-0.3f * (float)l);
              const float lam = expf(wave_sum(dl[lane] * dl[64 + lane])) - expf(wave_sum(dl[128 + lane] * dl[192 + lane])) + lin;
              const int nqb = Tp / 256;
              for (int hh = 7; hh >= 0; --hh) { const int np = TBR(T_NPH + hh); if (np <= 1) continue; const int pb0 = TBR(T_PB + hh);
                  for (int m = gw; m < PASS_ROWS; m += ngw) { const int sq = m / Tp, t = m - sq * Tp, qb = t >> 8, rr = t & 255;
                      diff_final_row(ws, pb0 + (sq * nqb + qb) * np, np, rr, lam, lin, PROJ + (size_t)m * LDP + C_DZ + hh * 128, dng, (bf16*)(ws + WS_Y + 2 * SZ_Y1) + (size_t)m * 1024 + hh * 128, lane); } } }
        }
        SEAM(pb + 4);
        if (PH_ON(6) && IN(pb + 5)) for (int rep = 0; rep < ((DUP_PHASE == 6 || DUP_PHASE == 15) ? 2 : 1); ++rep) {
            if (rep) xcd_barrier(bar);
            pg8::MergeOrder S; S.S.init(PASS_ROWS, DM, G, bx);
            pg8::Gemm g{(const bf16*)(ws + WS_Y), (const bf16*)(ws + WS_WBR + (size_t)(l * 3) * SZ_WBR_1), 3 * PASS_ROWS, 3 * DM, 1024};
#if DUP_PHASE == 15
            if (rep == 1) { pg8::EpiNull EN{}; pg8::gemm_phase<pg8::EpiNull, pg8::MergeOrder, true, true>(lds, g, S, EN); } else
#endif
            { pg8::EpiMerge E{(const unsigned char*)(PROJ + C_GATE), LDP * 2, (bf16*)(ws + WS_MTMP), DM, MRG, DM};
              pg8::gemm_phase<pg8::EpiMerge, pg8::MergeOrder, true, true>(lds, g, S, E); }
        }
        SEAM(pb + 5);
        if (PH_ON(7) && IN(pb + 6)) for (int rep = 0; rep < ((l == 0) ? NREP(7) : 1); ++rep) {
            if (rep) xcd_barrier(bar);
            pg8::Gemm g{MRG, (const bf16*)(ws + WS_WOUT + (size_t)l * SZ_WOUT_L), PASS_ROWS, DM, DM}; pg8::StaticOrder S; S.init(PASS_ROWS, DM, G, bx);
            pg8::EpiOut E{XIN(), args.out + (size_t)p * PASS_ROWS * DM, DM, (l + 1 < DEPTH) ? norm_gain + (l + 1) * DM : (const float*)nullptr, HNp, (float*)(ws + WS_ROWSS) + (size_t)(l + 1 < DEPTH ? l + 1 : l) * NTOK + (size_t)p * PASS_ROWS};
            pg8::gemm_phase<pg8::EpiOut, pg8::StaticOrder, true, true>(lds, g, S, E);
        }
    }
#undef IN
#undef SEAM
#undef TBR
#undef T_GT
#undef T_PB
#undef T_NPH
#undef T_NDF
#undef T_LEN
#undef DIFF_TABLE
#undef DIFF_BOUND
#undef XIN
#undef x_prompt
#undef x_sample
#undef norm_gain
#undef w_in
#undef conv_w
#undef a_log
#undef dt_bias
#undef gdn_norm_gain
#undef swa_q_gain
#undef swa_k_gain
#undef swa_sink
#undef diff_q_gain
#undef diff_k_gain
#undef diff_lambda
#undef diff_norm_gain
#undef w_branch
#undef w_out
#undef INP
}

extern "C" void kernel_launch(void* const* d_in, const int* in_sizes, int n_in, void* d_out, int out_size, void* d_ws, size_t ws_size, hipStream_t stream) {
    static int grid = 0;
    if (grid == 0) {
        if (n_in != 17 || in_sizes[0] != 2 * 16384 * DM || in_sizes[1] != 8 * 4096 * DM || out_size != NTOK * DM || ws_size < WS_END) {
            fprintf(stderr, "kernel_launch: shape mismatch (n_in %d, in0 %d, in1 %d, out %d, ws %zu, need %zu); nothing launched\n", n_in, n_in > 0 ? in_sizes[0] : -1, n_in > 1 ? in_sizes[1] : -1, out_size, ws_size, (size_t)WS_END);
            grid = -1; return; }
        int dev = 0, cus = 0, per_cu = 0;
        if (hipGetDevice(&dev) != hipSuccess || hipDeviceGetAttribute(&cus, hipDeviceAttributeMultiprocessorCount, dev) != hipSuccess) { fprintf(stderr, "kernel_launch: device query failed\n"); grid = -1; return; }
        if (hipFuncSetAttribute((const void*)fwd_kernel, hipFuncAttributeMaxDynamicSharedMemorySize, LDS_BYTES) != hipSuccess) { fprintf(stderr, "kernel_launch: hipFuncSetAttribute(%d B LDS) failed\n", LDS_BYTES); grid = -1; return; }
        if (hipOccupancyMaxActiveBlocksPerMultiprocessor(&per_cu, (const void*)fwd_kernel, NTHREADS, LDS_BYTES) != hipSuccess || per_cu < 1)
            fprintf(stderr, "kernel_launch: note: occupancy query reports %d workgroups per CU\n", per_cu);
        (void)hipGetLastError();
        grid = cus;
    }
    if (grid < 0) return;
    if (hipMemsetAsync((char*)d_ws + WS_CTL, 0, CTL_ZERO_BYTES, stream) != hipSuccess) { fprintf(stderr, "kernel_launch: memset failed\n"); return; }
    Args a{};
    for (int i = 0; i < 17; ++i) a.in[i] = (const float*)d_in[i];
    a.out = (float*)d_out; a.ws = (unsigned char*)d_ws;
#if MK_PER_PHASE
    for (int k = 0; k < N_PHASES; ++k) { a.ph_lo = k; a.ph_hi = k + 1; hipLaunchKernelGGL(fwd_kernel, dim3(grid), dim3(NTHREADS), LDS_BYTES, stream, a); }
#else
    a.ph_lo = 0; a.ph_hi = N_PHASES;
    hipLaunchKernelGGL(fwd_kernel, dim3(grid), dim3(NTHREADS), LDS_BYTES, stream, a);
#endif
    const hipError_t le = hipPeekAtLastError();
    if (le != hipSuccess) fprintf(stderr, "kernel_launch: launch failed: %s\n", hipGetErrorName(le));
}
```

```cpp
#include <hip/hip_runtime.h>
#include <cstdio>
#include <cstdint>
namespace pg8 {
#define PG8_LAS __attribute__((address_space(3)))
typedef unsigned short bf16_t;
typedef short bf16x8 __attribute__((ext_vector_type(8)));
typedef float f32x4 __attribute__((ext_vector_type(4)));
typedef unsigned u32x4 __attribute__((ext_vector_type(4)));
constexpr int BM = 256, BK = 64, HALF = 128, HTB = HALF * BK * 2  , STAGE_BYTES = 8 * HTB, NXCD = 8, WGM = 4;

__host__ __device__ __forceinline__ int lds_byte(int r, int c) { const int st = (r >> 4) * 2 + (c >> 5), rr = r & 15, cc = c & 31, ob = rr * 64 + cc * 2; return st * 1024 + (ob ^ (((ob >> 9) & 1) << 5)); }
__host__ __device__ __forceinline__ void stage_rc(int b, int& R, int& C) { const int st = b / 1024, sb = b % 1024, swz = sb ^ (((sb >> 9) & 1) << 5); R = (st >> 1) * 16 + swz / 64; C = (st & 1) * 32 + (swz % 64) / 2; }
__host__ __device__ __forceinline__ int perm32(int rho) { const int n = rho >> 4, i = rho & 15; return 8 * (i >> 2) + 4 * n + (i & 3); }

struct Unit { int pm, pn; };
struct Gemm { const bf16_t* A; const bf16_t* Bt; int M, N, K; };

struct StaticOrder {
    int nM, nN, nwg, G, c;
    __host__ __device__ void init(int M, int N, int G_, int c_) { nM = M / BM; nN = N / BM; nwg = nM * nN; G = G_; c = c_; }
    __host__ __device__ bool next(int i, Unit& u) const {
        const long L = (long)i * G + c; if (L >= nwg) return false;
        int wgid = (int)L; { const int q = nwg / NXCD, r = nwg % NXCD, xcd = wgid % NXCD, off = wgid / NXCD; wgid = (xcd < r ? xcd * (q + 1) : r * (q + 1) + (xcd - r) * q) + off; }
        const int nig = WGM * nN, gid = wgid / nig, fm = gid * WGM, gsz = (nM - fm) < WGM ? (nM - fm) : WGM;
        u.pm = fm + ((wgid % nig) % gsz); u.pn = (wgid % nig) / gsz; return true;
    }
    __device__ __forceinline__ void a_ready(const Unit&) const {}
    __device__ __forceinline__ void done(const Unit&) const {}
};

typedef float f32x2_c __attribute__((ext_vector_type(2)));
typedef unsigned u32x2 __attribute__((ext_vector_type(2)));
typedef __bf16 bf16x2_c __attribute__((ext_vector_type(2)));
__device__ __forceinline__ unsigned cvt_pk_bf16(float lo, float hi) { const f32x2_c v = {lo, hi}; const bf16x2_c b = __builtin_convertvector(v, bf16x2_c); return __builtin_bit_cast(unsigned, b); }
__device__ __forceinline__ float sigmoid_f(float v) { return __builtin_amdgcn_rcpf(1.0f + __builtin_amdgcn_exp2f(-1.4426950408889634f * v)); }
__device__ __forceinline__ float bflo(unsigned w) { return __uint_as_float(w << 16); }
__device__ __forceinline__ float bfhi(unsigned w) { return __uint_as_float(w & 0xffff0000u); }

struct EpiProj {
    static constexpr bool PERM = true, AFTER_DRAIN = false;
    bf16_t* O; int ldc; int sig_lo, sig_hi; const float* rowss; float inv_d, eps;
#if DUP_PHASE == 17
    size_t tstride;
#endif
    int sig_col0;
    int ba_tile;
    unsigned long long ztiles;
    int qn_lo, qn_hi; const float* qgain; float qscale;
    int kn_lo, kn_hi; const float* kgain;
    __device__ __forceinline__ void operator()(const f32x4 (&acc)[2][2][4][2], const Unit& u, int wr, int wc, int fr, int fq) const {
        const int row0 = u.pm * BM + wr * 64 + fr, col0 = u.pn * BM + wc * 64 + 8 * fq;
        const bool sig = (u.pn >= sig_lo) && (u.pn < sig_hi);
        const bool qn = (u.pn >= qn_lo) && (u.pn < qn_hi);
        const bool kn = qn || ((u.pn >= kn_lo) && (u.pn < kn_hi));
        const float* ngain = qn ? qgain : kgain; const float nsc = qn ? qscale : 1.0f;
        const bool zt = (u.pn < 64) && ((ztiles >> u.pn) & 1ull);
        const bool ba = (u.pn == ba_tile);
        if (ba && wc != 0) return;
        f32x4 kg[2][2];
#pragma unroll
        for (int bj = 0; bj < 2; ++bj)
#pragma unroll
            for (int n = 0; n < 2; ++n) kg[bj][n] = kn ? *(const f32x4*)(ngain + bj * 32 + 8 * fq + 4 * n) * nsc : (f32x4){1.f, 1.f, 1.f, 1.f};
        float rs[2][4];
#pragma unroll
        for (int ai = 0; ai < 2; ++ai)
#pragma unroll
            for (int m = 0; m < 4; ++m) rs[ai][m] = rowss[row0 + ai * HALF + m * 16];
#pragma unroll
        for (int ai = 0; ai < 2; ++ai)
#pragma unroll
            for (int m = 0; m < 4; ++m) { const int row = row0 + ai * HALF + m * 16; bf16_t* rowp = O + (size_t)row * ldc + col0;
#if DUP_PHASE == 17
                rowp += (size_t)u.pn * tstride;
#endif
                const float rstd = __builtin_amdgcn_rsqf(rs[ai][m] * inv_d + eps);
                f32x4 v[2][2];
#pragma unroll
                for (int bj = 0; bj < 2; ++bj) { v[bj][0] = acc[ai][bj][m][0] * rstd; v[bj][1] = acc[ai][bj][m][1] * rstd; }
                if (kn) {
                    float ss = 0.f;
#pragma unroll
                    for (int bj = 0; bj < 2; ++bj)
#pragma unroll
                        for (int n = 0; n < 2; ++n)
#pragma unroll
                            for (int j = 0; j < 4; ++j) ss += v[bj][n][j] * v[bj][n][j];
                    ss += __builtin_bit_cast(float, __builtin_amdgcn_ds_swizzle(__builtin_bit_cast(int, ss), 0x1F | (16 << 10)));
                    ss += __shfl_xor(ss, 32);
                    const float rk = __builtin_amdgcn_rsqf(ss * (1.0f / 64.0f) + eps);
#pragma unroll
                    for (int bj = 0; bj < 2; ++bj)
#pragma unroll
                        for (int n = 0; n < 2; ++n) v[bj][n] = v[bj][n] * rk * kg[bj][n];
                }
                if (zt) {
#pragma unroll
                    for (int bj = 0; bj < 2; ++bj)
#pragma unroll
                        for (int n = 0; n < 2; ++n)
#pragma unroll
                            for (int j = 0; j < 4; ++j) v[bj][n][j] *= sigmoid_f(v[bj][n][j]);
                }
                if (sig) {
                    unsigned char* rowb = (unsigned char*)(O + (size_t)row * ldc + sig_col0) + (u.pn * BM + wc * 64 + 16 * fq - sig_col0);
                    u32x4 w;
#pragma unroll
                    for (int bj = 0; bj < 2; ++bj)
#pragma unroll
                        for (int n = 0; n < 2; ++n) { unsigned pk = 0u;
#pragma unroll
                            for (int j = 0; j < 4; ++j) pk = __builtin_amdgcn_cvt_pk_u8_f32(__builtin_floorf(sigmoid_f(v[bj][n][j]) * 255.0f + 0.5f), j, pk);
                            w[bj * 2 + n] = pk; }
                    __builtin_nontemporal_store(w, (u32x4*)rowb);
                } else {
#pragma unroll
                for (int bj = 0; bj < 2; ++bj) { f32x4 v0 = v[bj][0], v1 = v[bj][1];
                    if (ba && bj == 1) continue;
                    u32x4 w; w.x = cvt_pk_bf16(v0[0], v0[1]); w.y = cvt_pk_bf16(v0[2], v0[3]); w.z = cvt_pk_bf16(v1[0], v1[1]); w.w = cvt_pk_bf16(v1[2], v1[3]);
                    __builtin_nontemporal_store(w, (u32x4*)(rowp + bj * 32)); } } }
    }
};
struct EpiNull {
    static constexpr bool PERM = true, AFTER_DRAIN = false;
    __device__ __forceinline__ void operator()(const f32x4 (&acc)[2][2][4][2], const Unit& u, int wr, int wc, int fr, int fq) const {
        float s = 0.f;
#pragma unroll
        for (int a = 0; a < 2; ++a)
#pragma unroll
            for (int b = 0; b < 2; ++b)
#pragma unroll
                for (int m = 0; m < 4; ++m)
#pragma unroll
                    for (int n = 0; n < 2; ++n) s += acc[a][b][m][n][0];
        asm volatile("" :: "v"(s));
    }
};
struct EpiMerge {
    static constexpr bool PERM = true, AFTER_DRAIN = false;
    static constexpr int MB = 4;
    const unsigned char* G; int ldg; bf16_t* T; int ldt; bf16_t* O; int ldo;
    __device__ __forceinline__ void operator()(const f32x4 (&acc)[2][2][4][2], const Unit& u, int wr, int wc, int fr, int fq) const {
        const int n = u.pm >> 6, pm = u.pm & 63, pn = u.pn & 7;
        const int row0 = pm * BM + wr * 64 + fr, col0 = pn * BM + wc * 32 + 8 * fq;
        const unsigned char* Gn = G + n * 2048;
#pragma unroll
        for (int ai = 0; ai < 2; ++ai)
#pragma unroll
            for (int m2 = 0; m2 < 4; m2 += MB) {
                u32x2 gw[MB][2]; u32x4 tw[MB][2];
#pragma unroll
                for (int mm = 0; mm < MB; ++mm)
#pragma unroll
                    for (int bj = 0; bj < 2; ++bj) { const size_t row = (size_t)(row0 + ai * HALF + (m2 + mm) * 16); const int col = col0 + bj * HALF;
                        gw[mm][bj] = *(const u32x2*)(Gn + row * ldg + col); if (n >= 1) tw[mm][bj] = *(const u32x4*)(T + row * ldt + col); else tw[mm][bj] = (u32x4){0u, 0u, 0u, 0u}; }
#pragma unroll
                for (int mm = 0; mm < MB; ++mm)
#pragma unroll
                    for (int bj = 0; bj < 2; ++bj) { const int m = m2 + mm; const size_t row = (size_t)(row0 + ai * HALF + m * 16); const int col = col0 + bj * HALF;
                        const u32x2 g = gw[mm][bj]; const u32x4 t = tw[mm][bj];
                        const float qs = 1.0f / 255.0f;
                        f32x4 v0 = acc[ai][bj][m][0], v1 = acc[ai][bj][m][1];
                        v0[0] = v0[0] * ((float)(g.x & 0xffu) * qs) + bflo(t.x); v0[1] = v0[1] * ((float)((g.x >> 8) & 0xffu) * qs) + bfhi(t.x); v0[2] = v0[2] * ((float)((g.x >> 16) & 0xffu) * qs) + bflo(t.y); v0[3] = v0[3] * ((float)(g.x >> 24) * qs) + bfhi(t.y);
                        v1[0] = v1[0] * ((float)(g.y & 0xffu) * qs) + bflo(t.z); v1[1] = v1[1] * ((float)((g.y >> 8) & 0xffu) * qs) + bfhi(t.z); v1[2] = v1[2] * ((float)((g.y >> 16) & 0xffu) * qs) + bflo(t.w); v1[3] = v1[3] * ((float)(g.y >> 24) * qs) + bfhi(t.w);
                        u32x4 w; w.x = cvt_pk_bf16(v0[0], v0[1]); w.y = cvt_pk_bf16(v0[2], v0[3]); w.z = cvt_pk_bf16(v1[0], v1[1]); w.w = cvt_pk_bf16(v1[2], v1[3]);
                        if (n <= 1) *(u32x4*)(T + row * ldt + col) = w; else *(u32x4*)(O + row * ldo + col) = w; }
                asm volatile("" ::: "memory"); }
    }
};
struct MergeOrder {
    StaticOrder S;
    __device__ __forceinline__ bool next(int i, Unit& u) const { const int ou = i / 3, n = i - ou * 3; Unit v; if (!S.next(ou, v)) return false; u.pm = n * 64 + v.pm; u.pn = n * 8 + v.pn; return true; }
    __device__ __forceinline__ void a_ready(const Unit&) const {}
    __device__ __forceinline__ void done(const Unit&) const {}
};
struct EpiOut {
    static constexpr bool PERM = false, AFTER_DRAIN = false;
    const float* base; float* out; int ldc; const float* gain_next; bf16_t* hn; float* rowss;
    __device__ __forceinline__ void operator()(const f32x4 (&acc)[2][2][4][2], const Unit& u, int wr, int wc, int fr, int fq) const {
        const int row0 = u.pm * BM + wr * 64 + fr, col0 = u.pn * BM + wc * 32 + 4 * fq;
        f32x4 gn[2][2];
        if (gain_next) {
#pragma unroll
            for (int bj = 0; bj < 2; ++bj)
#pragma unroll
                for (int n = 0; n < 2; ++n) gn[bj][n] = *(const f32x4*)(gain_next + col0 + bj * HALF + n * 16); }
#pragma unroll
        for (int ai = 0; ai < 2; ++ai)
#pragma unroll
            for (int m2 = 0; m2 < 4; m2 += 2) {
                f32x4 bb[2][2][2];
#pragma unroll
                for (int mm = 0; mm < 2; ++mm)
#pragma unroll
                    for (int bj = 0; bj < 2; ++bj)
#pragma unroll
                        for (int n = 0; n < 2; ++n) bb[mm][bj][n] = *(const f32x4*)(base + (size_t)(row0 + ai * HALF + (m2 + mm) * 16) * ldc + col0 + bj * HALF + n * 16);
#pragma unroll
                for (int mm = 0; mm < 2; ++mm) { const int m = m2 + mm; const int row = row0 + ai * HALF + m * 16; const size_t off = (size_t)row * ldc + col0; float ss = 0.f;
#pragma unroll
                    for (int bj = 0; bj < 2; ++bj)
#pragma unroll
                        for (int n = 0; n < 2; ++n) { const f32x4 x = bb[mm][bj][n] + acc[ai][bj][m][n]; *(f32x4*)(out + off + bj * HALF + n * 16) = x;
                            if (gain_next) { const f32x4 g = gn[bj][n]; ss += (x[0] * x[0] + x[1] * x[1]) + (x[2] * x[2] + x[3] * x[3]);
                                u32x2 w; w.x = cvt_pk_bf16(x[0] * g[0], x[1] * g[1]); w.y = cvt_pk_bf16(x[2] * g[2], x[3] * g[3]); *(u32x2*)(hn + off + bj * HALF + n * 16) = w; } }
                    if (gain_next) {
                        ss += __builtin_bit_cast(float, __builtin_amdgcn_ds_swizzle(__builtin_bit_cast(int, ss), 0x1F | (16 << 10)));
                        ss += __shfl_xor(ss, 32);
                        if (fq == 0) __hip_atomic_fetch_add(rowss + row, ss, __ATOMIC_RELAXED, __HIP_MEMORY_SCOPE_AGENT); } }
                asm volatile("" ::: "memory"); }
    }
};

template <class Epi, class Sched, bool ALIGN_EPI = false, bool SP2 = false>
__device__ __forceinline__ void gemm_phase(PG8_LAS unsigned char* lds, const Gemm g, const Sched& S, const Epi& E) {
    int tid_ = threadIdx.x; asm volatile("" : "+v"(tid_));
    const int tid = tid_, wid = __builtin_amdgcn_readfirstlane(tid >> 6), lane = tid & 63, wr = wid >> 2, wc = wid & 3, fr = lane & 15, fq = lane >> 4;
    const int K = g.K, nt = K / BK;
    unsigned voffA[2], voffB[2];
#pragma unroll
    for (int i = 0; i < 2; ++i) { int R, C; stage_rc(tid * 16 + i * 8192, R, C); const int Rb = Epi::PERM ? ((R & ~31) + perm32(R & 31)) : R;
        voffA[i] = (unsigned)(R * K + C) * 2u; voffB[i] = (unsigned)(Rb * K + C) * 2u; }
    const size_t kstep = (size_t)(BK * 2);
    const size_t hstep = (size_t)HALF * K * 2;
    const size_t tstep = 2 * hstep;
    const unsigned ldsw = (unsigned)wid * 1024u;
    const int aoff = lds_byte(wr * 64 + fr, fq * 8), boff = lds_byte(wc * 32 + fr, fq * 8);
#define PG8_SA(b, h) (((b) * 2 + (h)) * HTB)
#define PG8_SB(b, h) ((4 + (b) * 2 + (h)) * HTB)
#define PG8_STAGE(bufoff, gbase, voff) do { _Pragma("unroll") for (int _i = 0; _i < 2; ++_i) \
        __builtin_amdgcn_global_load_lds((const unsigned*)((const char*)(gbase) + (voff)[_i]), (PG8_LAS unsigned*)(lds + (bufoff) + ldsw + _i * 8192), 16, 0, 0); } while (0)
#define PG8_LDA(dst, b, h) do { _Pragma("unroll") for (int m = 0; m < 4; ++m) _Pragma("unroll") for (int k = 0; k < 2; ++k) dst[m][k] = *(const PG8_LAS bf16x8*)(lds + PG8_SA(b, h) + aoff + m * 2048 + k * 1024); } while (0)
#define PG8_LDB(dst, b, h) do { _Pragma("unroll") for (int n = 0; n < 2; ++n) _Pragma("unroll") for (int k = 0; k < 2; ++k) dst[n][k] = *(const PG8_LAS bf16x8*)(lds + PG8_SB(b, h) + boff + n * 2048 + k * 1024); } while (0)
#define PG8_MMA(ai, bj, At, Bt) do { __builtin_amdgcn_s_setprio(1); _Pragma("unroll") for (int m = 0; m < 4; ++m) _Pragma("unroll") for (int n = 0; n < 2; ++n) _Pragma("unroll") for (int k = 0; k < 2; ++k) \
        acc[ai][bj][m][n] = __builtin_amdgcn_mfma_f32_16x16x32_bf16(Bt[n][k], At[m][k], acc[ai][bj][m][n], 0, 0, 0); __builtin_amdgcn_s_setprio(0); } while (0)
#define PG8_WAIT_V(n) asm volatile("s_waitcnt vmcnt(" #n ")" ::: "memory")
#define PG8_WAIT_L(n) asm volatile("s_waitcnt lgkmcnt(" #n ")" ::: "memory")
#define PG8_BAR __builtin_amdgcn_s_barrier()
#define PG8_SCHED __builtin_amdgcn_sched_barrier(0)
    Unit cur, nxt; int ui = 0;
    if (!S.next(0, cur)) return;
    f32x4 acc[2][2][4][2];
#pragma unroll
    for (int a = 0; a < 2; ++a)
#pragma unroll
        for (int b = 0; b < 2; ++b)
#pragma unroll
            for (int m = 0; m < 4; ++m)
#pragma unroll
                for (int n = 0; n < 2; ++n) acc[a][b][m][n] = (f32x4){0.f, 0.f, 0.f, 0.f};
    bf16x8 At[4][2], B0[2][2], B1[2][2];
    const char* cA = (const char*)g.A + (size_t)cur.pm * tstep; const char* cB = (const char*)g.Bt + (size_t)cur.pn * tstep;
    S.a_ready(cur);
    if constexpr (SP2) {
        PG8_STAGE(PG8_SB(0, 0), cB, voffB); PG8_STAGE(PG8_SB(0, 1), cB + hstep, voffB); PG8_STAGE(PG8_SA(0, 0), cA, voffA); PG8_STAGE(PG8_SA(0, 1), cA + hstep, voffA);
        if (wr == 1) PG8_BAR;
        PG8_WAIT_V(2); PG8_BAR;
        PG8_STAGE(PG8_SB(1, 0), cB + kstep, voffB); PG8_STAGE(PG8_SA(1, 0), cA + kstep, voffA); PG8_STAGE(PG8_SB(1, 1), cB + hstep + kstep, voffB);
        PG8_WAIT_V(6); PG8_BAR;
    } else {
        PG8_STAGE(PG8_SB(0, 0), cB, voffB); PG8_STAGE(PG8_SA(0, 0), cA, voffA); PG8_STAGE(PG8_SB(0, 1), cB + hstep, voffB); PG8_STAGE(PG8_SA(0, 1), cA + hstep, voffA);
        if (wr == 1) PG8_BAR;
        PG8_WAIT_V(4); PG8_BAR;
        PG8_STAGE(PG8_SB(1, 0), cB + kstep, voffB); PG8_STAGE(PG8_SA(1, 0), cA + kstep, voffA); PG8_STAGE(PG8_SB(1, 1), cB + hstep + kstep, voffB);
        PG8_WAIT_V(6); PG8_BAR;
    }
    for (;;) {
        const bool has_next = S.next(ui + 1, nxt);
        const char* nA = has_next ? (const char*)g.A + (size_t)nxt.pm * tstep : cA; const char* nB = has_next ? (const char*)g.Bt + (size_t)nxt.pn * tstep : cB;
        for (int t = 0; t < nt; t += 2) {
            const bool last = (t == nt - 2);
            const char* a1 = cA + (size_t)(t + 1) * kstep;
            const char* a2 = last ? nA : cA + (size_t)(t + 2) * kstep; const char* b2 = last ? nB : cB + (size_t)(t + 2) * kstep;
            const char* a3 = a2 + kstep; const char* b3 = b2 + kstep;
            if (last && has_next) S.a_ready(nxt);
            if constexpr (SP2) {
            PG8_LDB(B0, 0, 0); PG8_LDB(B1, 0, 1); PG8_SCHED; PG8_LDA(At, 0, 0); PG8_STAGE(PG8_SA(1, 1), a1 + hstep, voffA);
            PG8_WAIT_V(8); PG8_WAIT_L(0); PG8_BAR; PG8_MMA(0, 0, At, B0); PG8_MMA(0, 1, At, B1); PG8_BAR; PG8_SCHED;
            PG8_LDA(At, 0, 1); PG8_STAGE(PG8_SB(0, 0), b2, voffB); PG8_STAGE(PG8_SB(0, 1), b2 + hstep, voffB); PG8_STAGE(PG8_SA(0, 0), a2, voffA);
            PG8_WAIT_V(8); PG8_WAIT_L(0); PG8_BAR; PG8_MMA(1, 0, At, B0); PG8_MMA(1, 1, At, B1); PG8_BAR; PG8_SCHED;
            PG8_LDB(B0, 1, 0); PG8_LDB(B1, 1, 1); PG8_SCHED; PG8_LDA(At, 1, 0); PG8_STAGE(PG8_SA(0, 1), a2 + hstep, voffA);
            PG8_WAIT_V(8); PG8_WAIT_L(0); PG8_BAR; PG8_MMA(0, 0, At, B0); PG8_MMA(0, 1, At, B1); PG8_BAR; PG8_SCHED;
            PG8_LDA(At, 1, 1); PG8_STAGE(PG8_SB(1, 0), b3, voffB); PG8_STAGE(PG8_SB(1, 1), b3 + hstep, voffB); PG8_STAGE(PG8_SA(1, 0), a3, voffA);
            PG8_WAIT_V(8); PG8_WAIT_L(0); PG8_BAR; PG8_MMA(1, 0, At, B0); PG8_MMA(1, 1, At, B1); PG8_BAR; PG8_SCHED;
            } else {
            PG8_LDB(B0, 0, 0); PG8_SCHED; PG8_LDA(At, 0, 0); PG8_STAGE(PG8_SA(1, 1), a1 + hstep, voffA);
            PG8_WAIT_L(8); PG8_BAR; PG8_WAIT_L(0); PG8_MMA(0, 0, At, B0); PG8_BAR; PG8_SCHED;
            PG8_LDB(B1, 0, 1); PG8_STAGE(PG8_SB(0, 0), b2, voffB);
            PG8_BAR; PG8_WAIT_L(0); PG8_MMA(0, 1, At, B1); PG8_BAR;
            PG8_LDA(At, 0, 1); PG8_STAGE(PG8_SA(0, 0), a2, voffA);
            PG8_BAR; PG8_WAIT_L(0); PG8_MMA(1, 0, At, B0); PG8_BAR; PG8_SCHED;
            PG8_STAGE(PG8_SB(0, 1), b2 + hstep, voffB);
            PG8_WAIT_V(6); PG8_BAR; PG8_MMA(1, 1, At, B1); PG8_BAR;
            PG8_LDB(B0, 1, 0); PG8_SCHED; PG8_LDA(At, 1, 0); PG8_STAGE(PG8_SA(0, 1), a2 + hstep, voffA);
            PG8_WAIT_L(8); PG8_BAR; PG8_WAIT_L(0); PG8_MMA(0, 0, At, B0); PG8_BAR; PG8_SCHED;
            PG8_LDB(B1, 1, 1); PG8_STAGE(PG8_SB(1, 0), b3, voffB);
            PG8_BAR; PG8_WAIT_L(0); PG8_MMA(0, 1, At, B1); PG8_BAR;
            PG8_LDA(At, 1, 1); PG8_STAGE(PG8_SA(1, 0), a3, voffA);
            PG8_BAR; PG8_WAIT_L(0); PG8_MMA(1, 0, At, B0); PG8_BAR; PG8_SCHED;
            PG8_STAGE(PG8_SB(1, 1), b3 + hstep, voffB);
            PG8_WAIT_V(6); PG8_BAR; PG8_MMA(1, 1, At, B1); PG8_BAR;
            }
        }
        if constexpr (ALIGN_EPI) { if (wr == 0) PG8_BAR; }
        if constexpr (!Epi::AFTER_DRAIN) { E(acc, cur, wr, wc, fr, fq); S.done(cur); }
        if (!has_next) break;
#pragma unroll
        for (int a = 0; a < 2; ++a)
#pragma unroll
            for (int b = 0; b < 2; ++b)
#pragma unroll
                for (int m = 0; m < 4; ++m)
#pragma unroll
                    for (int n = 0; n < 2; ++n) acc[a][b][m][n] = (f32x4){0.f, 0.f, 0.f, 0.f};
        cur = nxt; cA = nA; cB = nB; ++ui;
        if constexpr (ALIGN_EPI) { if (wr == 1) PG8_BAR; }
    }
    PG8_WAIT_V(0);
    if constexpr (!ALIGN_EPI) { if (wr == 0) PG8_BAR; }
    PG8_BAR;
    if constexpr (Epi::AFTER_DRAIN) { E.fused(acc, cur, wr, wc, fr, fq, lds, wid, lane); S.done(cur); }
#undef PG8_SA
#undef PG8_SB
#undef PG8_STAGE
#undef PG8_LDA
#undef PG8_LDB
#undef PG8_MMA
#undef PG8_WAIT_V
#undef PG8_WAIT_L
#undef PG8_BAR
#undef PG8_SCHED
}
}

#define GAS __attribute__((address_space(1)))
#define LAS __attribute__((address_space(3)))
typedef unsigned short bf16;
typedef unsigned v4u __attribute__((ext_vector_type(4)));
typedef unsigned v2u __attribute__((ext_vector_type(2)));
typedef float f32x4 __attribute__((ext_vector_type(4)));
typedef float f32x16 __attribute__((ext_vector_type(16)));
typedef short bf16x8 __attribute__((ext_vector_type(8)));
typedef short s16x4 __attribute__((ext_vector_type(4)));

constexpr int DM = 2048, DEPTH = 4, NTOK = 65536, PASS_ROWS = 16384, NPASS = 4;
constexpr int IN_REAL = 16928, NPROJ = 17152, LDP = NPROJ;
constexpr int C_GQKV = 0, C_GZ = 3072, C_SQ = 4096, C_SKV = 5120, C_SZ = 5632, C_DQ = 6656, C_DK = 7680, C_DV = 8704, C_DZ = 9728, C_GATE = 10752, C_BA = 16896;
constexpr float NORM_EPS = 1e-6f, LOG2E = 1.4426950408889634f;
constexpr int NWAVES = 8, NTHREADS = 512;

constexpr size_t MiB = 1u << 20;
constexpr size_t WS_CTL = 0, CTL_ZERO_BYTES = 2 * MiB;
constexpr size_t WS_ROWSS = 1 * MiB;
constexpr size_t WS_WIN = 2 * MiB;
constexpr size_t SZ_WIN_L = (size_t)NPROJ * DM * 2;
constexpr size_t WS_WBR = WS_WIN + 4 * SZ_WIN_L;
constexpr size_t SZ_WBR_1 = (size_t)2048 * 1024 * 2;
constexpr size_t WS_WOUT = WS_WBR + 12 * SZ_WBR_1;
constexpr size_t SZ_WOUT_L = (size_t)DM * DM * 2;
constexpr size_t WS_HN = WS_WOUT + 4 * SZ_WOUT_L;
constexpr size_t WS_PROJ = WS_HN + (size_t)NTOK * DM * 2;
constexpr size_t WS_Y = WS_PROJ + (size_t)PASS_ROWS * NPROJ * 2;
constexpr size_t SZ_Y1 = (size_t)PASS_ROWS * 1024 * 2;
constexpr size_t WS_GDN = WS_Y + 3 * SZ_Y1;
constexpr int REC_BYTES = 73728, REC_FW = 0, REC_FQ = 16384, REC_FK = 32768, REC_FQK = 49152, REC_FU = 57344, REC_LOAD = 57344, REC_GAM = REC_FQK + 2048;
constexpr size_t WS_GAM = WS_GDN + (size_t)2 * 256 * 8 * REC_BYTES;
constexpr size_t WS_ODIR = WS_GAM + 16384;
constexpr size_t WS_MTMP = WS_ODIR + 2 * SZ_Y1;
constexpr size_t WS_MRG = WS_MTMP + (size_t)PASS_ROWS * DM * 2;
constexpr size_t WS_PARK = WS_MRG + (size_t)PASS_ROWS * DM * 2;
constexpr size_t WS_PART = WS_PARK + (size_t)256 * 8 * 64 * 64 * 4;
constexpr int PART_SLOTS = 640;
constexpr size_t WS_PARTL = WS_PART + (size_t)PART_SLOTS * 2 * 256 * 128 * 4;
constexpr size_t WS_END = WS_PARTL + (size_t)PART_SLOTS * 2 * 256 * 4;
constexpr int CW_BAR = 4096;
constexpr int CW_DEP = 32768;
constexpr int CW_QUEUE = 16384;

constexpr int LDS_BYTES = 159744;
constexpr int MISC_OFF = LDS_BYTES - 512;

#define LDS_WAIT() asm volatile("s_waitcnt lgkmcnt(0)" ::: "memory")
#define VM_WAIT() asm volatile("s_waitcnt vmcnt(0)" ::: "memory")
__device__ __forceinline__ float bf2f(bf16 b) { return __uint_as_float(((unsigned)b) << 16); }
__device__ __forceinline__ float bflo(unsigned w) { return __uint_as_float(w << 16); }
__device__ __forceinline__ float bfhi(unsigned w) { return __uint_as_float(w & 0xffff0000u); }
typedef float f32x2_t __attribute__((ext_vector_type(2)));
typedef __bf16 bf16x2_t __attribute__((ext_vector_type(2)));
__device__ __forceinline__ unsigned cvtpk(float lo, float hi) { const f32x2_t v = {lo, hi}; const bf16x2_t b = __builtin_convertvector(v, bf16x2_t); return __builtin_bit_cast(unsigned, b); }
__device__ __forceinline__ bf16 f2bf1(float f) { return (bf16)(cvtpk(f, 0.f) & 0xffffu); }
template <int O> __device__ __forceinline__ float xshfl(float v) {
    static_assert(O >= 1 && O <= 16, "xshfl: in-half xor only");
    return __builtin_bit_cast(float, __builtin_amdgcn_ds_swizzle(__builtin_bit_cast(int, v), 0x1F | (O << 10)));
}
__device__ __forceinline__ float half_sum(float v) {
    unsigned a = __float_as_uint(v), b = a; asm volatile("" : "+v"(b));
    auto rr = __builtin_amdgcn_permlane32_swap(a, b, false, false); return __uint_as_float(rr[0]) + __uint_as_float(rr[1]); }
__device__ __forceinline__ float half_max(float v) {
    unsigned a = __float_as_uint(v), b = a; asm volatile("" : "+v"(b));
    auto rr = __builtin_amdgcn_permlane32_swap(a, b, false, false); return fmaxf(__uint_as_float(rr[0]), __uint_as_float(rr[1])); }
__device__ __forceinline__ float wave_sum(float v) { v += xshfl<1>(v); v += xshfl<2>(v); v += xshfl<4>(v); v += xshfl<8>(v); v += xshfl<16>(v); return half_sum(v); }
__device__ __forceinline__ float wave_max(float v) { v = fmaxf(v, xshfl<1>(v)); v = fmaxf(v, xshfl<2>(v)); v = fmaxf(v, xshfl<4>(v)); v = fmaxf(v, xshfl<8>(v)); v = fmaxf(v, xshfl<16>(v)); return half_max(v); }
__device__ __forceinline__ float silu_f(float v) { return v * __builtin_amdgcn_rcpf(1.0f + __expf(-v)); }
__device__ __forceinline__ int crow(int r, int hi) { return (r & 3) + 8 * (r >> 2) + 4 * hi; }
#define MFMA32(a, b, c) __builtin_amdgcn_mfma_f32_32x32x16_bf16((a), (b), (c), 0, 0, 0)
#define XB_TMO      128
#define XB_XCNT(j)  (256  + 64 * (j))
#define XB_XSUB(j)  (1280 + 64 * (j))
#define XB_XGEN(j)  (2304 + 64 * (j))
#define XB_TOP      3328
#define XB_TOPGEN   3392
#define XCD_BAR_WORDS 3456
#define XB_SPIN_CAP (1u << 18)

__device__ __forceinline__ unsigned xb_ld(unsigned* p)              { return __hip_atomic_load(p, __ATOMIC_RELAXED, __HIP_MEMORY_SCOPE_AGENT); }
__device__ __forceinline__ unsigned xb_add(unsigned* p, unsigned v) { return __hip_atomic_fetch_add(p, v, __ATOMIC_RELAXED, __HIP_MEMORY_SCOPE_AGENT); }
__device__ __forceinline__ unsigned xb_xcc_id() { return (unsigned)__builtin_amdgcn_s_getreg((3 << 11) | 20) & 0xFu; }
#define XB_SPIN(cond, bar) do { unsigned _sp = 0; while (cond) { __builtin_amdgcn_s_sleep(1); \
    if ((++_sp & 255u) == 0u) { if (xb_ld(&(bar)[XB_TMO])) break; if (_sp > XB_SPIN_CAP) { atomicAdd(&(bar)[XB_TMO], 1u); break; } } } } while (0)

struct XcdBarrier {
    unsigned* bar; unsigned x;
    volatile LAS unsigned* st;
};

__device__ __forceinline__ XcdBarrier xcd_barrier_post(unsigned* bar, volatile LAS unsigned* st) {
    XcdBarrier b; b.bar = bar; b.x = xb_xcc_id(); b.st = st;
    if (threadIdx.x == 0) (void)xb_add(&bar[XB_XCNT(b.x)], 1u);
    return b;
}
__device__ __forceinline__ void xcd_barrier_complete(unsigned* bar, unsigned x, unsigned& nloc, unsigned& nx) {
    const unsigned G = gridDim.x * gridDim.y * gridDim.z;
    unsigned sum, cnt, mine, sp = 0u;
    for (;;) {
        sum = 0u; cnt = 0u; mine = 0u;
#pragma unroll
        for (unsigned j = 0; j < 16; ++j) { const unsigned c = xb_ld(&bar[XB_XCNT(j)]); sum += c; cnt += (c > 0u) ? 1u : 0u; mine = (j == x) ? c : mine; }
        if (sum == G) break;
        __builtin_amdgcn_s_sleep(1);
        if ((++sp & 255u) == 0u) { if (xb_ld(&bar[XB_TMO])) break; if (sp > XB_SPIN_CAP) { atomicAdd(&bar[XB_TMO], 1u); break; } }
    }
    nloc = mine > 0u ? mine : 1u; nx = cnt > 0u ? cnt : 1u;
}

__device__ __forceinline__ void xcd_barrier(const XcdBarrier& b) {
    asm volatile("s_waitcnt vmcnt(0)" ::: "memory");
    __syncthreads();
    if (threadIdx.x == 0) {
        unsigned* bar = b.bar;
        __builtin_amdgcn_s_waitcnt(0);
        unsigned nloc = b.st[0], nx = b.st[1];
        if (nloc == 0u) { xcd_barrier_complete(bar, b.x, nloc, nx); b.st[0] = nloc; b.st[1] = nx; }
        const unsigned old = xb_add(&bar[XB_XSUB(b.x)], 1u);
        const unsigned gen = old / nloc;
        if (old + 1u == (gen + 1u) * nloc) {
            __builtin_amdgcn_fence(__ATOMIC_RELEASE, "agent");
            asm volatile("s_waitcnt vmcnt(0)" ::: "memory");
            const unsigned og = xb_add(&bar[XB_TOP], 1u);
            const unsigned tg = og / nx;
            if (og + 1u == (tg + 1u) * nx) xb_add(&bar[XB_TOPGEN], 1u);
            else XB_SPIN(xb_ld(&bar[XB_TOPGEN]) == tg, bar);
            __builtin_amdgcn_fence(__ATOMIC_ACQUIRE, "agent");
            xb_add(&bar[XB_XGEN(b.x)], 1u);
            asm volatile("s_waitcnt vmcnt(0)" ::: "memory");
        } else {
            XB_SPIN(xb_ld(&bar[XB_XGEN(b.x)]) == gen, bar);
            __builtin_amdgcn_fence(__ATOMIC_ACQUIRE, "agent");
            asm volatile("s_waitcnt vmcnt(0)" ::: "memory");
        }
    }
    __syncthreads();
}
__device__ __forceinline__ int win_row(int dl) {
    const int L = dl & 255;
    const int p = (dl >= C_GATE && dl < C_GATE + 6144) ? (((L >> 3) & 1) * 128 + (L >> 6) * 32 + ((L >> 4) & 3) * 8 + (L & 7)) : (((L >> 5) & 1) * 128 + (L >> 6) * 32 + (L & 31));
    return (dl & ~255) + p;
}
template <bool MAPW = false>
__device__ __forceinline__ void transpose_item(const float* W, int K, int N, bf16* WT, int k0, int n0, int drow0, LAS float* scr, int lane) {
#pragma unroll 8
    for (int i = 0; i < 32; ++i) { const int kk = 2 * i + (lane >> 5); scr[kk * 33 + (lane & 31)] = W[(size_t)(k0 + kk) * N + n0 + (lane & 31)]; }
    LDS_WAIT(); asm volatile("" ::: "memory");
    const int c = lane & 7;
#pragma unroll
    for (int j = 0; j < 4; ++j) { const int n = (lane >> 3) + 8 * j; const LAS float* s = scr + (8 * c) * 33 + n;
        v4u o; o.x = cvtpk(s[0 * 33], s[1 * 33]); o.y = cvtpk(s[2 * 33], s[3 * 33]); o.z = cvtpk(s[4 * 33], s[5 * 33]); o.w = cvtpk(s[6 * 33], s[7 * 33]);
        *(v4u*)(WT + (size_t)(MAPW ? win_row(drow0 + n) : drow0 + n) * K + k0 + 8 * c) = o; }
    LDS_WAIT(); asm volatile("" ::: "memory");
}
__device__ __forceinline__ void phase_prologue(LAS unsigned char* lds, const float* w_in, const float* w_branch, const float* w_out, unsigned char* ws, int gw, int ngw, int wave, int lane) {
    LAS float* scr = (LAS float*)(lds + wave * 16384);
    constexpr int NB_IN = IN_REAL / 32;
    constexpr int I_IN = 32 * NB_IN;
    constexpr int I_BR = 16 * 64;
    constexpr int I_OUT = 32 * 64;
    constexpr int TOT = 4 * I_IN + 12 * I_BR + 4 * I_OUT;
    for (int it = gw; it < TOT; it += ngw) {
        int r = it;
        if (r < 4 * I_IN) { const int l = r / I_IN; r -= l * I_IN; const int kb = r / NB_IN, nb = r % NB_IN, n0 = nb * 32;
            const int drow = (n0 < 4096) ? n0 : ((n0 < 4128) ? (C_BA + (n0 - 4096)) : (n0 - 32));
            transpose_item<true>(w_in + (size_t)l * DM * IN_REAL, DM, IN_REAL, (bf16*)(ws + WS_WIN + (size_t)l * SZ_WIN_L), kb * 64, n0, drow, scr, lane); continue; }
        r -= 4 * I_IN;
        if (r < 12 * I_BR) { const int m = r / I_BR; r -= m * I_BR; const int kb = r / 64, nb = r % 64;
            transpose_item(w_branch + (size_t)m * 1024 * 2048, 1024, 2048, (bf16*)(ws + WS_WBR + (size_t)m * SZ_WBR_1), kb * 64, nb * 32, nb * 32, scr, lane); continue; }
        r -= 12 * I_BR;
        { const int l = r / I_OUT; r -= l * I_OUT; const int kb = r / 64, nb = r % 64;
            transpose_item(w_out + (size_t)l * DM * DM, DM, DM, (bf16*)(ws + WS_WOUT + (size_t)l * SZ_WOUT_L), kb * 64, nb * 32, nb * 32, scr, lane); }
    }
    const v4u z = {0u, 0u, 0u, 0u};
    for (int i = gw * 64 + lane; i < 4 * 57344; i += ngw * 64) { const int l = i / 57344, q = i % 57344;
        *(v4u*)(ws + WS_WIN + (size_t)l * SZ_WIN_L + (size_t)IN_REAL * DM * 2 + (size_t)q * 16) = z; }
}
__device__ __forceinline__ void rms_row(const float* xrow, const float* gain, bf16* orow, float* rowss, int lane) {
    const f32x4* xr = (const f32x4*)xrow + lane; const f32x4* gr = (const f32x4*)gain + lane;
    f32x4 v[8]; float s = 0.f;
#pragma unroll
    for (int j = 0; j < 8; ++j) { v[j] = xr[64 * j]; s += (v[j].x * v[j].x + v[j].y * v[j].y) + (v[j].z * v[j].z + v[j].w * v[j].w); }
    s = wave_sum(s);
    if (lane == 0) *rowss = s;
    v2u* o8 = (v2u*)orow + lane;
#pragma unroll
    for (int j = 0; j < 8; ++j) { const f32x4 g = gr[64 * j]; v2u o; o.x = cvtpk(v[j].x * g.x, v[j].y * g.y); o.y = cvtpk(v[j].z * g.z, v[j].w * g.w); o8[64 * j] = o; }
}
template <bool DIFF>
__device__ __forceinline__ void knorm_row(bf16* prow, const float* swa_k_gain, const float* diff_k_gain, int lane) {
    {
        v2u* p = (v2u*)(prow + C_SKV) + lane; const v2u w = *p;
        float a = bflo(w.x), b = bfhi(w.x), c = bflo(w.y), d = bfhi(w.y);
        float ss = (a * a + b * b) + (c * c + d * d);
        ss += xshfl<1>(ss); ss += xshfl<2>(ss); ss += xshfl<4>(ss); ss += xshfl<8>(ss); ss += xshfl<16>(ss);
        const float rs = 1.0f / sqrtf(ss * (1.0f / 128.0f) + NORM_EPS);
        const f32x4 g = *((const f32x4*)swa_k_gain + (lane & 31));
        v2u o; o.x = cvtpk(a * rs * g.x, b * rs * g.y); o.y = cvtpk(c * rs * g.z, d * rs * g.w); *p = o;
    }
    if (DIFF) {
        v4u* p = (v4u*)(prow + C_DK) + 2 * lane; const v4u w0 = p[0], w1 = p[1];
        float x[16] = {bflo(w0.x), bfhi(w0.x), bflo(w0.y), bfhi(w0.y), bflo(w0.z), bfhi(w0.z), bflo(w0.w), bfhi(w0.w),
                       bflo(w1.x), bfhi(w1.x), bflo(w1.y), bfhi(w1.y), bflo(w1.z), bfhi(w1.z), bflo(w1.w), bfhi(w1.w)};
        float ss = 0.f;
#pragma unroll
        for (int e = 0; e < 16; ++e) ss += x[e] * x[e];
        ss += xshfl<1>(ss); ss += xshfl<2>(ss);
        const float rs = 1.0f / sqrtf(ss * (1.0f / 64.0f) + NORM_EPS);
        const float* g = diff_k_gain + 16 * (lane & 3);
#pragma unroll
        for (int e = 0; e < 16; ++e) x[e] *= rs * g[e];
        v4u o0, o1; o0.x = cvtpk(x[0], x[1]); o0.y = cvtpk(x[2], x[3]); o0.z = cvtpk(x[4], x[5]); o0.w = cvtpk(x[6], x[7]);
        o1.x = cvtpk(x[8], x[9]); o1.y = cvtpk(x[10], x[11]); o1.z = cvtpk(x[12], x[13]); o1.w = cvtpk(x[14], x[15]);
        p[0] = o0; p[1] = o1;
    }
}
__device__ __forceinline__ void gdn_final_row(const bf16* of, const bf16* ob, const bf16* zrow, const float* gain, bf16* yrow, int lane) {
    const v4u* pf = (const v4u*)of + 2 * lane; const v4u* pb = (const v4u*)ob + 2 * lane; const v4u* pz = (const v4u*)zrow + 2 * lane;
    float x[16], z[16];
#pragma unroll
    for (int q = 0; q < 2; ++q) { const v4u a = pf[q], b = pb[q], c = pz[q];
        x[8 * q + 0] = bflo(a.x) + bflo(b.x); x[8 * q + 1] = bfhi(a.x) + bfhi(b.x); x[8 * q + 2] = bflo(a.y) + bflo(b.y); x[8 * q + 3] = bfhi(a.y) + bfhi(b.y);
        x[8 * q + 4] = bflo(a.z) + bflo(b.z); x[8 * q + 5] = bfhi(a.z) + bfhi(b.z); x[8 * q + 6] = bflo(a.w) + bflo(b.w); x[8 * q + 7] = bfhi(a.w) + bfhi(b.w);
        z[8 * q + 0] = bflo(c.x); z[8 * q + 1] = bfhi(c.x); z[8 * q + 2] = bflo(c.y); z[8 * q + 3] = bfhi(c.y);
        z[8 * q + 4] = bflo(c.z); z[8 * q + 5] = bfhi(c.z); z[8 * q + 6] = bflo(c.w); z[8 * q + 7] = bfhi(c.w); }
    float ss = 0.f;
#pragma unroll
    for (int e = 0; e < 16; ++e) ss += x[e] * x[e];
    ss += xshfl<1>(ss); ss += xshfl<2>(ss); ss += xshfl<4>(ss);
    const float rs = 1.0f / sqrtf(ss * (1.0f / 128.0f) + NORM_EPS);
    const float* g = gain + 16 * (lane & 7);
#pragma unroll
    for (int e = 0; e < 16; ++e) x[e] = x[e] * rs * g[e] * z[e];
    v4u o0, o1; o0.x = cvtpk(x[0], x[1]); o0.y = cvtpk(x[2], x[3]); o0.z = cvtpk(x[4], x[5]); o0.w = cvtpk(x[6], x[7]);
    o1.x = cvtpk(x[8], x[9]); o1.y = cvtpk(x[10], x[11]); o1.z = cvtpk(x[12], x[13]); o1.w = cvtpk(x[14], x[15]);
    v4u* py = (v4u*)yrow + 2 * lane; py[0] = o0; py[1] = o1;
}
template <int NB>
__device__ __forceinline__ void gdn_final_rows(const bf16* OD, const bf16* PROJ, int m0, int step, const float* gain, bf16* Y, int lane) {
    v4u a[NB][2], bq[NB][2], c[NB][2];
#pragma unroll
    for (int k = 0; k < NB; ++k) { const size_t m = (size_t)(m0 + k * step);
        const v4u* pf = (const v4u*)(OD + m * 1024) + 2 * lane; const v4u* pb = (const v4u*)(OD + ((size_t)PASS_ROWS + m) * 1024) + 2 * lane; const v4u* pz = (const v4u*)(PROJ + m * LDP + C_GZ) + 2 * lane;
        a[k][0] = pf[0]; a[k][1] = pf[1]; bq[k][0] = pb[0]; bq[k][1] = pb[1]; c[k][0] = pz[0]; c[k][1] = pz[1]; }
    const float* g = gain + 16 * (lane & 7);
#pragma unroll
    for (int k = 0; k < NB; ++k) {
        float x[16], z[16];
#pragma unroll
        for (int q = 0; q < 2; ++q) { const v4u aa = a[k][q], bb = bq[k][q], cc = c[k][q];
            x[8 * q + 0] = bflo(aa.x) + bflo(bb.x); x[8 * q + 1] = bfhi(aa.x) + bfhi(bb.x); x[8 * q + 2] = bflo(aa.y) + bflo(bb.y); x[8 * q + 3] = bfhi(aa.y) + bfhi(bb.y);
            x[8 * q + 4] = bflo(aa.z) + bflo(bb.z); x[8 * q + 5] = bfhi(aa.z) + bfhi(bb.z); x[8 * q + 6] = bflo(aa.w) + bflo(bb.w); x[8 * q + 7] = bfhi(aa.w) + bfhi(bb.w);
            z[8 * q + 0] = bflo(cc.x); z[8 * q + 1] = bfhi(cc.x); z[8 * q + 2] = bflo(cc.y); z[8 * q + 3] = bfhi(cc.y);
            z[8 * q + 4] = bflo(cc.z); z[8 * q + 5] = bfhi(cc.z); z[8 * q + 6] = bflo(cc.w); z[8 * q + 7] = bfhi(cc.w); }
        float ss = 0.f;
#pragma unroll
        for (int e = 0; e < 16; ++e) ss += x[e] * x[e];
        ss += xshfl<1>(ss); ss += xshfl<2>(ss); ss += xshfl<4>(ss);
        const float rs = 1.0f / sqrtf(ss * (1.0f / 128.0f) + NORM_EPS);
#pragma unroll
        for (int e = 0; e < 16; ++e) x[e] = x[e] * rs * g[e] * z[e];
        v4u o0, o1; o0.x = cvtpk(x[0], x[1]); o0.y = cvtpk(x[2], x[3]); o0.z = cvtpk(x[4], x[5]); o0.w = cvtpk(x[6], x[7]);
        o1.x = cvtpk(x[8], x[9]); o1.y = cvtpk(x[10], x[11]); o1.z = cvtpk(x[12], x[13]); o1.w = cvtpk(x[14], x[15]);
        v4u* py = (v4u*)(Y + (size_t)(m0 + k * step) * 1024) + 2 * lane; py[0] = o0; py[1] = o1;
    }
}
__device__ __forceinline__ void diff_final_row(const unsigned char* ws, int slot0, int np, int rr, float lam, float lambda_init, const bf16* zrow, const float* gain, bf16* yrow, int lane) {
    typedef float f32x2v __attribute__((ext_vector_type(2)));
    const float* PO = (const float*)(ws + WS_PART); const float* PL = (const float*)(ws + WS_PARTL);
    f32x2v o0 = {0.f, 0.f}, o1 = {0.f, 0.f}; float l0 = 0.f, l1 = 0.f;
    for (int p = 0; p < np; ++p) { const int s = slot0 + p;
        o0 += *(const f32x2v*)(PO + ((size_t)(s * 2 + 0) * 256 + rr) * 128 + 2 * lane); o1 += *(const f32x2v*)(PO + ((size_t)(s * 2 + 1) * 256 + rr) * 128 + 2 * lane);
        l0 += PL[(s * 2 + 0) * 256 + rr]; l1 += PL[(s * 2 + 1) * 256 + rr]; }
    const float r0 = 1.0f / l0, r1 = lam / l1;
    const float a = o0.x * r0 - o1.x * r1, b = o0.y * r0 - o1.y * r1;
    const float rs = (1.0f / sqrtf(wave_sum(a * a + b * b) * (1.0f / 128.0f) + NORM_EPS)) * (1.0f - lambda_init);
    const unsigned zw = *(const unsigned*)(zrow + 2 * lane);
    const float ya = a * rs * gain[2 * lane] * bflo(zw), yb = b * rs * gain[2 * lane + 1] * bfhi(zw);
    *(unsigned*)(yrow + 2 * lane) = cvtpk(ya, yb);
}
constexpr int D1_QROW = 0, D1_KROW = 17408, D1_KT = 34816, D1_VT = 53248, D1_LM = 71680, D1_TB = 106496, D1_BETA = 143360, D1_GC = 143872, D1_END = 144384;
constexpr int ROWP = 272, TRP = 144, LMP = 272, TBP = 144;
#define TSW(rw, boff) ((rw) * TRP + ((boff) ^ ((((rw) >> 3) & 7) << 4)))
__device__ __forceinline__ unsigned char* gdn_rec(unsigned char* ws, int d, int ci, int h) { return ws + WS_GDN + (((size_t)d * 256 + ci) * 8 + h) * REC_BYTES; }

#ifndef DUP_D1
#define DUP_D1 0
#endif
__device__ __forceinline__ void gdn_prep_unit(LAS unsigned char* lds, unsigned char* ws, const float* conv_w, const float* a_log, const float* dt_bias,
                                              int l, int Tp, int ci, int h, int nci, int nh, unsigned& pre_ba, int tid, int wave, int lane) {
    const bf16* PROJ = (const bf16*)(ws + WS_PROJ);
    const int row0 = ci * 64, tin = row0 % Tp; const bool first = (tin == 0), last = (tin + 64 == Tp);
    LAS float* BETA = (LAS float*)(lds + D1_BETA); LAS float* GC = (LAS float*)(lds + D1_GC);
    if (tid < 128) {
        const int d = tid >> 6, r = tid & 63, c = d ? 63 - r : r;
        const float braw = bflo(pre_ba), araw = bfhi(pre_ba);
        if (nci >= 0) { const bf16* pn = PROJ + (size_t)(nci * 64 + c) * LDP + C_BA; pre_ba = (unsigned)pn[d * 8 + nh] | ((unsigned)pn[16 + d * 8 + nh] << 16); }
        const float beta = __builtin_amdgcn_rcpf(1.0f + __expf(-braw));
        const float x = araw + dt_bias[(l * 2 + d) * 8 + h];
        const float sp = fmaxf(x, 0.f) + log1pf(__expf(-fabsf(x)));
        float gcv = -__expf(a_log[(l * 2 + d) * 8 + h]) * sp;
#pragma unroll
        for (int off = 1; off < 64; off <<= 1) { const float t = __shfl_up(gcv, off); if (r >= off) gcv += t; }
        BETA[d * 64 + r] = beta; GC[d * 64 + r] = gcv;
        if (r == 63) *(float*)(gdn_rec(ws, d, ci, h) + REC_GAM) = __expf(gcv);
    }
    __syncthreads();
    for (int rep1 = 0; rep1 < (DUP_D1 == 1 ? 2 : 1); ++rep1) {
        const int sub = tid & 15, ch0 = sub * 8;
#pragma unroll 6
        for (int rnd = 0; rnd < 6; ++rnd) {
            const int it = rnd * 32 + (tid >> 4), mat = it >> 6, c = it & 63;
            const int chan = mat * 1024 + h * 128 + ch0;
            const bf16* px = PROJ + (size_t)(row0 + c) * LDP + C_GQKV + chan;
            const v4u zz = {0u, 0u, 0u, 0u};
            const v4u x1 = *(const v4u*)px;
            const v4u x0 = (c == 0 && first) ? zz : *(const v4u*)(px - LDP);
            const v4u x2 = (c == 63 && last) ? zz : *(const v4u*)(px + LDP);
            const float* cw = conv_w + (size_t)l * 3 * 3072 + chan;
            const f32x4 w0a = *(const f32x4*)cw, w0b = *(const f32x4*)(cw + 4), w1a = *(const f32x4*)(cw + 3072), w1b = *(const f32x4*)(cw + 3072 + 4), w2a = *(const f32x4*)(cw + 6144), w2b = *(const f32x4*)(cw + 6144 + 4);
            const float w0[8] = {w0a.x, w0a.y, w0a.z, w0a.w, w0b.x, w0b.y, w0b.z, w0b.w}, w1[8] = {w1a.x, w1a.y, w1a.z, w1a.w, w1b.x, w1b.y, w1b.z, w1b.w}, w2[8] = {w2a.x, w2a.y, w2a.z, w2a.w, w2b.x, w2b.y, w2b.z, w2b.w};
            const float a0[8] = {bflo(x0.x), bfhi(x0.x), bflo(x0.y), bfhi(x0.y), bflo(x0.z), bfhi(x0.z), bflo(x0.w), bfhi(x0.w)};
            const float a1[8] = {bflo(x1.x), bfhi(x1.x), bflo(x1.y), bfhi(x1.y), bflo(x1.z), bfhi(x1.z), bflo(x1.w), bfhi(x1.w)};
            const float a2[8] = {bflo(x2.x), bfhi(x2.x), bflo(x2.y), bfhi(x2.y), bflo(x2.z), bfhi(x2.z), bflo(x2.w), bfhi(x2.w)};
            float y[8]; float ss = 0.f;
#pragma unroll
            for (int e = 0; e < 8; ++e) { const float a = a0[e] * w0[e] + a1[e] * w1[e] + a2[e] * w2[e]; y[e] = a * __builtin_amdgcn_rcpf(1.0f + __expf(-a)); ss += y[e] * y[e]; }
            if (mat < 2) {
                ss += xshfl<1>(ss); ss += xshfl<2>(ss); ss += xshfl<4>(ss); ss += xshfl<8>(ss);
                float rs = __builtin_amdgcn_rsqf(ss + NORM_EPS); if (mat == 0) rs *= 0.08838834764831845f;
#pragma unroll
                for (int e = 0; e < 8; ++e) y[e] *= rs;
            }
            if (mat == 0) {
                v4u o; o.x = cvtpk(y[0], y[1]); o.y = cvtpk(y[2], y[3]); o.z = cvtpk(y[4], y[5]); o.w = cvtpk(y[6], y[7]);
                *(LAS v4u*)(lds + D1_QROW + c * ROWP + ch0 * 2) = o;
                const int t = ch0 >> 5, kk = ch0 & 31, s = kk >> 4, b = (kk >> 3) & 1;
#pragma unroll
                for (int d = 0; d < 2; ++d) { const int r = d ? 63 - c : c; const float e = __expf(GC[d * 64 + r]); const int i = r >> 5, rr = r & 31;
                    unsigned char* fb = gdn_rec(ws, d, ci, h) + REC_FQ + (((i * 4 + t) * 2 + s) * 64) * 16 + b * 8;
                    v2u lo, hi2; lo.x = cvtpk(y[0] * e, y[1] * e); lo.y = cvtpk(y[2] * e, y[3] * e); hi2.x = cvtpk(y[4] * e, y[5] * e); hi2.y = cvtpk(y[6] * e, y[7] * e);
                    *(v2u*)(fb + rr * 16) = lo; *(v2u*)(fb + (rr + 32) * 16) = hi2; }
            } else if (mat == 1) {
                v4u o; o.x = cvtpk(y[0], y[1]); o.y = cvtpk(y[2], y[3]); o.z = cvtpk(y[4], y[5]); o.w = cvtpk(y[6], y[7]);
                *(LAS v4u*)(lds + D1_KROW + c * ROWP + ch0 * 2) = o;
#pragma unroll
                for (int e = 0; e < 8; ++e) *(LAS bf16*)(lds + D1_KT + TSW(ch0 + e, c * 2)) = f2bf1(y[e]);
            } else {
#pragma unroll
                for (int e = 0; e < 8; ++e) *(LAS bf16*)(lds + D1_VT + TSW(ch0 + e, c * 2)) = f2bf1(y[e]);
            }
        }
    }
    __syncthreads();
    for (int rep2 = 0; rep2 < (DUP_D1 == 2 ? 2 : 1); ++rep2) {
        const int r32 = lane & 31, hi = lane >> 5;
#pragma unroll 1
        for (int k = wave; k < 12; k += 8) {
            const int d = k / 6, sel = k % 6;
            int ta, tb; int boff;
            if (sel < 3) { ta = (sel >= 1); tb = (sel == 2); boff = D1_KROW; }
            else { ta = (sel == 5); tb = (sel >= 4); boff = D1_QROW; }
            const int ra = 32 * ta + r32, rb = 32 * tb + r32;
            const int rowa = d ? 63 - ra : ra, rowb = d ? 63 - rb : rb;
            const LAS unsigned char* pa = lds + D1_KROW + rowa * ROWP + hi * 16; const LAS unsigned char* pb = lds + boff + rowb * ROWP + hi * 16;
            f32x16 acc = {0.f, 0.f, 0.f, 0.f, 0.f, 0.f, 0.f, 0.f, 0.f, 0.f, 0.f, 0.f, 0.f, 0.f, 0.f, 0.f};
#pragma unroll
            for (int s = 0; s < 8; ++s) acc = MFMA32(*(const LAS bf16x8*)(pa + s * 32), *(const LAS bf16x8*)(pb + s * 32), acc);
            const int colp = 32 * tb + r32;
            const float gcc = GC[d * 64 + colp];
            if (sel < 3) {
                LAS float* Lm = (LAS float*)(lds + D1_LM + d * 17408);
#pragma unroll
                for (int r = 0; r < 16; ++r) { const int rp = 32 * ta + crow(r, hi);
                    const float v = (rp > colp) ? BETA[d * 64 + rp] * acc[r] * __expf(GC[d * 64 + rp] - gcc) : 0.f;
                    Lm[rp * (LMP / 4) + colp] = v; }
            } else {
                float v[16];
#pragma unroll
                for (int r = 0; r < 16; ++r) { const int cp = 32 * ta + crow(r, hi);
                    v[r] = (colp >= cp) ? acc[r] * __expf(gcc - GC[d * 64 + cp]) : 0.f; }
                unsigned char* fb = gdn_rec(ws, d, ci, h) + REC_FQK + (((tb * 2 + ta) * 2) * 64 + lane) * 16;
                v4u o0, o1; o0.x = cvtpk(v[0], v[1]); o0.y = cvtpk(v[2], v[3]); o0.z = cvtpk(v[4], v[5]); o0.w = cvtpk(v[6], v[7]);
                o1.x = cvtpk(v[8], v[9]); o1.y = cvtpk(v[10], v[11]); o1.z = cvtpk(v[12], v[13]); o1.w = cvtpk(v[14], v[15]);
                *(v4u*)fb = o0; *(v4u*)(fb + 1024) = o1;
            }
        }
    }
    __syncthreads();
    constexpr int D1_TS = D1_QROW;
    for (int rep3 = 0; rep3 < (DUP_D1 == 3 ? 2 : 1); ++rep3)
    if (wave < 4) {
        const int d = wave >> 1, blk = wave & 1, j = lane & 31, jp = 32 * blk + j;
        const LAS float* Lm = (const LAS float*)(lds + D1_LM + d * 17408) + (32 * blk) * (LMP / 4) + 32 * blk;
        const float bj = BETA[d * 64 + jp], bgj = bj * __expf(GC[d * 64 + jp]);
        const int col = d ? 63 - jp : jp;
        LAS unsigned char* tb = lds + D1_TB + d * 18432 + (32 * blk) * TBP + col * 2;
        LAS float* ts = (LAS float*)(lds + D1_TS + (d * 2 + blk) * 4352) + j;
        if (lane < 32) {
            float t[32];
#pragma unroll
            for (int r = 0; r < 32; ++r) {
                float a4[4] = {(r == j) ? 1.f : 0.f, 0.f, 0.f, 0.f};
#pragma unroll
                for (int m4 = 0; m4 < (r + 3) / 4; ++m4) { const f32x4 lv = *(const LAS f32x4*)(Lm + r * (LMP / 4) + m4 * 4);
#pragma unroll
                    for (int e = 0; e < 4; ++e) if (m4 * 4 + e < r) a4[e] -= lv[e] * t[m4 * 4 + e]; }
                const float a = (a4[0] + a4[1]) + (a4[2] + a4[3]);
                t[r] = a; ts[r * 33] = a;
                *(LAS bf16*)(tb + r * TBP) = f2bf1(a * bj); *(LAS bf16*)(tb + 9216 + r * TBP) = f2bf1(a * bgj);
            }
        } else if (blk == 0) {
            const int colz = d ? 63 - (32 + j) : 32 + j; LAS unsigned char* tz = lds + D1_TB + d * 18432 + colz * 2;
#pragma unroll
            for (int r = 0; r < 32; ++r) { *(LAS bf16*)(tz + r * TBP) = (bf16)0; *(LAS bf16*)(tz + 9216 + r * TBP) = (bf16)0; }
        }
    } else {
        const int rr = lane & 31, hh = lane >> 5;
#pragma unroll 1
        for (int f = wave - 4; f < 32; f += 4) {
            const int d = f >> 4, t = (f >> 2) & 3, ip = (f >> 1) & 1, s = f & 1;
            const int c0 = 32 * ip + 16 * s + 4 * hh;
            const float gl = GC[d * 64 + 63];
            const int ktr = 32 * t + rr; const LAS unsigned char* kt = lds + D1_KT;
            float ea[4], eb[4];
#pragma unroll
            for (int x = 0; x < 4; ++x) { ea[x] = __expf(gl - GC[d * 64 + c0 + x]); eb[x] = __expf(gl - GC[d * 64 + c0 + 8 + x]); }
            float ka[4], kb[4];
            if (d == 0) { const v2u wa = *(const LAS v2u*)(kt + TSW(ktr, c0 * 2)), wb = *(const LAS v2u*)(kt + TSW(ktr, (c0 + 8) * 2));
                ka[0] = bflo(wa.x); ka[1] = bfhi(wa.x); ka[2] = bflo(wa.y); ka[3] = bfhi(wa.y); kb[0] = bflo(wb.x); kb[1] = bfhi(wb.x); kb[2] = bflo(wb.y); kb[3] = bfhi(wb.y); }
            else { const v2u wa = *(const LAS v2u*)(kt + TSW(ktr, (60 - c0) * 2)), wb = *(const LAS v2u*)(kt + TSW(ktr, (52 - c0) * 2));
                ka[3] = bflo(wa.x); ka[2] = bfhi(wa.x); ka[1] = bflo(wa.y); ka[0] = bfhi(wa.y); kb[3] = bflo(wb.x); kb[2] = bfhi(wb.x); kb[1] = bflo(wb.y); kb[0] = bfhi(wb.y); }
            v4u o; o.x = cvtpk(ka[0] * ea[0], ka[1] * ea[1]); o.y = cvtpk(ka[2] * ea[2], ka[3] * ea[3]); o.z = cvtpk(kb[0] * eb[0], kb[1] * eb[1]); o.w = cvtpk(kb[2] * eb[2], kb[3] * eb[3]);
            *(v4u*)(gdn_rec(ws, d, ci, h) + REC_FK + (((t * 2 + ip) * 2 + s) * 64 + lane) * 16) = o;
        }
    }
    __syncthreads();
    if (wave < 2) {
        const int d = wave, i = lane & 31, hh = lane >> 5;
        const LAS float* L21 = (const LAS float*)(lds + D1_LM + d * 17408) + (32 + i) * (LMP / 4);
        const LAS float* T11 = (const LAS float*)(lds + D1_TS + (d * 2 + 0) * 4352);
        const LAS float* T22 = (const LAS float*)(lds + D1_TS + (d * 2 + 1) * 4352);
        f32x16 P = {0.f, 0.f, 0.f, 0.f, 0.f, 0.f, 0.f, 0.f, 0.f, 0.f, 0.f, 0.f, 0.f, 0.f, 0.f, 0.f};
#pragma unroll
        for (int s = 0; s < 16; ++s) P = __builtin_amdgcn_mfma_f32_32x32x2f32(L21[2 * s + hh], T11[(2 * s + hh) * 33 + i], P, 0, 0, 0);
        f32x16 R = {0.f, 0.f, 0.f, 0.f, 0.f, 0.f, 0.f, 0.f, 0.f, 0.f, 0.f, 0.f, 0.f, 0.f, 0.f, 0.f};
#pragma unroll
        for (int s = 0; s < 16; ++s) R = __builtin_amdgcn_mfma_f32_32x32x2f32(T22[i * 33 + crow(s, hh)], P[s], R, 0, 0, 0);
        const float bj = BETA[d * 64 + i], bgj = bj * __expf(GC[d * 64 + i]);
        const int col = d ? 63 - i : i;
        LAS unsigned char* tb = lds + D1_TB + d * 18432 + 32 * TBP + col * 2;
#pragma unroll
        for (int r = 0; r < 16; ++r) { const float a = -R[r]; const int row = crow(r, hh);
            *(LAS bf16*)(tb + row * TBP) = f2bf1(a * bj); *(LAS bf16*)(tb + 9216 + row * TBP) = f2bf1(a * bgj); }
    }
    __syncthreads();
    for (int rep4 = 0; rep4 < (DUP_D1 == 4 ? 2 : 1); ++rep4) {
        const int r32 = lane & 31, hi = lane >> 5;
#pragma unroll 1
        for (int f = wave; f < 32; f += 8) {
            const int d = f >> 4, kind = (f >> 3) & 1, idx = f & 7;
            const LAS unsigned char* pa; const LAS unsigned char* pb; int xa = 0, xb = 0;
            if (kind == 0) { const int i = idx >> 2, w = idx & 3;
                pa = lds + D1_TB + d * 18432 + (32 * i + r32) * TBP; pb = lds + D1_VT + (32 * w + r32) * TRP; xb = (((32 * w + r32) >> 3) & 7) << 4; }
            else { const int t = idx >> 1, i = idx & 1;
                pa = lds + D1_KT + (32 * t + r32) * TRP; xa = (((32 * t + r32) >> 3) & 7) << 4; pb = lds + D1_TB + d * 18432 + 9216 + (32 * i + r32) * TBP; }
            f32x16 acc = {0.f, 0.f, 0.f, 0.f, 0.f, 0.f, 0.f, 0.f, 0.f, 0.f, 0.f, 0.f, 0.f, 0.f, 0.f, 0.f};
#pragma unroll
            for (int s = 0; s < 4; ++s) acc = MFMA32(*(const LAS bf16x8*)(pa + ((s * 32 + hi * 16) ^ xa)), *(const LAS bf16x8*)(pb + ((s * 32 + hi * 16) ^ xb)), acc);
            const float sg = kind ? -1.f : 1.f;
            v4u o0, o1; o0.x = cvtpk(sg * acc[0], sg * acc[1]); o0.y = cvtpk(sg * acc[2], sg * acc[3]); o0.z = cvtpk(sg * acc[4], sg * acc[5]); o0.w = cvtpk(sg * acc[6], sg * acc[7]);
            o1.x = cvtpk(sg * acc[8], sg * acc[9]); o1.y = cvtpk(sg * acc[10], sg * acc[11]); o1.z = cvtpk(sg * acc[12], sg * acc[13]); o1.w = cvtpk(sg * acc[14], sg * acc[15]);
            if (kind == 0) { const int i = idx >> 2, w = idx & 3; unsigned char* fb = gdn_rec(ws, d, ci, h) + REC_FU + ((w * 2 + i) * 64 + lane) * 32; *(v4u*)fb = o0; *(v4u*)(fb + 16) = o1; }
            else { const int t = idx >> 1, i = idx & 1; unsigned char* fb = gdn_rec(ws, d, ci, h) + REC_FW + (((i * 4 + t) * 2) * 64 + lane) * 16; *(v4u*)fb = o0; *(v4u*)(fb + 1024) = o1; }
        }
    }
    __syncthreads();
}
__device__ __forceinline__ bf16x8 pack8(const f32x16& v, int s) {
    v4u w; w.x = cvtpk(v[8 * s + 0], v[8 * s + 1]); w.y = cvtpk(v[8 * s + 2], v[8 * s + 3]); w.z = cvtpk(v[8 * s + 4], v[8 * s + 5]); w.w = cvtpk(v[8 * s + 6], v[8 * s + 7]);
    return __builtin_bit_cast(bf16x8, w);
}
#define SCAN_BAR() do { asm volatile("s_waitcnt lgkmcnt(0)" ::: "memory"); __builtin_amdgcn_s_barrier(); asm volatile("" ::: "memory"); } while (0)
constexpr int SC_BUF = REC_BYTES;
__device__ __forceinline__ void gdn_scan_unit(LAS unsigned char* lds, unsigned char* ws, int Tp, int sq, int h, int d, int half, int tid, int wave, int lane) {
    const int Nc = Tp / 64, cb = sq * Nc;
    bf16* ODIR = (bf16*)(ws + WS_ODIR) + (size_t)d * PASS_ROWS * 1024;
#define SC_SRC(n) ((const unsigned char*)gdn_rec(ws, d, cb + (d ? Nc - 1 - (n) : (n)), h))
    if (wave >= 2) {
        const int lt = tid - 128;
#define SC_LOAD(st, n) do { const unsigned char* src_ = SC_SRC(n); _Pragma("unroll") for (int k = 0; k < 12; ++k) st[k] = *(const v4u*)(src_ + (lt + 384 * k) * 16); } while (0)
#define SC_WRITE(st, b) do { _Pragma("unroll") for (int k = 0; k < 12; ++k) *(LAS v4u*)(lds + (b) * SC_BUF + (lt + 384 * k) * 16) = st[k]; } while (0)
        v4u s0[12], s1[12];
        SC_LOAD(s0, 0); SC_WRITE(s0, 0);
        if (1 < Nc) SC_LOAD(s1, 1);
        if (2 < Nc) SC_LOAD(s0, 2);
        SCAN_BAR();
#define SC_STEP(n, st) do { if ((n) < Nc) { if ((n) + 1 < Nc) SC_WRITE(st, ((n) + 1) & 1); if ((n) + 3 < Nc) SC_LOAD(st, (n) + 3); SCAN_BAR(); } } while (0)
#pragma unroll 1
        for (int n = 0; n < Nc; n += 2) { SC_STEP(n, s1); SC_STEP(n + 1, s0); }
#undef SC_STEP
#undef SC_WRITE
#undef SC_LOAD
    } else {
        const int w = half * 2 + wave, r32 = lane & 31, hi = lane >> 5;
        f32x16 S[4];
#pragma unroll
        for (int t = 0; t < 4; ++t)
#pragma unroll
            for (int r = 0; r < 16; ++r) S[t][r] = 0.f;
        const __amdgpu_buffer_rsrc_t orsrc = __builtin_amdgcn_make_buffer_rsrc((void*)(ODIR + (size_t)(sq * Tp) * 1024 + h * 128 + 32 * w), 0, 0x7fffffff, 0x00020000);
        SCAN_BAR();
#pragma unroll 1
        for (int n = 0; n < Nc; ++n) {
            const LAS unsigned char* buf = lds + (n & 1) * SC_BUF + lane * 16;
            const float gam = *(const LAS float*)(lds + (n & 1) * SC_BUF + REC_GAM);
#define LDF(off) (*(const LAS bf16x8*)(buf + (off)))
#define FWO(i, t, s) (REC_FW + (((i) * 4 + (t)) * 2 + (s)) * 1024)
#define FQO(i, t, s) (REC_FQ + (((i) * 4 + (t)) * 2 + (s)) * 1024)
#define FKO(t, ip, s) (REC_FK + (((t) * 2 + (ip)) * 2 + (s)) * 1024)
#define FQKO(i, ip, s) (REC_FQK + (((i) * 2 + (ip)) * 2 + (s)) * 1024)
            bf16x8 A[8], B[8];
#pragma unroll
            for (int e = 0; e < 8; ++e) { A[e] = LDF(FWO(e & 1, e >> 2, (e >> 1) & 1)); B[e] = LDF(FWO(e & 1, 2 + (e >> 2), (e >> 1) & 1)); }
            v4u ua[2], ub[2];
#pragma unroll
            for (int i = 0; i < 2; ++i) { const LAS v4u* pu = (const LAS v4u*)(lds + (n & 1) * SC_BUF + REC_FU + ((w * 2 + i) * 64 + lane) * 32); ua[i] = pu[0]; ub[i] = pu[1]; }
            __builtin_amdgcn_sched_barrier(0);
            bf16x8 Sf[4][2];
#pragma unroll
            for (int t = 0; t < 4; ++t) { Sf[t][0] = pack8(S[t], 0); Sf[t][1] = pack8(S[t], 1); }
            f32x16 V[2];
#pragma unroll
            for (int i = 0; i < 2; ++i) { const v4u a = ua[i], b = ub[i];
                V[i][0] = bflo(a.x); V[i][1] = bfhi(a.x); V[i][2] = bflo(a.y); V[i][3] = bfhi(a.y); V[i][4] = bflo(a.z); V[i][5] = bfhi(a.z); V[i][6] = bflo(a.w); V[i][7] = bfhi(a.w);
                V[i][8] = bflo(b.x); V[i][9] = bfhi(b.x); V[i][10] = bflo(b.y); V[i][11] = bfhi(b.y); V[i][12] = bflo(b.z); V[i][13] = bfhi(b.z); V[i][14] = bflo(b.w); V[i][15] = bfhi(b.w); }
            __builtin_amdgcn_sched_barrier(0);
#pragma unroll
            for (int e = 0; e < 8; ++e) V[e & 1] = MFMA32(A[e], Sf[e >> 2][(e >> 1) & 1], V[e & 1]);
            __builtin_amdgcn_sched_barrier(0);
#pragma unroll
            for (int e = 0; e < 8; ++e) A[e] = LDF(FQO(e & 1, e >> 2, (e >> 1) & 1));
            __builtin_amdgcn_sched_barrier(0);
#pragma unroll
            for (int e = 0; e < 8; ++e) V[e & 1] = MFMA32(B[e], Sf[2 + (e >> 2)][(e >> 1) & 1], V[e & 1]);
            __builtin_amdgcn_sched_barrier(0);
#pragma unroll
            for (int e = 0; e < 8; ++e) B[e] = LDF(FQO(e & 1, 2 + (e >> 2), (e >> 1) & 1));
            __builtin_amdgcn_sched_barrier(0);
            f32x16 O[2];
#pragma unroll
            for (int i = 0; i < 2; ++i)
#pragma unroll
                for (int r = 0; r < 16; ++r) O[i][r] = 0.f;
#pragma unroll
            for (int e = 0; e < 8; ++e) O[e & 1] = MFMA32(A[e], Sf[e >> 2][(e >> 1) & 1], O[e & 1]);
            __builtin_amdgcn_sched_barrier(0);
#pragma unroll
            for (int e = 0; e < 8; ++e) A[e] = LDF(FKO(e & 3, 0, e >> 2));
            bf16x8 Vf[2][2];
#pragma unroll
            for (int i = 0; i < 2; ++i) { Vf[i][0] = pack8(V[i], 0); Vf[i][1] = pack8(V[i], 1); }
#pragma unroll
            for (int t = 0; t < 4; ++t)
#pragma unroll
                for (int r = 0; r < 16; ++r) S[t][r] *= gam;
            __builtin_amdgcn_sched_barrier(0);
#pragma unroll
            for (int e = 0; e < 8; ++e) O[e & 1] = MFMA32(B[e], Sf[2 + (e >> 2)][(e >> 1) & 1], O[e & 1]);
            __builtin_amdgcn_sched_barrier(0);
#pragma unroll
            for (int e = 0; e < 8; ++e) B[e] = LDF(FKO(e & 3, 1, e >> 2));
            __builtin_amdgcn_sched_barrier(0);
#pragma unroll
            for (int e = 0; e < 8; ++e) S[e & 3] = MFMA32(A[e], Vf[0][e >> 2], S[e & 3]);
            __builtin_amdgcn_sched_barrier(0);
            A[0] = LDF(FQKO(0, 0, 0)); A[1] = LDF(FQKO(1, 0, 0)); A[2] = LDF(FQKO(0, 0, 1)); A[3] = LDF(FQKO(1, 0, 1)); A[4] = LDF(FQKO(1, 1, 0)); A[5] = LDF(FQKO(1, 1, 1));
            __builtin_amdgcn_sched_barrier(0);
#pragma unroll
            for (int e = 0; e < 8; ++e) S[e & 3] = MFMA32(B[e], Vf[1][e >> 2], S[e & 3]);
            __builtin_amdgcn_sched_barrier(0);
            O[0] = MFMA32(A[0], Vf[0][0], O[0]); O[1] = MFMA32(A[1], Vf[0][0], O[1]); O[0] = MFMA32(A[2], Vf[0][1], O[0]); O[1] = MFMA32(A[3], Vf[0][1], O[1]);
            O[1] = MFMA32(A[4], Vf[1][0], O[1]); O[1] = MFMA32(A[5], Vf[1][1], O[1]);
#undef LDF
#undef FWO
#undef FQO
#undef FKO
#undef FQKO
            { const int tau0 = 64 * n + 4 * hi;
#pragma unroll
              for (int i = 0; i < 2; ++i)
#pragma unroll
                for (int r = 0; r < 16; ++r) { const int tau = tau0 + 32 * i + (r & 3) + 8 * (r >> 2); const int trow = d ? Tp - 1 - tau : tau;
                    __builtin_amdgcn_raw_buffer_store_b16((short)f2bf1(O[i][r]), orsrc, (trow * 1024 + r32) * 2, 0, 0); } }
            SCAN_BAR();
        }
    }
#undef SC_SRC
}
#define KSWZ(row, colB) ((row) * 256 + ((colB) ^ (((row) & 7) << 4)))
#define SBAR() __builtin_amdgcn_sched_barrier(0)
constexpr int AT_V = 0, AT_K = 32768, AT_OST = 0, AT_OST_W = 16896, AT_WS = 8 * AT_OST_W;
constexpr float ATT_THR = 11.5f;
__device__ __forceinline__ int v_st(int k, int c) { const int kk = (k & ~0xC) | ((k & 4) << 1) | ((k & 8) >> 1); return ((kk >> 3) * 4 + (c >> 5)) * 512 + ((kk & 7) * 32 + (c & 31)) * 2; }
__device__ __forceinline__ int v_rd_base(int lane) { return ((lane & 3) << 3) | (((lane >> 2) & 3) << 6) | (((lane >> 4) & 1) << 5) | (((lane >> 5) & 1) << 8); }
constexpr int v_rd_off(int d0, int ks, int half) { return d0 * 512 + ks * 4096 + half * 2048; }
template <int OFF> __device__ __forceinline__ s16x4 tr_read(int vb) {
    s16x4 r; asm volatile("ds_read_b64_tr_b16 %0, %1 offset:%2" : "=&v"(r) : "v"(vb), "i"(OFF) : "memory"); return r;
}
template <int D0> __device__ __forceinline__ void pv_one(f32x16& od, int vb, bf16x8 pa0, bf16x8 pa1, bf16x8 pa2, bf16x8 pa3) {
    const s16x4 l0 = tr_read<v_rd_off(D0, 0, 0)>(vb), h0 = tr_read<v_rd_off(D0, 0, 1)>(vb), l1 = tr_read<v_rd_off(D0, 1, 0)>(vb), h1 = tr_read<v_rd_off(D0, 1, 1)>(vb);
    const s16x4 l2 = tr_read<v_rd_off(D0, 2, 0)>(vb), h2 = tr_read<v_rd_off(D0, 2, 1)>(vb), l3 = tr_read<v_rd_off(D0, 3, 0)>(vb), h3 = tr_read<v_rd_off(D0, 3, 1)>(vb);
    asm volatile("s_waitcnt lgkmcnt(0)" ::: "memory"); SBAR();
#define PK(L, H) (bf16x8){L[0], L[1], L[2], L[3], H[0], H[1], H[2], H[3]}
    od = MFMA32(pa0, PK(l0, h0), od); od = MFMA32(pa1, PK(l1, h1), od); od = MFMA32(pa2, PK(l2, h2), od); od = MFMA32(pa3, PK(l3, h3), od);
#undef PK
}
__device__ __forceinline__ void pv_d0(f32x16* o, int vb, bf16x8 pa0, bf16x8 pa1, bf16x8 pa2, bf16x8 pa3) {
    pv_one<0>(o[0], vb, pa0, pa1, pa2, pa3); pv_one<1>(o[1], vb, pa0, pa1, pa2, pa3); pv_one<2>(o[2], vb, pa0, pa1, pa2, pa3); pv_one<3>(o[3], vb, pa0, pa1, pa2, pa3);
}
template <bool FIXED>
__device__ __forceinline__ float softmax_tile(f32x16& p0, f32x16& p1, float& m_reg, float& l_reg, bf16x8& pa0, bf16x8& pa1, bf16x8& pa2, bf16x8& pa3) {
    float alpha = 1.f;
    if (!FIXED) {
        float pmax = p0[0];
#pragma unroll
        for (int r = 1; r < 16; ++r) pmax = fmaxf(pmax, p0[r]);
#pragma unroll
        for (int r = 0; r < 16; ++r) pmax = fmaxf(pmax, p1[r]);
        pmax = half_max(pmax);
        if (!__all(pmax - m_reg <= ATT_THR)) { const float mn = fmaxf(m_reg, pmax); alpha = __builtin_amdgcn_exp2f(m_reg - mn); m_reg = mn; }
        const float mn = m_reg;
#pragma unroll
        for (int r = 0; r < 16; ++r) { p0[r] = __builtin_amdgcn_exp2f(p0[r] - mn); p1[r] = __builtin_amdgcn_exp2f(p1[r] - mn); }
    } else {
#pragma unroll
        for (int r = 0; r < 16; ++r) { p0[r] = __builtin_amdgcn_exp2f(p0[r]); p1[r] = __builtin_amdgcn_exp2f(p1[r]); }
    }
    float ps = 0.f;
#pragma unroll
    for (int r = 0; r < 16; ++r) ps += p0[r];
#pragma unroll
    for (int r = 0; r < 16; ++r) ps += p1[r];
    ps = half_sum(ps);
    l_reg = l_reg * alpha + ps;
#define PK4(P, BASE, OUT) do { unsigned a0 = cvtpk(P[BASE + 0], P[BASE + 1]), a1 = cvtpk(P[BASE + 2], P[BASE + 3]);   \
    unsigned b0 = cvtpk(P[BASE + 4], P[BASE + 5]), b1 = cvtpk(P[BASE + 6], P[BASE + 7]);                              \
    auto r0 = __builtin_amdgcn_permlane32_swap(a0, b0, false, false); auto r1 = __builtin_amdgcn_permlane32_swap(a1, b1, false, false); \
    v4u w = {r0[0], r1[0], r0[1], r1[1]}; OUT = __builtin_bit_cast(bf16x8, w); } while (0)
    PK4(p0, 0, pa0); PK4(p0, 8, pa1); PK4(p1, 0, pa2); PK4(p1, 8, pa3);
#undef PK4
    return alpha;
}

__device__ __forceinline__ int diff_radius(float bnat, int h) {
    const float slope_n = exp2f(-(float)(h + 1));
    const float dn = (2.0f * bnat + logf(2.0f / (1.0f - expf(-slope_n))) + 22.18f) / slope_n;
    return (dn < 1.0e6f) ? (int)dn + 1 : 1000000;
}
struct AttnParams { const float* q_gain; const float* sink; const float* lam; const float* norm_gain; float bnat; };
#define KSWZ64(row, colB) ((row) * 128 + ((colB) ^ ((((row) >> 1) & 7) << 4)))

template <int MODE, bool FIXED>
__device__ __forceinline__ void attn_unit(LAS unsigned char* lds, unsigned char* ws, const AttnParams& P, int l, int Tp, int sq, int h, int qb, int part, int np, int pslot, int tid, int wave, int lane) {
    constexpr int NPASS_M = MODE ? 2 : 1, NDD = MODE ? 4 : 8;
    const bf16* PROJ = (const bf16*)(ws + WS_PROJ);
    const int r32 = lane & 31, hi = lane >> 5;
    const int seq0 = sq * Tp, q0 = qb * 256;
    const int qcol = MODE ? C_DQ + h * 128 : C_SQ + h * 128;
    const int kcol = MODE ? C_DK + h * 128 : C_SKV + (h >> 2) * 128;
    const int vcol = MODE ? C_DV + h * 128 : C_SKV + 256 + (h >> 2) * 128;
    const int zcol = MODE ? C_DZ + h * 128 : C_SZ + h * 128;
    int jlo = 0, jhi = Tp / 64;
    const float slope_n = exp2f(-(float)(h + 1)), slope2 = slope_n * LOG2E;
    if (MODE == 0) { jlo = (q0 - 128) / 64; if (jlo < 0) jlo = 0; const int e = (q0 + 384) / 64; if (e < jhi) jhi = e; }
    else {
        float bn = P.bnat; asm volatile("" : "+v"(bn));
        float smin = 1.0e30f;
        { const bf16* qp = PROJ + (size_t)(seq0 + q0 + wave * 32 + r32) * LDP + qcol + hi * 8; const bf16* kp = PROJ + (size_t)(seq0 + q0 + wave * 32 + r32) * LDP + kcol + hi * 8;
#pragma unroll
          for (int mq = 0; mq < 2; ++mq) { float dot = 0.f;
#pragma unroll
              for (int d0 = 0; d0 < 4; ++d0) { const v4u wq = *(const v4u*)(qp + mq * 64 + d0 * 16), wk = *(const v4u*)(kp + mq * 64 + d0 * 16);
                  const float q8[8] = {bflo(wq.x), bfhi(wq.x), bflo(wq.y), bfhi(wq.y), bflo(wq.z), bfhi(wq.z), bflo(wq.w), bfhi(wq.w)};
                  const float k8[8] = {bflo(wk.x), bfhi(wk.x), bflo(wk.y), bfhi(wk.y), bflo(wk.z), bfhi(wk.z), bflo(wk.w), bfhi(wk.w)};
#pragma unroll
                  for (int e = 0; e < 8; ++e) dot += q8[e] * k8[e]; }
              dot = half_sum(dot);
              smin = fminf(smin, dot * (1.0f / LOG2E)); }
          smin = -wave_max(-smin);
          LAS float* sm = (LAS float*)(lds + AT_WS) + 512;
          if (lane == 0) sm[wave] = smin;
          asm volatile("s_waitcnt lgkmcnt(0)" ::: "memory"); __builtin_amdgcn_s_barrier(); asm volatile("" ::: "memory");
          smin = fminf(fminf(fminf(sm[0], sm[1]), fminf(sm[2], sm[3])), fminf(fminf(sm[4], sm[5]), fminf(sm[6], sm[7]))); }
        float beff = 0.5f * (bn - smin + 0.1f); if (!(beff < bn)) beff = bn;
        const int dk = diff_radius(beff, h);
        const int a = q0 - dk; jlo = a > 0 ? (a >> 6) : 0; const int e = ((q0 + 255 + dk) >> 6) + 1; if (e < jhi) jhi = e;
        if (np > 1) { const int len = (jhi - jlo + np - 1) / np; jlo += part * len; const int e2 = jlo + len; if (e2 < jhi) jhi = e2; }
    }
    LAS unsigned char* V_lds = lds + AT_V; LAS unsigned char* K_lds = lds + AT_K;
    LAS float* wsf = (LAS float*)(lds + AT_WS) + wave * 64; LAS float* li_l = wsf; LAS float* al_l = wsf + 32;
    float* park = (float*)(ws + WS_PARK) + (size_t)(blockIdx.x * NWAVES + wave) * 4096 + lane * 4;
    const float qposh = (float)(q0 + wave * 32 + r32 - 4 * hi), qposf = (float)(q0 + wave * 32 + r32);
    const int vb0 = (int)(uintptr_t)V_lds + v_rd_base(lane);
    const int sr = tid >> 4, sc = (tid & 15) * 8, vst0 = v_st(sr, sc), vst1 = v_st(32 + sr, sc);
    const int kr1 = tid >> 3, kc1 = (tid & 7) * 8;
    f32x16 o[4]; float l_reg = 0.f;
#pragma unroll 1
    for (int mp = 0; mp < NPASS_M; ++mp) {
        bf16x8 qr[NDD];
        if (MODE == 1) {
            const bf16* qp = PROJ + (size_t)(seq0 + q0 + wave * 32 + r32) * LDP + qcol + mp * 64 + hi * 8;
#pragma unroll
            for (int d0 = 0; d0 < NDD; ++d0) qr[d0] = *(const bf16x8*)(qp + d0 * 16);
        } else {
            const bf16* qp = PROJ + (size_t)(seq0 + q0 + wave * 32 + r32) * LDP + qcol + mp * 64 + hi * 8;
            float qf[NDD][8]; float ss = 0.f;
#pragma unroll
            for (int d0 = 0; d0 < NDD; ++d0) { const v4u w = *(const v4u*)(qp + d0 * 16);
                qf[d0][0] = bflo(w.x); qf[d0][1] = bfhi(w.x); qf[d0][2] = bflo(w.y); qf[d0][3] = bfhi(w.y); qf[d0][4] = bflo(w.z); qf[d0][5] = bfhi(w.z); qf[d0][6] = bflo(w.w); qf[d0][7] = bfhi(w.w);
#pragma unroll
                for (int e = 0; e < 8; ++e) ss += qf[d0][e] * qf[d0][e]; }
            ss = half_sum(ss);
            const float rs = MODE ? (1.0f / sqrtf(ss * (1.0f / 64.0f) + NORM_EPS)) * (0.125f * LOG2E) : (1.0f / sqrtf(ss * (1.0f / 128.0f) + NORM_EPS)) * (0.08838834764831845f * LOG2E);
#pragma unroll
            for (int d0 = 0; d0 < NDD; ++d0) { const float* g = P.q_gain + d0 * 16 + hi * 8;
                const f32x4 ga = *(const f32x4*)g, gb = *(const f32x4*)(g + 4);
                v4u w; w.x = cvtpk(qf[d0][0] * rs * ga.x, qf[d0][1] * rs * ga.y); w.y = cvtpk(qf[d0][2] * rs * ga.z, qf[d0][3] * rs * ga.w);
                w.z = cvtpk(qf[d0][4] * rs * gb.x, qf[d0][5] * rs * gb.y); w.w = cvtpk(qf[d0][6] * rs * gb.z, qf[d0][7] * rs * gb.w);
                qr[d0] = __builtin_bit_cast(bf16x8, w); }
        }
        float m_reg = (MODE == 0) ? P.sink[h] * LOG2E : -1e30f; l_reg = (MODE == 0) ? (FIXED ? exp2f(P.sink[h] * LOG2E) : 1.f) : 0.f;
#pragma unroll
        for (int d = 0; d < 4; ++d)
#pragma unroll
            for (int r = 0; r < 16; ++r) o[d][r] = 0.f;
        const bf16* Vg = PROJ + (size_t)seq0 * LDP + vcol + sc;
        const bf16* Kg = MODE ? PROJ + (size_t)(seq0 + kr1) * LDP + kcol + mp * 64 + kc1 : PROJ + (size_t)seq0 * LDP + kcol + sc;
        constexpr int DEPTH = 1;
        struct Stg { v4u vs0, vs1, ks0, ks1; };
        Stg sA, sB;
#define SLOAD(S, k0) do { S.vs0 = *(const v4u*)(Vg + (size_t)((k0) + sr) * LDP); S.vs1 = *(const v4u*)(Vg + (size_t)((k0) + 32 + sr) * LDP); \
        if (MODE) { S.ks0 = *(const v4u*)(Kg + (size_t)(k0) * LDP); } \
        else { S.ks0 = *(const v4u*)(Kg + (size_t)((k0) + sr) * LDP); S.ks1 = *(const v4u*)(Kg + (size_t)((k0) + 32 + sr) * LDP); } } while (0)
#define SWRITE(S, b) do { *(LAS v4u*)(V_lds + (b) * 16384 + vst0) = S.vs0; *(LAS v4u*)(V_lds + (b) * 16384 + vst1) = S.vs1; \
        if (MODE) { *(LAS v4u*)(K_lds + (b) * 16384 + KSWZ64(kr1, kc1 * 2)) = S.ks0; } \
        else { *(LAS v4u*)(K_lds + (b) * 16384 + KSWZ(sr, sc * 2)) = S.ks0; *(LAS v4u*)(K_lds + (b) * 16384 + KSWZ(32 + sr, sc * 2)) = S.ks1; } } while (0)
#define TILE(S, jj) do { const int j_ = (jj); const int b_ = (j_ - jlo) & 1; \
            SWRITE(S, b_); \
            if (j_ + DEPTH < jhi) SLOAD(S, (j_ + DEPTH) * 64); \
            asm volatile("s_waitcnt lgkmcnt(0)" ::: "memory"); __builtin_amdgcn_s_barrier(); asm volatile("" ::: "memory"); \
              \
            if (MODE == 1 || (j_ * 64 + 63 >= q0 + wave * 32 - 128 && j_ * 64 <= q0 + wave * 32 + 31 + 128)) { \
            const LAS unsigned char* Kb = K_lds + b_ * 16384; const int vb = vb0 + b_ * 16384; \
            const float fi = qposh - (float)(j_ * 64);                 \
            f32x16 p0, p1; \
            _Pragma("unroll") for (int r = 0; r < 16; ++r) { p0[r] = 0.f; p1[r] = 0.f; } \
            _Pragma("unroll") for (int dd = 0; dd < NDD; ++dd) { const int cb = (dd * 16 + hi * 8) * 2; \
                const bf16x8 b0 = MODE ? *(const LAS bf16x8*)(Kb + KSWZ64(r32, cb)) : *(const LAS bf16x8*)(Kb + KSWZ(r32, cb)); \
                const bf16x8 b1 = MODE ? *(const LAS bf16x8*)(Kb + KSWZ64(32 + r32, cb)) : *(const LAS bf16x8*)(Kb + KSWZ(32 + r32, cb)); \
                p0 = MFMA32(b0, qr[dd], p0); p1 = MFMA32(b1, qr[dd], p1); } \
              \
            const bool lin_ = (MODE == 1) && FIXED && (j_ * 64 + 63 < q0 + wave * 32 || j_ * 64 > q0 + wave * 32 + 31); \
            if (lin_) { const float sg = (j_ * 64 + 63 < q0 + wave * 32) ? 1.f : -1.f, slv = sg * slope2, lcv = -slv * (qposf - (float)(j_ * 64)); \
                const unsigned hw = cvtpk(lcv, slv), lw = cvtpk(lcv - bflo(hw), slv - bfhi(hw)); \
                v4u qx = {(hw & 0xffffu) | (lw << 16), (hw >> 16) | (lw & 0xffff0000u), 0u, 0u}; if (hi) qx = (v4u){0u, 0u, 0u, 0u}; \
                const LAS unsigned char* Kx = K_lds + 8192 + hi * 16; \
                p0 = MFMA32(*(const LAS bf16x8*)(Kx + r32 * 32), __builtin_bit_cast(bf16x8, qx), p0); p1 = MFMA32(*(const LAS bf16x8*)(Kx + (32 + r32) * 32), __builtin_bit_cast(bf16x8, qx), p1); } \
            if (!lin_) { \
            _Pragma("unroll") for (int r = 0; r < 16; ++r) { const float dd0 = fabsf(fi - (float)((r & 3) + 8 * (r >> 2))), dd1 = fabsf(fi - (float)(32 + (r & 3) + 8 * (r >> 2))); \
                p0[r] = fmaf(-slope2, dd0, p0[r]); p1[r] = fmaf(-slope2, dd1, p1[r]); \
                if (MODE == 0) { if (dd0 > 128.f) p0[r] = -INFINITY; if (dd1 > 128.f) p1[r] = -INFINITY; } } } \
            bf16x8 pa0, pa1, pa2, pa3; \
            const float alpha = softmax_tile<FIXED>(p0, p1, m_reg, l_reg, pa0, pa1, pa2, pa3); \
            if (!FIXED && __any(alpha < 1.f)) { if (hi == 0) al_l[r32] = alpha; asm volatile("s_waitcnt lgkmcnt(0)" ::: "memory"); \
                _Pragma("unroll") for (int r = 0; r < 16; ++r) { const float a = al_l[crow(r, hi)]; \
                    _Pragma("unroll") for (int d = 0; d < 4; ++d) o[d][r] *= a; } } \
            SBAR(); pv_d0(o, vb, pa0, pa1, pa2, pa3); } } while (0)
        if (MODE == 1 && tid < 64) {
            const unsigned one2 = 0x3F803F80u, cw = cvtpk((float)tid, (float)tid);
            *(LAS v4u*)(K_lds + 8192 + tid * 32) = (v4u){one2, cw, 0u, 0u}; *(LAS v4u*)(K_lds + 8192 + tid * 32 + 16) = (v4u){0u, 0u, 0u, 0u}; }
        if (jlo < jhi) SLOAD(sA, jlo * 64);
        if (DEPTH == 2 && jlo + 1 < jhi) SLOAD(sB, (jlo + 1) * 64);
#pragma unroll 1
        for (int j = jlo; j < jhi; j += 2) {
            TILE(sA, j);
            if (j + 1 < jhi) { if (DEPTH == 2) TILE(sB, j + 1); else TILE(sA, j + 1); }
        }
#undef TILE
#undef SLOAD
#undef SWRITE
        asm volatile("s_waitcnt lgkmcnt(0)" ::: "memory"); __builtin_amdgcn_s_barrier(); asm volatile("" ::: "memory");
        if (MODE == 1 && pslot >= 0) {
            float* po = (float*)(ws + WS_PART) + ((size_t)(pslot * 2 + mp) * 256 + wave * 32 + 4 * hi) * 128 + r32;
#pragma unroll
            for (int g = 0; g < 4; ++g) { float* pg = po + g * 8 * 128; asm volatile("" : "+v"(pg));
#pragma unroll
                for (int e = 0; e < 4; ++e)
#pragma unroll
                    for (int d = 0; d < 4; ++d) pg[e * 128 + d * 32] = o[d][4 * g + e]; }
            if (hi == 0) ((float*)(ws + WS_PARTL))[(pslot * 2 + mp) * 256 + wave * 32 + r32] = l_reg;
        } else
        if (MODE == 1 && mp == 0) {
            if (hi == 0) li_l[r32] = l_reg;
            asm volatile("s_waitcnt lgkmcnt(0)" ::: "memory");
#pragma unroll
            for (int r4 = 0; r4 < 4; ++r4) { float rl[4];
#pragma unroll
                for (int e = 0; e < 4; ++e) rl[e] = __builtin_amdgcn_rcpf(li_l[crow(4 * r4 + e, hi)]);
#pragma unroll
                for (int d = 0; d < 4; ++d) { f32x4 t; t.x = o[d][4 * r4] * rl[0]; t.y = o[d][4 * r4 + 1] * rl[1]; t.z = o[d][4 * r4 + 2] * rl[2]; t.w = o[d][4 * r4 + 3] * rl[3];
                    *(f32x4*)(park + (d * 4 + r4) * 256) = t; } }
            asm volatile("s_waitcnt lgkmcnt(0)" ::: "memory");
        }
    }
    if (MODE == 1 && pslot >= 0) return;
    float lam = 0.f; int ll_ = l; asm volatile("" : "+s"(ll_)); const float lin = 0.8f - 0.6f * expf(-0.3f * (float)ll_);
    if (MODE == 1) { const float a = P.lam[lane] * P.lam[64 + lane], bq = P.lam[128 + lane] * P.lam[192 + lane]; lam = expf(wave_sum(a)) - expf(wave_sum(bq)) + lin; }
    LAS float* ost = (LAS float*)(lds + AT_OST + wave * AT_OST_W);
    {
        if (hi == 0) li_l[r32] = l_reg;
        asm volatile("s_waitcnt lgkmcnt(0)" ::: "memory");
#pragma unroll
        for (int r4 = 0; r4 < 4; ++r4) { float rl[4];
#pragma unroll
            for (int e = 0; e < 4; ++e) rl[e] = __builtin_amdgcn_rcpf(li_l[crow(4 * r4 + e, hi)]);
#pragma unroll
            for (int d = 0; d < 4; ++d) { f32x4 pk = {0.f, 0.f, 0.f, 0.f}; if (MODE == 1) pk = *(const f32x4*)(park + (d * 4 + r4) * 256);
#pragma unroll
                for (int e = 0; e < 4; ++e) { float v = o[d][4 * r4 + e] * rl[e]; if (MODE == 1) v = pk[e] - lam * v;
                    ost[crow(4 * r4 + e, hi) * 132 + d * 32 + r32] = v; } } }
    }
    asm volatile("s_waitcnt lgkmcnt(0)" ::: "memory");
    {
        const int row = lane >> 1, half = lane & 1;
        const LAS f32x4* src = (const LAS f32x4*)(ost + row * 132 + half * 64);
        float v[64];
#pragma unroll
        for (int k = 0; k < 16; ++k) { const f32x4 t = src[k]; v[4 * k] = t.x; v[4 * k + 1] = t.y; v[4 * k + 2] = t.z; v[4 * k + 3] = t.w; }
        const size_t grow = (size_t)(seq0 + q0 + wave * 32 + row);
        float rs = 1.f;
        if (MODE == 1) { float ss = 0.f;
#pragma unroll
            for (int e = 0; e < 64; ++e) ss += v[e] * v[e];
            ss += xshfl<1>(ss); rs = (1.0f / sqrtf(ss * (1.0f / 128.0f) + NORM_EPS)) * (1.0f - lin); }
        const v4u* zp = (const v4u*)(PROJ + grow * LDP + zcol + half * 64);
        bf16* yb = (bf16*)(ws + WS_Y + (MODE ? 2 : 1) * SZ_Y1) + grow * 1024 + h * 128 + half * 64;
#pragma unroll
        for (int k = 0; k < 8; ++k) { const v4u zw = zp[k];
            const float z[8] = {bflo(zw.x), bfhi(zw.x), bflo(zw.y), bfhi(zw.y), bflo(zw.z), bfhi(zw.z), bflo(zw.w), bfhi(zw.w)};
            float y[8];
#pragma unroll
            for (int e = 0; e < 8; ++e) { float g = 1.f; if (MODE == 1) g = P.norm_gain[half * 64 + 8 * k + e]; y[e] = v[8 * k + e] * rs * g * z[e]; }
            v4u w; w.x = cvtpk(y[0], y[1]); w.y = cvtpk(y[2], y[3]); w.z = cvtpk(y[4], y[5]); w.w = cvtpk(y[6], y[7]);
            *(v4u*)(yb + 8 * k) = w; }
    }
    asm volatile("s_waitcnt lgkmcnt(0)" ::: "memory"); __builtin_amdgcn_s_barrier(); asm volatile("" ::: "memory");
}
#ifndef ONLY_PHASE
#define ONLY_PHASE -1
#endif
#ifndef ONLY_SUB
#define ONLY_SUB -1
#endif
#define PH4_ON(k) (ONLY_SUB < 0 || ONLY_SUB == (k))
#define PH_ON(k) (ONLY_PHASE < 0 || ONLY_PHASE == (k))
#ifndef DUP_PHASE
#define DUP_PHASE -1
#endif
#define NREP(k) ((DUP_PHASE == (k)) ? 2 : 1)
#ifndef DUP_PASSES
#define DUP_PASSES 15
#endif
#ifndef SPLIT_TILES
#define SPLIT_TILES 128
#endif
#ifndef SPLIT_MAX
#define SPLIT_MAX 2
#endif
#ifndef B_SKEW_NS
#define B_SKEW_NS 0
#endif
#ifndef MK_PER_PHASE
#define MK_PER_PHASE 0
#endif
constexpr int N_ITER = DEPTH * NPASS, PH_PER_IT = 7, N_PHASES = 1 + N_ITER * PH_PER_IT;
struct Args { const float* in[17]; float* out; unsigned char* ws; int ph_lo, ph_hi; };
#define WG_SYNC_LDS() do { asm volatile("s_waitcnt lgkmcnt(0)" ::: "memory"); __builtin_amdgcn_s_barrier(); asm volatile("" ::: "memory"); } while (0)

__global__ void __launch_bounds__(NTHREADS, 2) fwd_kernel(Args args) {
    extern __shared__ __attribute__((aligned(16))) unsigned char lds_raw[];
    LAS unsigned char* lds = (LAS unsigned char*)lds_raw;
    volatile LAS unsigned* MISC = (volatile LAS unsigned*)(lds + MISC_OFF);
    const int tid0 = threadIdx.x;
    const int G = gridDim.x, bx = blockIdx.x, ngw = G * NWAVES;
    unsigned char* ws = args.ws;
    unsigned* ctl = (unsigned*)(ws + WS_CTL);
    if (tid0 < 128) MISC[tid0] = 0u;
    __syncthreads();
    XcdBarrier bar; bar.bar = ctl + CW_BAR; bar.x = 0; bar.st = nullptr;
    if (!MK_PER_PHASE) bar = xcd_barrier_post(ctl + CW_BAR, MISC + 8);
    const int lo = args.ph_lo, hi = args.ph_hi;
#define IN(k) (lo <= (k) && (k) < hi)
#define LAUNDER_TID() int tid = tid0; asm volatile("" : "+v"(tid)); const int lane = tid & 63, wave = __builtin_amdgcn_readfirstlane(tid >> 6), gw = bx * NWAVES + wave; (void)lane; (void)gw
#define TBR(i) __builtin_amdgcn_readfirstlane((int)TB[i])
#define T_GT 0
#define T_PB 32
#define T_NPH 40
#define T_NDF 48
#define T_LEN 56
#define DIFF_TABLE(bd_, fixd_) volatile LAS int* TB = (volatile LAS int*)(MISC + 16); do { const int per_ = nseq * (Tp / 256); \
        if (tid0 == 0) { int ps = 0; \
            for (int hh = 7; hh >= 0; --hh) { const int dk = diff_radius((bd_), hh); int ntm = (255 + 2 * dk) / 64 + 2; if (ntm > Tp / 64) ntm = Tp / 64; \
                int np = (fixd_) ? (ntm + SPLIT_TILES - 1) / SPLIT_TILES : 1; if (np > SPLIT_MAX) np = SPLIT_MAX; if (np > 1 && ps + np * per_ > PART_SLOTS) np = 1; \
                TB[T_NPH + hh] = np; TB[T_PB + hh] = (np > 1) ? ps : -1; if (np > 1) ps += np * per_; TB[T_LEN + hh] = (ntm + np - 1) / np; } \
              \
            int g = 0; unsigned done_ = 0u; \
            for (int k = 0; k < 8; ++k) { int best = -1, bl = -1; for (int hh = 7; hh >= 0; --hh) if (!((done_ >> hh) & 1u) && TB[T_LEN + hh] > bl) { bl = TB[T_LEN + hh]; best = hh; } \
                done_ |= 1u << best; const int np = TB[T_NPH + best]; for (int p = 0; p < np; ++p) TB[T_GT + g++] = best | (p << 8) | (np << 16); } \
            TB[T_NDF] = g * per_; } \
        __syncthreads(); } while (0)
#define DIFF_BOUND(bd_) float bd_; { int ln_ = tid0; asm volatile("" : "+v"(ln_)); const int ln = ln_ & 63; const float* dqg_ = diff_q_gain + l * 64; const float* dkg_ = diff_k_gain + l * 64; \
        float gq = fabsf(dqg_[ln]), gk = fabsf(dkg_[ln]); \
        gq = wave_max(gq); gk = wave_max(gk); \
        bd_ = 8.0f * gq * gk * 1.02f; }
#define SEAM(k) do { if (!MK_PER_PHASE && IN(k) && IN((k) + 1)) xcd_barrier(bar); } while (0)

    const __attribute__((address_space(4))) unsigned char* kargs = (const __attribute__((address_space(4))) unsigned char*)__builtin_amdgcn_kernarg_segment_ptr();
#define INP(k) ([&]() { const __attribute__((address_space(4))) unsigned char* kp_ = kargs; asm volatile("" : "+s"(kp_)); return *(const float* const __attribute__((address_space(4)))*)(kp_ + 8 * (k)); }())
#define x_prompt INP(0)
#define x_sample INP(1)
#define norm_gain INP(2)
#define w_in INP(3)
#define conv_w INP(4)
#define a_log INP(5)
#define dt_bias INP(6)
#define gdn_norm_gain INP(7)
#define swa_q_gain INP(8)
#define swa_k_gain INP(9)
#define swa_sink INP(10)
#define diff_q_gain INP(11)
#define diff_k_gain INP(12)
#define diff_lambda INP(13)
#define diff_norm_gain INP(14)
#define w_branch INP(15)
#define w_out INP(16)

    if (PH_ON(0) && IN(0)) for (int rep = 0; rep < NREP(12); ++rep) { LAUNDER_TID(); phase_prologue(lds, w_in, w_branch, w_out, ws, gw, ngw, wave, lane); __syncthreads(); }
    SEAM(0);

    bf16* HN = (bf16*)(ws + WS_HN); bf16* PROJ = (bf16*)(ws + WS_PROJ); bf16* MRG = (bf16*)(ws + WS_MRG);
#pragma unroll 1
    for (int it = 0; it < N_ITER; ++it) {
        const int l = it >> 2, p = it & 3, pb = 1 + it * PH_PER_IT;
        const int Tp = (p < 2) ? 16384 : 4096, nseq = PASS_ROWS / Tp;
#define XIN() ((l == 0) ? ((p < 2) ? x_prompt + (size_t)p * PASS_ROWS * DM : x_sample + (size_t)(p - 2) * PASS_ROWS * DM) : (const float*)args.out + (size_t)p * PASS_ROWS * DM)

        bf16* HNp = HN + (size_t)p * PASS_ROWS * DM; float* RSp = (float*)(ws + WS_ROWSS) + (size_t)l * NTOK + (size_t)p * PASS_ROWS;
        if (PH_ON(1) && IN(pb + 0) && l == 0) { LAUNDER_TID(); const float* xin = XIN(); const float* ng = norm_gain; for (int m = gw; m < PASS_ROWS; m += ngw) rms_row(xin + (size_t)m * DM, ng, HNp + (size_t)m * DM, RSp + m, lane); }
        if (l == 0) SEAM(pb + 0);
        if (PH_ON(2) && IN(pb + 1)) for (int rep = 0; rep < ((DUP_PHASE == 2 || DUP_PHASE == 14 || DUP_PHASE == 16 || DUP_PHASE == 17) ? 2 : 1); ++rep) {
            if (rep) xcd_barrier(bar);
#if B_SKEW_NS > 0
            { const unsigned long long t0 = __builtin_amdgcn_s_memrealtime(), dl = (unsigned long long)((bx >> 3) & 3) * (unsigned long long)(B_SKEW_NS / 10); while (__builtin_amdgcn_s_memrealtime() - t0 < dl) __builtin_amdgcn_s_sleep(4); }
#endif
            pg8::Gemm g{HNp, (const bf16*)(ws + WS_WIN + (size_t)l * SZ_WIN_L), PASS_ROWS, NPROJ, DM}; pg8::StaticOrder S; S.init(PASS_ROWS, NPROJ, G, bx);
#if DUP_PHASE == 14
            if (rep == 1) { pg8::EpiNull EN{}; pg8::gemm_phase<pg8::EpiNull, pg8::StaticOrder, true, true>(lds, g, S, EN); } else
#endif
            {
#if DUP_PHASE == 17
            pg8::EpiProj E{PROJ, LDP, 0, 0, RSp, 1.0f / DM, NORM_EPS, 0, C_DK / 256, C_DK / 256 + 4, diff_k_gain + l * 64};
            if (rep == 0) { E.ldc = 256; E.tstride = (size_t)PASS_ROWS * 256 - 256; }
#else
            pg8::EpiProj E{PROJ, LDP, C_GATE / 256, C_GATE / 256 + 24, RSp, 1.0f / DM, NORM_EPS, C_GATE, C_BA / 256, (0xFull << (C_GZ / 256)) | (0xFull << (C_SZ / 256)) | (0xFull << (C_DZ / 256)), C_DQ / 256, C_DQ / 256 + 4, diff_q_gain + l * 64, 0.125f * LOG2E, C_DK / 256, C_DK / 256 + 4, diff_k_gain + l * 64};
#endif
#if DUP_PHASE == 16
            if (rep == 1) { E.O = (bf16*)(ws + WS_MTMP); E.ldc = 0; }
#endif
            pg8::gemm_phase<pg8::EpiProj, pg8::StaticOrder, true, true>(lds, g, S, E);
            }
        }
        SEAM(pb + 1);
        if (PH_ON(3) && IN(pb + 2)) {
            LAUNDER_TID();
            { const float* cw = conv_w; const float* al = a_log; const float* db = dt_bias;
              for (int rep = 0; rep < NREP(3); ++rep) {
                  unsigned pre_ba = 0u;
                  if (tid < 128 && bx < 2048) { const int d = tid >> 6, r = tid & 63, c = d ? 63 - r : r; const bf16* pn = PROJ + (size_t)((bx >> 3) * 64 + c) * LDP + C_BA;
                      pre_ba = (unsigned)pn[d * 8 + (bx & 7)] | ((unsigned)pn[16 + d * 8 + (bx & 7)] << 16); }
                  for (int u = bx; u < 2048; u += G) { const int un = u + G; gdn_prep_unit(lds, ws, cw, al, db, l, Tp, u >> 3, u & 7, un < 2048 ? (un >> 3) : -1, un & 7, pre_ba, tid, wave, lane); } } }
            { const float* skg = swa_k_gain + l * 128; const float* dkg = diff_k_gain + l * 64;
              for (int m = gw; m < PASS_ROWS; m += ngw) knorm_row<false>(PROJ + (size_t)m * LDP, skg, dkg, lane); }
        }
        SEAM(pb + 2);
#if DUP_PHASE == 10
        for (int xb = 0; xb < 5; ++xb) xcd_barrier(bar);
#endif
        if (PH_ON(4) && IN(pb + 3)) for (int rep = 0; rep < (((DUP_PHASE == 4 || DUP_PHASE == 5 || DUP_PHASE == 8 || DUP_PHASE == 9 || DUP_PHASE == 11) && (DUP_PASSES >> p & 1)) ? 2 : 1); ++rep) {
            if (rep) xcd_barrier(bar);
            const int nchain = nseq * 32, nqb = Tp / 256, nblk = nseq * 8 * nqb;
            float bd, bs;
            const float* dqg = diff_q_gain + l * 64; const float* sqg = swa_q_gain + l * 128;
            { int ln_ = tid0; asm volatile("" : "+v"(ln_)); const int ln = ln_ & 63; const float* dkg = diff_k_gain + l * 64; const float* skg = swa_k_gain + l * 128;
              float gq = fabsf(dqg[ln]), gk = fabsf(dkg[ln]);
              float sq_ = fmaxf(fabsf(sqg[ln]), fabsf(sqg[64 + ln])), sk_ = fmaxf(fabsf(skg[ln]), fabsf(skg[64 + ln]));
              gq = wave_max(gq); gk = wave_max(gk); sq_ = wave_max(sq_); sk_ = wave_max(sk_);
              bd = 8.0f * gq * gk * 1.02f; bs = 11.3137085f * sq_ * sk_ * 1.02f; }
            const bool fixd = (bd * LOG2E < 60.f) && (bd == bd), fixs = (bs * LOG2E < 60.f) && (bs == bs);
#define UNIFORM_F(x) __builtin_bit_cast(float, __builtin_amdgcn_readfirstlane(__builtin_bit_cast(int, (float)(x))))
            AttnParams PD{dqg, nullptr, diff_lambda + l * 256, diff_norm_gain + l * 128, UNIFORM_F(bd)};
            AttnParams PS{sqg, swa_sink + l * 8, nullptr, nullptr, UNIFORM_F(bs)};
            DIFF_TABLE(bd, fixd);
            const int ndiff = TBR(T_NDF);
            const int item_lo = (rep == 1 && (DUP_PHASE == 8 || DUP_PHASE == 11)) ? nchain : ((rep == 1 && DUP_PHASE == 9) ? nchain + ndiff : 0);
            const int total = (rep == 1 && DUP_PHASE == 5) ? nchain : ((rep == 1 && (DUP_PHASE == 8 || DUP_PHASE == 11)) ? nchain + ndiff : nchain + ndiff + nblk);
#pragma unroll 1
            for (;;) {
                LAUNDER_TID();
                if (tid == 0) MISC[0] = __hip_atomic_fetch_add(ctl + CW_QUEUE + it * 64 + rep * 32, 1u, __ATOMIC_RELAXED, __HIP_MEMORY_SCOPE_AGENT);
                __syncthreads();
                const int item = __builtin_amdgcn_readfirstlane((int)MISC[0]) + item_lo;
                __syncthreads();
                if (item >= total) break;
                if (PH4_ON(0) && item < nchain) { gdn_scan_unit(lds, ws, Tp, item >> 5, (item >> 2) & 7, (item >> 1) & 1, item & 1, tid, wave, lane); }
                else if (PH4_ON(1) && item < nchain + ndiff) { const int u = item - nchain, per = nseq * nqb;
                    const int g = u / per, un = u - g * per, e = TBR(T_GT + g), hh = e & 0xff, part = (e >> 8) & 0xff, np = e >> 16, sq = un / nqb, qb = un - sq * nqb;
                    const int pslot = (np > 1) ? TBR(T_PB + hh) + un * np + part : -1;
                    const bool pe_ = (DUP_PHASE == 11 && rep == 1);
                    if (fixd) attn_unit<1, true>(lds, ws, PD, l, Tp, sq, hh, qb, pe_ ? 999999 : part, pe_ ? 1000000 : np, pe_ ? PART_SLOTS - 1 : pslot, tid, wave, lane); else if (DUP_PHASE < 0) attn_unit<1, false>(lds, ws, PD, l, Tp, sq, hh, qb, 0, 1, -1, tid, wave, lane); }
                else if (PH4_ON(2)) { const int u = item - nchain - ndiff;
                    if (fixs) attn_unit<0, true>(lds, ws, PS, l, Tp, u / (8 * nqb), (u / nqb) & 7, u % nqb, 0, 1, -1, tid, wave, lane); else attn_unit<0, false>(lds, ws, PS, l, Tp, u / (8 * nqb), (u / nqb) & 7, u % nqb, 0, 1, -1, tid, wave, lane); }
                __syncthreads();
            }
        }
        SEAM(pb + 3);
        if (PH_ON(5) && IN(pb + 4)) for (int rep = 0; rep < NREP(13); ++rep) {
            if (rep) xcd_barrier(bar);
            LAUNDER_TID();
            const bf16* OD = (const bf16*)(ws + WS_ODIR);
            const float* gng = gdn_norm_gain + l * 128;
            { int m = gw;
              for (; m + 3 * ngw < PASS_ROWS; m += 4 * ngw) gdn_final_rows<4>(OD, PROJ, m, ngw, gng, (bf16*)(ws + WS_Y), lane);
              for (; m < PASS_ROWS; m += ngw)
                gdn_final_row(OD + (size_t)m * 1024, OD + (size_t)(PASS_ROWS + m) * 1024, PROJ + (size_t)m * LDP + C_GZ, gng, (bf16*)(ws + WS_Y) + (size_t)m * 1024, lane); }
            { DIFF_BOUND(bdf); const bool fixf = (bdf * LOG2E < 60.f) && (bdf == bdf);
              DIFF_TABLE(bdf, fixf);
              const float* dl = diff_lambda + l * 256; const float* dng = diff_norm_gain + l * 128;
              const float lin = 0.8f - 0.6f * expf(-0.3f * (float)l);
              const float lam = expf(wave_sum(dl[lane] * dl[64 + lane])) - expf(wave_sum(dl[128 + lane] * dl[192 + lane])) + lin;
              const int nqb = Tp / 256;
              for (int hh = 7; hh >= 0; --hh) { const int np = TBR(T_NPH + hh); if (np <= 1) continue; const int pb0 = TBR(T_PB + hh);
                  for (int m = gw; m < PASS_ROWS; m += ngw) { const int sq = m / Tp, t = m - sq * Tp, qb = t >> 8, rr = t & 255;
                      diff_final_row(ws, pb0 + (sq * nqb + qb) * np, np, rr, lam, lin, PROJ + (size_t)m * LDP + C_DZ + hh * 128, dng, (bf16*)(ws + WS_Y + 2 * SZ_Y1) + (size_t)m * 1024 + hh * 128, lane); } } }
        }
        SEAM(pb + 4);
        if (PH_ON(6) && IN(pb + 5)) for (int rep = 0; rep < ((DUP_PHASE == 6 || DUP_PHASE == 15) ? 2 : 1); ++rep) {
            if (rep) xcd_barrier(bar);
            pg8::MergeOrder S; S.S.init(PASS_ROWS, DM, G, bx);
            pg8::Gemm g{(const bf16*)(ws + WS_Y), (const bf16*)(ws + WS_WBR + (size_t)(l * 3) * SZ_WBR_1), 3 * PASS_ROWS, 3 * DM, 1024};
#if DUP_PHASE == 15
            if (rep == 1) { pg8::EpiNull EN{}; pg8::gemm_phase<pg8::EpiNull, pg8::MergeOrder, true, true>(lds, g, S, EN); } else
#endif
            { pg8::EpiMerge E{(const unsigned char*)(PROJ + C_GATE), LDP * 2, (bf16*)(ws + WS_MTMP), DM, MRG, DM};
              pg8::gemm_phase<pg8::EpiMerge, pg8::MergeOrder, true, true>(lds, g, S, E); }
        }
        SEAM(pb + 5);
        if (PH_ON(7) && IN(pb + 6)) for (int rep = 0; rep < ((l == 0) ? NREP(7) : 1); ++rep) {
            if (rep) xcd_barrier(bar);
            pg8::Gemm g{MRG, (const bf16*)(ws + WS_WOUT + (size_t)l * SZ_WOUT_L), PASS_ROWS, DM, DM}; pg8::StaticOrder S; S.init(PASS_ROWS, DM, G, bx);
            pg8::EpiOut E{XIN(), args.out + (size_t)p * PASS_ROWS * DM, DM, (l + 1 < DEPTH) ? norm_gain + (l + 1) * DM : (const float*)nullptr, HNp, (float*)(ws + WS_ROWSS) + (size_t)(l + 1 < DEPTH ? l + 1 : l) * NTOK + (size_t)p * PASS_ROWS};
            pg8::gemm_phase<pg8::EpiOut, pg8::StaticOrder, true, true>(lds, g, S, E);
        }
    }
#undef IN
#undef SEAM
#undef TBR
#undef T_GT
#undef T_PB
#undef T_NPH
#undef T_NDF
#undef T_LEN
#undef DIFF_TABLE
#undef DIFF_BOUND
#undef XIN
#undef x_prompt
#undef x_sample
#undef norm_gain
#undef w_in
#undef conv_w
#undef a_log
#undef dt_bias
#undef gdn_norm_gain
#undef swa_q_gain
#undef swa_k_gain
#undef swa_sink
#undef diff_q_gain
#undef diff_k_gain
#undef diff_lambda
#undef diff_norm_gain
#undef w_branch
#undef w_out
#undef INP
}

extern "C" void kernel_launch(void* const* d_in, const int* in_sizes, int n_in, void* d_out, int out_size, void* d_ws, size_t ws_size, hipStream_t stream) {
    static int grid = 0;
    if (grid == 0) {
        if (n_in != 17 || in_sizes[0] != 2 * 16384 * DM || in_sizes[1] != 8 * 4096 * DM || out_size != NTOK * DM || ws_size < WS_END) {
            fprintf(stderr, "kernel_launch: shape mismatch (n_in %d, in0 %d, in1 %d, out %d, ws %zu, need %zu); nothing launched\n", n_in, n_in > 0 ? in_sizes[0] : -1, n_in > 1 ? in_sizes[1] : -1, out_size, ws_size, (size_t)WS_END);
            grid = -1; return; }
        int dev = 0, cus = 0, per_cu = 0;
        if (hipGetDevice(&dev) != hipSuccess || hipDeviceGetAttribute(&cus, hipDeviceAttributeMultiprocessorCount, dev) != hipSuccess) { fprintf(stderr, "kernel_launch: device query failed\n"); grid = -1; return; }
        if (hipFuncSetAttribute((const void*)fwd_kernel, hipFuncAttributeMaxDynamicSharedMemorySize, LDS_BYTES) != hipSuccess) { fprintf(stderr, "kernel_launch: hipFuncSetAttribute(%d B LDS) failed\n", LDS_BYTES); grid = -1; return; }
        if (hipOccupancyMaxActiveBlocksPerMultiprocessor(&per_cu, (const void*)fwd_kernel, NTHREADS, LDS_BYTES) != hipSuccess || per_cu < 1)
            fprintf(stderr, "kernel_launch: note: occupancy query reports %d workgroups per CU\n", per_cu);
        (void)hipGetLastError();
        grid = cus;
    }
    if (grid < 0) return;
    if (hipMemsetAsync((char*)d_ws + WS_CTL, 0, CTL_ZERO_BYTES, stream) != hipSuccess) { fprintf(stderr, "kernel_launch: memset failed\n"); return; }
    Args a{};
    for (int i = 0; i < 17; ++i) a.in[i] = (const float*)d_in[i];
    a.out = (float*)d_out; a.ws = (unsigned char*)d_ws;
#if MK_PER_PHASE
    for (int k = 0; k < N_PHASES; ++k) { a.ph_lo = k; a.ph_hi = k + 1; hipLaunchKernelGGL(fwd_kernel, dim3(grid), dim3(NTHREADS), LDS_BYTES, stream, a); }
#else
    a.ph_lo = 0; a.ph_hi = N_PHASES;
    hipLaunchKernelGGL(fwd_kernel, dim3(grid), dim3(NTHREADS), LDS_BYTES, stream, a);
#endif
    const hipError_t le = hipPeekAtLastError();
    if (le != hipSuccess) fprintf(stderr, "kernel_launch: launch failed: %s\n", hipGetErrorName(le));
}
```

```cpp
#include <hip/hip_runtime.h>
#include <cstdio>
#include <cstdint>
namespace pg8 {
#define PG8_LAS __attribute__((address_space(3)))
typedef unsigned short bf16_t;
typedef short bf16x8 __attribute__((ext_vector_type(8)));
typedef float f32x4 __attribute__((ext_vector_type(4)));
typedef unsigned u32x4 __attribute__((ext_vector_type(4)));
constexpr int BM = 256, BK = 64, HALF = 128, HTB = HALF * BK * 2  , STAGE_BYTES = 8 * HTB, NXCD = 8, WGM = 4;

__host__ __device__ __forceinline__ int lds_byte(int r, int c) { const int st = (r >> 4) * 2 + (c >> 5), rr = r & 15, cc = c & 31, ob = rr * 64 + cc * 2; return st * 1024 + (ob ^ (((ob >> 9) & 1) << 5)); }
__host__ __device__ __forceinline__ void stage_rc(int b, int& R, int& C) { const int st = b / 1024, sb = b % 1024, swz = sb ^ (((sb >> 9) & 1) << 5); R = (st >> 1) * 16 + swz / 64; C = (st & 1) * 32 + (swz % 64) / 2; }
__host__ __device__ __forceinline__ int perm32(int rho) { const int n = rho >> 4, i = rho & 15; return 8 * (i >> 2) + 4 * n + (i & 3); }

struct Unit { int pm, pn; };
struct Gemm { const bf16_t* A; const bf16_t* Bt; int M, N, K; };

struct StaticOrder {
    int nM, nN, nwg, G, c;
    __host__ __device__ void init(int M, int N, int G_, int c_) { nM = M / BM; nN = N / BM; nwg = nM * nN; G = G_; c = c_; }
    __host__ __device__ bool next(int i, Unit& u) const {
        const long L = (long)i * G + c; if (L >= nwg) return false;
        int wgid = (int)L; { const int q = nwg / NXCD, r = nwg % NXCD, xcd = wgid % NXCD, off = wgid / NXCD; wgid = (xcd < r ? xcd * (q + 1) : r * (q + 1) + (xcd - r) * q) + off; }
        const int nig = WGM * nN, gid = wgid / nig, fm = gid * WGM, gsz = (nM - fm) < WGM ? (nM - fm) : WGM;
        u.pm = fm + ((wgid % nig) % gsz); u.pn = (wgid % nig) / gsz; return true;
    }
    __device__ __forceinline__ void a_ready(const Unit&) const {}
    __device__ __forceinline__ void done(const Unit&) const {}
};

typedef float f32x2_c __attribute__((ext_vector_type(2)));
typedef unsigned u32x2 __attribute__((ext_vector_type(2)));
typedef __bf16 bf16x2_c __attribute__((ext_vector_type(2)));
__device__ __forceinline__ unsigned cvt_pk_bf16(float lo, float hi) { const f32x2_c v = {lo, hi}; const bf16x2_c b = __builtin_convertvector(v, bf16x2_c); return __builtin_bit_cast(unsigned, b); }
__device__ __forceinline__ float sigmoid_f(float v) { return __builtin_amdgcn_rcpf(1.0f + __builtin_amdgcn_exp2f(-1.4426950408889634f * v)); }
__device__ __forceinline__ float bflo(unsigned w) { return __uint_as_float(w << 16); }
__device__ __forceinline__ float bfhi(unsigned w) { return __uint_as_float(w & 0xffff0000u); }

struct EpiProj {
    static constexpr bool PERM = true, AFTER_DRAIN = false;
    bf16_t* O; int ldc; int sig_lo, sig_hi; const float* rowss; float inv_d, eps;
#if DUP_PHASE == 17
    size_t tstride;
#endif
    int sig_col0;
    int ba_tile;
    unsigned long long ztiles;
    int qn_lo, qn_hi; const float* qgain; float qscale;
    int kn_lo, kn_hi; const float* kgain;
    __device__ __forceinline__ void operator()(const f32x4 (&acc)[2][2][4][2], const Unit& u, int wr, int wc, int fr, int fq) const {
        const int row0 = u.pm * BM + wr * 64 + fr, col0 = u.pn * BM + wc * 64 + 8 * fq;
        const bool sig = (u.pn >= sig_lo) && (u.pn < sig_hi);
        const bool qn = (u.pn >= qn_lo) && (u.pn < qn_hi);
        const bool kn = qn || ((u.pn >= kn_lo) && (u.pn < kn_hi));
        const float* ngain = qn ? qgain : kgain; const float nsc = qn ? qscale : 1.0f;
        const bool zt = (u.pn < 64) && ((ztiles >> u.pn) & 1ull);
        const bool ba = (u.pn == ba_tile);
        if (ba && wc != 0) return;
        f32x4 kg[2][2];
#pragma unroll
        for (int bj = 0; bj < 2; ++bj)
#pragma unroll
            for (int n = 0; n < 2; ++n) kg[bj][n] = kn ? *(const f32x4*)(ngain + bj * 32 + 8 * fq + 4 * n) * nsc : (f32x4){1.f, 1.f, 1.f, 1.f};
        float rs[2][4];
#pragma unroll
        for (int ai = 0; ai < 2; ++ai)
#pragma unroll
            for (int m = 0; m < 4; ++m) rs[ai][m] = rowss[row0 + ai * HALF + m * 16];
#pragma unroll
        for (int ai = 0; ai < 2; ++ai)
#pragma unroll
            for (int m = 0; m < 4; ++m) { const int row = row0 + ai * HALF + m * 16; bf16_t* rowp = O + (size_t)row * ldc + col0;
#if DUP_PHASE == 17
                rowp += (size_t)u.pn * tstride;
#endif
                const float rstd = __builtin_amdgcn_rsqf(rs[ai][m] * inv_d + eps);
                f32x4 v[2][2];
#pragma unroll
                for (int bj = 0; bj < 2; ++bj) { v[bj][0] = acc[ai][bj][m][0] * rstd; v[bj][1] = acc[ai][bj][m][1] * rstd; }
                if (kn) {
                    float ss = 0.f;
#pragma unroll
                    for (int bj = 0; bj < 2; ++bj)
#pragma unroll
                        for (int n = 0; n < 2; ++n)
#pragma unroll
                            for (int j = 0; j < 4; ++j) ss += v[bj][n][j] * v[bj][n][j];
                    ss += __builtin_bit_cast(float, __builtin_amdgcn_ds_swizzle(__builtin_bit_cast(int, ss), 0x1F | (16 << 10)));
                    ss += __shfl_xor(ss, 32);
                    const float rk = __builtin_amdgcn_rsqf(ss * (1.0f / 64.0f) + eps);
#pragma unroll
                    for (int bj = 0; bj < 2; ++bj)
#pragma unroll
                        for (int n = 0; n < 2; ++n) v[bj][n] = v[bj][n] * rk * kg[bj][n];
                }
                if (zt) {
#pragma unroll
                    for (int bj = 0; bj < 2; ++bj)
#pragma unroll
                        for (int n = 0; n < 2; ++n)
#pragma unroll
                            for (int j = 0; j < 4; ++j) v[bj][n][j] *= sigmoid_f(v[bj][n][j]);
                }
                if (sig) {
                    unsigned char* rowb = (unsigned char*)(O + (size_t)row * ldc + sig_col0) + (u.pn * BM + wc * 64 + 16 * fq - sig_col0);
                    u32x4 w;
#pragma unroll
                    for (int bj = 0; bj < 2; ++bj)
#pragma unroll
                        for (int n = 0; n < 2; ++n) { unsigned pk = 0u;
#pragma unroll
                            for (int j = 0; j < 4; ++j) pk = __builtin_amdgcn_cvt_pk_u8_f32(__builtin_floorf(sigmoid_f(v[bj][n][j]) * 255.0f + 0.5f), j, pk);
                            w[bj * 2 + n] = pk; }
                    __builtin_nontemporal_store(w, (u32x4*)rowb);
                } else {
#pragma unroll
                for (int bj = 0; bj < 2; ++bj) { f32x4 v0 = v[bj][0], v1 = v[bj][1];
                    if (ba && bj == 1) continue;
                    u32x4 w; w.x = cvt_pk_bf16(v0[0], v0[1]); w.y = cvt_pk_bf16(v0[2], v0[3]); w.z = cvt_pk_bf16(v1[0], v1[1]); w.w = cvt_pk_bf16(v1[2], v1[3]);
                    __builtin_nontemporal_store(w, (u32x4*)(rowp + bj * 32)); } } }
    }
};
struct EpiNull {
    static constexpr bool PERM = true, AFTER_DRAIN = false;
    __device__ __forceinline__ void operator()(const f32x4 (&acc)[2][2][4][2], const Unit& u, int wr, int wc, int fr, int fq) const {
        float s = 0.f;
#pragma unroll
        for (int a = 0; a < 2; ++a)
#pragma unroll
            for (int b = 0; b < 2; ++b)
#pragma unroll
                for (int m = 0; m < 4; ++m)
#pragma unroll
                    for (int n = 0; n < 2; ++n) s += acc[a][b][m][n][0];
        asm volatile("" :: "v"(s));
    }
};
struct EpiMerge {
    static constexpr bool PERM = true, AFTER_DRAIN = false;
    static constexpr int MB = 4;
    const unsigned char* G; int ldg; bf16_t* T; int ldt; bf16_t* O; int ldo;
    __device__ __forceinline__ void operator()(const f32x4 (&acc)[2][2][4][2], const Unit& u, int wr, int wc, int fr, int fq) const {
        const int n = u.pm >> 6, pm = u.pm & 63, pn = u.pn & 7;
        const int row0 = pm * BM + wr * 64 + fr, col0 = pn * BM + wc * 32 + 8 * fq;
        const unsigned char* Gn = G + n * 2048;
#pragma unroll
        for (int ai = 0; ai < 2; ++ai)
#pragma unroll
            for (int m2 = 0; m2 < 4; m2 += MB) {
                u32x2 gw[MB][2]; u32x4 tw[MB][2];
#pragma unroll
                for (int mm = 0; mm < MB; ++mm)
#pragma unroll
                    for (int bj = 0; bj < 2; ++bj) { const size_t row = (size_t)(row0 + ai * HALF + (m2 + mm) * 16); const int col = col0 + bj * HALF;
                        gw[mm][bj] = *(const u32x2*)(Gn + row * ldg + col); if (n >= 1) tw[mm][bj] = *(const u32x4*)(T + row * ldt + col); else tw[mm][bj] = (u32x4){0u, 0u, 0u, 0u}; }
#pragma unroll
                for (int mm = 0; mm < MB; ++mm)
#pragma unroll
                    for (int bj = 0; bj < 2; ++bj) { const int m = m2 + mm; const size_t row = (size_t)(row0 + ai * HALF + m * 16); const int col = col0 + bj * HALF;
                        const u32x2 g = gw[mm][bj]; const u32x4 t = tw[mm][bj];
                        const float qs = 1.0f / 255.0f;
                        f32x4 v0 = acc[ai][bj][m][0], v1 = acc[ai][bj][m][1];
                        v0[0] = v0[0] * ((float)(g.x & 0xffu) * qs) + bflo(t.x); v0[1] = v0[1] * ((float)((g.x >> 8) & 0xffu) * qs) + bfhi(t.x); v0[2] = v0[2] * ((float)((g.x >> 16) & 0xffu) * qs) + bflo(t.y); v0[3] = v0[3] * ((float)(g.x >> 24) * qs) + bfhi(t.y);
                        v1[0] = v1[0] * ((float)(g.y & 0xffu) * qs) + bflo(t.z); v1[1] = v1[1] * ((float)((g.y >> 8) & 0xffu) * qs) + bfhi(t.z); v1[2] = v1[2] * ((float)((g.y >> 16) & 0xffu) * qs) + bflo(t.w); v1[3] = v1[3] * ((float)(g.y >> 24) * qs) + bfhi(t.w);
                        u32x4 w; w.x = cvt_pk_bf16(v0[0], v0[1]); w.y = cvt_pk_bf16(v0[2], v0[3]); w.z = cvt_pk_bf16(v1[0], v1[1]); w.w = cvt_pk_bf16(v1[2], v1[3]);
                        if (n <= 1) *(u32x4*)(T + row * ldt + col) = w; else *(u32x4*)(O + row * ldo + col) = w; }
                asm volatile("" ::: "memory"); }
    }
};
struct MergeOrder {
    StaticOrder S;
    __device__ __forceinline__ bool next(int i, Unit& u) const { const int ou = i / 3, n = i - ou * 3; Unit v; if (!S.next(ou, v)) return false; u.pm = n * 64 + v.pm; u.pn = n * 8 + v.pn; return true; }
    __device__ __forceinline__ void a_ready(const Unit&) const {}
    __device__ __forceinline__ void done(const Unit&) const {}
};
struct EpiOut {
    static constexpr bool PERM = false, AFTER_DRAIN = false;
    const float* base; float* out; int ldc; const float* gain_next; bf16_t* hn; float* rowss;
    __device__ __forceinline__ void operator()(const f32x4 (&acc)[2][2][4][2], const Unit& u, int wr, int wc, int fr, int fq) const {
        const int row0 = u.pm * BM + wr * 64 + fr, col0 = u.pn * BM + wc * 32 + 4 * fq;
        f32x4 gn[2][2];
        if (gain_next) {
#pragma unroll
            for (int bj = 0; bj < 2; ++bj)
#pragma unroll
                for (int n = 0; n < 2; ++n) gn[bj][n] = *(const f32x4*)(gain_next + col0 + bj * HALF + n * 16); }
#pragma unroll
        for (int ai = 0; ai < 2; ++ai)
#pragma unroll
            for (int m2 = 0; m2 < 4; m2 += 2) {
                f32x4 bb[2][2][2];
#pragma unroll
                for (int mm = 0; mm < 2; ++mm)
#pragma unroll
                    for (int bj = 0; bj < 2; ++bj)
#pragma unroll
                        for (int n = 0; n < 2; ++n) bb[mm][bj][n] = *(const f32x4*)(base + (size_t)(row0 + ai * HALF + (m2 + mm) * 16) * ldc + col0 + bj * HALF + n * 16);
#pragma unroll
                for (int mm = 0; mm < 2; ++mm) { const int m = m2 + mm; const int row = row0 + ai * HALF + m * 16; const size_t off = (size_t)row * ldc + col0; float ss = 0.f;
#pragma unroll
                    for (int bj = 0; bj < 2; ++bj)
#pragma unroll
                        for (int n = 0; n < 2; ++n) { const f32x4 x = bb[mm][bj][n] + acc[ai][bj][m][n]; *(f32x4*)(out + off + bj * HALF + n * 16) = x;
                            if (gain_next) { const f32x4 g = gn[bj][n]; ss += (x[0] * x[0] + x[1] * x[1]) + (x[2] * x[2] + x[3] * x[3]);
                                u32x2 w; w.x = cvt_pk_bf16(x[0] * g[0], x[1] * g[1]); w.y = cvt_pk_bf16(x[2] * g[2], x[3] * g[3]); *(u32x2*)(hn + off + bj * HALF + n * 16) = w; } }
                    if (gain_next) {
                        ss += __builtin_bit_cast(float, __builtin_amdgcn_ds_swizzle(__builtin_bit_cast(int, ss), 0x1F | (16 << 10)));
                        ss += __shfl_xor(ss, 32);
                        if (fq == 0) __hip_atomic_fetch_add(rowss + row, ss, __ATOMIC_RELAXED, __HIP_MEMORY_SCOPE_AGENT); } }
                asm volatile("" ::: "memory"); }
    }
};

template <class Epi, class Sched, bool ALIGN_EPI = false, bool SP2 = false>
__device__ __forceinline__ void gemm_phase(PG8_LAS unsigned char* lds, const Gemm g, const Sched& S, const Epi& E) {
    int tid_ = threadIdx.x; asm volatile("" : "+v"(tid_));
    const int tid = tid_, wid = __builtin_amdgcn_readfirstlane(tid >> 6), lane = tid & 63, wr = wid >> 2, wc = wid & 3, fr = lane & 15, fq = lane >> 4;
    const int K = g.K, nt = K / BK;
    unsigned voffA[2], voffB[2];
#pragma unroll
    for (int i = 0; i < 2; ++i) { int R, C; stage_rc(tid * 16 + i * 8192, R, C); const int Rb = Epi::PERM ? ((R & ~31) + perm32(R & 31)) : R;
        voffA[i] = (unsigned)(R * K + C) * 2u; voffB[i] = (unsigned)(Rb * K + C) * 2u; }
    const size_t kstep = (size_t)(BK * 2);
    const size_t hstep = (size_t)HALF * K * 2;
    const size_t tstep = 2 * hstep;
    const unsigned ldsw = (unsigned)wid * 1024u;
    const int aoff = lds_byte(wr * 64 + fr, fq * 8), boff = lds_byte(wc * 32 + fr, fq * 8);
#define PG8_SA(b, h) (((b) * 2 + (h)) * HTB)
#define PG8_SB(b, h) ((4 + (b) * 2 + (h)) * HTB)
#define PG8_STAGE(bufoff, gbase, voff) do { _Pragma("unroll") for (int _i = 0; _i < 2; ++_i) \
        __builtin_amdgcn_global_load_lds((const unsigned*)((const char*)(gbase) + (voff)[_i]), (PG8_LAS unsigned*)(lds + (bufoff) + ldsw + _i * 8192), 16, 0, 0); } while (0)
#define PG8_LDA(dst, b, h) do { _Pragma("unroll") for (int m = 0; m < 4; ++m) _Pragma("unroll") for (int k = 0; k < 2; ++k) dst[m][k] = *(const PG8_LAS bf16x8*)(lds + PG8_SA(b, h) + aoff + m * 2048 + k * 1024); } while (0)
#define PG8_LDB(dst, b, h) do { _Pragma("unroll") for (int n = 0; n < 2; ++n) _Pragma("unroll") for (int k = 0; k < 2; ++k) dst[n][k] = *(const PG8_LAS bf16x8*)(lds + PG8_SB(b, h) + boff + n * 2048 + k * 1024); } while (0)
#define PG8_MMA(ai, bj, At, Bt) do { __builtin_amdgcn_s_setprio(1); _Pragma("unroll") for (int m = 0; m < 4; ++m) _Pragma("unroll") for (int n = 0; n < 2; ++n) _Pragma("unroll") for (int k = 0; k < 2; ++k) \
        acc[ai][bj][m][n] = __builtin_amdgcn_mfma_f32_16x16x32_bf16(Bt[n][k], At[m][k], acc[ai][bj][m][n], 0, 0, 0); __builtin_amdgcn_s_setprio(0); } while (0)
#define PG8_WAIT_V(n) asm volatile("s_waitcnt vmcnt(" #n ")" ::: "memory")
#define PG8_WAIT_L(n) asm volatile("s_waitcnt lgkmcnt(" #n ")" ::: "memory")
#define PG8_BAR __builtin_amdgcn_s_barrier()
#define PG8_SCHED __builtin_amdgcn_sched_barrier(0)
    Unit cur, nxt; int ui = 0;
    if (!S.next(0, cur)) return;
    f32x4 acc[2][2][4][2];
#pragma unroll
    for (int a = 0; a < 2; ++a)
#pragma unroll
        for (int b = 0; b < 2; ++b)
#pragma unroll
            for (int m = 0; m < 4; ++m)
#pragma unroll
                for (int n = 0; n < 2; ++n) acc[a][b][m][n] = (f32x4){0.f, 0.f, 0.f, 0.f};
    bf16x8 At[4][2], B0[2][2], B1[2][2];
    const char* cA = (const char*)g.A + (size_t)cur.pm * tstep; const char* cB = (const char*)g.Bt + (size_t)cur.pn * tstep;
    S.a_ready(cur);
    if constexpr (SP2) {
        PG8_STAGE(PG8_SB(0, 0), cB, voffB); PG8_STAGE(PG8_SB(0, 1), cB + hstep, voffB); PG8_STAGE(PG8_SA(0, 0), cA, voffA); PG8_STAGE(PG8_SA(0, 1), cA + hstep, voffA);
        if (wr == 1) PG8_BAR;
        PG8_WAIT_V(2); PG8_BAR;
        PG8_STAGE(PG8_SB(1, 0), cB + kstep, voffB); PG8_STAGE(PG8_SA(1, 0), cA + kstep, voffA); PG8_STAGE(PG8_SB(1, 1), cB + hstep + kstep, voffB);
        PG8_WAIT_V(6); PG8_BAR;
    } else {
        PG8_STAGE(PG8_SB(0, 0), cB, voffB); PG8_STAGE(PG8_SA(0, 0), cA, voffA); PG8_STAGE(PG8_SB(0, 1), cB + hstep, voffB); PG8_STAGE(PG8_SA(0, 1), cA + hstep, voffA);
        if (wr == 1) PG8_BAR;
        PG8_WAIT_V(4); PG8_BAR;
        PG8_STAGE(PG8_SB(1, 0), cB + kstep, voffB); PG8_STAGE(PG8_SA(1, 0), cA + kstep, voffA); PG8_STAGE(PG8_SB(1, 1), cB + hstep + kstep, voffB);
        PG8_WAIT_V(6); PG8_BAR;
    }
    for (;;) {
        const bool has_next = S.next(ui + 1, nxt);
        const char* nA = has_next ? (const char*)g.A + (size_t)nxt.pm * tstep : cA; const char* nB = has_next ? (const char*)g.Bt + (size_t)nxt.pn * tstep : cB;
        for (int t = 0; t < nt; t += 2) {
            const bool last = (t == nt - 2);
            const char* a1 = cA + (size_t)(t + 1) * kstep;
            const char* a2 = last ? nA : cA + (size_t)(t + 2) * kstep; const char* b2 = last ? nB : cB + (size_t)(t + 2) * kstep;
            const char* a3 = a2 + kstep; const char* b3 = b2 + kstep;
            if (last && has_next) S.a_ready(nxt);
            if constexpr (SP2) {
            PG8_LDB(B0, 0, 0); PG8_LDB(B1, 0, 1); PG8_SCHED; PG8_LDA(At, 0, 0); PG8_STAGE(PG8_SA(1, 1), a1 + hstep, voffA);
            PG8_WAIT_V(8); PG8_WAIT_L(0); PG8_BAR; PG8_MMA(0, 0, At, B0); PG8_MMA(0, 1, At, B1); PG8_BAR; PG8_SCHED;
            PG8_LDA(At, 0, 1); PG8_STAGE(PG8_SB(0, 0), b2, voffB); PG8_STAGE(PG8_SB(0, 1), b2 + hstep, voffB); PG8_STAGE(PG8_SA(0, 0), a2, voffA);
            PG8_WAIT_V(8); PG8_WAIT_L(0); PG8_BAR; PG8_MMA(1, 0, At, B0); PG8_MMA(1, 1, At, B1); PG8_BAR; PG8_SCHED;
            PG8_LDB(B0, 1, 0); PG8_LDB(B1, 1, 1); PG8_SCHED; PG8_LDA(At, 1, 0); PG8_STAGE(PG8_SA(0, 1), a2 + hstep, voffA);
            PG8_WAIT_V(8); PG8_WAIT_L(0); PG8_BAR; PG8_MMA(0, 0, At, B0); PG8_MMA(0, 1, At, B1); PG8_BAR; PG8_SCHED;
            PG8_LDA(At, 1, 1); PG8_STAGE(PG8_SB(1, 0), b3, voffB); PG8_STAGE(PG8_SB(1, 1), b3 + hstep, voffB); PG8_STAGE(PG8_SA(1, 0), a3, voffA);
            PG8_WAIT_V(8); PG8_WAIT_L(0); PG8_BAR; PG8_MMA(1, 0, At, B0); PG8_MMA(1, 1, At, B1); PG8_BAR; PG8_SCHED;
            } else {
            PG8_LDB(B0, 0, 0); PG8_SCHED; PG8_LDA(At, 0, 0); PG8_STAGE(PG8_SA(1, 1), a1 + hstep, voffA);
            PG8_WAIT_L(8); PG8_BAR; PG8_WAIT_L(0); PG8_MMA(0, 0, At, B0); PG8_BAR; PG8_SCHED;
            PG8_LDB(B1, 0, 1); PG8_STAGE(PG8_SB(0, 0), b2, voffB);
            PG8_BAR; PG8_WAIT_L(0); PG8_MMA(0, 1, At, B1); PG8_BAR;
            PG8_LDA(At, 0, 1); PG8_STAGE(PG8_SA(0, 0), a2, voffA);
            PG8_BAR; PG8_WAIT_L(0); PG8_MMA(1, 0, At, B0); PG8_BAR; PG8_SCHED;
            PG8_STAGE(PG8_SB(0, 1), b2 + hstep, voffB);
            PG8_WAIT_V(6); PG8_BAR; PG8_MMA(1, 1, At, B1); PG8_BAR;
            PG8_LDB(B0, 1, 0); PG8_SCHED; PG8_LDA(At, 1, 0); PG8_STAGE(PG8_SA(0, 1), a2 + hstep, voffA);
            PG8_WAIT_L(8); PG8_BAR; PG8_WAIT_L(0); PG8_MMA(0, 0, At, B0); PG8_BAR; PG8_SCHED;
            PG8_LDB(B1, 1, 1); PG8_STAGE(PG8_SB(1, 0), b3, voffB);
            PG8_BAR; PG8_WAIT_L(0); PG8_MMA(0, 1, At, B1); PG8_BAR;
            PG8_LDA(At, 1, 1); PG8_STAGE(PG8_SA(1, 0), a3, voffA);
            PG8_BAR; PG8_WAIT_L(0); PG8_MMA(1, 0, At, B0); PG8_BAR; PG8_SCHED;
            PG8_STAGE(PG8_SB(1, 1), b3 + hstep, voffB);
            PG8_WAIT_V(6); PG8_BAR; PG8_MMA(1, 1, At, B1); PG8_BAR;
            }
        }
        if constexpr (ALIGN_EPI) { if (wr == 0) PG8_BAR; }
        if constexpr (!Epi::AFTER_DRAIN) { E(acc, cur, wr, wc, fr, fq); S.done(cur); }
        if (!has_next) break;
#pragma unroll
        for (int a = 0; a < 2; ++a)
#pragma unroll
            for (int b = 0; b < 2; ++b)
#pragma unroll
                for (int m = 0; m < 4; ++m)
#pragma unroll
                    for (int n = 0; n < 2; ++n) acc[a][b][m][n] = (f32x4){0.f, 0.f, 0.f, 0.f};
        cur = nxt; cA = nA; cB = nB; ++ui;
        if constexpr (ALIGN_EPI) { if (wr == 1) PG8_BAR; }
    }
    PG8_WAIT_V(0);
    if constexpr (!ALIGN_EPI) { if (wr == 0) PG8_BAR; }
    PG8_BAR;
    if constexpr (Epi::AFTER_DRAIN) { E.fused(acc, cur, wr, wc, fr, fq, lds, wid, lane); S.done(cur); }
#undef PG8_SA
#undef PG8_SB
#undef PG8_STAGE
#undef PG8_LDA
#undef PG8_LDB
#undef PG8_MMA
#undef PG8_WAIT_V
#undef PG8_WAIT_L
#undef PG8_BAR
#undef PG8_SCHED
}
}

#define GAS __attribute__((address_space(1)))
#define LAS __attribute__((address_space(3)))
typedef unsigned short bf16;
typedef unsigned v4u __attribute__((ext_vector_type(4)));
typedef unsigned v2u __attribute__((ext_vector_type(2)));
typedef float f32x4 __attribute__((ext_vector_type(4)));
typedef float f32x16 __attribute__((ext_vector_type(16)));
typedef short bf16x8 __attribute__((ext_vector_type(8)));
typedef short s16x4 __attribute__((ext_vector_type(4)));

constexpr int DM = 2048, DEPTH = 4, NTOK = 65536, PASS_ROWS = 16384, NPASS = 4;
constexpr int IN_REAL = 16928, NPROJ = 17152, LDP = NPROJ;
constexpr int C_GQKV = 0, C_GZ = 3072, C_SQ = 4096, C_SKV = 5120, C_SZ = 5632, C_DQ = 6656, C_DK = 7680, C_DV = 8704, C_DZ = 9728, C_GATE = 10752, C_BA = 16896;
constexpr float NORM_EPS = 1e-6f, LOG2E = 1.4426950408889634f;
constexpr int NWAVES = 8, NTHREADS = 512;

constexpr size_t MiB = 1u << 20;
constexpr size_t WS_CTL = 0, CTL_ZERO_BYTES = 2 * MiB;
constexpr size_t WS_ROWSS = 1 * MiB;
constexpr size_t WS_WIN = 2 * MiB;
constexpr size_t SZ_WIN_L = (size_t)NPROJ * DM * 2;
constexpr size_t WS_WBR = WS_WIN + 4 * SZ_WIN_L;
constexpr size_t SZ_WBR_1 = (size_t)2048 * 1024 * 2;
constexpr size_t WS_WOUT = WS_WBR + 12 * SZ_WBR_1;
constexpr size_t SZ_WOUT_L = (size_t)DM * DM * 2;
constexpr size_t WS_HN = WS_WOUT + 4 * SZ_WOUT_L;
constexpr size_t WS_PROJ = WS_HN + (size_t)NTOK * DM * 2;
constexpr size_t WS_Y = WS_PROJ + (size_t)PASS_ROWS * NPROJ * 2;
constexpr size_t SZ_Y1 = (size_t)PASS_ROWS * 1024 * 2;
constexpr size_t WS_GDN = WS_Y + 3 * SZ_Y1;
constexpr int REC_BYTES = 73728, REC_FW = 0, REC_FQ = 16384, REC_FK = 32768, REC_FQK = 49152, REC_FU = 57344, REC_LOAD = 57344, REC_GAM = REC_FQK + 2048;
constexpr size_t WS_GAM = WS_GDN + (size_t)2 * 256 * 8 * REC_BYTES;
constexpr size_t WS_ODIR = WS_GAM + 16384;
constexpr size_t WS_MTMP = WS_ODIR + 2 * SZ_Y1;
constexpr size_t WS_MRG = WS_MTMP + (size_t)PASS_ROWS * DM * 2;
constexpr size_t WS_PARK = WS_MRG + (size_t)PASS_ROWS * DM * 2;
constexpr size_t WS_PART = WS_PARK + (size_t)256 * 8 * 64 * 64 * 4;
constexpr int PART_SLOTS = 640;
constexpr size_t WS_PARTL = WS_PART + (size_t)PART_SLOTS * 2 * 256 * 128 * 4;
constexpr size_t WS_END = WS_PARTL + (size_t)PART_SLOTS * 2 * 256 * 4;
constexpr int CW_BAR = 4096;
constexpr int CW_DEP = 32768;
constexpr int CW_QUEUE = 16384;

constexpr int LDS_BYTES = 159744;
constexpr int MISC_OFF = LDS_BYTES - 512;

#define LDS_WAIT() asm volatile("s_waitcnt lgkmcnt(0)" ::: "memory")
#define VM_WAIT() asm volatile("s_waitcnt vmcnt(0)" ::: "memory")
__device__ __forceinline__ float bf2f(bf16 b) { return __uint_as_float(((unsigned)b) << 16); }
__device__ __forceinline__ float bflo(unsigned w) { return __uint_as_float(w << 16); }
__device__ __forceinline__ float bfhi(unsigned w) { return __uint_as_float(w & 0xffff0000u); }
typedef float f32x2_t __attribute__((ext_vector_type(2)));
typedef __bf16 bf16x2_t __attribute__((ext_vector_type(2)));
__device__ __forceinline__ unsigned cvtpk(float lo, float hi) { const f32x2_t v = {lo, hi}; const bf16x2_t b = __builtin_convertvector(v, bf16x2_t); return __builtin_bit_cast(unsigned, b); }
__device__ __forceinline__ bf16 f2bf1(float f) { return (bf16)(cvtpk(f, 0.f) & 0xffffu); }
template <int O> __device__ __forceinline__ float xshfl(float v) {
    static_assert(O >= 1 && O <= 16, "xshfl: in-half xor only");
    return __builtin_bit_cast(float, __builtin_amdgcn_ds_swizzle(__builtin_bit_cast(int, v), 0x1F | (O << 10)));
}
__device__ __forceinline__ float half_sum(float v) {
    unsigned a = __float_as_uint(v), b = a; asm volatile("" : "+v"(b));
    auto rr = __builtin_amdgcn_permlane32_swap(a, b, false, false); return __uint_as_float(rr[0]) + __uint_as_float(rr[1]); }
__device__ __forceinline__ float half_max(float v) {
    unsigned a = __float_as_uint(v), b = a; asm volatile("" : "+v"(b));
    auto rr = __builtin_amdgcn_permlane32_swap(a, b, false, false); return fmaxf(__uint_as_float(rr[0]), __uint_as_float(rr[1])); }
__device__ __forceinline__ float wave_sum(float v) { v += xshfl<1>(v); v += xshfl<2>(v); v += xshfl<4>(v); v += xshfl<8>(v); v += xshfl<16>(v); return half_sum(v); }
__device__ __forceinline__ float wave_max(float v) { v = fmaxf(v, xshfl<1>(v)); v = fmaxf(v, xshfl<2>(v)); v = fmaxf(v, xshfl<4>(v)); v = fmaxf(v, xshfl<8>(v)); v = fmaxf(v, xshfl<16>(v)); return half_max(v); }
__device__ __forceinline__ float silu_f(float v) { return v * __builtin_amdgcn_rcpf(1.0f + __expf(-v)); }
__device__ __forceinline__ int crow(int r, int hi) { return (r & 3) + 8 * (r >> 2) + 4 * hi; }
#define MFMA32(a, b, c) __builtin_amdgcn_mfma_f32_32x32x16_bf16((a), (b), (c), 0, 0, 0)
#define XB_TMO      128
#define XB_XCNT(j)  (256  + 64 * (j))
#define XB_XSUB(j)  (1280 + 64 * (j))
#define XB_XGEN(j)  (2304 + 64 * (j))
#define XB_TOP      3328
#define XB_TOPGEN   3392
#define XCD_BAR_WORDS 3456
#define XB_SPIN_CAP (1u << 18)

__device__ __forceinline__ unsigned xb_ld(unsigned* p)              { return __hip_atomic_load(p, __ATOMIC_RELAXED, __HIP_MEMORY_SCOPE_AGENT); }
__device__ __forceinline__ unsigned xb_add(unsigned* p, unsigned v) { return __hip_atomic_fetch_add(p, v, __ATOMIC_RELAXED, __HIP_MEMORY_SCOPE_AGENT); }
__device__ __forceinline__ unsigned xb_xcc_id() { return (unsigned)__builtin_amdgcn_s_getreg((3 << 11) | 20) & 0xFu; }
#define XB_SPIN(cond, bar) do { unsigned _sp = 0; while (cond) { __builtin_amdgcn_s_sleep(1); \
    if ((++_sp & 255u) == 0u) { if (xb_ld(&(bar)[XB_TMO])) break; if (_sp > XB_SPIN_CAP) { atomicAdd(&(bar)[XB_TMO], 1u); break; } } } } while (0)

struct XcdBarrier {
    unsigned* bar; unsigned x;
    volatile LAS unsigned* st;
};

__device__ __forceinline__ XcdBarrier xcd_barrier_post(unsigned* bar, volatile LAS unsigned* st) {
    XcdBarrier b; b.bar = bar; b.x = xb_xcc_id(); b.st = st;
    if (threadIdx.x == 0) (void)xb_add(&bar[XB_XCNT(b.x)], 1u);
    return b;
}
__device__ __forceinline__ void xcd_barrier_complete(unsigned* bar, unsigned x, unsigned& nloc, unsigned& nx) {
    const unsigned G = gridDim.x * gridDim.y * gridDim.z;
    unsigned sum, cnt, mine, sp = 0u;
    for (;;) {
        sum = 0u; cnt = 0u; mine = 0u;
#pragma unroll
        for (unsigned j = 0; j < 16; ++j) { const unsigned c = xb_ld(&bar[XB_XCNT(j)]); sum += c; cnt += (c > 0u) ? 1u : 0u; mine = (j == x) ? c : mine; }
        if (sum == G) break;
        __builtin_amdgcn_s_sleep(1);
        if ((++sp & 255u) == 0u) { if (xb_ld(&bar[XB_TMO])) break; if (sp > XB_SPIN_CAP) { atomicAdd(&bar[XB_TMO], 1u); break; } }
    }
    nloc = mine > 0u ? mine : 1u; nx = cnt > 0u ? cnt : 1u;
}

__device__ __forceinline__ void xcd_barrier(const XcdBarrier& b) {
    asm volatile("s_waitcnt vmcnt(0)" ::: "memory");
    __syncthreads();
    if (threadIdx.x == 0) {
        unsigned* bar = b.bar;
        __builtin_amdgcn_s_waitcnt(0);
        unsigned nloc = b.st[0], nx = b.st[1];
        if (nloc == 0u) { xcd_barrier_complete(bar, b.x, nloc, nx); b.st[0] = nloc; b.st[1] = nx; }
        const unsigned old = xb_add(&bar[XB_XSUB(b.x)], 1u);
        const unsigned gen = old / nloc;
        if (old + 1u == (gen + 1u) * nloc) {
            __builtin_amdgcn_fence(__ATOMIC_RELEASE, "agent");
            asm volatile("s_waitcnt vmcnt(0)" ::: "memory");
            const unsigned og = xb_add(&bar[XB_TOP], 1u);
            const unsigned tg = og / nx;
            if (og + 1u == (tg + 1u) * nx) xb_add(&bar[XB_TOPGEN], 1u);
            else XB_SPIN(xb_ld(&bar[XB_TOPGEN]) == tg, bar);
            __builtin_amdgcn_fence(__ATOMIC_ACQUIRE, "agent");
            xb_add(&bar[XB_XGEN(b.x)], 1u);
            asm volatile("s_waitcnt vmcnt(0)" ::: "memory");
        } else {
            XB_SPIN(xb_ld(&bar[XB_XGEN(b.x)]) == gen, bar);
            __builtin_amdgcn_fence(__ATOMIC_ACQUIRE, "agent");
            asm volatile("s_waitcnt vmcnt(0)" ::: "memory");
        }
    }
    __syncthreads();
}
__device__ __forceinline__ int win_row(int dl) {
    const int L = dl & 255;
    const int p = (dl >= C_GATE && dl < C_GATE + 6144) ? (((L >> 3) & 1) * 128 + (L >> 6) * 32 + ((L >> 4) & 3) * 8 + (L & 7)) : (((L >> 5) & 1) * 128 + (L >> 6) * 32 + (L & 31));
    return (dl & ~255) + p;
}
template <bool MAPW = false>
__device__ __forceinline__ void transpose_item(const float* W, int K, int N, bf16* WT, int k0, int n0, int drow0, LAS float* scr, int lane) {
#pragma unroll 8
    for (int i = 0; i < 32; ++i) { const int kk = 2 * i + (lane >> 5); scr[kk * 33 + (lane & 31)] = W[(size_t)(k0 + kk) * N + n0 + (lane & 31)]; }
    LDS_WAIT(); asm volatile("" ::: "memory");
    const int c = lane & 7;
#pragma unroll
    for (int j = 0; j < 4; ++j) { const int n = (lane >> 3) + 8 * j; const LAS float* s = scr + (8 * c) * 33 + n;
        v4u o; o.x = cvtpk(s[0 * 33], s[1 * 33]); o.y = cvtpk(s[2 * 33], s[3 * 33]); o.z = cvtpk(s[4 * 33], s[5 * 33]); o.w = cvtpk(s[6 * 33], s[7 * 33]);
        *(v4u*)(WT + (size_t)(MAPW ? win_row(drow0 + n) : drow0 + n) * K + k0 + 8 * c) = o; }
    LDS_WAIT(); asm volatile("" ::: "memory");
}
__device__ __forceinline__ void phase_prologue(LAS unsigned char* lds, const float* w_in, const float* w_branch, const float* w_out, unsigned char* ws, int gw, int ngw, int wave, int lane) {
    LAS float* scr = (LAS float*)(lds + wave * 16384);
    constexpr int NB_IN = IN_REAL / 32;
    constexpr int I_IN = 32 * NB_IN;
    constexpr int I_BR = 16 * 64;
    constexpr int I_OUT = 32 * 64;
    constexpr int TOT = 4 * I_IN + 12 * I_BR + 4 * I_OUT;
    for (int it = gw; it < TOT; it += ngw) {
        int r = it;
        if (r < 4 * I_IN) { const int l = r / I_IN; r -= l * I_IN; const int kb = r / NB_IN, nb = r % NB_IN, n0 = nb * 32;
            const int drow = (n0 < 4096) ? n0 : ((n0 < 4128) ? (C_BA + (n0 - 4096)) : (n0 - 32));
            transpose_item<true>(w_in + (size_t)l * DM * IN_REAL, DM, IN_REAL, (bf16*)(ws + WS_WIN + (size_t)l * SZ_WIN_L), kb * 64, n0, drow, scr, lane); continue; }
        r -= 4 * I_IN;
        if (r < 12 * I_BR) { const int m = r / I_BR; r -= m * I_BR; const int kb = r / 64, nb = r % 64;
            transpose_item(w_branch + (size_t)m * 1024 * 2048, 1024, 2048, (bf16*)(ws + WS_WBR + (size_t)m * SZ_WBR_1), kb * 64, nb * 32, nb * 32, scr, lane); continue; }
        r -= 12 * I_BR;
        { const int l = r / I_OUT; r -= l * I_OUT; const int kb = r / 64, nb = r % 64;
            transpose_item(w_out + (size_t)l * DM * DM, DM, DM, (bf16*)(ws + WS_WOUT + (size_t)l * SZ_WOUT_L), kb * 64, nb * 32, nb * 32, scr, lane); }
    }
    const v4u z = {0u, 0u, 0u, 0u};
    for (int i = gw * 64 + lane; i < 4 * 57344; i += ngw * 64) { const int l = i / 57344, q = i % 57344;
        *(v4u*)(ws + WS_WIN + (size_t)l * SZ_WIN_L + (size_t)IN_REAL * DM * 2 + (size_t)q * 16) = z; }
}
__device__ __forceinline__ void rms_row(const float* xrow, const float* gain, bf16* orow, float* rowss, int lane) {
    const f32x4* xr = (const f32x4*)xrow + lane; const f32x4* gr = (const f32x4*)gain + lane;
    f32x4 v[8]; float s = 0.f;
#pragma unroll
    for (int j = 0; j < 8; ++j) { v[j] = xr[64 * j]; s += (v[j].x * v[j].x + v[j].y * v[j].y) + (v[j].z * v[j].z + v[j].w * v[j].w); }
    s = wave_sum(s);
    if (lane == 0) *rowss = s;
    v2u* o8 = (v2u*)orow + lane;
#pragma unroll
    for (int j = 0; j < 8; ++j) { const f32x4 g = gr[64 * j]; v2u o; o.x = cvtpk(v[j].x * g.x, v[j].y * g.y); o.y = cvtpk(v[j].z * g.z, v[j].w * g.w); o8[64 * j] = o; }
}
template <bool DIFF>
__device__ __forceinline__ void knorm_row(bf16* prow, const float* swa_k_gain, const float* diff_k_gain, int lane) {
    {
        v2u* p = (v2u*)(prow + C_SKV) + lane; const v2u w = *p;
        float a = bflo(w.x), b = bfhi(w.x), c = bflo(w.y), d = bfhi(w.y);
        float ss = (a * a + b * b) + (c * c + d * d);
        ss += xshfl<1>(ss); ss += xshfl<2>(ss); ss += xshfl<4>(ss); ss += xshfl<8>(ss); ss += xshfl<16>(ss);
        const float rs = 1.0f / sqrtf(ss * (1.0f / 128.0f) + NORM_EPS);
        const f32x4 g = *((const f32x4*)swa_k_gain + (lane & 31));
        v2u o; o.x = cvtpk(a * rs * g.x, b * rs * g.y); o.y = cvtpk(c * rs * g.z, d * rs * g.w); *p = o;
    }
    if (DIFF) {
        v4u* p = (v4u*)(prow + C_DK) + 2 * lane; const v4u w0 = p[0], w1 = p[1];
        float x[16] = {bflo(w0.x), bfhi(w0.x), bflo(w0.y), bfhi(w0.y), bflo(w0.z), bfhi(w0.z), bflo(w0.w), bfhi(w0.w),
                       bflo(w1.x), bfhi(w1.x), bflo(w1.y), bfhi(w1.y), bflo(w1.z), bfhi(w1.z), bflo(w1.w), bfhi(w1.w)};
        float ss = 0.f;
#pragma unroll
        for (int e = 0; e < 16; ++e) ss += x[e] * x[e];
        ss += xshfl<1>(ss); ss += xshfl<2>(ss);
        const float rs = 1.0f / sqrtf(ss * (1.0f / 64.0f) + NORM_EPS);
        const float* g = diff_k_gain + 16 * (lane & 3);
#pragma unroll
        for (int e = 0; e < 16; ++e) x[e] *= rs * g[e];
        v4u o0, o1; o0.x = cvtpk(x[0], x[1]); o0.y = cvtpk(x[2], x[3]); o0.z = cvtpk(x[4], x[5]); o0.w = cvtpk(x[6], x[7]);
        o1.x = cvtpk(x[8], x[9]); o1.y = cvtpk(x[10], x[11]); o1.z = cvtpk(x[12], x[13]); o1.w = cvtpk(x[14], x[15]);
        p[0] = o0; p[1] = o1;
    }
}
__device__ __forceinline__ void gdn_final_row(const bf16* of, const bf16* ob, const bf16* zrow, const float* gain, bf16* yrow, int lane) {
    const v4u* pf = (const v4u*)of + 2 * lane; const v4u* pb = (const v4u*)ob + 2 * lane; const v4u* pz = (const v4u*)zrow + 2 * lane;
    float x[16], z[16];
#pragma unroll
    for (int q = 0; q < 2; ++q) { const v4u a = pf[q], b = pb[q], c = pz[q];
        x[8 * q + 0] = bflo(a.x) + bflo(b.x); x[8 * q + 1] = bfhi(a.x) + bfhi(b.x); x[8 * q + 2] = bflo(a.y) + bflo(b.y); x[8 * q + 3] = bfhi(a.y) + bfhi(b.y);
        x[8 * q + 4] = bflo(a.z) + bflo(b.z); x[8 * q + 5] = bfhi(a.z) + bfhi(b.z); x[8 * q + 6] = bflo(a.w) + bflo(b.w); x[8 * q + 7] = bfhi(a.w) + bfhi(b.w);
        z[8 * q + 0] = bflo(c.x); z[8 * q + 1] = bfhi(c.x); z[8 * q + 2] = bflo(c.y); z[8 * q + 3] = bfhi(c.y);
        z[8 * q + 4] = bflo(c.z); z[8 * q + 5] = bfhi(c.z); z[8 * q + 6] = bflo(c.w); z[8 * q + 7] = bfhi(c.w); }
    float ss = 0.f;
#pragma unroll
    for (int e = 0; e < 16; ++e) ss += x[e] * x[e];
    ss += xshfl<1>(ss); ss += xshfl<2>(ss); ss += xshfl<4>(ss);
    const float rs = 1.0f / sqrtf(ss * (1.0f / 128.0f) + NORM_EPS);
    const float* g = gain + 16 * (lane & 7);
#pragma unroll
    for (int e = 0; e < 16; ++e) x[e] = x[e] * rs * g[e] * z[e];
    v4u o0, o1; o0.x = cvtpk(x[0], x[1]); o0.y = cvtpk(x[2], x[3]); o0.z = cvtpk(x[4], x[5]); o0.w = cvtpk(x[6], x[7]);
    o1.x = cvtpk(x[8], x[9]); o1.y = cvtpk(x[10], x[11]); o1.z = cvtpk(x[12], x[13]); o1.w = cvtpk(x[14], x[15]);
    v4u* py = (v4u*)yrow + 2 * lane; py[0] = o0; py[1] = o1;
}
template <int NB>
__device__ __forceinline__ void gdn_final_rows(const bf16* OD, const bf16* PROJ, int m0, int step, const float* gain, bf16* Y, int lane) {
    v4u a[NB][2], bq[NB][2], c[NB][2];
#pragma unroll
    for (int k = 0; k < NB; ++k) { const size_t m = (size_t)(m0 + k * step);
        const v4u* pf = (const v4u*)(OD + m * 1024) + 2 * lane; const v4u* pb = (const v4u*)(OD + ((size_t)PASS_ROWS + m) * 1024) + 2 * lane; const v4u* pz = (const v4u*)(PROJ + m * LDP + C_GZ) + 2 * lane;
        a[k][0] = pf[0]; a[k][1] = pf[1]; bq[k][0] = pb[0]; bq[k][1] = pb[1]; c[k][0] = pz[0]; c[k][1] = pz[1]; }
    const float* g = gain + 16 * (lane & 7);
#pragma unroll
    for (int k = 0; k < NB; ++k) {
        float x[16], z[16];
#pragma unroll
        for (int q = 0; q < 2; ++q) { const v4u aa = a[k][q], bb = bq[k][q], cc = c[k][q];
            x[8 * q + 0] = bflo(aa.x) + bflo(bb.x); x[8 * q + 1] = bfhi(aa.x) + bfhi(bb.x); x[8 * q + 2] = bflo(aa.y) + bflo(bb.y); x[8 * q + 3] = bfhi(aa.y) + bfhi(bb.y);
            x[8 * q + 4] = bflo(aa.z) + bflo(bb.z); x[8 * q + 5] = bfhi(aa.z) + bfhi(bb.z); x[8 * q + 6] = bflo(aa.w) + bflo(bb.w); x[8 * q + 7] = bfhi(aa.w) + bfhi(bb.w);
            z[8 * q + 0] = bflo(cc.x); z[8 * q + 1] = bfhi(cc.x); z[8 * q + 2] = bflo(cc.y); z[8 * q + 3] = bfhi(cc.y);
            z[8 * q + 4] = bflo(cc.z); z[8 * q + 5] = bfhi(cc.z); z[8 * q + 6] = bflo(cc.w); z[8 * q + 7] = bfhi(cc.w); }
        float ss = 0.f;
#pragma unroll
        for (int e = 0; e < 16; ++e) ss += x[e] * x[e];
        ss += xshfl<1>(ss); ss += xshfl<2>(ss); ss += xshfl<4>(ss);
        const float rs = 1.0f / sqrtf(ss * (1.0f / 128.0f) + NORM_EPS);
#pragma unroll
        for (int e = 0; e < 16; ++e) x[e] = x[e] * rs * g[e] * z[e];
        v4u o0, o1; o0.x = cvtpk(x[0], x[1]); o0.y = cvtpk(x[2], x[3]); o0.z = cvtpk(x[4], x[5]); o0.w = cvtpk(x[6], x[7]);
        o1.x = cvtpk(x[8], x[9]); o1.y = cvtpk(x[10], x[11]); o1.z = cvtpk(x[12], x[13]); o1.w = cvtpk(x[14], x[15]);
        v4u* py = (v4u*)(Y + (size_t)(m0 + k * step) * 1024) + 2 * lane; py[0] = o0; py[1] = o1;
    }
}
__device__ __forceinline__ void diff_final_row(const unsigned char* ws, int slot0, int np, int rr, float lam, float lambda_init, const bf16* zrow, const float* gain, bf16* yrow, int lane) {
    typedef float f32x2v __attribute__((ext_vector_type(2)));
    const float* PO = (const float*)(ws + WS_PART); const float* PL = (const float*)(ws + WS_PARTL);
    f32x2v o0 = {0.f, 0.f}, o1 = {0.f, 0.f}; float l0 = 0.f, l1 = 0.f;
    for (int p = 0; p < np; ++p) { const int s = slot0 + p;
        o0 += *(const f32x2v*)(PO + ((size_t)(s * 2 + 0) * 256 + rr) * 128 + 2 * lane); o1 += *(const f32x2v*)(PO + ((size_t)(s * 2 + 1) * 256 + rr) * 128 + 2 * lane);
        l0 += PL[(s * 2 + 0) * 256 + rr]; l1 += PL[(s * 2 + 1) * 256 + rr]; }
    const float r0 = 1.0f / l0, r1 = lam / l1;
    const float a = o0.x * r0 - o1.x * r1, b = o0.y * r0 - o1.y * r1;
    const float rs = (1.0f / sqrtf(wave_sum(a * a + b * b) * (1.0f / 128.0f) + NORM_EPS)) * (1.0f - lambda_init);
    const unsigned zw = *(const unsigned*)(zrow + 2 * lane);
    const float ya = a * rs * gain[2 * lane] * bflo(zw), yb = b * rs * gain[2 * lane + 1] * bfhi(zw);
    *(unsigned*)(yrow + 2 * lane) = cvtpk(ya, yb);
}
template <int NB>
__device__ __forceinline__ void diff_final_rows(const unsigned char* ws, int pb0, int np, int Tp, int nqb, int m0, int step, float lam, float lambda_init, const bf16* zbase, const float* gain, bf16* ybase, int lane) {
    typedef float f32x2v __attribute__((ext_vector_type(2)));
    const float* PO = (const float*)(ws + WS_PART); const float* PL = (const float*)(ws + WS_PARTL);
    f32x2v o0[NB][2], o1[NB][2]; float l0[NB][2], l1[NB][2]; unsigned zw[NB];
#pragma unroll
    for (int k = 0; k < NB; ++k) { const int m = m0 + k * step, sq = m / Tp, t = m - sq * Tp, qb = t >> 8, rr = t & 255, slot0 = pb0 + (sq * nqb + qb) * np;
#pragma unroll
        for (int p = 0; p < 2; ++p) {
            if (p < np) { const int s = slot0 + p;
                o0[k][p] = *(const f32x2v*)(PO + ((size_t)(s * 2 + 0) * 256 + rr) * 128 + 2 * lane); o1[k][p] = *(const f32x2v*)(PO + ((size_t)(s * 2 + 1) * 256 + rr) * 128 + 2 * lane);
                l0[k][p] = PL[(s * 2 + 0) * 256 + rr]; l1[k][p] = PL[(s * 2 + 1) * 256 + rr]; }
            else { o0[k][p] = (f32x2v){0.f, 0.f}; o1[k][p] = (f32x2v){0.f, 0.f}; l0[k][p] = 0.f; l1[k][p] = 0.f; } }
        zw[k] = *(const unsigned*)(zbase + (size_t)m * LDP + 2 * lane); }
    const float g0 = gain[2 * lane], g1 = gain[2 * lane + 1];
#pragma unroll
    for (int k = 0; k < NB; ++k) { const int m = m0 + k * step;
        const f32x2v a0 = o0[k][0] + o0[k][1], a1 = o1[k][0] + o1[k][1];
        const float r0 = 1.0f / (l0[k][0] + l0[k][1]), r1 = lam / (l1[k][0] + l1[k][1]);
        const float a = a0.x * r0 - a1.x * r1, b = a0.y * r0 - a1.y * r1;
        const float rs = (1.0f / sqrtf(wave_sum(a * a + b * b) * (1.0f / 128.0f) + NORM_EPS)) * (1.0f - lambda_init);
        const float ya = a * rs * g0 * bflo(zw[k]), yb = b * rs * g1 * bfhi(zw[k]);
        *(unsigned*)(ybase + (size_t)m * 1024 + 2 * lane) = cvtpk(ya, yb); }
}
constexpr int D1_QROW = 0, D1_KROW = 17408, D1_KT = 34816, D1_VT = 53248, D1_LM = 71680, D1_TB = 106496, D1_BETA = 143360, D1_GC = 143872, D1_END = 144384;
constexpr int ROWP = 272, TRP = 144, LMP = 272, TBP = 144;
#define TSW(rw, boff) ((rw) * TRP + ((boff) ^ ((((rw) >> 3) & 7) << 4)))
__device__ __forceinline__ unsigned char* gdn_rec(unsigned char* ws, int d, int ci, int h) { return ws + WS_GDN + (((size_t)d * 256 + ci) * 8 + h) * REC_BYTES; }

#ifndef DUP_D1
#define DUP_D1 0
#endif
__device__ __forceinline__ void gdn_prep_unit(LAS unsigned char* lds, unsigned char* ws, const float* conv_w, const float* a_log, const float* dt_bias,
                                              int l, int Tp, int ci, int h, int nci, int nh, unsigned& pre_ba, int tid, int wave, int lane) {
    const bf16* PROJ = (const bf16*)(ws + WS_PROJ);
    const int row0 = ci * 64, tin = row0 % Tp; const bool first = (tin == 0), last = (tin + 64 == Tp);
    LAS float* BETA = (LAS float*)(lds + D1_BETA); LAS float* GC = (LAS float*)(lds + D1_GC);
    if (tid < 128) {
        const int d = tid >> 6, r = tid & 63, c = d ? 63 - r : r;
        const float braw = bflo(pre_ba), araw = bfhi(pre_ba);
        if (nci >= 0) { const bf16* pn = PROJ + (size_t)(nci * 64 + c) * LDP + C_BA; pre_ba = (unsigned)pn[d * 8 + nh] | ((unsigned)pn[16 + d * 8 + nh] << 16); }
        const float beta = __builtin_amdgcn_rcpf(1.0f + __expf(-braw));
        const float x = araw + dt_bias[(l * 2 + d) * 8 + h];
        const float sp = fmaxf(x, 0.f) + log1pf(__expf(-fabsf(x)));
        float gcv = -__expf(a_log[(l * 2 + d) * 8 + h]) * sp;
#pragma unroll
        for (int off = 1; off < 64; off <<= 1) { const float t = __shfl_up(gcv, off); if (r >= off) gcv += t; }
        BETA[d * 64 + r] = beta; GC[d * 64 + r] = gcv;
        if (r == 63) *(float*)(gdn_rec(ws, d, ci, h) + REC_GAM) = __expf(gcv);
    }
    __syncthreads();
    for (int rep1 = 0; rep1 < (DUP_D1 == 1 ? 2 : 1); ++rep1) {
        const int sub = tid & 15, ch0 = sub * 8;
#pragma unroll 6
        for (int rnd = 0; rnd < 6; ++rnd) {
            const int it = rnd * 32 + (tid >> 4), mat = it >> 6, c = it & 63;
            const int chan = mat * 1024 + h * 128 + ch0;
            const bf16* px = PROJ + (size_t)(row0 + c) * LDP + C_GQKV + chan;
            const v4u zz = {0u, 0u, 0u, 0u};
            const v4u x1 = *(const v4u*)px;
            const v4u x0 = (c == 0 && first) ? zz : *(const v4u*)(px - LDP);
            const v4u x2 = (c == 63 && last) ? zz : *(const v4u*)(px + LDP);
            const float* cw = conv_w + (size_t)l * 3 * 3072 + chan;
            const f32x4 w0a = *(const f32x4*)cw, w0b = *(const f32x4*)(cw + 4), w1a = *(const f32x4*)(cw + 3072), w1b = *(const f32x4*)(cw + 3072 + 4), w2a = *(const f32x4*)(cw + 6144), w2b = *(const f32x4*)(cw + 6144 + 4);
            const float w0[8] = {w0a.x, w0a.y, w0a.z, w0a.w, w0b.x, w0b.y, w0b.z, w0b.w}, w1[8] = {w1a.x, w1a.y, w1a.z, w1a.w, w1b.x, w1b.y, w1b.z, w1b.w}, w2[8] = {w2a.x, w2a.y, w2a.z, w2a.w, w2b.x, w2b.y, w2b.z, w2b.w};
            const float a0[8] = {bflo(x0.x), bfhi(x0.x), bflo(x0.y), bfhi(x0.y), bflo(x0.z), bfhi(x0.z), bflo(x0.w), bfhi(x0.w)};
            const float a1[8] = {bflo(x1.x), bfhi(x1.x), bflo(x1.y), bfhi(x1.y), bflo(x1.z), bfhi(x1.z), bflo(x1.w), bfhi(x1.w)};
            const float a2[8] = {bflo(x2.x), bfhi(x2.x), bflo(x2.y), bfhi(x2.y), bflo(x2.z), bfhi(x2.z), bflo(x2.w), bfhi(x2.w)};
            float y[8]; float ss = 0.f;
#pragma unroll
            for (int e = 0; e < 8; ++e) { const float a = a0[e] * w0[e] + a1[e] * w1[e] + a2[e] * w2[e]; y[e] = a * __builtin_amdgcn_rcpf(1.0f + __expf(-a)); ss += y[e] * y[e]; }
            if (mat < 2) {
                ss += xshfl<1>(ss); ss += xshfl<2>(ss); ss += xshfl<4>(ss); ss += xshfl<8>(ss);
                float rs = __builtin_amdgcn_rsqf(ss + NORM_EPS); if (mat == 0) rs *= 0.08838834764831845f;
#pragma unroll
                for (int e = 0; e < 8; ++e) y[e] *= rs;
            }
            if (mat == 0) {
                v4u o; o.x = cvtpk(y[0], y[1]); o.y = cvtpk(y[2], y[3]); o.z = cvtpk(y[4], y[5]); o.w = cvtpk(y[6], y[7]);
                *(LAS v4u*)(lds + D1_QROW + c * ROWP + ch0 * 2) = o;
                const int t = ch0 >> 5, kk = ch0 & 31, s = kk >> 4, b = (kk >> 3) & 1;
#pragma unroll
                for (int d = 0; d < 2; ++d) { const int r = d ? 63 - c : c; const float e = __expf(GC[d * 64 + r]); const int i = r >> 5, rr = r & 31;
                    unsigned char* fb = gdn_rec(ws, d, ci, h) + REC_FQ + (((i * 4 + t) * 2 + s) * 64) * 16 + b * 8;
                    v2u lo, hi2; lo.x = cvtpk(y[0] * e, y[1] * e); lo.y = cvtpk(y[2] * e, y[3] * e); hi2.x = cvtpk(y[4] * e, y[5] * e); hi2.y = cvtpk(y[6] * e, y[7] * e);
                    *(v2u*)(fb + rr * 16) = lo; *(v2u*)(fb + (rr + 32) * 16) = hi2; }
            } else if (mat == 1) {
                v4u o; o.x = cvtpk(y[0], y[1]); o.y = cvtpk(y[2], y[3]); o.z = cvtpk(y[4], y[5]); o.w = cvtpk(y[6], y[7]);
                *(LAS v4u*)(lds + D1_KROW + c * ROWP + ch0 * 2) = o;
#pragma unroll
                for (int e = 0; e < 8; ++e) *(LAS bf16*)(lds + D1_KT + TSW(ch0 + e, c * 2)) = f2bf1(y[e]);
            } else {
#pragma unroll
                for (int e = 0; e < 8; ++e) *(LAS bf16*)(lds + D1_VT + TSW(ch0 + e, c * 2)) = f2bf1(y[e]);
            }
        }
    }
    __syncthreads();
    for (int rep2 = 0; rep2 < (DUP_D1 == 2 ? 2 : 1); ++rep2) {
        const int r32 = lane & 31, hi = lane >> 5;
#pragma unroll 1
        for (int k = wave; k < 12; k += 8) {
            const int d = k / 6, sel = k % 6;
            int ta, tb; int boff;
            if (sel < 3) { ta = (sel >= 1); tb = (sel == 2); boff = D1_KROW; }
            else { ta = (sel == 5); tb = (sel >= 4); boff = D1_QROW; }
            const int ra = 32 * ta + r32, rb = 32 * tb + r32;
            const int rowa = d ? 63 - ra : ra, rowb = d ? 63 - rb : rb;
            const LAS unsigned char* pa = lds + D1_KROW + rowa * ROWP + hi * 16; const LAS unsigned char* pb = lds + boff + rowb * ROWP + hi * 16;
            f32x16 acc = {0.f, 0.f, 0.f, 0.f, 0.f, 0.f, 0.f, 0.f, 0.f, 0.f, 0.f, 0.f, 0.f, 0.f, 0.f, 0.f};
#pragma unroll
            for (int s = 0; s < 8; ++s) acc = MFMA32(*(const LAS bf16x8*)(pa + s * 32), *(const LAS bf16x8*)(pb + s * 32), acc);
            const int colp = 32 * tb + r32;
            const float gcc = GC[d * 64 + colp];
            if (sel < 3) {
                LAS float* Lm = (LAS float*)(lds + D1_LM + d * 17408);
#pragma unroll
                for (int r = 0; r < 16; ++r) { const int rp = 32 * ta + crow(r, hi);
                    const float v = (rp > colp) ? BETA[d * 64 + rp] * acc[r] * __expf(GC[d * 64 + rp] - gcc) : 0.f;
                    Lm[rp * (LMP / 4) + colp] = v; }
            } else {
                float v[16];
#pragma unroll
                for (int r = 0; r < 16; ++r) { const int cp = 32 * ta + crow(r, hi);
                    v[r] = (colp >= cp) ? acc[r] * __expf(gcc - GC[d * 64 + cp]) : 0.f; }
                unsigned char* fb = gdn_rec(ws, d, ci, h) + REC_FQK + (((tb * 2 + ta) * 2) * 64 + lane) * 16;
                v4u o0, o1; o0.x = cvtpk(v[0], v[1]); o0.y = cvtpk(v[2], v[3]); o0.z = cvtpk(v[4], v[5]); o0.w = cvtpk(v[6], v[7]);
                o1.x = cvtpk(v[8], v[9]); o1.y = cvtpk(v[10], v[11]); o1.z = cvtpk(v[12], v[13]); o1.w = cvtpk(v[14], v[15]);
                *(v4u*)fb = o0; *(v4u*)(fb + 1024) = o1;
            }
        }
    }
    __syncthreads();
    constexpr int D1_TS = D1_QROW;
    for (int rep3 = 0; rep3 < (DUP_D1 == 3 ? 2 : 1); ++rep3)
    if (wave < 4) {
        const int d = wave >> 1, blk = wave & 1, j = lane & 31, jp = 32 * blk + j;
        const LAS float* Lm = (const LAS float*)(lds + D1_LM + d * 17408) + (32 * blk) * (LMP / 4) + 32 * blk;
        const float bj = BETA[d * 64 + jp], bgj = bj * __expf(GC[d * 64 + jp]);
        const int col = d ? 63 - jp : jp;
        LAS unsigned char* tb = lds + D1_TB + d * 18432 + (32 * blk) * TBP + col * 2;
        LAS float* ts = (LAS float*)(lds + D1_TS + (d * 2 + blk) * 4352) + j;
        if (lane < 32) {
            float t[32];
#pragma unroll
            for (int r = 0; r < 32; ++r) {
                float a4[4] = {(r == j) ? 1.f : 0.f, 0.f, 0.f, 0.f};
#pragma unroll
                for (int m4 = 0; m4 < (r + 3) / 4; ++m4) { const f32x4 lv = *(const LAS f32x4*)(Lm + r * (LMP / 4) + m4 * 4);
#pragma unroll
                    for (int e = 0; e < 4; ++e) if (m4 * 4 + e < r) a4[e] -= lv[e] * t[m4 * 4 + e]; }
                const float a = (a4[0] + a4[1]) + (a4[2] + a4[3]);
                t[r] = a; ts[r * 33] = a;
                *(LAS bf16*)(tb + r * TBP) = f2bf1(a * bj); *(LAS bf16*)(tb + 9216 + r * TBP) = f2bf1(a * bgj);
            }
        } else if (blk == 0) {
            const int colz = d ? 63 - (32 + j) : 32 + j; LAS unsigned char* tz = lds + D1_TB + d * 18432 + colz * 2;
#pragma unroll
            for (int r = 0; r < 32; ++r) { *(LAS bf16*)(tz + r * TBP) = (bf16)0; *(LAS bf16*)(tz + 9216 + r * TBP) = (bf16)0; }
        }
    } else {
        const int rr = lane & 31, hh = lane >> 5;
#pragma unroll 1
        for (int f = wave - 4; f < 32; f += 4) {
            const int d = f >> 4, t = (f >> 2) & 3, ip = (f >> 1) & 1, s = f & 1;
            const int c0 = 32 * ip + 16 * s + 4 * hh;
            const float gl = GC[d * 64 + 63];
            const int ktr = 32 * t + rr; const LAS unsigned char* kt = lds + D1_KT;
            float ea[4], eb[4];
#pragma unroll
            for (int x = 0; x < 4; ++x) { ea[x] = __expf(gl - GC[d * 64 + c0 + x]); eb[x] = __expf(gl - GC[d * 64 + c0 + 8 + x]); }
            float ka[4], kb[4];
            if (d == 0) { const v2u wa = *(const LAS v2u*)(kt + TSW(ktr, c0 * 2)), wb = *(const LAS v2u*)(kt + TSW(ktr, (c0 + 8) * 2));
                ka[0] = bflo(wa.x); ka[1] = bfhi(wa.x); ka[2] = bflo(wa.y); ka[3] = bfhi(wa.y); kb[0] = bflo(wb.x); kb[1] = bfhi(wb.x); kb[2] = bflo(wb.y); kb[3] = bfhi(wb.y); }
            else { const v2u wa = *(const LAS v2u*)(kt + TSW(ktr, (60 - c0) * 2)), wb = *(const LAS v2u*)(kt + TSW(ktr, (52 - c0) * 2));
                ka[3] = bflo(wa.x); ka[2] = bfhi(wa.x); ka[1] = bflo(wa.y); ka[0] = bfhi(wa.y); kb[3] = bflo(wb.x); kb[2] = bfhi(wb.x); kb[1] = bflo(wb.y); kb[0] = bfhi(wb.y); }
            v4u o; o.x = cvtpk(ka[0] * ea[0], ka[1] * ea[1]); o.y = cvtpk(ka[2] * ea[2], ka[3] * ea[3]); o.z = cvtpk(kb[0] * eb[0], kb[1] * eb[1]); o.w = cvtpk(kb[2] * eb[2], kb[3] * eb[3]);
            *(v4u*)(gdn_rec(ws, d, ci, h) + REC_FK + (((t * 2 + ip) * 2 + s) * 64 + lane) * 16) = o;
        }
    }
    __syncthreads();
    if (wave < 2) {
        const int d = wave, i = lane & 31, hh = lane >> 5;
        const LAS float* L21 = (const LAS float*)(lds + D1_LM + d * 17408) + (32 + i) * (LMP / 4);
        const LAS float* T11 = (const LAS float*)(lds + D1_TS + (d * 2 + 0) * 4352);
        const LAS float* T22 = (const LAS float*)(lds + D1_TS + (d * 2 + 1) * 4352);
        f32x16 P = {0.f, 0.f, 0.f, 0.f, 0.f, 0.f, 0.f, 0.f, 0.f, 0.f, 0.f, 0.f, 0.f, 0.f, 0.f, 0.f};
#pragma unroll
        for (int s = 0; s < 16; ++s) P = __builtin_amdgcn_mfma_f32_32x32x2f32(L21[2 * s + hh], T11[(2 * s + hh) * 33 + i], P, 0, 0, 0);
        f32x16 R = {0.f, 0.f, 0.f, 0.f, 0.f, 0.f, 0.f, 0.f, 0.f, 0.f, 0.f, 0.f, 0.f, 0.f, 0.f, 0.f};
#pragma unroll
        for (int s = 0; s < 16; ++s) R = __builtin_amdgcn_mfma_f32_32x32x2f32(T22[i * 33 + crow(s, hh)], P[s], R, 0, 0, 0);
        const float bj = BETA[d * 64 + i], bgj = bj * __expf(GC[d * 64 + i]);
        const int col = d ? 63 - i : i;
        LAS unsigned char* tb = lds + D1_TB + d * 18432 + 32 * TBP + col * 2;
#pragma unroll
        for (int r = 0; r < 16; ++r) { const float a = -R[r]; const int row = crow(r, hh);
            *(LAS bf16*)(tb + row * TBP) = f2bf1(a * bj); *(LAS bf16*)(tb + 9216 + row * TBP) = f2bf1(a * bgj); }
    }
    __syncthreads();
    for (int rep4 = 0; rep4 < (DUP_D1 == 4 ? 2 : 1); ++rep4) {
        const int r32 = lane & 31, hi = lane >> 5;
#pragma unroll 1
        for (int f = wave; f < 32; f += 8) {
            const int d = f >> 4, kind = (f >> 3) & 1, idx = f & 7;
            const LAS unsigned char* pa; const LAS unsigned char* pb; int xa = 0, xb = 0;
            if (kind == 0) { const int i = idx >> 2, w = idx & 3;
                pa = lds + D1_TB + d * 18432 + (32 * i + r32) * TBP; pb = lds + D1_VT + (32 * w + r32) * TRP; xb = (((32 * w + r32) >> 3) & 7) << 4; }
            else { const int t = idx >> 1, i = idx & 1;
                pa = lds + D1_KT + (32 * t + r32) * TRP; xa = (((32 * t + r32) >> 3) & 7) << 4; pb = lds + D1_TB + d * 18432 + 9216 + (32 * i + r32) * TBP; }
            f32x16 acc = {0.f, 0.f, 0.f, 0.f, 0.f, 0.f, 0.f, 0.f, 0.f, 0.f, 0.f, 0.f, 0.f, 0.f, 0.f, 0.f};
#pragma unroll
            for (int s = 0; s < 4; ++s) acc = MFMA32(*(const LAS bf16x8*)(pa + ((s * 32 + hi * 16) ^ xa)), *(const LAS bf16x8*)(pb + ((s * 32 + hi * 16) ^ xb)), acc);
            const float sg = kind ? -1.f : 1.f;
            v4u o0, o1; o0.x = cvtpk(sg * acc[0], sg * acc[1]); o0.y = cvtpk(sg * acc[2], sg * acc[3]); o0.z = cvtpk(sg * acc[4], sg * acc[5]); o0.w = cvtpk(sg * acc[6], sg * acc[7]);
            o1.x = cvtpk(sg * acc[8], sg * acc[9]); o1.y = cvtpk(sg * acc[10], sg * acc[11]); o1.z = cvtpk(sg * acc[12], sg * acc[13]); o1.w = cvtpk(sg * acc[14], sg * acc[15]);
            if (kind == 0) { const int i = idx >> 2, w = idx & 3; unsigned char* fb = gdn_rec(ws, d, ci, h) + REC_FU + ((w * 2 + i) * 64 + lane) * 32; *(v4u*)fb = o0; *(v4u*)(fb + 16) = o1; }
            else { const int t = idx >> 1, i = idx & 1; unsigned char* fb = gdn_rec(ws, d, ci, h) + REC_FW + (((i * 4 + t) * 2) * 64 + lane) * 16; *(v4u*)fb = o0; *(v4u*)(fb + 1024) = o1; }
        }
    }
    __syncthreads();
}
__device__ __forceinline__ bf16x8 pack8(const f32x16& v, int s) {
    v4u w; w.x = cvtpk(v[8 * s + 0], v[8 * s + 1]); w.y = cvtpk(v[8 * s + 2], v[8 * s + 3]); w.z = cvtpk(v[8 * s + 4], v[8 * s + 5]); w.w = cvtpk(v[8 * s + 6], v[8 * s + 7]);
    return __builtin_bit_cast(bf16x8, w);
}
#define SCAN_BAR() do { asm volatile("s_waitcnt lgkmcnt(0)" ::: "memory"); __builtin_amdgcn_s_barrier(); asm volatile("" ::: "memory"); } while (0)
constexpr int SC_BUF = REC_BYTES;
__device__ __forceinline__ void gdn_scan_unit(LAS unsigned char* lds, unsigned char* ws, int Tp, int sq, int h, int d, int half, int tid, int wave, int lane) {
    const int Nc = Tp / 64, cb = sq * Nc;
    bf16* ODIR = (bf16*)(ws + WS_ODIR) + (size_t)d * PASS_ROWS * 1024;
#define SC_SRC(n) ((const unsigned char*)gdn_rec(ws, d, cb + (d ? Nc - 1 - (n) : (n)), h))
    if (wave >= 2) {
        const int lt = tid - 128;
#define SC_LOAD(st, n) do { const unsigned char* src_ = SC_SRC(n); _Pragma("unroll") for (int k = 0; k < 12; ++k) st[k] = *(const v4u*)(src_ + (lt + 384 * k) * 16); } while (0)
#define SC_WRITE(st, b) do { _Pragma("unroll") for (int k = 0; k < 12; ++k) *(LAS v4u*)(lds + (b) * SC_BUF + (lt + 384 * k) * 16) = st[k]; } while (0)
        v4u s0[12], s1[12];
        SC_LOAD(s0, 0); SC_WRITE(s0, 0);
        if (1 < Nc) SC_LOAD(s1, 1);
        if (2 < Nc) SC_LOAD(s0, 2);
        SCAN_BAR();
#define SC_STEP(n, st) do { if ((n) < Nc) { if ((n) + 1 < Nc) SC_WRITE(st, ((n) + 1) & 1); if ((n) + 3 < Nc) SC_LOAD(st, (n) + 3); SCAN_BAR(); } } while (0)
#pragma unroll 1
        for (int n = 0; n < Nc; n += 2) { SC_STEP(n, s1); SC_STEP(n + 1, s0); }
#undef SC_STEP
#undef SC_WRITE
#undef SC_LOAD
    } else {
        const int w = half * 2 + wave, r32 = lane & 31, hi = lane >> 5;
        f32x16 S[4];
#pragma unroll
        for (int t = 0; t < 4; ++t)
#pragma unroll
            for (int r = 0; r < 16; ++r) S[t][r] = 0.f;
        const __amdgpu_buffer_rsrc_t orsrc = __builtin_amdgcn_make_buffer_rsrc((void*)(ODIR + (size_t)(sq * Tp) * 1024 + h * 128 + 32 * w), 0, 0x7fffffff, 0x00020000);
        SCAN_BAR();
#pragma unroll 1
        for (int n = 0; n < Nc; ++n) {
            const LAS unsigned char* buf = lds + (n & 1) * SC_BUF + lane * 16;
            const float gam = *(const LAS float*)(lds + (n & 1) * SC_BUF + REC_GAM);
#define LDF(off) (*(const LAS bf16x8*)(buf + (off)))
#define FWO(i, t, s) (REC_FW + (((i) * 4 + (t)) * 2 + (s)) * 1024)
#define FQO(i, t, s) (REC_FQ + (((i) * 4 + (t)) * 2 + (s)) * 1024)
#define FKO(t, ip, s) (REC_FK + (((t) * 2 + (ip)) * 2 + (s)) * 1024)
#define FQKO(i, ip, s) (REC_FQK + (((i) * 2 + (ip)) * 2 + (s)) * 1024)
            bf16x8 A[8], B[8];
#pragma unroll
            for (int e = 0; e < 8; ++e) { A[e] = LDF(FWO(e & 1, e >> 2, (e >> 1) & 1)); B[e] = LDF(FWO(e & 1, 2 + (e >> 2), (e >> 1) & 1)); }
            v4u ua[2], ub[2];
#pragma unroll
            for (int i = 0; i < 2; ++i) { const LAS v4u* pu = (const LAS v4u*)(lds + (n & 1) * SC_BUF + REC_FU + ((w * 2 + i) * 64 + lane) * 32); ua[i] = pu[0]; ub[i] = pu[1]; }
            __builtin_amdgcn_sched_barrier(0);
            bf16x8 Sf[4][2];
#pragma unroll
            for (int t = 0; t < 4; ++t) { Sf[t][0] = pack8(S[t], 0); Sf[t][1] = pack8(S[t], 1); }
            f32x16 V[2];
#pragma unroll
            for (int i = 0; i < 2; ++i) { const v4u a = ua[i], b = ub[i];
                V[i][0] = bflo(a.x); V[i][1] = bfhi(a.x); V[i][2] = bflo(a.y); V[i][3] = bfhi(a.y); V[i][4] = bflo(a.z); V[i][5] = bfhi(a.z); V[i][6] = bflo(a.w); V[i][7] = bfhi(a.w);
                V[i][8] = bflo(b.x); V[i][9] = bfhi(b.x); V[i][10] = bflo(b.y); V[i][11] = bfhi(b.y); V[i][12] = bflo(b.z); V[i][13] = bfhi(b.z); V[i][14] = bflo(b.w); V[i][15] = bfhi(b.w); }
            __builtin_amdgcn_sched_barrier(0);
#pragma unroll
            for (int e = 0; e < 8; ++e) V[e & 1] = MFMA32(A[e], Sf[e >> 2][(e >> 1) & 1], V[e & 1]);
            __builtin_amdgcn_sched_barrier(0);
#pragma unroll
            for (int e = 0; e < 8; ++e) A[e] = LDF(FQO(e & 1, e >> 2, (e >> 1) & 1));
            __builtin_amdgcn_sched_barrier(0);
#pragma unroll
            for (int e = 0; e < 8; ++e) V[e & 1] = MFMA32(B[e], Sf[2 + (e >> 2)][(e >> 1) & 1], V[e & 1]);
            __builtin_amdgcn_sched_barrier(0);
#pragma unroll
            for (int e = 0; e < 8; ++e) B[e] = LDF(FQO(e & 1, 2 + (e >> 2), (e >> 1) & 1));
            __builtin_amdgcn_sched_barrier(0);
            f32x16 O[2];
#pragma unroll
            for (int i = 0; i < 2; ++i)
#pragma unroll
                for (int r = 0; r < 16; ++r) O[i][r] = 0.f;
#pragma unroll
            for (int e = 0; e < 8; ++e) O[e & 1] = MFMA32(A[e], Sf[e >> 2][(e >> 1) & 1], O[e & 1]);
            __builtin_amdgcn_sched_barrier(0);
#pragma unroll
            for (int e = 0; e < 8; ++e) A[e] = LDF(FKO(e & 3, 0, e >> 2));
            bf16x8 Vf[2][2];
#pragma unroll
            for (int i = 0; i < 2; ++i) { Vf[i][0] = pack8(V[i], 0); Vf[i][1] = pack8(V[i], 1); }
#pragma unroll
            for (int t = 0; t < 4; ++t)
#pragma unroll
                for (int r = 0; r < 16; ++r) S[t][r] *= gam;
            __builtin_amdgcn_sched_barrier(0);
#pragma unroll
            for (int e = 0; e < 8; ++e) O[e & 1] = MFMA32(B[e], Sf[2 + (e >> 2)][(e >> 1) & 1], O[e & 1]);
            __builtin_amdgcn_sched_barrier(0);
#pragma unroll
            for (int e = 0; e < 8; ++e) B[e] = LDF(FKO(e & 3, 1, e >> 2));
            __builtin_amdgcn_sched_barrier(0);
#pragma unroll
            for (int e = 0; e < 8; ++e) S[e & 3] = MFMA32(A[e], Vf[0][e >> 2], S[e & 3]);
            __builtin_amdgcn_sched_barrier(0);
            A[0] = LDF(FQKO(0, 0, 0)); A[1] = LDF(FQKO(1, 0, 0)); A[2] = LDF(FQKO(0, 0, 1)); A[3] = LDF(FQKO(1, 0, 1)); A[4] = LDF(FQKO(1, 1, 0)); A[5] = LDF(FQKO(1, 1, 1));
            __builtin_amdgcn_sched_barrier(0);
#pragma unroll
            for (int e = 0; e < 8; ++e) S[e & 3] = MFMA32(B[e], Vf[1][e >> 2], S[e & 3]);
            __builtin_amdgcn_sched_barrier(0);
            O[0] = MFMA32(A[0], Vf[0][0], O[0]); O[1] = MFMA32(A[1], Vf[0][0], O[1]); O[0] = MFMA32(A[2], Vf[0][1], O[0]); O[1] = MFMA32(A[3], Vf[0][1], O[1]);
            O[1] = MFMA32(A[4], Vf[1][0], O[1]); O[1] = MFMA32(A[5], Vf[1][1], O[1]);
#undef LDF
#undef FWO
#undef FQO
#undef FKO
#undef FQKO
            { const int tau0 = 64 * n + 4 * hi;
#pragma unroll
              for (int i = 0; i < 2; ++i)
#pragma unroll
                for (int r = 0; r < 16; ++r) { const int tau = tau0 + 32 * i + (r & 3) + 8 * (r >> 2); const int trow = d ? Tp - 1 - tau : tau;
                    __builtin_amdgcn_raw_buffer_store_b16((short)f2bf1(O[i][r]), orsrc, (trow * 1024 + r32) * 2, 0, 0); } }
            SCAN_BAR();
        }
    }
#undef SC_SRC
}
#define KSWZ(row, colB) ((row) * 256 + ((colB) ^ (((row) & 7) << 4)))
#define SBAR() __builtin_amdgcn_sched_barrier(0)
constexpr int AT_V = 0, AT_K = 32768, AT_OST = 0, AT_OST_W = 16896, AT_WS = 8 * AT_OST_W;
constexpr float ATT_THR = 11.5f;
__device__ __forceinline__ int v_st(int k, int c) { const int kk = (k & ~0xC) | ((k & 4) << 1) | ((k & 8) >> 1); return ((kk >> 3) * 4 + (c >> 5)) * 512 + ((kk & 7) * 32 + (c & 31)) * 2; }
__device__ __forceinline__ int v_rd_base(int lane) { return ((lane & 3) << 3) | (((lane >> 2) & 3) << 6) | (((lane >> 4) & 1) << 5) | (((lane >> 5) & 1) << 8); }
constexpr int v_rd_off(int d0, int ks, int half) { return d0 * 512 + ks * 4096 + half * 2048; }
template <int OFF> __device__ __forceinline__ s16x4 tr_read(int vb) {
    s16x4 r; asm volatile("ds_read_b64_tr_b16 %0, %1 offset:%2" : "=&v"(r) : "v"(vb), "i"(OFF) : "memory"); return r;
}
template <int D0> __device__ __forceinline__ void pv_one(f32x16& od, int vb, bf16x8 pa0, bf16x8 pa1, bf16x8 pa2, bf16x8 pa3) {
    const s16x4 l0 = tr_read<v_rd_off(D0, 0, 0)>(vb), h0 = tr_read<v_rd_off(D0, 0, 1)>(vb), l1 = tr_read<v_rd_off(D0, 1, 0)>(vb), h1 = tr_read<v_rd_off(D0, 1, 1)>(vb);
    const s16x4 l2 = tr_read<v_rd_off(D0, 2, 0)>(vb), h2 = tr_read<v_rd_off(D0, 2, 1)>(vb), l3 = tr_read<v_rd_off(D0, 3, 0)>(vb), h3 = tr_read<v_rd_off(D0, 3, 1)>(vb);
    asm volatile("s_waitcnt lgkmcnt(0)" ::: "memory"); SBAR();
#define PK(L, H) (bf16x8){L[0], L[1], L[2], L[3], H[0], H[1], H[2], H[3]}
    od = MFMA32(pa0, PK(l0, h0), od); od = MFMA32(pa1, PK(l1, h1), od); od = MFMA32(pa2, PK(l2, h2), od); od = MFMA32(pa3, PK(l3, h3), od);
#undef PK
}
__device__ __forceinline__ void pv_d0(f32x16* o, int vb, bf16x8 pa0, bf16x8 pa1, bf16x8 pa2, bf16x8 pa3) {
    pv_one<0>(o[0], vb, pa0, pa1, pa2, pa3); pv_one<1>(o[1], vb, pa0, pa1, pa2, pa3); pv_one<2>(o[2], vb, pa0, pa1, pa2, pa3); pv_one<3>(o[3], vb, pa0, pa1, pa2, pa3);
}
template <bool FIXED>
__device__ __forceinline__ float softmax_tile(f32x16& p0, f32x16& p1, float& m_reg, float& l_reg, bf16x8& pa0, bf16x8& pa1, bf16x8& pa2, bf16x8& pa3) {
    float alpha = 1.f;
    if (!FIXED) {
        float pmax = p0[0];
#pragma unroll
        for (int r = 1; r < 16; ++r) pmax = fmaxf(pmax, p0[r]);
#pragma unroll
        for (int r = 0; r < 16; ++r) pmax = fmaxf(pmax, p1[r]);
        pmax = half_max(pmax);
        if (!__all(pmax - m_reg <= ATT_THR)) { const float mn = fmaxf(m_reg, pmax); alpha = __builtin_amdgcn_exp2f(m_reg - mn); m_reg = mn; }
        const float mn = m_reg;
#pragma unroll
        for (int r = 0; r < 16; ++r) { p0[r] = __builtin_amdgcn_exp2f(p0[r] - mn); p1[r] = __builtin_amdgcn_exp2f(p1[r] - mn); }
    } else {
#pragma unroll
        for (int r = 0; r < 16; ++r) { p0[r] = __builtin_amdgcn_exp2f(p0[r]); p1[r] = __builtin_amdgcn_exp2f(p1[r]); }
    }
    float ps = 0.f;
#pragma unroll
    for (int r = 0; r < 16; ++r) ps += p0[r];
#pragma unroll
    for (int r = 0; r < 16; ++r) ps += p1[r];
    ps = half_sum(ps);
    l_reg = l_reg * alpha + ps;
#define PK4(P, BASE, OUT) do { unsigned a0 = cvtpk(P[BASE + 0], P[BASE + 1]), a1 = cvtpk(P[BASE + 2], P[BASE + 3]);   \
    unsigned b0 = cvtpk(P[BASE + 4], P[BASE + 5]), b1 = cvtpk(P[BASE + 6], P[BASE + 7]);                              \
    auto r0 = __builtin_amdgcn_permlane32_swap(a0, b0, false, false); auto r1 = __builtin_amdgcn_permlane32_swap(a1, b1, false, false); \
    v4u w = {r0[0], r1[0], r0[1], r1[1]}; OUT = __builtin_bit_cast(bf16x8, w); } while (0)
    PK4(p0, 0, pa0); PK4(p0, 8, pa1); PK4(p1, 0, pa2); PK4(p1, 8, pa3);
#undef PK4
    return alpha;
}

__device__ __forceinline__ int diff_radius(float bnat, int h) {
    const float slope_n = exp2f(-(float)(h + 1));
    const float dn = (2.0f * bnat + logf(2.0f / (1.0f - expf(-slope_n))) + 22.18f) / slope_n;
    return (dn < 1.0e6f) ? (int)dn + 1 : 1000000;
}
struct AttnParams { const float* q_gain; const float* sink; const float* lam; const float* norm_gain; float bnat; };
#define KSWZ64(row, colB) ((row) * 128 + ((colB) ^ ((((row) >> 1) & 7) << 4)))

template <int MODE, bool FIXED>
__device__ __forceinline__ void attn_unit(LAS unsigned char* lds, unsigned char* ws, const AttnParams& P, int l, int Tp, int sq, int h, int qb, int part, int np, int pslot, int tid, int wave, int lane) {
    constexpr int NPASS_M = MODE ? 2 : 1, NDD = MODE ? 4 : 8;
    const bf16* PROJ = (const bf16*)(ws + WS_PROJ);
    const int r32 = lane & 31, hi = lane >> 5;
    const int seq0 = sq * Tp, q0 = qb * 256;
    const int qcol = MODE ? C_DQ + h * 128 : C_SQ + h * 128;
    const int kcol = MODE ? C_DK + h * 128 : C_SKV + (h >> 2) * 128;
    const int vcol = MODE ? C_DV + h * 128 : C_SKV + 256 + (h >> 2) * 128;
    const int zcol = MODE ? C_DZ + h * 128 : C_SZ + h * 128;
    int jlo = 0, jhi = Tp / 64;
    const float slope_n = exp2f(-(float)(h + 1)), slope2 = slope_n * LOG2E;
    if (MODE == 0) { jlo = (q0 - 128) / 64; if (jlo < 0) jlo = 0; const int e = (q0 + 384) / 64; if (e < jhi) jhi = e; }
    else {
        float bn = P.bnat; asm volatile("" : "+v"(bn));
        float smin = 1.0e30f;
        { const bf16* qp = PROJ + (size_t)(seq0 + q0 + wave * 32 + r32) * LDP + qcol + hi * 8; const bf16* kp = PROJ + (size_t)(seq0 + q0 + wave * 32 + r32) * LDP + kcol + hi * 8;
#pragma unroll
          for (int mq = 0; mq < 2; ++mq) { float dot = 0.f;
#pragma unroll
              for (int d0 = 0; d0 < 4; ++d0) { const v4u wq = *(const v4u*)(qp + mq * 64 + d0 * 16), wk = *(const v4u*)(kp + mq * 64 + d0 * 16);
                  const float q8[8] = {bflo(wq.x), bfhi(wq.x), bflo(wq.y), bfhi(wq.y), bflo(wq.z), bfhi(wq.z), bflo(wq.w), bfhi(wq.w)};
                  const float k8[8] = {bflo(wk.x), bfhi(wk.x), bflo(wk.y), bfhi(wk.y), bflo(wk.z), bfhi(wk.z), bflo(wk.w), bfhi(wk.w)};
#pragma unroll
                  for (int e = 0; e < 8; ++e) dot += q8[e] * k8[e]; }
              dot = half_sum(dot);
              smin = fminf(smin, dot * (1.0f / LOG2E)); }
          smin = -wave_max(-smin);
          LAS float* sm = (LAS float*)(lds + AT_WS) + 512;
          if (lane == 0) sm[wave] = smin;
          asm volatile("s_waitcnt lgkmcnt(0)" ::: "memory"); __builtin_amdgcn_s_barrier(); asm volatile("" ::: "memory");
          smin = fminf(fminf(fminf(sm[0], sm[1]), fminf(sm[2], sm[3])), fminf(fminf(sm[4], sm[5]), fminf(sm[6], sm[7]))); }
        float beff = 0.5f * (bn - smin + 0.1f); if (!(beff < bn)) beff = bn;
        const int dk = diff_radius(beff, h);
        const int a = q0 - dk; jlo = a > 0 ? (a >> 6) : 0; const int e = ((q0 + 255 + dk) >> 6) + 1; if (e < jhi) jhi = e;
        if (np > 1) { const int len = (jhi - jlo + np - 1) / np; jlo += part * len; const int e2 = jlo + len; if (e2 < jhi) jhi = e2; }
    }
    LAS unsigned char* V_lds = lds + AT_V; LAS unsigned char* K_lds = lds + AT_K;
    LAS float* wsf = (LAS float*)(lds + AT_WS) + wave * 64; LAS float* li_l = wsf; LAS float* al_l = wsf + 32;
    float* park = (float*)(ws + WS_PARK) + (size_t)(blockIdx.x * NWAVES + wave) * 4096 + lane * 4;
    const float qposh = (float)(q0 + wave * 32 + r32 - 4 * hi), qposf = (float)(q0 + wave * 32 + r32);
    const int vb0 = (int)(uintptr_t)V_lds + v_rd_base(lane);
    const int sr = tid >> 4, sc = (tid & 15) * 8, vst0 = v_st(sr, sc), vst1 = v_st(32 + sr, sc);
    const int kr1 = tid >> 3, kc1 = (tid & 7) * 8;
    f32x16 o[4]; float l_reg = 0.f;
#pragma unroll 1
    for (int mp = 0; mp < NPASS_M; ++mp) {
        bf16x8 qr[NDD];
        if (MODE == 1) {
            const bf16* qp = PROJ + (size_t)(seq0 + q0 + wave * 32 + r32) * LDP + qcol + mp * 64 + hi * 8;
#pragma unroll
            for (int d0 = 0; d0 < NDD; ++d0) qr[d0] = *(const bf16x8*)(qp + d0 * 16);
        } else {
            const bf16* qp = PROJ + (size_t)(seq0 + q0 + wave * 32 + r32) * LDP + qcol + mp * 64 + hi * 8;
            float qf[NDD][8]; float ss = 0.f;
#pragma unroll
            for (int d0 = 0; d0 < NDD; ++d0) { const v4u w = *(const v4u*)(qp + d0 * 16);
                qf[d0][0] = bflo(w.x); qf[d0][1] = bfhi(w.x); qf[d0][2] = bflo(w.y); qf[d0][3] = bfhi(w.y); qf[d0][4] = bflo(w.z); qf[d0][5] = bfhi(w.z); qf[d0][6] = bflo(w.w); qf[d0][7] = bfhi(w.w);
#pragma unroll
                for (int e = 0; e < 8; ++e) ss += qf[d0][e] * qf[d0][e]; }
            ss = half_sum(ss);
            const float rs = MODE ? (1.0f / sqrtf(ss * (1.0f / 64.0f) + NORM_EPS)) * (0.125f * LOG2E) : (1.0f / sqrtf(ss * (1.0f / 128.0f) + NORM_EPS)) * (0.08838834764831845f * LOG2E);
#pragma unroll
            for (int d0 = 0; d0 < NDD; ++d0) { const float* g = P.q_gain + d0 * 16 + hi * 8;
                const f32x4 ga = *(const f32x4*)g, gb = *(const f32x4*)(g + 4);
                v4u w; w.x = cvtpk(qf[d0][0] * rs * ga.x, qf[d0][1] * rs * ga.y); w.y = cvtpk(qf[d0][2] * rs * ga.z, qf[d0][3] * rs * ga.w);
                w.z = cvtpk(qf[d0][4] * rs * gb.x, qf[d0][5] * rs * gb.y); w.w = cvtpk(qf[d0][6] * rs * gb.z, qf[d0][7] * rs * gb.w);
                qr[d0] = __builtin_bit_cast(bf16x8, w); }
        }
        float m_reg = (MODE == 0) ? P.sink[h] * LOG2E : -1e30f; l_reg = (MODE == 0) ? (FIXED ? exp2f(P.sink[h] * LOG2E) : 1.f) : 0.f;
#pragma unroll
        for (int d = 0; d < 4; ++d)
#pragma unroll
            for (int r = 0; r < 16; ++r) o[d][r] = 0.f;
        const bf16* Vg = PROJ + (size_t)seq0 * LDP + vcol + sc;
        const bf16* Kg = MODE ? PROJ + (size_t)(seq0 + kr1) * LDP + kcol + mp * 64 + kc1 : PROJ + (size_t)seq0 * LDP + kcol + sc;
        constexpr int DEPTH = 1;
        struct Stg { v4u vs0, vs1, ks0, ks1; };
        Stg sA, sB;
#define SLOAD(S, k0) do { S.vs0 = *(const v4u*)(Vg + (size_t)((k0) + sr) * LDP); S.vs1 = *(const v4u*)(Vg + (size_t)((k0) + 32 + sr) * LDP); \
        if (MODE) { S.ks0 = *(const v4u*)(Kg + (size_t)(k0) * LDP); } \
        else { S.ks0 = *(const v4u*)(Kg + (size_t)((k0) + sr) * LDP); S.ks1 = *(const v4u*)(Kg + (size_t)((k0) + 32 + sr) * LDP); } } while (0)
#define SWRITE(S, b) do { *(LAS v4u*)(V_lds + (b) * 16384 + vst0) = S.vs0; *(LAS v4u*)(V_lds + (b) * 16384 + vst1) = S.vs1; \
        if (MODE) { *(LAS v4u*)(K_lds + (b) * 16384 + KSWZ64(kr1, kc1 * 2)) = S.ks0; } \
        else { *(LAS v4u*)(K_lds + (b) * 16384 + KSWZ(sr, sc * 2)) = S.ks0; *(LAS v4u*)(K_lds + (b) * 16384 + KSWZ(32 + sr, sc * 2)) = S.ks1; } } while (0)
#define TILE(S, jj) do { const int j_ = (jj); const int b_ = (j_ - jlo) & 1; \
            SWRITE(S, b_); \
            if (j_ + DEPTH < jhi) SLOAD(S, (j_ + DEPTH) * 64); \
            asm volatile("s_waitcnt lgkmcnt(0)" ::: "memory"); __builtin_amdgcn_s_barrier(); asm volatile("" ::: "memory"); \
              \
            if (MODE == 1 || (j_ * 64 + 63 >= q0 + wave * 32 - 128 && j_ * 64 <= q0 + wave * 32 + 31 + 128)) { \
            const LAS unsigned char* Kb = K_lds + b_ * 16384; const int vb = vb0 + b_ * 16384; \
            const float fi = qposh - (float)(j_ * 64);                 \
            f32x16 p0, p1; \
            _Pragma("unroll") for (int r = 0; r < 16; ++r) { p0[r] = 0.f; p1[r] = 0.f; } \
            _Pragma("unroll") for (int dd = 0; dd < NDD; ++dd) { const int cb = (dd * 16 + hi * 8) * 2; \
                const bf16x8 b0 = MODE ? *(const LAS bf16x8*)(Kb + KSWZ64(r32, cb)) : *(const LAS bf16x8*)(Kb + KSWZ(r32, cb)); \
                const bf16x8 b1 = MODE ? *(const LAS bf16x8*)(Kb + KSWZ64(32 + r32, cb)) : *(const LAS bf16x8*)(Kb + KSWZ(32 + r32, cb)); \
                p0 = MFMA32(b0, qr[dd], p0); p1 = MFMA32(b1, qr[dd], p1); } \
              \
            const bool lin_ = (MODE == 1) && FIXED && (j_ * 64 + 63 < q0 + wave * 32 || j_ * 64 > q0 + wave * 32 + 31); \
            if (lin_) { const float sg = (j_ * 64 + 63 < q0 + wave * 32) ? 1.f : -1.f, slv = sg * slope2, lcv = -slv * (qposf - (float)(j_ * 64)); \
                const unsigned hw = cvtpk(lcv, slv), lw = cvtpk(lcv - bflo(hw), slv - bfhi(hw)); \
                v4u qx = {(hw & 0xffffu) | (lw << 16), (hw >> 16) | (lw & 0xffff0000u), 0u, 0u}; if (hi) qx = (v4u){0u, 0u, 0u, 0u}; \
                const LAS unsigned char* Kx = K_lds + 8192 + hi * 16; \
                p0 = MFMA32(*(const LAS bf16x8*)(Kx + r32 * 32), __builtin_bit_cast(bf16x8, qx), p0); p1 = MFMA32(*(const LAS bf16x8*)(Kx + (32 + r32) * 32), __builtin_bit_cast(bf16x8, qx), p1); } \
            if (!lin_) { \
            _Pragma("unroll") for (int r = 0; r < 16; ++r) { const float dd0 = fabsf(fi - (float)((r & 3) + 8 * (r >> 2))), dd1 = fabsf(fi - (float)(32 + (r & 3) + 8 * (r >> 2))); \
                p0[r] = fmaf(-slope2, dd0, p0[r]); p1[r] = fmaf(-slope2, dd1, p1[r]); \
                if (MODE == 0) { if (dd0 > 128.f) p0[r] = -INFINITY; if (dd1 > 128.f) p1[r] = -INFINITY; } } } \
            bf16x8 pa0, pa1, pa2, pa3; \
            const float alpha = softmax_tile<FIXED>(p0, p1, m_reg, l_reg, pa0, pa1, pa2, pa3); \
            if (!FIXED && __any(alpha < 1.f)) { if (hi == 0) al_l[r32] = alpha; asm volatile("s_waitcnt lgkmcnt(0)" ::: "memory"); \
                _Pragma("unroll") for (int r = 0; r < 16; ++r) { const float a = al_l[crow(r, hi)]; \
                    _Pragma("unroll") for (int d = 0; d < 4; ++d) o[d][r] *= a; } } \
            SBAR(); pv_d0(o, vb, pa0, pa1, pa2, pa3); } } while (0)
        if (MODE == 1 && tid < 64) {
            const unsigned one2 = 0x3F803F80u, cw = cvtpk((float)tid, (float)tid);
            *(LAS v4u*)(K_lds + 8192 + tid * 32) = (v4u){one2, cw, 0u, 0u}; *(LAS v4u*)(K_lds + 8192 + tid * 32 + 16) = (v4u){0u, 0u, 0u, 0u}; }
        if (jlo < jhi) SLOAD(sA, jlo * 64);
        if (DEPTH == 2 && jlo + 1 < jhi) SLOAD(sB, (jlo + 1) * 64);
#pragma unroll 1
        for (int j = jlo; j < jhi; j += 2) {
            TILE(sA, j);
            if (j + 1 < jhi) { if (DEPTH == 2) TILE(sB, j + 1); else TILE(sA, j + 1); }
        }
#undef TILE
#undef SLOAD
#undef SWRITE
        asm volatile("s_waitcnt lgkmcnt(0)" ::: "memory"); __builtin_amdgcn_s_barrier(); asm volatile("" ::: "memory");
        if (MODE == 1 && pslot >= 0) {
            float* po = (float*)(ws + WS_PART) + ((size_t)(pslot * 2 + mp) * 256 + wave * 32 + 4 * hi) * 128 + r32;
#pragma unroll
            for (int g = 0; g < 4; ++g) { float* pg = po + g * 8 * 128; asm volatile("" : "+v"(pg));
#pragma unroll
                for (int e = 0; e < 4; ++e)
#pragma unroll
                    for (int d = 0; d < 4; ++d) pg[e * 128 + d * 32] = o[d][4 * g + e]; }
            if (hi == 0) ((float*)(ws + WS_PARTL))[(pslot * 2 + mp) * 256 + wave * 32 + r32] = l_reg;
        } else
        if (MODE == 1 && mp == 0) {
            if (hi == 0) li_l[r32] = l_reg;
            asm volatile("s_waitcnt lgkmcnt(0)" ::: "memory");
#pragma unroll
            for (int r4 = 0; r4 < 4; ++r4) { float rl[4];
#pragma unroll
                for (int e = 0; e < 4; ++e) rl[e] = __builtin_amdgcn_rcpf(li_l[crow(4 * r4 + e, hi)]);
#pragma unroll
                for (int d = 0; d < 4; ++d) { f32x4 t; t.x = o[d][4 * r4] * rl[0]; t.y = o[d][4 * r4 + 1] * rl[1]; t.z = o[d][4 * r4 + 2] * rl[2]; t.w = o[d][4 * r4 + 3] * rl[3];
                    *(f32x4*)(park + (d * 4 + r4) * 256) = t; } }
            asm volatile("s_waitcnt lgkmcnt(0)" ::: "memory");
        }
    }
    if (MODE == 1 && pslot >= 0) return;
    float lam = 0.f; int ll_ = l; asm volatile("" : "+s"(ll_)); const float lin = 0.8f - 0.6f * expf(-0.3f * (float)ll_);
    if (MODE == 1) { const float a = P.lam[lane] * P.lam[64 + lane], bq = P.lam[128 + lane] * P.lam[192 + lane]; lam = expf(wave_sum(a)) - expf(wave_sum(bq)) + lin; }
    LAS float* ost = (LAS float*)(lds + AT_OST + wave * AT_OST_W);
    {
        if (hi == 0) li_l[r32] = l_reg;
        asm volatile("s_waitcnt lgkmcnt(0)" ::: "memory");
#pragma unroll
        for (int r4 = 0; r4 < 4; ++r4) { float rl[4];
#pragma unroll
            for (int e = 0; e < 4; ++e) rl[e] = __builtin_amdgcn_rcpf(li_l[crow(4 * r4 + e, hi)]);
#pragma unroll
            for (int d = 0; d < 4; ++d) { f32x4 pk = {0.f, 0.f, 0.f, 0.f}; if (MODE == 1) pk = *(const f32x4*)(park + (d * 4 + r4) * 256);
#pragma unroll
                for (int e = 0; e < 4; ++e) { float v = o[d][4 * r4 + e] * rl[e]; if (MODE == 1) v = pk[e] - lam * v;
                    ost[crow(4 * r4 + e, hi) * 132 + d * 32 + r32] = v; } } }
    }
    asm volatile("s_waitcnt lgkmcnt(0)" ::: "memory");
    {
        const int row = lane >> 1, half = lane & 1;
        const LAS f32x4* src = (const LAS f32x4*)(ost + row * 132 + half * 64);
        float v[64];
#pragma unroll
        for (int k = 0; k < 16; ++k) { const f32x4 t = src[k]; v[4 * k] = t.x; v[4 * k + 1] = t.y; v[4 * k + 2] = t.z; v[4 * k + 3] = t.w; }
        const size_t grow = (size_t)(seq0 + q0 + wave * 32 + row);
        float rs = 1.f;
        if (MODE == 1) { float ss = 0.f;
#pragma unroll
            for (int e = 0; e < 64; ++e) ss += v[e] * v[e];
            ss += xshfl<1>(ss); rs = (1.0f / sqrtf(ss * (1.0f / 128.0f) + NORM_EPS)) * (1.0f - lin); }
        const v4u* zp = (const v4u*)(PROJ + grow * LDP + zcol + half * 64);
        bf16* yb = (bf16*)(ws + WS_Y + (MODE ? 2 : 1) * SZ_Y1) + grow * 1024 + h * 128 + half * 64;
#pragma unroll
        for (int k = 0; k < 8; ++k) { const v4u zw = zp[k];
            const float z[8] = {bflo(zw.x), bfhi(zw.x), bflo(zw.y), bfhi(zw.y), bflo(zw.z), bfhi(zw.z), bflo(zw.w), bfhi(zw.w)};
            float y[8];
#pragma unroll
            for (int e = 0; e < 8; ++e) { float g = 1.f; if (MODE == 1) g = P.norm_gain[half * 64 + 8 * k + e]; y[e] = v[8 * k + e] * rs * g * z[e]; }
            v4u w; w.x = cvtpk(y[0], y[1]); w.y = cvtpk(y[2], y[3]); w.z = cvtpk(y[4], y[5]); w.w = cvtpk(y[6], y[7]);
            *(v4u*)(yb + 8 * k) = w; }
    }
    asm volatile("s_waitcnt lgkmcnt(0)" ::: "memory"); __builtin_amdgcn_s_barrier(); asm volatile("" ::: "memory");
}
#ifndef ONLY_PHASE
#define ONLY_PHASE -1
#endif
#ifndef ONLY_SUB
#define ONLY_SUB -1
#endif
#define PH4_ON(k) (ONLY_SUB < 0 || ONLY_SUB == (k))
#define PH_ON(k) (ONLY_PHASE < 0 || ONLY_PHASE == (k))
#ifndef DUP_PHASE
#define DUP_PHASE -1
#endif
#define NREP(k) ((DUP_PHASE == (k)) ? 2 : 1)
#ifndef DUP_PASSES
#define DUP_PASSES 15
#endif
#ifndef SPLIT_TILES
#define SPLIT_TILES 128
#endif
#ifndef SPLIT_MAX
#define SPLIT_MAX 2
#endif
#ifndef B_SKEW_NS
#define B_SKEW_NS 0
#endif
#ifndef MK_PER_PHASE
#define MK_PER_PHASE 0
#endif
constexpr int N_ITER = DEPTH * NPASS, PH_PER_IT = 7, N_PHASES = 1 + N_ITER * PH_PER_IT;
struct Args { const float* in[17]; float* out; unsigned char* ws; int ph_lo, ph_hi; };
#define WG_SYNC_LDS() do { asm volatile("s_waitcnt lgkmcnt(0)" ::: "memory"); __builtin_amdgcn_s_barrier(); asm volatile("" ::: "memory"); } while (0)

__global__ void __launch_bounds__(NTHREADS, 2) fwd_kernel(Args args) {
    extern __shared__ __attribute__((aligned(16))) unsigned char lds_raw[];
    LAS unsigned char* lds = (LAS unsigned char*)lds_raw;
    volatile LAS unsigned* MISC = (volatile LAS unsigned*)(lds + MISC_OFF);
    const int tid0 = threadIdx.x;
    const int G = gridDim.x, bx = blockIdx.x, ngw = G * NWAVES;
    unsigned char* ws = args.ws;
    unsigned* ctl = (unsigned*)(ws + WS_CTL);
    if (tid0 < 128) MISC[tid0] = 0u;
    __syncthreads();
    XcdBarrier bar; bar.bar = ctl + CW_BAR; bar.x = 0; bar.st = nullptr;
    if (!MK_PER_PHASE) bar = xcd_barrier_post(ctl + CW_BAR, MISC + 8);
    const int lo = args.ph_lo, hi = args.ph_hi;
#define IN(k) (lo <= (k) && (k) < hi)
#define LAUNDER_TID() int tid = tid0; asm volatile("" : "+v"(tid)); const int lane = tid & 63, wave = __builtin_amdgcn_readfirstlane(tid >> 6), gw = bx * NWAVES + wave; (void)lane; (void)gw
#define TBR(i) __builtin_amdgcn_readfirstlane((int)TB[i])
#define T_GT 0
#define T_PB 32
#define T_NPH 40
#define T_NDF 48
#define T_LEN 56
#define DIFF_TABLE(bd_, fixd_) volatile LAS int* TB = (volatile LAS int*)(MISC + 16); do { const int per_ = nseq * (Tp / 256); \
        if (tid0 == 0) { int ps = 0; \
            for (int hh = 7; hh >= 0; --hh) { const int dk = diff_radius((bd_), hh); int ntm = (255 + 2 * dk) / 64 + 2; if (ntm > Tp / 64) ntm = Tp / 64; \
                int np = (fixd_) ? (ntm + SPLIT_TILES - 1) / SPLIT_TILES : 1; if (np > SPLIT_MAX) np = SPLIT_MAX; if (np > 1 && ps + np * per_ > PART_SLOTS) np = 1; \
                TB[T_NPH + hh] = np; TB[T_PB + hh] = (np > 1) ? ps : -1; if (np > 1) ps += np * per_; TB[T_LEN + hh] = (ntm + np - 1) / np; } \
              \
            int g = 0; unsigned done_ = 0u; \
            for (int k = 0; k < 8; ++k) { int best = -1, bl = -1; for (int hh = 7; hh >= 0; --hh) if (!((done_ >> hh) & 1u) && TB[T_LEN + hh] > bl) { bl = TB[T_LEN + hh]; best = hh; } \
                done_ |= 1u << best; const int np = TB[T_NPH + best]; for (int p = 0; p < np; ++p) TB[T_GT + g++] = best | (p << 8) | (np << 16); } \
            TB[T_NDF] = g * per_; } \
        __syncthreads(); } while (0)
#define DIFF_BOUND(bd_) float bd_; { int ln_ = tid0; asm volatile("" : "+v"(ln_)); const int ln = ln_ & 63; const float* dqg_ = diff_q_gain + l * 64; const float* dkg_ = diff_k_gain + l * 64; \
        float gq = fabsf(dqg_[ln]), gk = fabsf(dkg_[ln]); \
        gq = wave_max(gq); gk = wave_max(gk); \
        bd_ = 8.0f * gq * gk * 1.02f; }
#define SEAM(k) do { if (!MK_PER_PHASE && IN(k) && IN((k) + 1)) xcd_barrier(bar); } while (0)

    const __attribute__((address_space(4))) unsigned char* kargs = (const __attribute__((address_space(4))) unsigned char*)__builtin_amdgcn_kernarg_segment_ptr();
#define INP(k) ([&]() { const __attribute__((address_space(4))) unsigned char* kp_ = kargs; asm volatile("" : "+s"(kp_)); return *(const float* const __attribute__((address_space(4)))*)(kp_ + 8 * (k)); }())
#define x_prompt INP(0)
#define x_sample INP(1)
#define norm_gain INP(2)
#define w_in INP(3)
#define conv_w INP(4)
#define a_log INP(5)
#define dt_bias INP(6)
#define gdn_norm_gain INP(7)
#define swa_q_gain INP(8)
#define swa_k_gain INP(9)
#define swa_sink INP(10)
#define diff_q_gain INP(11)
#define diff_k_gain INP(12)
#define diff_lambda INP(13)
#define diff_norm_gain INP(14)
#define w_branch INP(15)
#define w_out INP(16)

    if (PH_ON(0) && IN(0)) for (int rep = 0; rep < NREP(12); ++rep) { LAUNDER_TID(); phase_prologue(lds, w_in, w_branch, w_out, ws, gw, ngw, wave, lane); __syncthreads(); }
    SEAM(0);

    bf16* HN = (bf16*)(ws + WS_HN); bf16* PROJ = (bf16*)(ws + WS_PROJ); bf16* MRG = (bf16*)(ws + WS_MRG);
#pragma unroll 1
    for (int it = 0; it < N_ITER; ++it) {
        const int l = it >> 2, p = it & 3, pb = 1 + it * PH_PER_IT;
        const int Tp = (p < 2) ? 16384 : 4096, nseq = PASS_ROWS / Tp;
#define XIN() ((l == 0) ? ((p < 2) ? x_prompt + (size_t)p * PASS_ROWS * DM : x_sample + (size_t)(p - 2) * PASS_ROWS * DM) : (const float*)args.out + (size_t)p * PASS_ROWS * DM)

        bf16* HNp = HN + (size_t)p * PASS_ROWS * DM; float* RSp = (float*)(ws + WS_ROWSS) + (size_t)l * NTOK + (size_t)p * PASS_ROWS;
        if (PH_ON(1) && IN(pb + 0) && l == 0) { LAUNDER_TID(); const float* xin = XIN(); const float* ng = norm_gain; for (int m = gw; m < PASS_ROWS; m += ngw) rms_row(xin + (size_t)m * DM, ng, HNp + (size_t)m * DM, RSp + m, lane); }
        if (l == 0) SEAM(pb + 0);
        if (PH_ON(2) && IN(pb + 1)) for (int rep = 0; rep < ((DUP_PHASE == 2 || DUP_PHASE == 14 || DUP_PHASE == 16 || DUP_PHASE == 17) ? 2 : 1); ++rep) {
            if (rep) xcd_barrier(bar);
#if B_SKEW_NS > 0
            { const unsigned long long t0 = __builtin_amdgcn_s_memrealtime(), dl = (unsigned long long)((bx >> 3) & 3) * (unsigned long long)(B_SKEW_NS / 10); while (__builtin_amdgcn_s_memrealtime() - t0 < dl) __builtin_amdgcn_s_sleep(4); }
#endif
            pg8::Gemm g{HNp, (const bf16*)(ws + WS_WIN + (size_t)l * SZ_WIN_L), PASS_ROWS, NPROJ, DM}; pg8::StaticOrder S; S.init(PASS_ROWS, NPROJ, G, bx);
#if DUP_PHASE == 14
            if (rep == 1) { pg8::EpiNull EN{}; pg8::gemm_phase<pg8::EpiNull, pg8::StaticOrder, true, true>(lds, g, S, EN); } else
#endif
            {
#if DUP_PHASE == 17
            pg8::EpiProj E{PROJ, LDP, 0, 0, RSp, 1.0f / DM, NORM_EPS, 0, C_DK / 256, C_DK / 256 + 4, diff_k_gain + l * 64};
            if (rep == 0) { E.ldc = 256; E.tstride = (size_t)PASS_ROWS * 256 - 256; }
#else
            pg8::EpiProj E{PROJ, LDP, C_GATE / 256, C_GATE / 256 + 24, RSp, 1.0f / DM, NORM_EPS, C_GATE, C_BA / 256, (0xFull << (C_GZ / 256)) | (0xFull << (C_SZ / 256)) | (0xFull << (C_DZ / 256)), C_DQ / 256, C_DQ / 256 + 4, diff_q_gain + l * 64, 0.125f * LOG2E, C_DK / 256, C_DK / 256 + 4, diff_k_gain + l * 64};
#endif
#if DUP_PHASE == 16
            if (rep == 1) { E.O = (bf16*)(ws + WS_MTMP); E.ldc = 0; }
#endif
            pg8::gemm_phase<pg8::EpiProj, pg8::StaticOrder, true, true>(lds, g, S, E);
            }
        }
        SEAM(pb + 1);
        if (PH_ON(3) && IN(pb + 2)) {
            LAUNDER_TID();
            { const float* cw = conv_w; const float* al = a_log; const float* db = dt_bias;
              for (int rep = 0; rep < NREP(3); ++rep) {
                  unsigned pre_ba = 0u;
                  if (tid < 128 && bx < 2048) { const int d = tid >> 6, r = tid & 63, c = d ? 63 - r : r; const bf16* pn = PROJ + (size_t)((bx >> 3) * 64 + c) * LDP + C_BA;
                      pre_ba = (unsigned)pn[d * 8 + (bx & 7)] | ((unsigned)pn[16 + d * 8 + (bx & 7)] << 16); }
                  for (int u = bx; u < 2048; u += G) { const int un = u + G; gdn_prep_unit(lds, ws, cw, al, db, l, Tp, u >> 3, u & 7, un < 2048 ? (un >> 3) : -1, un & 7, pre_ba, tid, wave, lane); } } }
            { const float* skg = swa_k_gain + l * 128; const float* dkg = diff_k_gain + l * 64;
              for (int m = gw; m < PASS_ROWS; m += ngw) knorm_row<false>(PROJ + (size_t)m * LDP, skg, dkg, lane); }
        }
        SEAM(pb + 2);
#if DUP_PHASE == 10
        for (int xb = 0; xb < 5; ++xb) xcd_barrier(bar);
#endif
        if (PH_ON(4) && IN(pb + 3)) for (int rep = 0; rep < (((DUP_PHASE == 4 || DUP_PHASE == 5 || DUP_PHASE == 8 || DUP_PHASE == 9 || DUP_PHASE == 11) && (DUP_PASSES >> p & 1)) ? 2 : 1); ++rep) {
            if (rep) xcd_barrier(bar);
            const int nchain = nseq * 32, nqb = Tp / 256, nblk = nseq * 8 * nqb;
            float bd, bs;
            const float* dqg = diff_q_gain + l * 64; const float* sqg = swa_q_gain + l * 128;
            { int ln_ = tid0; asm volatile("" : "+v"(ln_)); const int ln = ln_ & 63; const float* dkg = diff_k_gain + l * 64; const float* skg = swa_k_gain + l * 128;
              float gq = fabsf(dqg[ln]), gk = fabsf(dkg[ln]);
              float sq_ = fmaxf(fabsf(sqg[ln]), fabsf(sqg[64 + ln])), sk_ = fmaxf(fabsf(skg[ln]), fabsf(skg[64 + ln]));
              gq = wave_max(gq); gk = wave_max(gk); sq_ = wave_max(sq_); sk_ = wave_max(sk_);
              bd = 8.0f * gq * gk * 1.02f; bs = 11.3137085f * sq_ * sk_ * 1.02f; }
            const bool fixd = (bd * LOG2E < 60.f) && (bd == bd), fixs = (bs * LOG2E < 60.f) && (bs == bs);
#define UNIFORM_F(x) __builtin_bit_cast(float, __builtin_amdgcn_readfirstlane(__builtin_bit_cast(int, (float)(x))))
            AttnParams PD{dqg, nullptr, diff_lambda + l * 256, diff_norm_gain + l * 128, UNIFORM_F(bd)};
            AttnParams PS{sqg, swa_sink + l * 8, nullptr, nullptr, UNIFORM_F(bs)};
            DIFF_TABLE(bd, fixd);
            const int ndiff = TBR(T_NDF);
            const int item_lo = (rep == 1 && (DUP_PHASE == 8 || DUP_PHASE == 11)) ? nchain : ((rep == 1 && DUP_PHASE == 9) ? nchain + ndiff : 0);
            const int total = (rep == 1 && DUP_PHASE == 5) ? nchain : ((rep == 1 && (DUP_PHASE == 8 || DUP_PHASE == 11)) ? nchain + ndiff : nchain + ndiff + nblk);
#pragma unroll 1
            for (;;) {
                LAUNDER_TID();
                if (tid == 0) MISC[0] = __hip_atomic_fetch_add(ctl + CW_QUEUE + it * 64 + rep * 32, 1u, __ATOMIC_RELAXED, __HIP_MEMORY_SCOPE_AGENT);
                __syncthreads();
                const int item = __builtin_amdgcn_readfirstlane((int)MISC[0]) + item_lo;
                __syncthreads();
                if (item >= total) break;
                if (PH4_ON(0) && item < nchain) { gdn_scan_unit(lds, ws, Tp, item >> 5, (item >> 2) & 7, (item >> 1) & 1, item & 1, tid, wave, lane); }
                else if (PH4_ON(1) && item < nchain + ndiff) { const int u = item - nchain, per = nseq * nqb;
                    const int g = u / per, un = u - g * per, e = TBR(T_GT + g), hh = e & 0xff, part = (e >> 8) & 0xff, np = e >> 16, sq = un / nqb, qb = un - sq * nqb;
                    const int pslot = (np > 1) ? TBR(T_PB + hh) + un * np + part : -1;
                    const bool pe_ = (DUP_PHASE == 11 && rep == 1);
                    if (fixd) attn_unit<1, true>(lds, ws, PD, l, Tp, sq, hh, qb, pe_ ? 999999 : part, pe_ ? 1000000 : np, pe_ ? PART_SLOTS - 1 : pslot, tid, wave, lane); else if (DUP_PHASE < 0) attn_unit<1, false>(lds, ws, PD, l, Tp, sq, hh, qb, 0, 1, -1, tid, wave, lane); }
                else if (PH4_ON(2)) { const int u = item - nchain - ndiff;
                    if (fixs) attn_unit<0, true>(lds, ws, PS, l, Tp, u / (8 * nqb), (u / nqb) & 7, u % nqb, 0, 1, -1, tid, wave, lane); else attn_unit<0, false>(lds, ws, PS, l, Tp, u / (8 * nqb), (u / nqb) & 7, u % nqb, 0, 1, -1, tid, wave, lane); }
                __syncthreads();
            }
        }
        SEAM(pb + 3);
        if (PH_ON(5) && IN(pb + 4)) for (int rep = 0; rep < NREP(13); ++rep) {
            if (rep) xcd_barrier(bar);
            LAUNDER_TID();
            const bf16* OD = (const bf16*)(ws + WS_ODIR);
            const float* gng = gdn_norm_gain + l * 128;
            { int m = gw;
              for (; m + 3 * ngw < PASS_ROWS; m += 4 * ngw) gdn_final_rows<4>(OD, PROJ, m, ngw, gng, (bf16*)(ws + WS_Y), lane);
              for (; m < PASS_ROWS; m += ngw)
                gdn_final_row(OD + (size_t)m * 1024, OD + (size_t)(PASS_ROWS + m) * 1024, PROJ + (size_t)m * LDP + C_GZ, gng, (bf16*)(ws + WS_Y) + (size_t)m * 1024, lane); }
            { DIFF_BOUND(bdf); const bool fixf = (bdf * LOG2E < 60.f) && (bdf == bdf);
              DIFF_TABLE(bdf, fixf);
              const float* dl = diff_lambda + l * 256; const float* dng = diff_norm_gain + l * 128;
              const float lin = 0.8f - 0.6f * expf(-0.3f * (float)l);
              const float lam = expf(wave_sum(dl[lane] * dl[64 + lane])) - expf(wave_sum(dl[128 + lane] * dl[192 + lane])) + lin;
              const int nqb = Tp / 256;
              for (int hh = 7; hh >= 0; --hh) { const int np = TBR(T_NPH + hh); if (np <= 1) continue; const int pb0 = TBR(T_PB + hh);
                  int m = gw;
                  for (; m + 3 * ngw < PASS_ROWS; m += 4 * ngw) diff_final_rows<4>(ws, pb0, np, Tp, nqb, m, ngw, lam, lin, PROJ + C_DZ + hh * 128, dng, (bf16*)(ws + WS_Y + 2 * SZ_Y1) + hh * 128, lane);
                  for (; m < PASS_ROWS; m += ngw) { const int sq = m / Tp, t = m - sq * Tp, qb = t >> 8, rr = t & 255;
                      diff_final_row(ws, pb0 + (sq * nqb + qb) * np, np, rr, lam, lin, PROJ + (size_t)m * LDP + C_DZ + hh * 128, dng, (bf16*)(ws + WS_Y + 2 * SZ_Y1) + (size_t)m * 1024 + hh * 128, lane); } } }
        }
        SEAM(pb + 4);
        if (PH_ON(6) && IN(pb + 5)) for (int rep = 0; rep < ((DUP_PHASE == 6 || DUP_PHASE == 15) ? 2 : 1); ++rep) {
            if (rep) xcd_barrier(bar);
            pg8::MergeOrder S; S.S.init(PASS_ROWS, DM, G, bx);
            pg8::Gemm g{(const bf16*)(ws + WS_Y), (const bf16*)(ws + WS_WBR + (size_t)(l * 3) * SZ_WBR_1), 3 * PASS_ROWS, 3 * DM, 1024};
#if DUP_PHASE == 15
            if (rep == 1) { pg8::EpiNull EN{}; pg8::gemm_phase<pg8::EpiNull, pg8::MergeOrder, true, true>(lds, g, S, EN); } else
#endif
            { pg8::EpiMerge E{(const unsigned char*)(PROJ + C_GATE), LDP * 2, (bf16*)(ws + WS_MTMP), DM, MRG, DM};
              pg8::gemm_phase<pg8::EpiMerge, pg8::MergeOrder, true, true>(lds, g, S, E); }
        }
        SEAM(pb + 5);
        if (PH_ON(7) && IN(pb + 6)) for (int rep = 0; rep < ((l == 0) ? NREP(7) : 1); ++rep) {
            if (rep) xcd_barrier(bar);
            pg8::Gemm g{MRG, (const bf16*)(ws + WS_WOUT + (size_t)l * SZ_WOUT_L), PASS_ROWS, DM, DM}; pg8::StaticOrder S; S.init(PASS_ROWS, DM, G, bx);
            pg8::EpiOut E{XIN(), args.out + (size_t)p * PASS_ROWS * DM, DM, (l + 1 < DEPTH) ? norm_gain + (l + 1) * DM : (const float*)nullptr, HNp, (float*)(ws + WS_ROWSS) + (size_t)(l + 1 < DEPTH ? l + 1 : l) * NTOK + (size_t)p * PASS_ROWS};
            pg8::gemm_phase<pg8::EpiOut, pg8::StaticOrder, true, true>(lds, g, S, E);
        }
    }
#undef IN
#undef SEAM
#undef TBR
#undef T_GT
#undef T_PB
#undef T_NPH
#undef T_NDF
#undef T_LEN
#undef DIFF_TABLE
#undef DIFF_BOUND
#undef XIN
#undef x_prompt
#undef x_sample
#undef norm_gain
#undef w_in
#undef conv_w
#undef a_log
#undef dt_bias
#undef gdn_norm_gain
#undef swa_q_gain
#undef swa_k_gain
#undef swa_sink
#undef diff_q_gain
#undef diff_k_gain
#undef diff_lambda
#undef diff_norm_gain
#undef w_branch
#undef w_out
#undef INP
}

extern "C" void kernel_launch(void* const* d_in, const int* in_sizes, int n_in, void* d_out, int out_size, void* d_ws, size_t ws_size, hipStream_t stream) {
    static int grid = 0;
    if (grid == 0) {
        if (n_in != 17 || in_sizes[0] != 2 * 16384 * DM || in_sizes[1] != 8 * 4096 * DM || out_size != NTOK * DM || ws_size < WS_END) {
            fprintf(stderr, "kernel_launch: shape mismatch (n_in %d, in0 %d, in1 %d, out %d, ws %zu, need %zu); nothing launched\n", n_in, n_in > 0 ? in_sizes[0] : -1, n_in > 1 ? in_sizes[1] : -1, out_size, ws_size, (size_t)WS_END);
            grid = -1; return; }
        int dev = 0, cus = 0, per_cu = 0;
        if (hipGetDevice(&dev) != hipSuccess || hipDeviceGetAttribute(&cus, hipDeviceAttributeMultiprocessorCount, dev) != hipSuccess) { fprintf(stderr, "kernel_launch: device query failed\n"); grid = -1; return; }
        if (hipFuncSetAttribute((const void*)fwd_kernel, hipFuncAttributeMaxDynamicSharedMemorySize, LDS_BYTES) != hipSuccess) { fprintf(stderr, "kernel_launch: hipFuncSetAttribute(%d B LDS) failed\n", LDS_BYTES); grid = -1; return; }
        if (hipOccupancyMaxActiveBlocksPerMultiprocessor(&per_cu, (const void*)fwd_kernel, NTHREADS, LDS_BYTES) != hipSuccess || per_cu < 1)
            fprintf(stderr, "kernel_launch: note: occupancy query reports %d workgroups per CU\n", per_cu);
        (void)hipGetLastError();
        grid = cus;
    }
    if (grid < 0) return;
    if (hipMemsetAsync((char*)d_ws + WS_CTL, 0, CTL_ZERO_BYTES, stream) != hipSuccess) { fprintf(stderr, "kernel_launch: memset failed\n"); return; }
    Args a{};
    for (int i = 0; i < 17; ++i) a.in[i] = (const float*)d_in[i];
    a.out = (float*)d_out; a.ws = (unsigned char*)d_ws;
#if MK_PER_PHASE
    for (int k = 0; k < N_PHASES; ++k) { a.ph_lo = k; a.ph_hi = k + 1; hipLaunchKernelGGL(fwd_kernel, dim3(grid), dim3(NTHREADS), LDS_BYTES, stream, a); }
#else
    a.ph_lo = 0; a.ph_hi = N_PHASES;
    hipLaunchKernelGGL(fwd_kernel, dim3(grid), dim3(NTHREADS), LDS_BYTES, stream, a);
#endif
    const hipError_t le = hipPeekAtLastError();
    if (le != hipSuccess) fprintf(stderr, "kernel_launch: launch failed: %s\n", hipGetErrorName(le));
}
```
